# Optimizing an MI355X kernel written in HIP

```python
import jax, jax.numpy as jnp
from jax import lax
import numpy as np

D_MODEL = 1024
BATCH = 2
SEQ = 8192
DEPTH = 4

CHUNK = 64
N_MIXERS = 2
EPS = 1e-6

SGU_BLOCK = 128
GMLP_HIDDEN = 2 * D_MODEL
SGU_GROUPS = 8
SGU_GROUP_DIM = GMLP_HIDDEN // SGU_GROUPS

N_HEADS = 16
HEAD_DIM = D_MODEL // N_HEADS
LEFT_CHUNKS = 8
BAND = (LEFT_CHUNKS + 1) * CHUNK
REL_MIN = -(CHUNK - 1)
REL_MAX = 128
N_REL = REL_MAX - REL_MIN + 1

D_FF = -(-(8 * D_MODEL) // (3 * 256)) * 256

N_A = (DEPTH + 1) // 2
N_B = DEPTH // 2

kernel_name = "hybrid_gmlp_chunkattn_trunk"


def rms_norm(x, g):
    xf = x.astype(jnp.float32)
    y = xf * lax.rsqrt(jnp.mean(xf * xf, axis=-1, keepdims=True) + EPS)
    return (y * g.astype(jnp.float32)).astype(x.dtype)


def gmlp_mixer(h, w_in, v_gain, w_s, b_s, w_out):
    bsz, seq, _ = h.shape
    uv = jax.nn.gelu(h @ w_in)
    u, v = jnp.split(uv, 2, axis=-1)
    v = rms_norm(v, v_gain)
    nb = seq // SGU_BLOCK
    v = v.reshape(bsz, nb, SGU_BLOCK, SGU_GROUPS, SGU_GROUP_DIM)
    pos = jnp.arange(SGU_BLOCK)
    mask = (pos[None, :] // CHUNK) <= (pos[:, None] // CHUNK)
    w = w_s * mask.astype(w_s.dtype)[None]
    v = jnp.einsum('gpq,bnqgc->bnpgc', w, v) + b_s.T[None, None, :, :, None]
    y = u * v.reshape(bsz, seq, GMLP_HIDDEN)
    return y @ w_out


def chunk_attention(h, w_qkv, rel_bias, w_out):
    bsz, seq, _ = h.shape
    nc = seq // CHUNK
    qkv = (h @ w_qkv).reshape(bsz, seq, 3, N_HEADS, HEAD_DIM)
    q, k, v = qkv[:, :, 0], qkv[:, :, 1], qkv[:, :, 2]
    pad = LEFT_CHUNKS * CHUNK
    kp = jnp.pad(k, ((0, 0), (pad, 0), (0, 0), (0, 0)))
    vp = jnp.pad(v, ((0, 0), (pad, 0), (0, 0), (0, 0)))
    qi = jnp.arange(CHUNK)[:, None]
    kj = jnp.arange(BAND)[None, :]
    rel_idx = jnp.clip(qi - (kj - pad), REL_MIN, REL_MAX) - REL_MIN
    bias = rel_bias[:, rel_idx].astype(jnp.float32)
    scale = HEAD_DIM ** -0.5

    def one_chunk(c):
        start = c * CHUNK
        qc = lax.dynamic_slice_in_dim(q, start, CHUNK, axis=1)
        kc = lax.dynamic_slice_in_dim(kp, start, BAND, axis=1)
        vc = lax.dynamic_slice_in_dim(vp, start, BAND, axis=1)
        s = jnp.einsum('bqhd,bkhd->bhqk', qc, kc).astype(jnp.float32) * scale + bias
        valid = kj >= pad - start
        s = jnp.where(valid[None, None], s, -jnp.inf)
        p = jax.nn.softmax(s, axis=-1).astype(vc.dtype)
        return jnp.einsum('bhqk,bkhd->bqhd', p, vc)

    o = lax.map(one_chunk, jnp.arange(nc))
    o = jnp.moveaxis(o, 0, 1).reshape(bsz, seq, N_HEADS * HEAD_DIM)
    return o @ w_out


def swiglu(h, w_gate, w_up, w_down):
    return (jax.nn.silu(h @ w_gate) * (h @ w_up)) @ w_down


def setup_inputs(seed: int = 0) -> dict:
    key = jax.random.key(seed)
    ks = jax.random.split(key, 16)
    f32 = jnp.float32

    def nrm(k, shape, scale):
        return jax.random.normal(k, shape, f32) * scale

    return {
        "x": jax.random.normal(ks[0], (BATCH, SEQ, D_MODEL), f32),
        "norm_mix_g": 1.0 + nrm(ks[1], (DEPTH, D_MODEL), 0.05),
        "norm_ffn_g": 1.0 + nrm(ks[2], (DEPTH, D_MODEL), 0.05),
        "final_g": 1.0 + nrm(ks[3], (D_MODEL,), 0.05),
        "a_w_in": nrm(ks[4], (N_A, D_MODEL, 2 * GMLP_HIDDEN), D_MODEL ** -0.5),
        "a_v_gain": 1.0 + nrm(ks[5], (N_A, GMLP_HIDDEN), 0.05),
        "a_w_s": nrm(ks[6], (N_A, SGU_GROUPS, SGU_BLOCK, SGU_BLOCK), 0.5 * SGU_BLOCK ** -0.5),
        "a_b_s": 1.0 + nrm(ks[7], (N_A, SGU_GROUPS, SGU_BLOCK), 0.1),
        "a_w_out": nrm(ks[8], (N_A, GMLP_HIDDEN, D_MODEL), GMLP_HIDDEN ** -0.5),
        "b_w_qkv": nrm(ks[9], (N_B, D_MODEL, 3 * N_HEADS * HEAD_DIM), D_MODEL ** -0.5),
        "b_rel_bias": nrm(ks[10], (N_B, N_HEADS, N_REL), 0.5),
        "b_w_out": nrm(ks[11], (N_B, N_HEADS * HEAD_DIM, D_MODEL), (N_HEADS * HEAD_DIM) ** -0.5),
        "ffn_w_gate": nrm(ks[12], (DEPTH, D_MODEL, D_FF), D_MODEL ** -0.5),
        "ffn_w_up": nrm(ks[13], (DEPTH, D_MODEL, D_FF), D_MODEL ** -0.5),
        "ffn_w_down": nrm(ks[14], (DEPTH, D_FF, D_MODEL), D_FF ** -0.5),
    }


def reference(x, norm_mix_g, norm_ffn_g, final_g, a_w_in, a_v_gain, a_w_s, a_b_s,
              a_w_out, b_w_qkv, b_rel_bias, b_w_out, ffn_w_gate, ffn_w_up, ffn_w_down):
    for i in range(DEPTH):
        j = i // N_MIXERS
        hn = rms_norm(x, norm_mix_g[i])
        if i % N_MIXERS == 0:
            x = x + gmlp_mixer(hn, a_w_in[j], a_v_gain[j], a_w_s[j], a_b_s[j], a_w_out[j])
        else:
            x = x + chunk_attention(hn, b_w_qkv[j], b_rel_bias[j], b_w_out[j])
        hn = rms_norm(x, norm_ffn_g[i])
        x = x + swiglu(hn, ffn_w_gate[i], ffn_w_up[i], ffn_w_down[i])
    return rms_norm(x, final_g)
```

```cpp
#include <hip/hip_runtime.h>
#include <cstdio>
#include <cstdint>
#ifndef PROBE
#define PROBE 0
#endif
namespace pg8 {
#define PG8_LAS __attribute__((address_space(3)))
typedef unsigned short bf16_t;
typedef short bf16x8 __attribute__((ext_vector_type(8)));
typedef float f32x4 __attribute__((ext_vector_type(4)));
typedef unsigned u32x4 __attribute__((ext_vector_type(4)));
constexpr int BM = 256, BK = 64, HALF = 128, HTB = HALF * BK * 2  , STAGE_BYTES = 8 * HTB, NXCD = 8, WGM = 8;

__host__ __device__ __forceinline__ int lds_byte(int r, int c) { const int st = (r >> 4) * 2 + (c >> 5), rr = r & 15, cc = c & 31, ob = rr * 64 + cc * 2; return st * 1024 + (ob ^ (((ob >> 9) & 1) << 5)); }
__host__ __device__ __forceinline__ void stage_rc(int b, int& R, int& C) { const int st = b / 1024, sb = b % 1024, swz = sb ^ (((sb >> 9) & 1) << 5); R = (st >> 1) * 16 + swz / 64; C = (st & 1) * 32 + (swz % 64) / 2; }
__host__ __device__ __forceinline__ int perm32(int rho) { const int n = rho >> 4, i = rho & 15; return 8 * (i >> 2) + 4 * n + (i & 3); }

struct Unit { int pm, pn; };
struct Gemm { const bf16_t* A; const bf16_t* Bt; int M, N, K, lda; };

struct StaticOrder {
    int nM, nN, nwg, G, c;
    __host__ __device__ void init(int M, int N, int G_, int c_) { nM = M / BM; nN = N / BM; nwg = nM * nN; G = G_; c = c_; }
    __host__ __device__ bool next(int i, Unit& u) const {
        const long L = (long)i * G + c; if (L >= nwg) return false;
        int wgid = (int)L; { const int q = nwg / NXCD, r = nwg % NXCD, xcd = wgid % NXCD, off = wgid / NXCD; wgid = (xcd < r ? xcd * (q + 1) : r * (q + 1) + (xcd - r) * q) + off; }
        const int nig = WGM * nN, gid = wgid / nig, fm = gid * WGM, gsz = (nM - fm) < WGM ? (nM - fm) : WGM;
        u.pm = fm + ((wgid % nig) % gsz); u.pn = (wgid % nig) / gsz; return true;
    }
    __device__ __forceinline__ void a_ready(const Unit&) const {}
    __device__ __forceinline__ void done(const Unit&) const {}
};

__device__ __forceinline__ unsigned cvt_pk_bf16(float lo, float hi) { unsigned r; asm volatile("v_cvt_pk_bf16_f32 %0, %1, %2" : "=v"(r) : "v"(lo), "v"(hi)); return r; }
typedef float f32x2 __attribute__((ext_vector_type(2)));
#ifndef STORE_WT
#define STORE_WT 1
#endif
__device__ __forceinline__ void store16(void* p, u32x4 v) {
#if STORE_WT
    asm volatile("global_store_dwordx4 %0, %1, off sc1\n\ts_nop 1" :: "v"(p), "v"(v) : "memory");
#else
    *(u32x4*)p = v;
#endif
}
__device__ __forceinline__ void store16f(void* p, f32x4 v) {
#if STORE_WT
    asm volatile("global_store_dwordx4 %0, %1, off sc1\n\ts_nop 1" :: "v"(p), "v"(v) : "memory");
#else
    *(f32x4*)p = v;
#endif
}
typedef unsigned u32x2 __attribute__((ext_vector_type(2)));
__device__ __forceinline__ void store8(void* p, u32x2 v) {
#if STORE_WT
    asm volatile("global_store_dwordx2 %0, %1, off sc1\n\ts_nop 1" :: "v"(p), "v"(v) : "memory");
#else
    *(u32x2*)p = v;
#endif
}
constexpr int NSLOT_X = 16;
constexpr int NSLOT_V = 32;
__device__ __forceinline__ void row_scales(const float* ss, int row0, int fq, float inv_n, float eps, float (&rs)[2][4]) {
#pragma unroll
    for (int ai = 0; ai < 2; ++ai)
#pragma unroll
        for (int m = 0; m < 4; ++m) {
            const f32x4 v = *(const f32x4*)(ss + (size_t)(row0 + ai * HALF + m * 16) * NSLOT_X + fq * 4);
            float s = (v[0] + v[1]) + (v[2] + v[3]);
            s += __shfl_xor(s, 16); s += __shfl_xor(s, 32);
            rs[ai][m] = __builtin_amdgcn_rsqf(s * inv_n + eps);
        }
}
__device__ __forceinline__ float gelu_tanh(float x) {
    const float t = x * x, u2 = x * (2.302208198f + 0.1029432398f * t);
    const float e = __builtin_amdgcn_exp2f(-u2);
    return x * __builtin_amdgcn_rcpf(1.0f + e);
}
__device__ __forceinline__ float silu_mul(float g, float u) {
    const float e = __builtin_amdgcn_exp2f(g * -1.4426950408889634f);
    return (g * u) * __builtin_amdgcn_rcpf(1.0f + e);
}
struct EpiGeluStats {
    static constexpr bool PERM = true, AFTER_DRAIN = false, PROBE_TWICE = false;
    bf16_t* O; int ldc; const float* xss; float* vss; int vtile0; float eps;
    __device__ __forceinline__ void operator()(const f32x4 (&acc)[2][2][4][2], const Unit& u, int wr, int wc, int fr, int fq) const {
        const int row0 = u.pm * BM + wr * 64 + fr, col0 = u.pn * BM + wc * 32 + 8 * fq;
        float rs[2][4]; row_scales(xss, row0, fq, 1.0f / 1024.0f, eps, rs);
        const bool isv = u.pn >= vtile0;
#pragma unroll
        for (int ai = 0; ai < 2; ++ai)
#pragma unroll
            for (int m = 0; m < 4; ++m) { const int row = row0 + ai * HALF + m * 16; bf16_t* rowp = O + (size_t)row * ldc + col0; const float r = rs[ai][m]; float ssq = 0.f;
#pragma unroll
                for (int bj = 0; bj < 2; ++bj) { f32x4 v0 = acc[ai][bj][m][0] * r, v1 = acc[ai][bj][m][1] * r;
#pragma unroll
                    for (int e = 0; e < 4; ++e) { v0[e] = gelu_tanh(v0[e]); v1[e] = gelu_tanh(v1[e]); }
                    ssq += (v0[0] * v0[0] + v0[1] * v0[1]) + (v0[2] * v0[2] + v0[3] * v0[3]) + (v1[0] * v1[0] + v1[1] * v1[1]) + (v1[2] * v1[2] + v1[3] * v1[3]);
                    u32x4 w; w.x = cvt_pk_bf16(v0[0], v0[1]); w.y = cvt_pk_bf16(v0[2], v0[3]); w.z = cvt_pk_bf16(v1[0], v1[1]); w.w = cvt_pk_bf16(v1[2], v1[3]);
                    store16(rowp + bj * HALF, w); }
                if (isv) { ssq += __shfl_xor(ssq, 16); ssq += __shfl_xor(ssq, 32); if (fq == 0) vss[(size_t)row * NSLOT_V + (u.pn - vtile0) * 4 + wc] = ssq; } }
    }
};
struct EpiSwiglu {
    static constexpr bool PERM = true, AFTER_DRAIN = false, PROBE_TWICE = true;
    bf16_t* O; int ldc; const float* xss; float eps;
    __device__ __forceinline__ void operator()(const f32x4 (&acc)[2][2][4][2], const Unit& u, int wr, int wc, int fr, int fq) const {
        const int row0 = u.pm * BM + wr * 64 + fr, col0 = u.pn * HALF + wc * 32 + 8 * fq;
        float rs[2][4]; row_scales(xss, row0, fq, 1.0f / 1024.0f, eps, rs);
#pragma unroll
        for (int ai = 0; ai < 2; ++ai)
#pragma unroll
            for (int m = 0; m < 4; ++m) { const int row = row0 + ai * HALF + m * 16; const float r = rs[ai][m] * (PROBE == 9 ? 0.5f : 1.0f);
                const f32x4 g0 = acc[ai][0][m][0] * r, g1 = acc[ai][0][m][1] * r, u0 = acc[ai][1][m][0] * r, u1 = acc[ai][1][m][1] * r;
                float o[8];
#pragma unroll
                for (int e = 0; e < 4; ++e) { o[e] = silu_mul(g0[e], u0[e]); o[4 + e] = silu_mul(g1[e], u1[e]); }
                u32x4 w; w.x = cvt_pk_bf16(o[0], o[1]); w.y = cvt_pk_bf16(o[2], o[3]); w.z = cvt_pk_bf16(o[4], o[5]); w.w = cvt_pk_bf16(o[6], o[7]);
                store16(O + (size_t)row * ldc + col0, w); }
    }
};
struct EpiQkv {
    static constexpr bool PERM = true, AFTER_DRAIN = false, PROBE_TWICE = false;
    bf16_t* O; int ldc; size_t split_stride; const float* xss; float eps; float scale0;
    __device__ __forceinline__ void operator()(const f32x4 (&acc)[2][2][4][2], const Unit& u, int wr, int wc, int fr, int fq) const {
        const int t = u.pn >> 2; bf16_t* base = O + (size_t)t * split_stride; const float sc = (t == 0) ? scale0 : 1.0f;
        const int row0 = u.pm * BM + wr * 64 + fr, col0 = (u.pn & 3) * BM + wc * 32 + 8 * fq;
        float rs[2][4]; row_scales(xss, row0, fq, 1.0f / 1024.0f, eps, rs);
#pragma unroll
        for (int ai = 0; ai < 2; ++ai)
#pragma unroll
            for (int m = 0; m < 4; ++m) { const int row = row0 + ai * HALF + m * 16; bf16_t* rowp = base + (size_t)row * ldc + col0; const float r = rs[ai][m] * sc;
#pragma unroll
                for (int bj = 0; bj < 2; ++bj) { const f32x4 v0 = acc[ai][bj][m][0] * r, v1 = acc[ai][bj][m][1] * r;
                    u32x4 w; w.x = cvt_pk_bf16(v0[0], v0[1]); w.y = cvt_pk_bf16(v0[2], v0[3]); w.z = cvt_pk_bf16(v1[0], v1[1]); w.w = cvt_pk_bf16(v1[2], v1[3]);
                    store16(rowp + bj * HALF, w); } }
    }
};
struct EpiResid {
    static constexpr bool PERM = false, AFTER_DRAIN = false, PROBE_TWICE = false;
    const float* base; float* out; bf16_t* xb; float* xss; int ldc;
    __device__ __forceinline__ void operator()(const f32x4 (&acc)[2][2][4][2], const Unit& u, int wr, int wc, int fr, int fq) const {
        typedef unsigned u32x2v __attribute__((ext_vector_type(2)));
        asm volatile("" : "+v"(fr), "+v"(fq));
        const int row0 = u.pm * BM + wr * 64 + fr, col0 = u.pn * BM + wc * 32 + 4 * fq;
#pragma unroll
        for (int ai = 0; ai < 2; ++ai)
#pragma unroll
            for (int m = 0; m < 4; ++m) { const int row = row0 + ai * HALF + m * 16; const size_t off = (size_t)row * ldc + col0; float ssq = 0.f;
#pragma unroll
                for (int bj = 0; bj < 2; ++bj)
#pragma unroll
                    for (int n = 0; n < 2; ++n) { const f32x4 bs = *(const f32x4*)(base + off + bj * HALF + n * 16); const f32x4 o = bs + acc[ai][bj][m][n];
                        store16f(out + off + bj * HALF + n * 16, o); ssq += (o[0] * o[0] + o[1] * o[1]) + (o[2] * o[2] + o[3] * o[3]);
                        u32x2 w; w.x = cvt_pk_bf16(o[0], o[1]); w.y = cvt_pk_bf16(o[2], o[3]); store8(xb + off + bj * HALF + n * 16, w); }
                ssq += __shfl_xor(ssq, 16); ssq += __shfl_xor(ssq, 32);
                if (fq == 0) xss[(size_t)row * NSLOT_X + u.pn * 4 + wc] = ssq;
                if (m & 1) asm volatile("" ::: "memory"); }
    }
};
template <class Epi, class Sched, bool ALIGN_EPI = false, bool SP2 = false>
__device__ __forceinline__ void gemm_phase(PG8_LAS unsigned char* lds, const Gemm g, const Sched& S, const Epi& E) {
    int tid_ = threadIdx.x; asm volatile("" : "+v"(tid_));
    const int tid = tid_, wid = __builtin_amdgcn_readfirstlane(tid >> 6), lane = tid & 63, wr = wid >> 2, wc = wid & 3, fr = lane & 15, fq = lane >> 4;
    const int K = g.K, nt = K / BK;
    unsigned voffA[2], voffB[2];
#pragma unroll
    for (int i = 0; i < 2; ++i) { int R, C; stage_rc(tid * 16 + i * 8192, R, C); const int Rb = Epi::PERM ? ((R & ~31) + perm32(R & 31)) : R;
        voffA[i] = (unsigned)(R * g.lda + C) * 2u; voffB[i] = (unsigned)(Rb * K + C) * 2u; }
    const size_t kstep = (size_t)(BK * 2);
    const size_t hstep = (size_t)HALF * K * 2;
    const size_t tstep = 2 * hstep; const size_t hstepA = (size_t)HALF * g.lda * 2, tstepA = 2 * hstepA;
    const unsigned ldsw = (unsigned)wid * 1024u;
    const int aoff = lds_byte(wr * 64 + fr, fq * 8), boff = lds_byte(wc * 32 + fr, fq * 8);
#define PG8_SA(b, h) (((b) * 2 + (h)) * HTB)
#define PG8_SB(b, h) ((4 + (b) * 2 + (h)) * HTB)
#define PG8_STAGE(bufoff, gbase, voff) do { _Pragma("unroll") for (int _i = 0; _i < 2; ++_i) \
        __builtin_amdgcn_global_load_lds((const unsigned*)((const char*)(gbase) + (voff)[_i]), (PG8_LAS unsigned*)(lds + (bufoff) + ldsw + _i * 8192), 16, 0, 0); } while (0)
#define PG8_LDA(dst, b, h) do { _Pragma("unroll") for (int m = 0; m < 4; ++m) _Pragma("unroll") for (int k = 0; k < 2; ++k) dst[m][k] = *(const PG8_LAS bf16x8*)(lds + PG8_SA(b, h) + aoff + m * 2048 + k * 1024); } while (0)
#define PG8_LDB(dst, b, h) do { _Pragma("unroll") for (int n = 0; n < 2; ++n) _Pragma("unroll") for (int k = 0; k < 2; ++k) dst[n][k] = *(const PG8_LAS bf16x8*)(lds + PG8_SB(b, h) + boff + n * 2048 + k * 1024); } while (0)
#define PG8_MMA(ai, bj, At, Bt) do { __builtin_amdgcn_s_setprio(1); _Pragma("unroll") for (int m = 0; m < 4; ++m) _Pragma("unroll") for (int n = 0; n < 2; ++n) _Pragma("unroll") for (int k = 0; k < 2; ++k) \
        acc[ai][bj][m][n] = __builtin_amdgcn_mfma_f32_16x16x32_bf16(Bt[n][k], At[m][k], acc[ai][bj][m][n], 0, 0, 0); __builtin_amdgcn_s_setprio(0); } while (0)
#define PG8_WAIT_V(n) asm volatile("s_waitcnt vmcnt(" #n ")" ::: "memory")
#define PG8_WAIT_L(n) asm volatile("s_waitcnt lgkmcnt(" #n ")" ::: "memory")
#define PG8_BAR __builtin_amdgcn_s_barrier()
#define PG8_SCHED __builtin_amdgcn_sched_barrier(0)
    Unit cur, nxt; int ui = 0;
    if (!S.next(0, cur)) return;
    f32x4 acc[2][2][4][2];
#pragma unroll
    for (int a = 0; a < 2; ++a)
#pragma unroll
        for (int b = 0; b < 2; ++b)
#pragma unroll
            for (int m = 0; m < 4; ++m)
#pragma unroll
                for (int n = 0; n < 2; ++n) acc[a][b][m][n] = (f32x4){0.f, 0.f, 0.f, 0.f};
    bf16x8 At[4][2], B0[2][2], B1[2][2];
    const char* cA = (const char*)g.A + (size_t)cur.pm * tstepA; const char* cB = (const char*)g.Bt + (size_t)cur.pn * tstep;
    S.a_ready(cur);
    if constexpr (SP2) {
        PG8_STAGE(PG8_SB(0, 0), cB, voffB); PG8_STAGE(PG8_SB(0, 1), cB + hstep, voffB); PG8_STAGE(PG8_SA(0, 0), cA, voffA); PG8_STAGE(PG8_SA(0, 1), cA + hstepA, voffA);
        if (wr == 1) PG8_BAR;
        PG8_WAIT_V(2); PG8_BAR;
        PG8_STAGE(PG8_SB(1, 0), cB + kstep, voffB); PG8_STAGE(PG8_SA(1, 0), cA + kstep, voffA); PG8_STAGE(PG8_SB(1, 1), cB + hstep + kstep, voffB);
        PG8_WAIT_V(6); PG8_BAR;
    } else {
        PG8_STAGE(PG8_SB(0, 0), cB, voffB); PG8_STAGE(PG8_SA(0, 0), cA, voffA); PG8_STAGE(PG8_SB(0, 1), cB + hstep, voffB); PG8_STAGE(PG8_SA(0, 1), cA + hstepA, voffA);
        if (wr == 1) PG8_BAR;
        PG8_WAIT_V(4); PG8_BAR;
        PG8_STAGE(PG8_SB(1, 0), cB + kstep, voffB); PG8_STAGE(PG8_SA(1, 0), cA + kstep, voffA); PG8_STAGE(PG8_SB(1, 1), cB + hstep + kstep, voffB);
        PG8_WAIT_V(6); PG8_BAR;
    }
    for (;;) {
        const bool has_next = S.next(ui + 1, nxt);
        const char* nA = has_next ? (const char*)g.A + (size_t)nxt.pm * tstepA : cA; const char* nB = has_next ? (const char*)g.Bt + (size_t)nxt.pn * tstep : cB;
        const int ntl = (PROBE == 9 && Epi::PROBE_TWICE) ? 2 * nt : nt;
        for (int t = 0; t < ntl; t += 2) {
            const bool last = (t == ntl - 2);
            const int t1 = (t + 1 >= nt) ? t + 1 - nt : t + 1, t2 = (t + 2 >= nt) ? t + 2 - nt : t + 2;
            const char* a1 = cA + (size_t)t1 * kstep;
            const char* a2 = last ? nA : cA + (size_t)t2 * kstep; const char* b2 = last ? nB : cB + (size_t)t2 * kstep;
            const char* a3 = a2 + kstep; const char* b3 = b2 + kstep;
            if (last && has_next) S.a_ready(nxt);
            if constexpr (SP2) {
            PG8_LDB(B0, 0, 0); PG8_LDB(B1, 0, 1); PG8_SCHED; PG8_LDA(At, 0, 0); PG8_STAGE(PG8_SA(1, 1), a1 + hstepA, voffA);
            PG8_WAIT_V(8); PG8_WAIT_L(0); PG8_BAR; PG8_MMA(0, 0, At, B0); PG8_MMA(0, 1, At, B1); PG8_BAR; PG8_SCHED;
            PG8_LDA(At, 0, 1); PG8_STAGE(PG8_SB(0, 0), b2, voffB); PG8_STAGE(PG8_SB(0, 1), b2 + hstep, voffB); PG8_STAGE(PG8_SA(0, 0), a2, voffA);
            PG8_WAIT_V(8); PG8_WAIT_L(0); PG8_BAR; PG8_MMA(1, 0, At, B0); PG8_MMA(1, 1, At, B1); PG8_BAR; PG8_SCHED;
            PG8_LDB(B0, 1, 0); PG8_LDB(B1, 1, 1); PG8_SCHED; PG8_LDA(At, 1, 0); PG8_STAGE(PG8_SA(0, 1), a2 + hstepA, voffA);
            PG8_WAIT_V(8); PG8_WAIT_L(0); PG8_BAR; PG8_MMA(0, 0, At, B0); PG8_MMA(0, 1, At, B1); PG8_BAR; PG8_SCHED;
            PG8_LDA(At, 1, 1); PG8_STAGE(PG8_SB(1, 0), b3, voffB); PG8_STAGE(PG8_SB(1, 1), b3 + hstep, voffB); PG8_STAGE(PG8_SA(1, 0), a3, voffA);
            PG8_WAIT_V(8); PG8_WAIT_L(0); PG8_BAR; PG8_MMA(1, 0, At, B0); PG8_MMA(1, 1, At, B1); PG8_BAR; PG8_SCHED;
            } else {
            PG8_LDB(B0, 0, 0); PG8_SCHED; PG8_LDA(At, 0, 0); PG8_STAGE(PG8_SA(1, 1), a1 + hstepA, voffA);
            PG8_WAIT_L(8); PG8_BAR; PG8_WAIT_L(0); PG8_MMA(0, 0, At, B0); PG8_BAR; PG8_SCHED;
            PG8_LDB(B1, 0, 1); PG8_STAGE(PG8_SB(0, 0), b2, voffB);
            PG8_BAR; PG8_WAIT_L(0); PG8_MMA(0, 1, At, B1); PG8_BAR;
            PG8_LDA(At, 0, 1); PG8_STAGE(PG8_SA(0, 0), a2, voffA);
            PG8_BAR; PG8_WAIT_L(0); PG8_MMA(1, 0, At, B0); PG8_BAR; PG8_SCHED;
            PG8_STAGE(PG8_SB(0, 1), b2 + hstep, voffB);
            PG8_WAIT_V(6); PG8_BAR; PG8_MMA(1, 1, At, B1); PG8_BAR;
            PG8_LDB(B0, 1, 0); PG8_SCHED; PG8_LDA(At, 1, 0); PG8_STAGE(PG8_SA(0, 1), a2 + hstepA, voffA);
            PG8_WAIT_L(8); PG8_BAR; PG8_WAIT_L(0); PG8_MMA(0, 0, At, B0); PG8_BAR; PG8_SCHED;
            PG8_LDB(B1, 1, 1); PG8_STAGE(PG8_SB(1, 0), b3, voffB);
            PG8_BAR; PG8_WAIT_L(0); PG8_MMA(0, 1, At, B1); PG8_BAR;
            PG8_LDA(At, 1, 1); PG8_STAGE(PG8_SA(1, 0), a3, voffA);
            PG8_BAR; PG8_WAIT_L(0); PG8_MMA(1, 0, At, B0); PG8_BAR; PG8_SCHED;
            PG8_STAGE(PG8_SB(1, 1), b3 + hstep, voffB);
            PG8_WAIT_V(6); PG8_BAR; PG8_MMA(1, 1, At, B1); PG8_BAR;
            }
        }
        if constexpr (ALIGN_EPI) { if (wr == 0) PG8_BAR; }
        if constexpr (!Epi::AFTER_DRAIN) { E(acc, cur, wr, wc, fr, fq); if (PROBE == 8 && Epi::PROBE_TWICE) { asm volatile("" ::: "memory"); E(acc, cur, wr, wc, fr, fq); } S.done(cur); }
        if (!has_next) break;
#pragma unroll
        for (int a = 0; a < 2; ++a)
#pragma unroll
            for (int b = 0; b < 2; ++b)
#pragma unroll
                for (int m = 0; m < 4; ++m)
#pragma unroll
                    for (int n = 0; n < 2; ++n) acc[a][b][m][n] = (f32x4){0.f, 0.f, 0.f, 0.f};
        cur = nxt; cA = nA; cB = nB; ++ui;
        if constexpr (ALIGN_EPI) { if (wr == 1) PG8_BAR; }
    }
    PG8_WAIT_V(0);
    if constexpr (!ALIGN_EPI) { if (wr == 0) PG8_BAR; }
    PG8_BAR;
    if constexpr (Epi::AFTER_DRAIN) { E.fused(acc, cur, wr, wc, fr, fq, lds, wid, lane); S.done(cur); }
#undef PG8_SA
#undef PG8_SB
#undef PG8_STAGE
#undef PG8_LDA
#undef PG8_LDB
#undef PG8_MMA
#undef PG8_WAIT_V
#undef PG8_WAIT_L
#undef PG8_BAR
#undef PG8_SCHED
}
}

constexpr int NWAVES = 8;
constexpr int BATCH = 2, SEQ = 8192, D = 1024, DEPTH = 4, M = BATCH * SEQ;
constexpr int GH = 2048, GH2 = 4096, SGU_G = 8, SGU_P = 128, SGU_C = 256;
constexpr int NH = 16, HD = 64, NREL = 192, CHUNK = 64;
constexpr int FF = 2816, FF2 = 5632;
constexpr float EPS = 1e-6f;
constexpr float LOG2E = 1.4426950408889634f;
constexpr float QSCALE = 0.125f * LOG2E;

#ifndef MK_PER_PHASE
#define MK_PER_PHASE 0
#endif
constexpr int N_PHASES = 22;

constexpr size_t MiB = 1u << 20;
constexpr size_t WS_CTL = 0, CTL_ZERO_BYTES = 64 * 1024;
constexpr size_t WS_XSS = 1 * MiB;
constexpr size_t WS_VSS = 2 * MiB;
constexpr size_t WS_W = 4 * MiB;
constexpr size_t WS_XB = 110 * MiB;
constexpr size_t WS_ACT = 142 * MiB;
constexpr size_t WS_END = 270 * MiB;
constexpr size_t WO_IN = 0, WO_AOUT = 8388608, WO_QKV = 12582912, WO_BOUT = 18874368, WO_GU = 20971520, WO_DN = 44040192, WO_END = 55574528;
static_assert(WS_W + WO_END * 2 <= WS_XB && WS_XB + (size_t)M * D * 2 <= WS_ACT && WS_ACT + (size_t)M * GH2 * 2 <= WS_END, "d_ws map");
constexpr int CW_BAR = 1024;

constexpr int RING_OFF = 0, RING_BYTES = 131072;
constexpr int LDSCTL_OFF = RING_BYTES, MISC_OFF = LDSCTL_OFF + 320;
constexpr int LDS_BYTES = 147456;
static_assert(MISC_OFF + 128 <= LDS_BYTES, "LDS map");

#define GAS __attribute__((address_space(1)))
#define LAS __attribute__((address_space(3)))
typedef unsigned short bf16;
typedef unsigned v4u __attribute__((ext_vector_type(4)));
typedef unsigned v2u __attribute__((ext_vector_type(2)));
typedef float f32x4 __attribute__((ext_vector_type(4)));
typedef float f32x16 __attribute__((ext_vector_type(16)));
typedef short bf16x8 __attribute__((ext_vector_type(8)));
typedef short s16x4 __attribute__((ext_vector_type(4)));
typedef GAS unsigned gu32;
#define RLX_AGENT __ATOMIC_RELAXED, __HIP_MEMORY_SCOPE_AGENT
#define LDS_WAIT() asm volatile("s_waitcnt lgkmcnt(0)" ::: "memory")
#define VM_WAIT() asm volatile("s_waitcnt vmcnt(0)" ::: "memory")
__device__ __forceinline__ unsigned pk2(float lo, float hi) { return pg8::cvt_pk_bf16(lo, hi); }
__device__ __forceinline__ float bf_lo(unsigned w) { return __uint_as_float(w << 16); }
__device__ __forceinline__ float bf_hi(unsigned w) { return __uint_as_float(w & 0xffff0000u); }
__device__ __forceinline__ float wave_sum(float v) {
#pragma unroll
    for (int o = 1; o < 64; o <<= 1) v += __shfl_xor(v, o);
    return v;
}
#define XB_TMO      128
#define XB_XCNT(j)  (256  + 64 * (j))
#define XB_XSUB(j)  (1280 + 64 * (j))
#define XB_XGEN(j)  (2304 + 64 * (j))
#define XB_TOP      3328
#define XB_TOPGEN   3392
#define XCD_BAR_WORDS 3456
#define XB_SPIN_CAP (1u << 18)

__device__ __forceinline__ unsigned xb_ld(unsigned* p)              { return __hip_atomic_load(p, __ATOMIC_RELAXED, __HIP_MEMORY_SCOPE_AGENT); }
__device__ __forceinline__ unsigned xb_add(unsigned* p, unsigned v) { return __hip_atomic_fetch_add(p, v, __ATOMIC_RELAXED, __HIP_MEMORY_SCOPE_AGENT); }
__device__ __forceinline__ unsigned xb_xcc_id() { return (unsigned)__builtin_amdgcn_s_getreg((3 << 11) | 20) & 0xFu; }
#define XB_SPIN(cond, bar) do { unsigned _sp = 0; while (cond) { __builtin_amdgcn_s_sleep(1); \
    if ((++_sp & 255u) == 0u) { if (xb_ld(&(bar)[XB_TMO])) break; if (_sp > XB_SPIN_CAP) { atomicAdd(&(bar)[XB_TMO], 1u); break; } } } } while (0)

struct XcdBarrier {
    unsigned* bar; unsigned x;
    volatile LAS unsigned* st;
};

__device__ __forceinline__ XcdBarrier xcd_barrier_post(unsigned* bar, volatile LAS unsigned* st) {
    XcdBarrier b; b.bar = bar; b.x = xb_xcc_id(); b.st = st;
    if (threadIdx.x == 0) (void)xb_add(&bar[XB_XCNT(b.x)], 1u);
    return b;
}
__device__ __forceinline__ void xcd_barrier_complete(unsigned* bar, unsigned x, unsigned& nloc, unsigned& nx) {
    const unsigned G = gridDim.x * gridDim.y * gridDim.z;
    unsigned sum, cnt, mine, sp = 0u;
    for (;;) {
        sum = 0u; cnt = 0u; mine = 0u;
#pragma unroll
        for (unsigned j = 0; j < 16; ++j) { const unsigned c = xb_ld(&bar[XB_XCNT(j)]); sum += c; cnt += (c > 0u) ? 1u : 0u; mine = (j == x) ? c : mine; }
        if (sum == G) break;
        __builtin_amdgcn_s_sleep(1);
        if ((++sp & 255u) == 0u) { if (xb_ld(&bar[XB_TMO])) break; if (sp > XB_SPIN_CAP) { atomicAdd(&bar[XB_TMO], 1u); break; } }
    }
    nloc = mine > 0u ? mine : 1u; nx = cnt > 0u ? cnt : 1u;
}

__device__ __forceinline__ void xcd_barrier(const XcdBarrier& b) {
    asm volatile("s_waitcnt vmcnt(0)" ::: "memory");
    __syncthreads();
    if (threadIdx.x == 0) {
        unsigned* bar = b.bar;
        __builtin_amdgcn_s_waitcnt(0);
        unsigned nloc = b.st[0], nx = b.st[1];
        if (nloc == 0u) { xcd_barrier_complete(bar, b.x, nloc, nx); b.st[0] = nloc; b.st[1] = nx; }
        const unsigned old = xb_add(&bar[XB_XSUB(b.x)], 1u);
        const unsigned gen = old / nloc;
        if (old + 1u == (gen + 1u) * nloc) {
            __builtin_amdgcn_fence(__ATOMIC_RELEASE, "agent");
            asm volatile("s_waitcnt vmcnt(0)" ::: "memory");
            const unsigned og = xb_add(&bar[XB_TOP], 1u);
            const unsigned tg = og / nx;
            if (og + 1u == (tg + 1u) * nx) xb_add(&bar[XB_TOPGEN], 1u);
            else XB_SPIN(xb_ld(&bar[XB_TOPGEN]) == tg, bar);
            __builtin_amdgcn_fence(__ATOMIC_ACQUIRE, "agent");
            xb_add(&bar[XB_XGEN(b.x)], 1u);
            asm volatile("s_waitcnt vmcnt(0)" ::: "memory");
        } else {
            XB_SPIN(xb_ld(&bar[XB_XGEN(b.x)]) == gen, bar);
            __builtin_amdgcn_fence(__ATOMIC_ACQUIRE, "agent");
            asm volatile("s_waitcnt vmcnt(0)" ::: "memory");
        }
    }
    __syncthreads();
}

__device__ __forceinline__ void p0_transpose_item(const float* W, const float* gain, int K, int N, bf16* WT, int drow0, int k0, int n0, LAS unsigned* scr, int lane) {
    const int kp = lane >> 4, n4 = lane & 15;
    f32x4 w[8][2];
    const float* src = W + (size_t)(k0 + 2 * kp) * N + n0 + 4 * n4;
#pragma unroll
    for (int i = 0; i < 8; ++i) { w[i][0] = *(const f32x4*)(src + (size_t)(8 * i) * N); w[i][1] = *(const f32x4*)(src + (size_t)(8 * i + 1) * N); }
    if (gain) {
#pragma unroll
        for (int i = 0; i < 8; ++i) { const float g0 = gain[k0 + 8 * i + 2 * kp], g1 = gain[k0 + 8 * i + 2 * kp + 1]; w[i][0] = w[i][0] * g0; w[i][1] = w[i][1] * g1; }
    }
#pragma unroll
    for (int i = 0; i < 8; ++i)
#pragma unroll
        for (int e = 0; e < 4; ++e) scr[(4 * n4 + e) * 33 + 4 * i + kp] = pk2(w[i][0][e], w[i][1][e]);
    LDS_WAIT(); asm volatile("" ::: "memory");
    const int c = lane & 7;
#pragma unroll
    for (int jn = 0; jn < 8; ++jn) { const int n = (lane >> 3) + 8 * jn; const LAS unsigned* s = scr + n * 33 + 4 * c;
        v4u o; o.x = s[0]; o.y = s[1]; o.z = s[2]; o.w = s[3];
        pg8::store16(WT + (size_t)(drow0 + n) * K + k0 + 8 * c, o); }
    LDS_WAIT(); asm volatile("" ::: "memory");
}
struct Ptrs {
    const float *x, *norm_mix_g, *norm_ffn_g, *final_g, *a_w_in, *a_v_gain, *a_w_s, *a_b_s, *a_w_out, *b_w_qkv, *b_rel_bias, *b_w_out, *ffn_w_gate, *ffn_w_up, *ffn_w_down;
    float* out; bf16* wt; bf16* xb; bf16* act; float* xss; float* vss;
};
__device__ __forceinline__ void p0_prologue(const Ptrs& P, LAS unsigned char* lds, int vcu, int G, int wave, int lane) {
    LAS unsigned* scr = (LAS unsigned*)(lds + RING_OFF + wave * 16384);
    const int gw = vcu * NWAVES + wave, NGW = G * NWAVES;
    constexpr int I_IN = 16 * 64, I_AOUT = 32 * 16, I_QKV = 16 * 48, I_BOUT = 16 * 16, I_GU = 16 * 44, I_DN = 44 * 16;
    constexpr int NITEMS = 2 * I_IN + 2 * I_AOUT + 2 * I_QKV + 2 * I_BOUT + 8 * I_GU + 4 * I_DN;
    for (int it = gw; it < NITEMS; it += NGW) {
        int r = it; const float* W; const float* gain = nullptr; bf16* dst; int K, N, mode = 0;
        if (r < 2 * I_IN) { const int j = r / I_IN; r -= j * I_IN; W = P.a_w_in + (size_t)j * D * GH2; gain = P.norm_mix_g + (2 * j) * D; K = D; N = GH2; dst = P.wt + WO_IN + (size_t)j * D * GH2; }
        else if ((r -= 2 * I_IN) < 2 * I_AOUT) { const int j = r / I_AOUT; r -= j * I_AOUT; W = P.a_w_out + (size_t)j * GH * D; K = GH; N = D; dst = P.wt + WO_AOUT + (size_t)j * GH * D; }
        else if ((r -= 2 * I_AOUT) < 2 * I_QKV) { const int j = r / I_QKV; r -= j * I_QKV; W = P.b_w_qkv + (size_t)j * D * 3 * D; gain = P.norm_mix_g + (2 * j + 1) * D; K = D; N = 3 * D; dst = P.wt + WO_QKV + (size_t)j * D * 3 * D; }
        else if ((r -= 2 * I_QKV) < 2 * I_BOUT) { const int j = r / I_BOUT; r -= j * I_BOUT; W = P.b_w_out + (size_t)j * D * D; K = D; N = D; dst = P.wt + WO_BOUT + (size_t)j * D * D; }
        else if ((r -= 2 * I_BOUT) < 4 * I_GU) { const int i = r / I_GU; r -= i * I_GU; W = P.ffn_w_gate + (size_t)i * D * FF; gain = P.norm_ffn_g + i * D; K = D; N = FF; dst = P.wt + WO_GU + (size_t)i * D * FF2; mode = 1; }
        else if ((r -= 4 * I_GU) < 4 * I_GU) { const int i = r / I_GU; r -= i * I_GU; W = P.ffn_w_up + (size_t)i * D * FF; gain = P.norm_ffn_g + i * D; K = D; N = FF; dst = P.wt + WO_GU + (size_t)i * D * FF2; mode = 2; }
        else { r -= 4 * I_GU; const int i = r / I_DN; r -= i * I_DN; W = P.ffn_w_down + (size_t)i * FF * D; K = FF; N = D; dst = P.wt + WO_DN + (size_t)i * FF * D; }
        const int nblk = N / 64, kb = r / nblk, nb = r % nblk, k0 = 64 * kb, n0 = 64 * nb;
        const int drow0 = (mode == 0) ? n0 : ((n0 >> 7) * 256 + (n0 & 127) + (mode == 2 ? 128 : 0));
        p0_transpose_item(W, gain, K, N, dst, drow0, k0, n0, scr, lane);
    }
    for (int m = gw; m < M; m += 2 * NGW) {
        const int m2 = (m + NGW < M) ? m + NGW : m;
        const GAS f32x4* xr = (const GAS f32x4*)(P.x + (size_t)m * D) + lane; const GAS f32x4* xr2 = (const GAS f32x4*)(P.x + (size_t)m2 * D) + lane; f32x4 v[4], v2[4]; float s = 0.f, s2 = 0.f;
#pragma unroll
        for (int j = 0; j < 4; ++j) { v[j] = xr[64 * j]; v2[j] = xr2[64 * j]; }
#pragma unroll
        for (int j = 0; j < 4; ++j) { s += (v[j].x * v[j].x + v[j].y * v[j].y) + (v[j].z * v[j].z + v[j].w * v[j].w); s2 += (v2[j].x * v2[j].x + v2[j].y * v2[j].y) + (v2[j].z * v2[j].z + v2[j].w * v2[j].w); }
        s = wave_sum(s); s2 = wave_sum(s2);
        GAS unsigned long long* o8 = (GAS unsigned long long*)(P.xb + (size_t)m * D) + lane; GAS unsigned long long* o82 = (GAS unsigned long long*)(P.xb + (size_t)m2 * D) + lane;
#pragma unroll
        for (int j = 0; j < 4; ++j) { o8[64 * j] = (unsigned long long)pk2(v[j].x, v[j].y) | ((unsigned long long)pk2(v[j].z, v[j].w) << 32);
            o82[64 * j] = (unsigned long long)pk2(v2[j].x, v2[j].y) | ((unsigned long long)pk2(v2[j].z, v2[j].w) << 32); }
        if (lane < pg8::NSLOT_X) { P.xss[(size_t)m * pg8::NSLOT_X + lane] = (lane == 0) ? s : 0.f; P.xss[(size_t)m2 * pg8::NSLOT_X + lane] = (lane == 0) ? s2 : 0.f; }
    }
}

constexpr int SP_A_PITCH = 272, SP_V_PITCH = 528;
constexpr int SP_A_OFF = 0, SP_V_OFF = 36864, SP_R_OFF = 106496;
typedef short v4i16_t __attribute__((ext_vector_type(4)));
__device__ __forceinline__ s16x4 tr_read(const LAS unsigned char* p) { return __builtin_bit_cast(s16x4, __builtin_amdgcn_ds_read_tr16_b64_v4i16((LAS v4i16_t*)p)); }
template <bool DRY> __device__ __forceinline__ void spatial_phase(const Ptrs& P, int j, LAS unsigned char* lds, int vcu, int G, int tid, int wave, int lane) {
    asm volatile("" : "+v"(tid), "+v"(lane));
    bf16* uv = P.act;
    LAS unsigned char* Aimg = lds + SP_A_OFF; LAS unsigned char* Vimg = lds + SP_V_OFF; LAS float* rsL = (LAS float*)(lds + SP_R_OFF);
    const int fr = lane & 15, fq = lane >> 4;
    for (int unit = vcu; unit < (M / SGU_P) * SGU_G; unit += G) {
        const int nb = unit >> 3, g = unit & 7, row0 = nb * SGU_P;
        if (tid < SGU_P) { const f32x4* p = (const f32x4*)(P.vss + (size_t)(row0 + tid) * pg8::NSLOT_V); float s = 0.f;
#pragma unroll
            for (int k = 0; k < 8; ++k) { const f32x4 v = p[k]; s += (v[0] + v[1]) + (v[2] + v[3]); }
            rsL[tid] = __builtin_amdgcn_rsqf(s * (1.0f / GH) + EPS); }
        { v4u t[8];
#pragma unroll
            for (int i = 0; i < 8; ++i) { const int pc = tid + 512 * i, q = pc >> 5, ch = pc & 31; t[i] = *(const v4u*)(uv + (size_t)(row0 + q) * GH2 + GH + g * SGU_C + ch * 8); }
#pragma unroll
            for (int i = 0; i < 8; ++i) { const int pc = tid + 512 * i, q = pc >> 5, ch = pc & 31; *(LAS v4u*)(Vimg + q * SP_V_PITCH + ch * 16) = t[i]; } }
        __syncthreads();
        { const float* ws = P.a_w_s + ((size_t)j * SGU_G + g) * SGU_P * SGU_P;
#pragma unroll
            for (int i = 0; i < 4; ++i) { const int e = tid + 512 * i, p = e >> 4, q0 = (e & 15) * 8;
                const f32x4 w0 = *(const f32x4*)(ws + p * SGU_P + q0), w1 = *(const f32x4*)(ws + p * SGU_P + q0 + 4);
                const f32x4 r0 = *(const LAS f32x4*)(rsL + q0), r1 = *(const LAS f32x4*)(rsL + q0 + 4);
                v4u o; o.x = pk2(w0[0] * r0[0], w0[1] * r0[1]); o.y = pk2(w0[2] * r0[2], w0[3] * r0[3]); o.z = pk2(w1[0] * r1[0], w1[1] * r1[1]); o.w = pk2(w1[2] * r1[2], w1[3] * r1[3]);
                *(LAS v4u*)(Aimg + p * SP_A_PITCH + q0 * 2) = o; } }
        __syncthreads();
        bf16x8 vf[2][4];
        { const LAS unsigned char* vb = Vimg + (8 * fq + ((lane & 15) >> 2)) * SP_V_PITCH + (32 * wave + 8 * (lane & 3)) * 2;
#pragma unroll
            for (int ks = 0; ks < 4; ++ks)
#pragma unroll
                for (int n = 0; n < 2; ++n) { const s16x4 lo = tr_read(vb + ks * 32 * SP_V_PITCH + n * 8), hi = tr_read(vb + ks * 32 * SP_V_PITCH + 4 * SP_V_PITCH + n * 8);
                    vf[n][ks] = (bf16x8){lo[0], lo[1], lo[2], lo[3], hi[0], hi[1], hi[2], hi[3]}; } }
        const int cc = g * SGU_C + 32 * wave + 8 * fq;
        const f32x4 gn0 = *(const f32x4*)(P.a_v_gain + (size_t)j * GH + cc), gn1 = *(const f32x4*)(P.a_v_gain + (size_t)j * GH + cc + 4);
#pragma unroll
        for (int pt = 0; pt < 8; ++pt) {
            f32x4 a0 = {0.f, 0.f, 0.f, 0.f}, a1 = {0.f, 0.f, 0.f, 0.f};
            const LAS unsigned char* ab = Aimg + (16 * pt + fr) * SP_A_PITCH + (8 * fq) * 2;
#pragma unroll
            for (int ks = 0; ks < 4; ++ks) if (ks < (pt < 4 ? 2 : 4)) { const bf16x8 af = *(const LAS bf16x8*)(ab + ks * 64);
                a0 = __builtin_amdgcn_mfma_f32_16x16x32_bf16(vf[0][ks], af, a0, 0, 0, 0); a1 = __builtin_amdgcn_mfma_f32_16x16x32_bf16(vf[1][ks], af, a1, 0, 0, 0); }
            const int p = 16 * pt + fr; bf16* up = uv + (size_t)(row0 + p) * GH2 + cc;
            const float b = P.a_b_s[((size_t)j * SGU_G + g) * SGU_P + p];
            const v4u u8 = *(const v4u*)up;
            v4u o;
            o.x = pk2(bf_lo(u8.x) * (gn0[0] * a0[0] + b), bf_hi(u8.x) * (gn0[1] * a0[1] + b)); o.y = pk2(bf_lo(u8.y) * (gn0[2] * a0[2] + b), bf_hi(u8.y) * (gn0[3] * a0[3] + b));
            o.z = pk2(bf_lo(u8.z) * (gn1[0] * a1[0] + b), bf_hi(u8.z) * (gn1[1] * a1[1] + b)); o.w = pk2(bf_lo(u8.w) * (gn1[2] * a1[2] + b), bf_hi(u8.w) * (gn1[3] * a1[3] + b));
            if (DRY) *(v4u*)(P.xb + (size_t)(row0 + p) * D + (g & 3) * SGU_C + 32 * wave + 8 * fq) = o; else pg8::store16(up, o);
        }
        __syncthreads();
    }
}

constexpr int AT_K = 0, AT_V = 16384, AT_BT = 32768, AT_WS = 33792, AT_OST = 36864;
__device__ __forceinline__ int crow(int r, int hi) { return (r & 3) + 8 * (r >> 2) + 4 * hi; }
template <bool DRY> __device__ __forceinline__ void attn_phase(const Ptrs& P, int j, LAS unsigned char* lds, int vcu, int G, int tid, int wave, int lane) {
    asm volatile("" : "+v"(tid), "+v"(lane));
    bf16* Q = P.act; const bf16* Kt = P.act + (size_t)M * D; const bf16* Vt = P.act + (size_t)2 * M * D;
    const int r32 = lane & 31, hi = lane >> 5, ci = wave >> 1, qh = wave & 1;
    LAS float* bt = (LAS float*)(lds + AT_BT); LAS float* wsf = (LAS float*)(lds + AT_WS) + wave * 64;
    const int srow = tid >> 3, sch = tid & 7;
    for (int unit = vcu; unit < BATCH * NH * (SEQ / 256); unit += G) {
        const int bh = unit >> 5, cq = unit & 31, b = bh >> 4, h = bh & 15;
        const size_t rowbase = (size_t)b * SEQ;
        if (tid < NREL) bt[tid] = P.b_rel_bias[((size_t)j * NH + h) * NREL + tid] * LOG2E;
        const size_t qrow = rowbase + (size_t)(4 * cq + ci) * CHUNK + 32 * qh;
        bf16x8 qr[4];
#pragma unroll
        for (int d0 = 0; d0 < 4; ++d0) qr[d0] = *(const bf16x8*)(Q + (qrow + r32) * D + h * HD + d0 * 16 + hi * 8);
        float mrun = -1e30f, lrun = 0.f; f32x16 o0 = {}, o1 = {};
        const int s_lo = (4 * cq >= 8) ? 0 : 8 - 4 * cq;
        v4u kreg, vreg;
        { const size_t kr = (rowbase + (size_t)(4 * cq - 8 + s_lo) * CHUNK + srow) * D + h * HD + sch * 8; kreg = *(const v4u*)(Kt + kr); vreg = *(const v4u*)(Vt + kr); }
        { const int sl = (s_lo & 1) * 8192; *(LAS v4u*)(lds + AT_K + sl + sch * 1024 + srow * 16) = kreg; *(LAS v4u*)(lds + AT_V + sl + (sch >> 2) * 4096 + srow * 64 + (sch & 3) * 16) = vreg; }
        for (int s = s_lo; s < 12; ++s) {
            __syncthreads();
            if (s + 1 < 12) { const size_t kr = (rowbase + (size_t)(4 * cq - 8 + s + 1) * CHUNK + srow) * D + h * HD + sch * 8; kreg = *(const v4u*)(Kt + kr); vreg = *(const v4u*)(Vt + kr); }
            const int delta = ci + 8 - s;
            if (delta >= 0 && delta <= 8) {
                const LAS unsigned char* Ks = lds + AT_K + (s & 1) * 8192; const LAS unsigned char* Vs = lds + AT_V + (s & 1) * 8192;
                f32x16 p0, p1;
                { const float c0 = (delta >= 3) ? bt[NREL - 1] : 0.f;
#pragma unroll
                    for (int r = 0; r < 16; ++r) { p0[r] = c0; p1[r] = c0; } }
                { const LAS unsigned char* kb = Ks + hi * 1024 + r32 * 16;
#pragma unroll
                    for (int d0 = 0; d0 < 4; ++d0) { const bf16x8 k0 = *(const LAS bf16x8*)(kb + d0 * 2048), k1 = *(const LAS bf16x8*)(kb + d0 * 2048 + 512);
                        p0 = __builtin_amdgcn_mfma_f32_32x32x16_bf16(k0, qr[d0], p0, 0, 0, 0); p1 = __builtin_amdgcn_mfma_f32_32x32x16_bf16(k1, qr[d0], p1, 0, 0, 0); } }
                if (delta < 3) {
                    const int base = 64 * delta + 32 * qh + r32 + 63;
#pragma unroll
                    for (int r = 0; r < 16; ++r) { const int k0 = crow(r, hi); int i0 = base - k0, i1 = base - k0 - 32; i0 = i0 > NREL - 1 ? NREL - 1 : i0; i1 = i1 > NREL - 1 ? NREL - 1 : i1; i0 = i0 < 0 ? 0 : i0; i1 = i1 < 0 ? 0 : i1;
                        p0[r] += bt[i0]; p1[r] += bt[i1]; }
                }
                float mx = p0[0];
#pragma unroll
                for (int r = 1; r < 16; ++r) mx = fmaxf(mx, p0[r]);
#pragma unroll
                for (int r = 0; r < 16; ++r) mx = fmaxf(mx, p1[r]);
                mx = fmaxf(mx, __shfl_xor(mx, 32));
                const float mnew = fmaxf(mrun, mx), alpha = __builtin_amdgcn_exp2f(mrun - mnew);
                float psum = 0.f;
#pragma unroll
                for (int r = 0; r < 16; ++r) { p0[r] = __builtin_amdgcn_exp2f(p0[r] - mnew); p1[r] = __builtin_amdgcn_exp2f(p1[r] - mnew); psum += p0[r] + p1[r]; }
                lrun = lrun * alpha + psum; mrun = mnew;
                if (hi == 0) wsf[r32] = alpha;
#pragma unroll
                for (int r = 0; r < 16; ++r) { const float f = wsf[crow(r, hi)]; o0[r] *= f; o1[r] *= f; }
                v4u pw[4];
                pw[0] = (v4u){pk2(p0[0], p0[1]), pk2(p0[2], p0[3]), pk2(p0[4], p0[5]), pk2(p0[6], p0[7])};
                pw[1] = (v4u){pk2(p0[8], p0[9]), pk2(p0[10], p0[11]), pk2(p0[12], p0[13]), pk2(p0[14], p0[15])};
                pw[2] = (v4u){pk2(p1[0], p1[1]), pk2(p1[2], p1[3]), pk2(p1[4], p1[5]), pk2(p1[6], p1[7])};
                pw[3] = (v4u){pk2(p1[8], p1[9]), pk2(p1[10], p1[11]), pk2(p1[12], p1[13]), pk2(p1[14], p1[15])};
                const LAS unsigned char* vb = Vs + ((lane >> 4) & 1) * 32 + (lane & 3) * 8 + (4 * hi + ((lane & 15) >> 2)) * 64;
#pragma unroll
                for (int ks = 0; ks < 4; ++ks) { const bf16x8 pa = __builtin_bit_cast(bf16x8, pw[ks]);
                    { const s16x4 lo = tr_read(vb + ks * 1024), hh = tr_read(vb + ks * 1024 + 512); const bf16x8 vfr = (bf16x8){lo[0], lo[1], lo[2], lo[3], hh[0], hh[1], hh[2], hh[3]};
                        o0 = __builtin_amdgcn_mfma_f32_32x32x16_bf16(pa, vfr, o0, 0, 0, 0); }
                    { const s16x4 lo = tr_read(vb + 4096 + ks * 1024), hh = tr_read(vb + 4096 + ks * 1024 + 512); const bf16x8 vfr = (bf16x8){lo[0], lo[1], lo[2], lo[3], hh[0], hh[1], hh[2], hh[3]};
                        o1 = __builtin_amdgcn_mfma_f32_32x32x16_bf16(pa, vfr, o1, 0, 0, 0); } }
            }
            if (s + 1 < 12) { const int sl = ((s + 1) & 1) * 8192; *(LAS v4u*)(lds + AT_K + sl + sch * 1024 + srow * 16) = kreg; *(LAS v4u*)(lds + AT_V + sl + (sch >> 2) * 4096 + srow * 64 + (sch & 3) * 16) = vreg; }
        }
        lrun += __shfl_xor(lrun, 32);
        if (hi == 0) wsf[32 + r32] = lrun;
        { LAS bf16* stg = (LAS bf16*)(lds + AT_OST) + wave * 2048;
#pragma unroll
            for (int r = 0; r < 16; ++r) { const int orow = crow(r, hi); const float rl = __builtin_amdgcn_rcpf(wsf[32 + orow]);
                stg[orow * 64 + r32] = (bf16)(pk2(o0[r] * rl, 0.f) & 0xffffu); stg[orow * 64 + 32 + r32] = (bf16)(pk2(o1[r] * rl, 0.f) & 0xffffu); }
            bf16* Ow = (DRY ? P.xb : Q) + qrow * D + h * HD;
#pragma unroll
            for (int i = 0; i < 4; ++i) { const int row = i * 8 + (lane >> 3), ch = lane & 7; const v4u v = *(const LAS v4u*)(stg + row * 64 + ch * 8); pg8::store16(Ow + (size_t)row * D + ch * 8, v); } }
        __syncthreads();
    }
}

__device__ __forceinline__ void final_phase(const Ptrs& P, int vcu, int G, int wave, int lane) {
    const int gw = vcu * NWAVES + wave, NGW = G * NWAVES;
    f32x4 gn[4];
#pragma unroll
    for (int j = 0; j < 4; ++j) gn[j] = ((const f32x4*)P.final_g)[lane + 64 * j];
    for (int m = gw; m < M; m += NGW) {
        const f32x4 sv = *(const f32x4*)(P.xss + (size_t)m * pg8::NSLOT_X + (lane & 3) * 4);
        float s = (sv[0] + sv[1]) + (sv[2] + sv[3]); s += __shfl_xor(s, 1); s += __shfl_xor(s, 2);
        const float r = __builtin_amdgcn_rsqf(s * (1.0f / D) + EPS);
        GAS f32x4* xr = (GAS f32x4*)(P.out + (size_t)m * D) + lane;
#pragma unroll
        for (int j = 0; j < 4; ++j) { const f32x4 v = xr[64 * j]; xr[64 * j] = v * r * gn[j]; }
    }
}

struct Args { const float* in[15]; float* out; unsigned char* ws; int ph_lo, ph_hi; };
static_assert(sizeof(Args) == 17 * 8 + 8, "Args has no padding");
__global__ void __launch_bounds__(NWAVES * 64, 2) trunk_fwd(Args args) {
    extern __shared__ __attribute__((aligned(16))) unsigned char lds_raw[];
    LAS unsigned char* lds = (LAS unsigned char*)lds_raw;
    volatile LAS unsigned* MISC = (volatile LAS unsigned*)(lds + MISC_OFF);
    const int tid = threadIdx.x, lane = tid & 63, wave = __builtin_amdgcn_readfirstlane(tid >> 6);
    const int G = gridDim.x; const int bx = blockIdx.x; const int vcu = (G % 8 == 0) ? (bx % 8) * (G / 8) + bx / 8 : bx;
    unsigned char* ws = args.ws;
    gu32* ctl = (gu32*)(ws + WS_CTL);
    Ptrs P;
    P.x = args.in[0]; P.norm_mix_g = args.in[1]; P.norm_ffn_g = args.in[2]; P.final_g = args.in[3]; P.a_w_in = args.in[4]; P.a_v_gain = args.in[5]; P.a_w_s = args.in[6]; P.a_b_s = args.in[7];
    P.a_w_out = args.in[8]; P.b_w_qkv = args.in[9]; P.b_rel_bias = args.in[10]; P.b_w_out = args.in[11]; P.ffn_w_gate = args.in[12]; P.ffn_w_up = args.in[13]; P.ffn_w_down = args.in[14];
    P.out = args.out; P.wt = (bf16*)(ws + WS_W); P.xb = (bf16*)(ws + WS_XB); P.act = (bf16*)(ws + WS_ACT); P.xss = (float*)(ws + WS_XSS); P.vss = (float*)(ws + WS_VSS);
    for (int u = tid; u < (LDS_BYTES - LDSCTL_OFF) / 4; u += NWAVES * 64) ((LAS unsigned*)(lds + LDSCTL_OFF))[u] = 0u;
    __syncthreads();
    XcdBarrier bar; bar.bar = (unsigned*)(ctl + CW_BAR); bar.x = 0; bar.st = nullptr;
    if (!MK_PER_PHASE) bar = xcd_barrier_post((unsigned*)(ctl + CW_BAR), MISC + 8);
    const int lo = args.ph_lo, hi = args.ph_hi;
#ifndef DBG_MASK
#define DBG_MASK 0xff
#endif
#define IN(k) (lo <= (k) && (k) < hi)
#define SEAM(k) do { if (IN(k) && IN((k) + 1)) { xcd_barrier(bar); if (PROBE == 1) xcd_barrier(bar); } } while (0)

    if ((DBG_MASK & 1) && IN(0)) { p0_prologue(P, lds, vcu, G, wave, lane); if (PROBE == 2) { __syncthreads(); p0_prologue(P, lds, vcu, G, wave, lane); } }
    SEAM(0);
#pragma unroll 1
    for (int layer = 0; layer < DEPTH; ++layer) {
        const int j = layer >> 1, ph = 1 + 5 * layer;
        const bf16* wgu = P.wt + WO_GU + (size_t)layer * D * FF2; const bf16* wdn = P.wt + WO_DN + (size_t)layer * FF * D;
        if ((layer & 1) == 0) {
            if ((DBG_MASK & 2) && IN(ph)) { pg8::Gemm g{P.xb, P.wt + WO_IN + (size_t)j * D * GH2, M, GH2, D, D}; pg8::StaticOrder S; S.init(M, GH2, G, bx);
                pg8::EpiGeluStats E{P.act, GH2, P.xss, P.vss, GH / 256, EPS};
                pg8::gemm_phase<pg8::EpiGeluStats, pg8::StaticOrder, true, true>(lds + RING_OFF, g, S, E);
                if (PROBE == 5) { __syncthreads(); pg8::gemm_phase<pg8::EpiGeluStats, pg8::StaticOrder, true, true>(lds + RING_OFF, g, S, E); } }
            SEAM(ph);
            if ((DBG_MASK & 4) && IN(ph + 1)) { if (PROBE == 4) spatial_phase<true>(P, j, lds, vcu, G, tid, wave, lane); spatial_phase<false>(P, j, lds, vcu, G, tid, wave, lane); }
            SEAM(ph + 1);
            if ((DBG_MASK & 8) && IN(ph + 2)) { pg8::Gemm g{P.act, P.wt + WO_AOUT + (size_t)j * GH * D, M, D, GH, GH2}; pg8::StaticOrder S; S.init(M, D, G, bx);
                pg8::EpiResid E{layer == 0 ? P.x : P.out, P.out, P.xb, P.xss, D};
                pg8::gemm_phase<pg8::EpiResid, pg8::StaticOrder, false, true>(lds + RING_OFF, g, S, E); }
            SEAM(ph + 2);
        } else {
            if ((DBG_MASK & 16) && IN(ph)) { pg8::Gemm g{P.xb, P.wt + WO_QKV + (size_t)j * D * 3 * D, M, 3 * D, D, D}; pg8::StaticOrder S; S.init(M, 3 * D, G, bx);
                pg8::EpiQkv E{P.act, D, (size_t)M * D, P.xss, EPS, QSCALE};
                pg8::gemm_phase<pg8::EpiQkv, pg8::StaticOrder, true, true>(lds + RING_OFF, g, S, E);
                if (PROBE == 7) { __syncthreads(); pg8::gemm_phase<pg8::EpiQkv, pg8::StaticOrder, true, true>(lds + RING_OFF, g, S, E); } }
            SEAM(ph);
            if ((DBG_MASK & 32) && IN(ph + 1)) { if (PROBE == 3) attn_phase<true>(P, j, lds, vcu, G, tid, wave, lane); attn_phase<false>(P, j, lds, vcu, G, tid, wave, lane); }
            SEAM(ph + 1);
            if ((DBG_MASK & 8) && IN(ph + 2)) { pg8::Gemm g{P.act, P.wt + WO_BOUT + (size_t)j * D * D, M, D, D, D}; pg8::StaticOrder S; S.init(M, D, G, bx);
                pg8::EpiResid E{P.out, P.out, P.xb, P.xss, D};
                pg8::gemm_phase<pg8::EpiResid, pg8::StaticOrder, false, true>(lds + RING_OFF, g, S, E); }
            SEAM(ph + 2);
        }
        if ((DBG_MASK & 64) && IN(ph + 3)) { pg8::Gemm g{P.xb, wgu, M, FF2, D, D}; pg8::StaticOrder S; S.init(M, FF2, G, bx);
            pg8::EpiSwiglu E{P.act, FF, P.xss, EPS};
            pg8::gemm_phase<pg8::EpiSwiglu, pg8::StaticOrder, true, true>(lds + RING_OFF, g, S, E);
            if (PROBE == 6) { __syncthreads(); pg8::gemm_phase<pg8::EpiSwiglu, pg8::StaticOrder, true, true>(lds + RING_OFF, g, S, E); } }
        SEAM(ph + 3);
        if ((DBG_MASK & 8) && IN(ph + 4)) { pg8::Gemm g{P.act, wdn, M, D, FF, FF}; pg8::StaticOrder S; S.init(M, D, G, bx);
            pg8::EpiResid E{P.out, P.out, P.xb, P.xss, D};
            pg8::gemm_phase<pg8::EpiResid, pg8::StaticOrder, false, true>(lds + RING_OFF, g, S, E); }
        SEAM(ph + 4);
    }
    if ((DBG_MASK & 128) && IN(N_PHASES - 1)) final_phase(P, vcu, G, wave, lane);
#undef IN
#undef SEAM
}

extern "C" void kernel_launch(void* const* d_in, const int* in_sizes, int n_in, void* d_out, int out_size, void* d_ws, size_t ws_size, hipStream_t stream) {
    static int grid = 0;
    if (grid == 0) {
        if (n_in != 15 || in_sizes[0] != M * D || out_size != M * D || ws_size < WS_END) { fprintf(stderr, "kernel_launch: unexpected shapes (n_in %d, in0 %d, out %d, ws %zu < %zu); nothing launched\n", n_in, n_in > 0 ? in_sizes[0] : -1, out_size, ws_size, (size_t)WS_END); grid = -1; return; }
        int dev = 0, cus = 0, per_cu = 0;
        if (hipGetDevice(&dev) != hipSuccess || hipDeviceGetAttribute(&cus, hipDeviceAttributeMultiprocessorCount, dev) != hipSuccess) { grid = -1; return; }
        if (hipFuncSetAttribute((const void*)trunk_fwd, hipFuncAttributeMaxDynamicSharedMemorySize, LDS_BYTES) != hipSuccess) { fprintf(stderr, "kernel_launch: hipFuncSetAttribute failed\n"); grid = -1; return; }
        if (hipOccupancyMaxActiveBlocksPerMultiprocessor(&per_cu, (const void*)trunk_fwd, NWAVES * 64, LDS_BYTES) != hipSuccess || per_cu < 1) { fprintf(stderr, "kernel_launch: occupancy query reports %d workgroups per CU; nothing launched\n", per_cu); (void)hipGetLastError(); grid = -1; return; }
        grid = cus;
    }
    if (grid < 0) return;
    if (hipMemsetAsync((char*)d_ws + WS_CTL, 0, CTL_ZERO_BYTES, stream) != hipSuccess) return;
    Args a{};
    for (int i = 0; i < 15; ++i) a.in[i] = (const float*)d_in[i];
    a.out = (float*)d_out; a.ws = (unsigned char*)d_ws;
#if MK_PER_PHASE
    for (int p = 0; p < N_PHASES; ++p) { a.ph_lo = p; a.ph_hi = p + 1; hipLaunchKernelGGL(trunk_fwd, dim3(grid), dim3(NWAVES * 64), LDS_BYTES, stream, a); }
#else
    a.ph_lo = 0; a.ph_hi = N_PHASES;
    hipLaunchKernelGGL(trunk_fwd, dim3(grid), dim3(NWAVES * 64), LDS_BYTES, stream, a);
#endif
}
```

```cpp
#include <hip/hip_runtime.h>
#include <cstdio>
#include <cstdint>
#ifndef PROBE
#define PROBE 0
#endif
namespace pg8 {
#define PG8_LAS __attribute__((address_space(3)))
typedef unsigned short bf16_t;
typedef short bf16x8 __attribute__((ext_vector_type(8)));
typedef float f32x4 __attribute__((ext_vector_type(4)));
typedef unsigned u32x4 __attribute__((ext_vector_type(4)));
constexpr int BM = 256, BK = 64, HALF = 128, HTB = HALF * BK * 2  , STAGE_BYTES = 8 * HTB, NXCD = 8, WGM = 8;

__host__ __device__ __forceinline__ int lds_byte(int r, int c) { const int st = (r >> 4) * 2 + (c >> 5), rr = r & 15, cc = c & 31, ob = rr * 64 + cc * 2; return st * 1024 + (ob ^ (((ob >> 9) & 1) << 5)); }
__host__ __device__ __forceinline__ void stage_rc(int b, int& R, int& C) { const int st = b / 1024, sb = b % 1024, swz = sb ^ (((sb >> 9) & 1) << 5); R = (st >> 1) * 16 + swz / 64; C = (st & 1) * 32 + (swz % 64) / 2; }
__host__ __device__ __forceinline__ int perm32(int rho) { const int n = rho >> 4, i = rho & 15; return 8 * (i >> 2) + 4 * n + (i & 3); }

struct Unit { int pm, pn; };
struct Gemm { const bf16_t* A; const bf16_t* Bt; int M, N, K, lda; };

struct StaticOrder {
    int nM, nN, nwg, G, c;
    __host__ __device__ void init(int M, int N, int G_, int c_) { nM = M / BM; nN = N / BM; nwg = nM * nN; G = G_; c = c_; }
    __host__ __device__ bool next(int i, Unit& u) const {
        const long L = (long)i * G + c; if (L >= nwg) return false;
        int wgid = (int)L; { const int q = nwg / NXCD, r = nwg % NXCD, xcd = wgid % NXCD, off = wgid / NXCD; wgid = (xcd < r ? xcd * (q + 1) : r * (q + 1) + (xcd - r) * q) + off; }
        const int nig = WGM * nN, gid = wgid / nig, fm = gid * WGM, gsz = (nM - fm) < WGM ? (nM - fm) : WGM;
        u.pm = fm + ((wgid % nig) % gsz); u.pn = (wgid % nig) / gsz; return true;
    }
    __device__ __forceinline__ void a_ready(const Unit&) const {}
    __device__ __forceinline__ void done(const Unit&) const {}
};

__device__ __forceinline__ unsigned cvt_pk_bf16(float lo, float hi) { unsigned r; asm volatile("v_cvt_pk_bf16_f32 %0, %1, %2" : "=v"(r) : "v"(lo), "v"(hi)); return r; }
typedef float f32x2 __attribute__((ext_vector_type(2)));
#ifndef STORE_WT
#define STORE_WT 1
#endif
__device__ __forceinline__ void store16(void* p, u32x4 v) {
#if STORE_WT
    asm volatile("global_store_dwordx4 %0, %1, off sc1\n\ts_nop 1" :: "v"(p), "v"(v) : "memory");
#else
    *(u32x4*)p = v;
#endif
}
__device__ __forceinline__ void store16f(void* p, f32x4 v) {
#if STORE_WT
    asm volatile("global_store_dwordx4 %0, %1, off sc1\n\ts_nop 1" :: "v"(p), "v"(v) : "memory");
#else
    *(f32x4*)p = v;
#endif
}
typedef unsigned u32x2 __attribute__((ext_vector_type(2)));
__device__ __forceinline__ void store8(void* p, u32x2 v) {
#if STORE_WT
    asm volatile("global_store_dwordx2 %0, %1, off sc1\n\ts_nop 1" :: "v"(p), "v"(v) : "memory");
#else
    *(u32x2*)p = v;
#endif
}
constexpr int NSLOT_X = 16;
constexpr int NSLOT_V = 32;
__device__ __forceinline__ void row_scales(const float* ss, int row0, int fq, float inv_n, float eps, float (&rs)[2][4]) {
#pragma unroll
    for (int ai = 0; ai < 2; ++ai)
#pragma unroll
        for (int m = 0; m < 4; ++m) {
            const f32x4 v = *(const f32x4*)(ss + (size_t)(row0 + ai * HALF + m * 16) * NSLOT_X + fq * 4);
            float s = (v[0] + v[1]) + (v[2] + v[3]);
            s += __shfl_xor(s, 16); s += __shfl_xor(s, 32);
            rs[ai][m] = __builtin_amdgcn_rsqf(s * inv_n + eps);
        }
}
__device__ __forceinline__ float gelu_tanh(float x) {
    const float t = x * x, u2 = x * (2.302208198f + 0.1029432398f * t);
    const float e = __builtin_amdgcn_exp2f(-u2);
    return x * __builtin_amdgcn_rcpf(1.0f + e);
}
__device__ __forceinline__ float silu_mul(float g, float u) {
    const float e = __builtin_amdgcn_exp2f(g * -1.4426950408889634f);
    return (g * u) * __builtin_amdgcn_rcpf(1.0f + e);
}
struct EpiGeluStats {
    static constexpr bool PERM = true, AFTER_DRAIN = false, PROBE_TWICE = false;
    bf16_t* O; int ldc; const float* xss; float* vss; int vtile0; float eps;
    __device__ __forceinline__ void operator()(const f32x4 (&acc)[2][2][4][2], const Unit& u, int wr, int wc, int fr, int fq) const {
        const int row0 = u.pm * BM + wr * 64 + fr, col0 = u.pn * BM + wc * 32 + 8 * fq;
        float rs[2][4]; row_scales(xss, row0, fq, 1.0f / 1024.0f, eps, rs);
        const bool isv = u.pn >= vtile0;
#pragma unroll
        for (int ai = 0; ai < 2; ++ai)
#pragma unroll
            for (int m = 0; m < 4; ++m) { const int row = row0 + ai * HALF + m * 16; bf16_t* rowp = O + (size_t)row * ldc + col0; const float r = rs[ai][m]; float ssq = 0.f;
#pragma unroll
                for (int bj = 0; bj < 2; ++bj) { f32x4 v0 = acc[ai][bj][m][0] * r, v1 = acc[ai][bj][m][1] * r;
#pragma unroll
                    for (int e = 0; e < 4; ++e) { v0[e] = gelu_tanh(v0[e]); v1[e] = gelu_tanh(v1[e]); }
                    ssq += (v0[0] * v0[0] + v0[1] * v0[1]) + (v0[2] * v0[2] + v0[3] * v0[3]) + (v1[0] * v1[0] + v1[1] * v1[1]) + (v1[2] * v1[2] + v1[3] * v1[3]);
                    u32x4 w; w.x = cvt_pk_bf16(v0[0], v0[1]); w.y = cvt_pk_bf16(v0[2], v0[3]); w.z = cvt_pk_bf16(v1[0], v1[1]); w.w = cvt_pk_bf16(v1[2], v1[3]);
                    store16(rowp + bj * HALF, w); }
                if (isv) { ssq += __shfl_xor(ssq, 16); ssq += __shfl_xor(ssq, 32); if (fq == 0) vss[(size_t)row * NSLOT_V + (u.pn - vtile0) * 4 + wc] = ssq; } }
    }
};
struct EpiSwiglu {
    static constexpr bool PERM = true, AFTER_DRAIN = false, PROBE_TWICE = true;
    bf16_t* O; int ldc; const float* xss; float eps;
    __device__ __forceinline__ void operator()(const f32x4 (&acc)[2][2][4][2], const Unit& u, int wr, int wc, int fr, int fq) const {
        const int row0 = u.pm * BM + wr * 64 + fr, col0 = u.pn * HALF + wc * 32 + 8 * fq;
        float rs[2][4]; row_scales(xss, row0, fq, 1.0f / 1024.0f, eps, rs);
#pragma unroll
        for (int ai = 0; ai < 2; ++ai)
#pragma unroll
            for (int m = 0; m < 4; ++m) { const int row = row0 + ai * HALF + m * 16; const float r = rs[ai][m] * (PROBE == 9 ? 0.5f : 1.0f);
                const f32x4 g0 = acc[ai][0][m][0] * r, g1 = acc[ai][0][m][1] * r, u0 = acc[ai][1][m][0] * r, u1 = acc[ai][1][m][1] * r;
                float o[8];
#pragma unroll
                for (int e = 0; e < 4; ++e) { o[e] = silu_mul(g0[e], u0[e]); o[4 + e] = silu_mul(g1[e], u1[e]); }
                u32x4 w; w.x = cvt_pk_bf16(o[0], o[1]); w.y = cvt_pk_bf16(o[2], o[3]); w.z = cvt_pk_bf16(o[4], o[5]); w.w = cvt_pk_bf16(o[6], o[7]);
                store16(O + (size_t)row * ldc + col0, w); }
    }
};
struct EpiQkv {
    static constexpr bool PERM = true, AFTER_DRAIN = false, PROBE_TWICE = false;
    bf16_t* O; int ldc; size_t split_stride; const float* xss; float eps; float scale0;
    __device__ __forceinline__ void operator()(const f32x4 (&acc)[2][2][4][2], const Unit& u, int wr, int wc, int fr, int fq) const {
        const int t = u.pn >> 2; bf16_t* base = O + (size_t)t * split_stride; const float sc = (t == 0) ? scale0 : 1.0f;
        const int row0 = u.pm * BM + wr * 64 + fr, col0 = (u.pn & 3) * BM + wc * 32 + 8 * fq;
        float rs[2][4]; row_scales(xss, row0, fq, 1.0f / 1024.0f, eps, rs);
#pragma unroll
        for (int ai = 0; ai < 2; ++ai)
#pragma unroll
            for (int m = 0; m < 4; ++m) { const int row = row0 + ai * HALF + m * 16; bf16_t* rowp = base + (size_t)row * ldc + col0; const float r = rs[ai][m] * sc;
#pragma unroll
                for (int bj = 0; bj < 2; ++bj) { const f32x4 v0 = acc[ai][bj][m][0] * r, v1 = acc[ai][bj][m][1] * r;
                    u32x4 w; w.x = cvt_pk_bf16(v0[0], v0[1]); w.y = cvt_pk_bf16(v0[2], v0[3]); w.z = cvt_pk_bf16(v1[0], v1[1]); w.w = cvt_pk_bf16(v1[2], v1[3]);
                    store16(rowp + bj * HALF, w); } }
    }
};
struct EpiResid {
    static constexpr bool PERM = false, AFTER_DRAIN = false, PROBE_TWICE = false;
    const float* base; float* out; bf16_t* xb; float* xss; int ldc;
    __device__ __forceinline__ void operator()(const f32x4 (&acc)[2][2][4][2], const Unit& u, int wr, int wc, int fr, int fq) const {
        typedef unsigned u32x2v __attribute__((ext_vector_type(2)));
        asm volatile("" : "+v"(fr), "+v"(fq));
        const int row0 = u.pm * BM + wr * 64 + fr, col0 = u.pn * BM + wc * 32 + 4 * fq;
#pragma unroll
        for (int ai = 0; ai < 2; ++ai)
#pragma unroll
            for (int m = 0; m < 4; ++m) { const int row = row0 + ai * HALF + m * 16; const size_t off = (size_t)row * ldc + col0; float ssq = 0.f;
#pragma unroll
                for (int bj = 0; bj < 2; ++bj)
#pragma unroll
                    for (int n = 0; n < 2; ++n) { const f32x4 bs = *(const f32x4*)(base + off + bj * HALF + n * 16); const f32x4 o = bs + acc[ai][bj][m][n];
                        *(f32x4*)(out + off + bj * HALF + n * 16) = o; ssq += (o[0] * o[0] + o[1] * o[1]) + (o[2] * o[2] + o[3] * o[3]);
                        u32x2 w; w.x = cvt_pk_bf16(o[0], o[1]); w.y = cvt_pk_bf16(o[2], o[3]); *(u32x2*)(xb + off + bj * HALF + n * 16) = w; }
                ssq += __shfl_xor(ssq, 16); ssq += __shfl_xor(ssq, 32);
                if (fq == 0) xss[(size_t)row * NSLOT_X + u.pn * 4 + wc] = ssq;
                if (m & 1) asm volatile("" ::: "memory"); }
    }
};
template <class Epi, class Sched, bool ALIGN_EPI = false, bool SP2 = false>
__device__ __forceinline__ void gemm_phase(PG8_LAS unsigned char* lds, const Gemm g, const Sched& S, const Epi& E) {
    int tid_ = threadIdx.x; asm volatile("" : "+v"(tid_));
    const int tid = tid_, wid = __builtin_amdgcn_readfirstlane(tid >> 6), lane = tid & 63, wr = wid >> 2, wc = wid & 3, fr = lane & 15, fq = lane >> 4;
    const int K = g.K, nt = K / BK;
    unsigned voffA[2], voffB[2];
#pragma unroll
    for (int i = 0; i < 2; ++i) { int R, C; stage_rc(tid * 16 + i * 8192, R, C); const int Rb = Epi::PERM ? ((R & ~31) + perm32(R & 31)) : R;
        voffA[i] = (unsigned)(R * g.lda + C) * 2u; voffB[i] = (unsigned)(Rb * K + C) * 2u; }
    const size_t kstep = (size_t)(BK * 2);
    const size_t hstep = (size_t)HALF * K * 2;
    const size_t tstep = 2 * hstep; const size_t hstepA = (size_t)HALF * g.lda * 2, tstepA = 2 * hstepA;
    const unsigned ldsw = (unsigned)wid * 1024u;
    const int aoff = lds_byte(wr * 64 + fr, fq * 8), boff = lds_byte(wc * 32 + fr, fq * 8);
#define PG8_SA(b, h) (((b) * 2 + (h)) * HTB)
#define PG8_SB(b, h) ((4 + (b) * 2 + (h)) * HTB)
#define PG8_STAGE(bufoff, gbase, voff) do { _Pragma("unroll") for (int _i = 0; _i < 2; ++_i) \
        __builtin_amdgcn_global_load_lds((const unsigned*)((const char*)(gbase) + (voff)[_i]), (PG8_LAS unsigned*)(lds + (bufoff) + ldsw + _i * 8192), 16, 0, 0); } while (0)
#define PG8_LDA(dst, b, h) do { _Pragma("unroll") for (int m = 0; m < 4; ++m) _Pragma("unroll") for (int k = 0; k < 2; ++k) dst[m][k] = *(const PG8_LAS bf16x8*)(lds + PG8_SA(b, h) + aoff + m * 2048 + k * 1024); } while (0)
#define PG8_LDB(dst, b, h) do { _Pragma("unroll") for (int n = 0; n < 2; ++n) _Pragma("unroll") for (int k = 0; k < 2; ++k) dst[n][k] = *(const PG8_LAS bf16x8*)(lds + PG8_SB(b, h) + boff + n * 2048 + k * 1024); } while (0)
#define PG8_MMA(ai, bj, At, Bt) do { __builtin_amdgcn_s_setprio(1); _Pragma("unroll") for (int m = 0; m < 4; ++m) _Pragma("unroll") for (int n = 0; n < 2; ++n) _Pragma("unroll") for (int k = 0; k < 2; ++k) \
        acc[ai][bj][m][n] = __builtin_amdgcn_mfma_f32_16x16x32_bf16(Bt[n][k], At[m][k], acc[ai][bj][m][n], 0, 0, 0); __builtin_amdgcn_s_setprio(0); } while (0)
#define PG8_WAIT_V(n) asm volatile("s_waitcnt vmcnt(" #n ")" ::: "memory")
#define PG8_WAIT_L(n) asm volatile("s_waitcnt lgkmcnt(" #n ")" ::: "memory")
#define PG8_BAR __builtin_amdgcn_s_barrier()
#define PG8_SCHED __builtin_amdgcn_sched_barrier(0)
    Unit cur, nxt; int ui = 0;
    if (!S.next(0, cur)) return;
    f32x4 acc[2][2][4][2];
#pragma unroll
    for (int a = 0; a < 2; ++a)
#pragma unroll
        for (int b = 0; b < 2; ++b)
#pragma unroll
            for (int m = 0; m < 4; ++m)
#pragma unroll
                for (int n = 0; n < 2; ++n) acc[a][b][m][n] = (f32x4){0.f, 0.f, 0.f, 0.f};
    bf16x8 At[4][2], B0[2][2], B1[2][2];
    const char* cA = (const char*)g.A + (size_t)cur.pm * tstepA; const char* cB = (const char*)g.Bt + (size_t)cur.pn * tstep;
    S.a_ready(cur);
    if constexpr (SP2) {
        PG8_STAGE(PG8_SB(0, 0), cB, voffB); PG8_STAGE(PG8_SB(0, 1), cB + hstep, voffB); PG8_STAGE(PG8_SA(0, 0), cA, voffA); PG8_STAGE(PG8_SA(0, 1), cA + hstepA, voffA);
        if (wr == 1) PG8_BAR;
        PG8_WAIT_V(2); PG8_BAR;
        PG8_STAGE(PG8_SB(1, 0), cB + kstep, voffB); PG8_STAGE(PG8_SA(1, 0), cA + kstep, voffA); PG8_STAGE(PG8_SB(1, 1), cB + hstep + kstep, voffB);
        PG8_WAIT_V(6); PG8_BAR;
    } else {
        PG8_STAGE(PG8_SB(0, 0), cB, voffB); PG8_STAGE(PG8_SA(0, 0), cA, voffA); PG8_STAGE(PG8_SB(0, 1), cB + hstep, voffB); PG8_STAGE(PG8_SA(0, 1), cA + hstepA, voffA);
        if (wr == 1) PG8_BAR;
        PG8_WAIT_V(4); PG8_BAR;
        PG8_STAGE(PG8_SB(1, 0), cB + kstep, voffB); PG8_STAGE(PG8_SA(1, 0), cA + kstep, voffA); PG8_STAGE(PG8_SB(1, 1), cB + hstep + kstep, voffB);
        PG8_WAIT_V(6); PG8_BAR;
    }
    for (;;) {
        const bool has_next = S.next(ui + 1, nxt);
        const char* nA = has_next ? (const char*)g.A + (size_t)nxt.pm * tstepA : cA; const char* nB = has_next ? (const char*)g.Bt + (size_t)nxt.pn * tstep : cB;
        const int ntl = (PROBE == 9 && Epi::PROBE_TWICE) ? 2 * nt : nt;
        for (int t = 0; t < ntl; t += 2) {
            const bool last = (t == ntl - 2);
            const int t1 = (t + 1 >= nt) ? t + 1 - nt : t + 1, t2 = (t + 2 >= nt) ? t + 2 - nt : t + 2;
            const char* a1 = cA + (size_t)t1 * kstep;
            const char* a2 = last ? nA : cA + (size_t)t2 * kstep; const char* b2 = last ? nB : cB + (size_t)t2 * kstep;
            const char* a3 = a2 + kstep; const char* b3 = b2 + kstep;
            if (last && has_next) S.a_ready(nxt);
            if constexpr (SP2) {
            PG8_LDB(B0, 0, 0); PG8_LDB(B1, 0, 1); PG8_SCHED; PG8_LDA(At, 0, 0); PG8_STAGE(PG8_SA(1, 1), a1 + hstepA, voffA);
            PG8_WAIT_V(8); PG8_WAIT_L(0); PG8_BAR; PG8_MMA(0, 0, At, B0); PG8_MMA(0, 1, At, B1); PG8_BAR; PG8_SCHED;
            PG8_LDA(At, 0, 1); PG8_STAGE(PG8_SB(0, 0), b2, voffB); PG8_STAGE(PG8_SB(0, 1), b2 + hstep, voffB); PG8_STAGE(PG8_SA(0, 0), a2, voffA);
            PG8_WAIT_V(8); PG8_WAIT_L(0); PG8_BAR; PG8_MMA(1, 0, At, B0); PG8_MMA(1, 1, At, B1); PG8_BAR; PG8_SCHED;
            PG8_LDB(B0, 1, 0); PG8_LDB(B1, 1, 1); PG8_SCHED; PG8_LDA(At, 1, 0); PG8_STAGE(PG8_SA(0, 1), a2 + hstepA, voffA);
            PG8_WAIT_V(8); PG8_WAIT_L(0); PG8_BAR; PG8_MMA(0, 0, At, B0); PG8_MMA(0, 1, At, B1); PG8_BAR; PG8_SCHED;
            PG8_LDA(At, 1, 1); PG8_STAGE(PG8_SB(1, 0), b3, voffB); PG8_STAGE(PG8_SB(1, 1), b3 + hstep, voffB); PG8_STAGE(PG8_SA(1, 0), a3, voffA);
            PG8_WAIT_V(8); PG8_WAIT_L(0); PG8_BAR; PG8_MMA(1, 0, At, B0); PG8_MMA(1, 1, At, B1); PG8_BAR; PG8_SCHED;
            } else {
            PG8_LDB(B0, 0, 0); PG8_SCHED; PG8_LDA(At, 0, 0); PG8_STAGE(PG8_SA(1, 1), a1 + hstepA, voffA);
            PG8_WAIT_L(8); PG8_BAR; PG8_WAIT_L(0); PG8_MMA(0, 0, At, B0); PG8_BAR; PG8_SCHED;
            PG8_LDB(B1, 0, 1); PG8_STAGE(PG8_SB(0, 0), b2, voffB);
            PG8_BAR; PG8_WAIT_L(0); PG8_MMA(0, 1, At, B1); PG8_BAR;
            PG8_LDA(At, 0, 1); PG8_STAGE(PG8_SA(0, 0), a2, voffA);
            PG8_BAR; PG8_WAIT_L(0); PG8_MMA(1, 0, At, B0); PG8_BAR; PG8_SCHED;
            PG8_STAGE(PG8_SB(0, 1), b2 + hstep, voffB);
            PG8_WAIT_V(6); PG8_BAR; PG8_MMA(1, 1, At, B1); PG8_BAR;
            PG8_LDB(B0, 1, 0); PG8_SCHED; PG8_LDA(At, 1, 0); PG8_STAGE(PG8_SA(0, 1), a2 + hstepA, voffA);
            PG8_WAIT_L(8); PG8_BAR; PG8_WAIT_L(0); PG8_MMA(0, 0, At, B0); PG8_BAR; PG8_SCHED;
            PG8_LDB(B1, 1, 1); PG8_STAGE(PG8_SB(1, 0), b3, voffB);
            PG8_BAR; PG8_WAIT_L(0); PG8_MMA(0, 1, At, B1); PG8_BAR;
            PG8_LDA(At, 1, 1); PG8_STAGE(PG8_SA(1, 0), a3, voffA);
            PG8_BAR; PG8_WAIT_L(0); PG8_MMA(1, 0, At, B0); PG8_BAR; PG8_SCHED;
            PG8_STAGE(PG8_SB(1, 1), b3 + hstep, voffB);
            PG8_WAIT_V(6); PG8_BAR; PG8_MMA(1, 1, At, B1); PG8_BAR;
            }
        }
        if constexpr (ALIGN_EPI) { if (wr == 0) PG8_BAR; }
        if constexpr (!Epi::AFTER_DRAIN) { E(acc, cur, wr, wc, fr, fq); if (PROBE == 8 && Epi::PROBE_TWICE) { asm volatile("" ::: "memory"); E(acc, cur, wr, wc, fr, fq); } S.done(cur); }
        if (!has_next) break;
#pragma unroll
        for (int a = 0; a < 2; ++a)
#pragma unroll
            for (int b = 0; b < 2; ++b)
#pragma unroll
                for (int m = 0; m < 4; ++m)
#pragma unroll
                    for (int n = 0; n < 2; ++n) acc[a][b][m][n] = (f32x4){0.f, 0.f, 0.f, 0.f};
        cur = nxt; cA = nA; cB = nB; ++ui;
        if constexpr (ALIGN_EPI) { if (wr == 1) PG8_BAR; }
    }
    PG8_WAIT_V(0);
    if constexpr (!ALIGN_EPI) { if (wr == 0) PG8_BAR; }
    PG8_BAR;
    if constexpr (Epi::AFTER_DRAIN) { E.fused(acc, cur, wr, wc, fr, fq, lds, wid, lane); S.done(cur); }
#undef PG8_SA
#undef PG8_SB
#undef PG8_STAGE
#undef PG8_LDA
#undef PG8_LDB
#undef PG8_MMA
#undef PG8_WAIT_V
#undef PG8_WAIT_L
#undef PG8_BAR
#undef PG8_SCHED
}
}

constexpr int NWAVES = 8;
constexpr int BATCH = 2, SEQ = 8192, D = 1024, DEPTH = 4, M = BATCH * SEQ;
constexpr int GH = 2048, GH2 = 4096, SGU_G = 8, SGU_P = 128, SGU_C = 256;
constexpr int NH = 16, HD = 64, NREL = 192, CHUNK = 64;
constexpr int FF = 2816, FF2 = 5632;
constexpr float EPS = 1e-6f;
constexpr float LOG2E = 1.4426950408889634f;
constexpr float QSCALE = 0.125f * LOG2E;

#ifndef MK_PER_PHASE
#define MK_PER_PHASE 0
#endif
constexpr int N_PHASES = 22;

constexpr size_t MiB = 1u << 20;
constexpr size_t WS_CTL = 0, CTL_ZERO_BYTES = 64 * 1024;
constexpr size_t WS_XSS = 1 * MiB;
constexpr size_t WS_VSS = 2 * MiB;
constexpr size_t WS_W = 4 * MiB;
constexpr size_t WS_XB = 110 * MiB;
constexpr size_t WS_ACT = 142 * MiB;
constexpr size_t WS_END = 270 * MiB;
constexpr size_t WO_IN = 0, WO_AOUT = 8388608, WO_QKV = 12582912, WO_BOUT = 18874368, WO_GU = 20971520, WO_DN = 44040192, WO_END = 55574528;
static_assert(WS_W + WO_END * 2 <= WS_XB && WS_XB + (size_t)M * D * 2 <= WS_ACT && WS_ACT + (size_t)M * GH2 * 2 <= WS_END, "d_ws map");
constexpr int CW_BAR = 1024;

constexpr int RING_OFF = 0, RING_BYTES = 131072;
constexpr int LDSCTL_OFF = RING_BYTES, MISC_OFF = LDSCTL_OFF + 320;
constexpr int LDS_BYTES = 147456;
static_assert(MISC_OFF + 128 <= LDS_BYTES, "LDS map");

#define GAS __attribute__((address_space(1)))
#define LAS __attribute__((address_space(3)))
typedef unsigned short bf16;
typedef unsigned v4u __attribute__((ext_vector_type(4)));
typedef unsigned v2u __attribute__((ext_vector_type(2)));
typedef float f32x4 __attribute__((ext_vector_type(4)));
typedef float f32x16 __attribute__((ext_vector_type(16)));
typedef short bf16x8 __attribute__((ext_vector_type(8)));
typedef short s16x4 __attribute__((ext_vector_type(4)));
typedef GAS unsigned gu32;
#define RLX_AGENT __ATOMIC_RELAXED, __HIP_MEMORY_SCOPE_AGENT
#define LDS_WAIT() asm volatile("s_waitcnt lgkmcnt(0)" ::: "memory")
#define VM_WAIT() asm volatile("s_waitcnt vmcnt(0)" ::: "memory")
__device__ __forceinline__ unsigned pk2(float lo, float hi) { return pg8::cvt_pk_bf16(lo, hi); }
__device__ __forceinline__ float bf_lo(unsigned w) { return __uint_as_float(w << 16); }
__device__ __forceinline__ float bf_hi(unsigned w) { return __uint_as_float(w & 0xffff0000u); }
__device__ __forceinline__ float wave_sum(float v) {
#pragma unroll
    for (int o = 1; o < 64; o <<= 1) v += __shfl_xor(v, o);
    return v;
}
#define XB_TMO      128
#define XB_XCNT(j)  (256  + 64 * (j))
#define XB_XSUB(j)  (1280 + 64 * (j))
#define XB_XGEN(j)  (2304 + 64 * (j))
#define XB_TOP      3328
#define XB_TOPGEN   3392
#define XCD_BAR_WORDS 3456
#define XB_SPIN_CAP (1u << 18)

__device__ __forceinline__ unsigned xb_ld(unsigned* p)              { return __hip_atomic_load(p, __ATOMIC_RELAXED, __HIP_MEMORY_SCOPE_AGENT); }
__device__ __forceinline__ unsigned xb_add(unsigned* p, unsigned v) { return __hip_atomic_fetch_add(p, v, __ATOMIC_RELAXED, __HIP_MEMORY_SCOPE_AGENT); }
__device__ __forceinline__ unsigned xb_xcc_id() { return (unsigned)__builtin_amdgcn_s_getreg((3 << 11) | 20) & 0xFu; }
#define XB_SPIN(cond, bar) do { unsigned _sp = 0; while (cond) { __builtin_amdgcn_s_sleep(1); \
    if ((++_sp & 255u) == 0u) { if (xb_ld(&(bar)[XB_TMO])) break; if (_sp > XB_SPIN_CAP) { atomicAdd(&(bar)[XB_TMO], 1u); break; } } } } while (0)

struct XcdBarrier {
    unsigned* bar; unsigned x;
    volatile LAS unsigned* st;
};

__device__ __forceinline__ XcdBarrier xcd_barrier_post(unsigned* bar, volatile LAS unsigned* st) {
    XcdBarrier b; b.bar = bar; b.x = xb_xcc_id(); b.st = st;
    if (threadIdx.x == 0) (void)xb_add(&bar[XB_XCNT(b.x)], 1u);
    return b;
}
__device__ __forceinline__ void xcd_barrier_complete(unsigned* bar, unsigned x, unsigned& nloc, unsigned& nx) {
    const unsigned G = gridDim.x * gridDim.y * gridDim.z;
    unsigned sum, cnt, mine, sp = 0u;
    for (;;) {
        sum = 0u; cnt = 0u; mine = 0u;
#pragma unroll
        for (unsigned j = 0; j < 16; ++j) { const unsigned c = xb_ld(&bar[XB_XCNT(j)]); sum += c; cnt += (c > 0u) ? 1u : 0u; mine = (j == x) ? c : mine; }
        if (sum == G) break;
        __builtin_amdgcn_s_sleep(1);
        if ((++sp & 255u) == 0u) { if (xb_ld(&bar[XB_TMO])) break; if (sp > XB_SPIN_CAP) { atomicAdd(&bar[XB_TMO], 1u); break; } }
    }
    nloc = mine > 0u ? mine : 1u; nx = cnt > 0u ? cnt : 1u;
}

__device__ __forceinline__ void xcd_barrier(const XcdBarrier& b) {
    asm volatile("s_waitcnt vmcnt(0)" ::: "memory");
    __syncthreads();
    if (threadIdx.x == 0) {
        unsigned* bar = b.bar;
        __builtin_amdgcn_s_waitcnt(0);
        unsigned nloc = b.st[0], nx = b.st[1];
        if (nloc == 0u) { xcd_barrier_complete(bar, b.x, nloc, nx); b.st[0] = nloc; b.st[1] = nx; }
        const unsigned old = xb_add(&bar[XB_XSUB(b.x)], 1u);
        const unsigned gen = old / nloc;
        if (old + 1u == (gen + 1u) * nloc) {
            __builtin_amdgcn_fence(__ATOMIC_RELEASE, "agent");
            asm volatile("s_waitcnt vmcnt(0)" ::: "memory");
            const unsigned og = xb_add(&bar[XB_TOP], 1u);
            const unsigned tg = og / nx;
            if (og + 1u == (tg + 1u) * nx) xb_add(&bar[XB_TOPGEN], 1u);
            else XB_SPIN(xb_ld(&bar[XB_TOPGEN]) == tg, bar);
            __builtin_amdgcn_fence(__ATOMIC_ACQUIRE, "agent");
            xb_add(&bar[XB_XGEN(b.x)], 1u);
            asm volatile("s_waitcnt vmcnt(0)" ::: "memory");
        } else {
            XB_SPIN(xb_ld(&bar[XB_XGEN(b.x)]) == gen, bar);
            __builtin_amdgcn_fence(__ATOMIC_ACQUIRE, "agent");
            asm volatile("s_waitcnt vmcnt(0)" ::: "memory");
        }
    }
    __syncthreads();
}

__device__ __forceinline__ void p0_transpose_item(const float* W, const float* gain, int K, int N, bf16* WT, int drow0, int k0, int n0, LAS unsigned* scr, int lane) {
    const int kp = lane >> 4, n4 = lane & 15;
    f32x4 w[8][2];
    const float* src = W + (size_t)(k0 + 2 * kp) * N + n0 + 4 * n4;
#pragma unroll
    for (int i = 0; i < 8; ++i) { w[i][0] = *(const f32x4*)(src + (size_t)(8 * i) * N); w[i][1] = *(const f32x4*)(src + (size_t)(8 * i + 1) * N); }
    if (gain) {
#pragma unroll
        for (int i = 0; i < 8; ++i) { const float g0 = gain[k0 + 8 * i + 2 * kp], g1 = gain[k0 + 8 * i + 2 * kp + 1]; w[i][0] = w[i][0] * g0; w[i][1] = w[i][1] * g1; }
    }
#pragma unroll
    for (int i = 0; i < 8; ++i)
#pragma unroll
        for (int e = 0; e < 4; ++e) scr[(4 * n4 + e) * 33 + 4 * i + kp] = pk2(w[i][0][e], w[i][1][e]);
    LDS_WAIT(); asm volatile("" ::: "memory");
    const int c = lane & 7;
#pragma unroll
    for (int jn = 0; jn < 8; ++jn) { const int n = (lane >> 3) + 8 * jn; const LAS unsigned* s = scr + n * 33 + 4 * c;
        v4u o; o.x = s[0]; o.y = s[1]; o.z = s[2]; o.w = s[3];
        pg8::store16(WT + (size_t)(drow0 + n) * K + k0 + 8 * c, o); }
    LDS_WAIT(); asm volatile("" ::: "memory");
}
struct Ptrs {
    const float *x, *norm_mix_g, *norm_ffn_g, *final_g, *a_w_in, *a_v_gain, *a_w_s, *a_b_s, *a_w_out, *b_w_qkv, *b_rel_bias, *b_w_out, *ffn_w_gate, *ffn_w_up, *ffn_w_down;
    float* out; bf16* wt; bf16* xb; bf16* act; float* xss; float* vss;
};
__device__ __forceinline__ void p0_prologue(const Ptrs& P, LAS unsigned char* lds, int vcu, int G, int wave, int lane) {
    LAS unsigned* scr = (LAS unsigned*)(lds + RING_OFF + wave * 16384);
    const int gw = vcu * NWAVES + wave, NGW = G * NWAVES;
    constexpr int I_IN = 16 * 64, I_AOUT = 32 * 16, I_QKV = 16 * 48, I_BOUT = 16 * 16, I_GU = 16 * 44, I_DN = 44 * 16;
    constexpr int NITEMS = 2 * I_IN + 2 * I_AOUT + 2 * I_QKV + 2 * I_BOUT + 8 * I_GU + 4 * I_DN;
    for (int it = gw; it < NITEMS; it += NGW) {
        int r = it; const float* W; const float* gain = nullptr; bf16* dst; int K, N, mode = 0;
        if (r < 2 * I_IN) { const int j = r / I_IN; r -= j * I_IN; W = P.a_w_in + (size_t)j * D * GH2; gain = P.norm_mix_g + (2 * j) * D; K = D; N = GH2; dst = P.wt + WO_IN + (size_t)j * D * GH2; }
        else if ((r -= 2 * I_IN) < 2 * I_AOUT) { const int j = r / I_AOUT; r -= j * I_AOUT; W = P.a_w_out + (size_t)j * GH * D; K = GH; N = D; dst = P.wt + WO_AOUT + (size_t)j * GH * D; }
        else if ((r -= 2 * I_AOUT) < 2 * I_QKV) { const int j = r / I_QKV; r -= j * I_QKV; W = P.b_w_qkv + (size_t)j * D * 3 * D; gain = P.norm_mix_g + (2 * j + 1) * D; K = D; N = 3 * D; dst = P.wt + WO_QKV + (size_t)j * D * 3 * D; }
        else if ((r -= 2 * I_QKV) < 2 * I_BOUT) { const int j = r / I_BOUT; r -= j * I_BOUT; W = P.b_w_out + (size_t)j * D * D; K = D; N = D; dst = P.wt + WO_BOUT + (size_t)j * D * D; }
        else if ((r -= 2 * I_BOUT) < 4 * I_GU) { const int i = r / I_GU; r -= i * I_GU; W = P.ffn_w_gate + (size_t)i * D * FF; gain = P.norm_ffn_g + i * D; K = D; N = FF; dst = P.wt + WO_GU + (size_t)i * D * FF2; mode = 1; }
        else if ((r -= 4 * I_GU) < 4 * I_GU) { const int i = r / I_GU; r -= i * I_GU; W = P.ffn_w_up + (size_t)i * D * FF; gain = P.norm_ffn_g + i * D; K = D; N = FF; dst = P.wt + WO_GU + (size_t)i * D * FF2; mode = 2; }
        else { r -= 4 * I_GU; const int i = r / I_DN; r -= i * I_DN; W = P.ffn_w_down + (size_t)i * FF * D; K = FF; N = D; dst = P.wt + WO_DN + (size_t)i * FF * D; }
        const int nblk = N / 64, kb = r / nblk, nb = r % nblk, k0 = 64 * kb, n0 = 64 * nb;
        const int drow0 = (mode == 0) ? n0 : ((n0 >> 7) * 256 + (n0 & 127) + (mode == 2 ? 128 : 0));
        p0_transpose_item(W, gain, K, N, dst, drow0, k0, n0, scr, lane);
    }
    for (int m = gw; m < M; m += 2 * NGW) {
        const int m2 = (m + NGW < M) ? m + NGW : m;
        const GAS f32x4* xr = (const GAS f32x4*)(P.x + (size_t)m * D) + lane; const GAS f32x4* xr2 = (const GAS f32x4*)(P.x + (size_t)m2 * D) + lane; f32x4 v[4], v2[4]; float s = 0.f, s2 = 0.f;
#pragma unroll
        for (int j = 0; j < 4; ++j) { v[j] = xr[64 * j]; v2[j] = xr2[64 * j]; }
#pragma unroll
        for (int j = 0; j < 4; ++j) { s += (v[j].x * v[j].x + v[j].y * v[j].y) + (v[j].z * v[j].z + v[j].w * v[j].w); s2 += (v2[j].x * v2[j].x + v2[j].y * v2[j].y) + (v2[j].z * v2[j].z + v2[j].w * v2[j].w); }
        s = wave_sum(s); s2 = wave_sum(s2);
        GAS unsigned long long* o8 = (GAS unsigned long long*)(P.xb + (size_t)m * D) + lane; GAS unsigned long long* o82 = (GAS unsigned long long*)(P.xb + (size_t)m2 * D) + lane;
#pragma unroll
        for (int j = 0; j < 4; ++j) { o8[64 * j] = (unsigned long long)pk2(v[j].x, v[j].y) | ((unsigned long long)pk2(v[j].z, v[j].w) << 32);
            o82[64 * j] = (unsigned long long)pk2(v2[j].x, v2[j].y) | ((unsigned long long)pk2(v2[j].z, v2[j].w) << 32); }
        if (lane < pg8::NSLOT_X) { P.xss[(size_t)m * pg8::NSLOT_X + lane] = (lane == 0) ? s : 0.f; P.xss[(size_t)m2 * pg8::NSLOT_X + lane] = (lane == 0) ? s2 : 0.f; }
    }
}

constexpr int SP_A_PITCH = 272, SP_V_PITCH = 528;
constexpr int SP_A_OFF = 0, SP_V_OFF = 36864, SP_R_OFF = 106496;
typedef short v4i16_t __attribute__((ext_vector_type(4)));
__device__ __forceinline__ s16x4 tr_read(const LAS unsigned char* p) { return __builtin_bit_cast(s16x4, __builtin_amdgcn_ds_read_tr16_b64_v4i16((LAS v4i16_t*)p)); }
template <bool DRY> __device__ __forceinline__ void spatial_phase(const Ptrs& P, int j, LAS unsigned char* lds, int vcu, int G, int tid, int wave, int lane) {
    asm volatile("" : "+v"(tid), "+v"(lane));
    bf16* uv = P.act;
    LAS unsigned char* Aimg = lds + SP_A_OFF; LAS unsigned char* Vimg = lds + SP_V_OFF; LAS float* rsL = (LAS float*)(lds + SP_R_OFF);
    const int fr = lane & 15, fq = lane >> 4;
    for (int unit = vcu; unit < (M / SGU_P) * SGU_G; unit += G) {
        const int nb = unit >> 3, g = unit & 7, row0 = nb * SGU_P;
        if (tid < SGU_P) { const f32x4* p = (const f32x4*)(P.vss + (size_t)(row0 + tid) * pg8::NSLOT_V); float s = 0.f;
#pragma unroll
            for (int k = 0; k < 8; ++k) { const f32x4 v = p[k]; s += (v[0] + v[1]) + (v[2] + v[3]); }
            rsL[tid] = __builtin_amdgcn_rsqf(s * (1.0f / GH) + EPS); }
        { v4u t[8];
#pragma unroll
            for (int i = 0; i < 8; ++i) { const int pc = tid + 512 * i, q = pc >> 5, ch = pc & 31; t[i] = *(const v4u*)(uv + (size_t)(row0 + q) * GH2 + GH + g * SGU_C + ch * 8); }
#pragma unroll
            for (int i = 0; i < 8; ++i) { const int pc = tid + 512 * i, q = pc >> 5, ch = pc & 31; *(LAS v4u*)(Vimg + q * SP_V_PITCH + ch * 16) = t[i]; } }
        __syncthreads();
        { const float* ws = P.a_w_s + ((size_t)j * SGU_G + g) * SGU_P * SGU_P;
#pragma unroll
            for (int i = 0; i < 4; ++i) { const int e = tid + 512 * i, p = e >> 4, q0 = (e & 15) * 8;
                const f32x4 w0 = *(const f32x4*)(ws + p * SGU_P + q0), w1 = *(const f32x4*)(ws + p * SGU_P + q0 + 4);
                const f32x4 r0 = *(const LAS f32x4*)(rsL + q0), r1 = *(const LAS f32x4*)(rsL + q0 + 4);
                v4u o; o.x = pk2(w0[0] * r0[0], w0[1] * r0[1]); o.y = pk2(w0[2] * r0[2], w0[3] * r0[3]); o.z = pk2(w1[0] * r1[0], w1[1] * r1[1]); o.w = pk2(w1[2] * r1[2], w1[3] * r1[3]);
                *(LAS v4u*)(Aimg + p * SP_A_PITCH + q0 * 2) = o; } }
        __syncthreads();
        bf16x8 vf[2][4];
        { const LAS unsigned char* vb = Vimg + (8 * fq + ((lane & 15) >> 2)) * SP_V_PITCH + (32 * wave + 8 * (lane & 3)) * 2;
#pragma unroll
            for (int ks = 0; ks < 4; ++ks)
#pragma unroll
                for (int n = 0; n < 2; ++n) { const s16x4 lo = tr_read(vb + ks * 32 * SP_V_PITCH + n * 8), hi = tr_read(vb + ks * 32 * SP_V_PITCH + 4 * SP_V_PITCH + n * 8);
                    vf[n][ks] = (bf16x8){lo[0], lo[1], lo[2], lo[3], hi[0], hi[1], hi[2], hi[3]}; } }
        const int cc = g * SGU_C + 32 * wave + 8 * fq;
        const f32x4 gn0 = *(const f32x4*)(P.a_v_gain + (size_t)j * GH + cc), gn1 = *(const f32x4*)(P.a_v_gain + (size_t)j * GH + cc + 4);
#pragma unroll
        for (int pt = 0; pt < 8; ++pt) {
            f32x4 a0 = {0.f, 0.f, 0.f, 0.f}, a1 = {0.f, 0.f, 0.f, 0.f};
            const LAS unsigned char* ab = Aimg + (16 * pt + fr) * SP_A_PITCH + (8 * fq) * 2;
#pragma unroll
            for (int ks = 0; ks < 4; ++ks) if (ks < (pt < 4 ? 2 : 4)) { const bf16x8 af = *(const LAS bf16x8*)(ab + ks * 64);
                a0 = __builtin_amdgcn_mfma_f32_16x16x32_bf16(vf[0][ks], af, a0, 0, 0, 0); a1 = __builtin_amdgcn_mfma_f32_16x16x32_bf16(vf[1][ks], af, a1, 0, 0, 0); }
            const int p = 16 * pt + fr; bf16* up = uv + (size_t)(row0 + p) * GH2 + cc;
            const float b = P.a_b_s[((size_t)j * SGU_G + g) * SGU_P + p];
            const v4u u8 = *(const v4u*)up;
            v4u o;
            o.x = pk2(bf_lo(u8.x) * (gn0[0] * a0[0] + b), bf_hi(u8.x) * (gn0[1] * a0[1] + b)); o.y = pk2(bf_lo(u8.y) * (gn0[2] * a0[2] + b), bf_hi(u8.y) * (gn0[3] * a0[3] + b));
            o.z = pk2(bf_lo(u8.z) * (gn1[0] * a1[0] + b), bf_hi(u8.z) * (gn1[1] * a1[1] + b)); o.w = pk2(bf_lo(u8.w) * (gn1[2] * a1[2] + b), bf_hi(u8.w) * (gn1[3] * a1[3] + b));
            if (DRY) *(v4u*)(P.xb + (size_t)(row0 + p) * D + (g & 3) * SGU_C + 32 * wave + 8 * fq) = o; else pg8::store16(up, o);
        }
        __syncthreads();
    }
}

constexpr int AT_K = 0, AT_V = 16384, AT_BT = 32768, AT_WS = 33792, AT_OST = 36864;
__device__ __forceinline__ int crow(int r, int hi) { return (r & 3) + 8 * (r >> 2) + 4 * hi; }
template <bool DRY> __device__ __forceinline__ void attn_phase(const Ptrs& P, int j, LAS unsigned char* lds, int vcu, int G, int tid, int wave, int lane) {
    asm volatile("" : "+v"(tid), "+v"(lane));
    bf16* Q = P.act; const bf16* Kt = P.act + (size_t)M * D; const bf16* Vt = P.act + (size_t)2 * M * D;
    const int r32 = lane & 31, hi = lane >> 5, ci = wave >> 1, qh = wave & 1;
    LAS float* bt = (LAS float*)(lds + AT_BT); LAS float* wsf = (LAS float*)(lds + AT_WS) + wave * 64;
    const int srow = tid >> 3, sch = tid & 7;
    for (int unit = vcu; unit < BATCH * NH * (SEQ / 256); unit += G) {
        const int bh = unit >> 5, cq = unit & 31, b = bh >> 4, h = bh & 15;
        const size_t rowbase = (size_t)b * SEQ;
        if (tid < NREL) bt[tid] = P.b_rel_bias[((size_t)j * NH + h) * NREL + tid] * LOG2E;
        const size_t qrow = rowbase + (size_t)(4 * cq + ci) * CHUNK + 32 * qh;
        bf16x8 qr[4];
#pragma unroll
        for (int d0 = 0; d0 < 4; ++d0) qr[d0] = *(const bf16x8*)(Q + (qrow + r32) * D + h * HD + d0 * 16 + hi * 8);
        float mrun = -1e30f, lrun = 0.f; f32x16 o0 = {}, o1 = {};
        const int s_lo = (4 * cq >= 8) ? 0 : 8 - 4 * cq;
        v4u kreg, vreg;
        { const size_t kr = (rowbase + (size_t)(4 * cq - 8 + s_lo) * CHUNK + srow) * D + h * HD + sch * 8; kreg = *(const v4u*)(Kt + kr); vreg = *(const v4u*)(Vt + kr); }
        { const int sl = (s_lo & 1) * 8192; *(LAS v4u*)(lds + AT_K + sl + sch * 1024 + srow * 16) = kreg; *(LAS v4u*)(lds + AT_V + sl + (sch >> 2) * 4096 + srow * 64 + (sch & 3) * 16) = vreg; }
        for (int s = s_lo; s < 12; ++s) {
            __syncthreads();
            if (s + 1 < 12) { const size_t kr = (rowbase + (size_t)(4 * cq - 8 + s + 1) * CHUNK + srow) * D + h * HD + sch * 8; kreg = *(const v4u*)(Kt + kr); vreg = *(const v4u*)(Vt + kr); }
            const int delta = ci + 8 - s;
            if (delta >= 0 && delta <= 8) {
                const LAS unsigned char* Ks = lds + AT_K + (s & 1) * 8192; const LAS unsigned char* Vs = lds + AT_V + (s & 1) * 8192;
                f32x16 p0, p1;
                { const float c0 = (delta >= 3) ? bt[NREL - 1] : 0.f;
#pragma unroll
                    for (int r = 0; r < 16; ++r) { p0[r] = c0; p1[r] = c0; } }
                { const LAS unsigned char* kb = Ks + hi * 1024 + r32 * 16;
#pragma unroll
                    for (int d0 = 0; d0 < 4; ++d0) { const bf16x8 k0 = *(const LAS bf16x8*)(kb + d0 * 2048), k1 = *(const LAS bf16x8*)(kb + d0 * 2048 + 512);
                        p0 = __builtin_amdgcn_mfma_f32_32x32x16_bf16(k0, qr[d0], p0, 0, 0, 0); p1 = __builtin_amdgcn_mfma_f32_32x32x16_bf16(k1, qr[d0], p1, 0, 0, 0); } }
                if (delta < 3) {
                    const int base = 64 * delta + 32 * qh + r32 + 63;
#pragma unroll
                    for (int r = 0; r < 16; ++r) { const int k0 = crow(r, hi); int i0 = base - k0, i1 = base - k0 - 32; i0 = i0 > NREL - 1 ? NREL - 1 : i0; i1 = i1 > NREL - 1 ? NREL - 1 : i1; i0 = i0 < 0 ? 0 : i0; i1 = i1 < 0 ? 0 : i1;
                        p0[r] += bt[i0]; p1[r] += bt[i1]; }
                }
                float mx = p0[0];
#pragma unroll
                for (int r = 1; r < 16; ++r) mx = fmaxf(mx, p0[r]);
#pragma unroll
                for (int r = 0; r < 16; ++r) mx = fmaxf(mx, p1[r]);
                mx = fmaxf(mx, __shfl_xor(mx, 32));
                const float mnew = fmaxf(mrun, mx), alpha = __builtin_amdgcn_exp2f(mrun - mnew);
                float psum = 0.f;
#pragma unroll
                for (int r = 0; r < 16; ++r) { p0[r] = __builtin_amdgcn_exp2f(p0[r] - mnew); p1[r] = __builtin_amdgcn_exp2f(p1[r] - mnew); psum += p0[r] + p1[r]; }
                lrun = lrun * alpha + psum; mrun = mnew;
                if (hi == 0) wsf[r32] = alpha;
#pragma unroll
                for (int r = 0; r < 16; ++r) { const float f = wsf[crow(r, hi)]; o0[r] *= f; o1[r] *= f; }
                v4u pw[4];
                pw[0] = (v4u){pk2(p0[0], p0[1]), pk2(p0[2], p0[3]), pk2(p0[4], p0[5]), pk2(p0[6], p0[7])};
                pw[1] = (v4u){pk2(p0[8], p0[9]), pk2(p0[10], p0[11]), pk2(p0[12], p0[13]), pk2(p0[14], p0[15])};
                pw[2] = (v4u){pk2(p1[0], p1[1]), pk2(p1[2], p1[3]), pk2(p1[4], p1[5]), pk2(p1[6], p1[7])};
                pw[3] = (v4u){pk2(p1[8], p1[9]), pk2(p1[10], p1[11]), pk2(p1[12], p1[13]), pk2(p1[14], p1[15])};
                const LAS unsigned char* vb = Vs + ((lane >> 4) & 1) * 32 + (lane & 3) * 8 + (4 * hi + ((lane & 15) >> 2)) * 64;
#pragma unroll
                for (int ks = 0; ks < 4; ++ks) { const bf16x8 pa = __builtin_bit_cast(bf16x8, pw[ks]);
                    { const s16x4 lo = tr_read(vb + ks * 1024), hh = tr_read(vb + ks * 1024 + 512); const bf16x8 vfr = (bf16x8){lo[0], lo[1], lo[2], lo[3], hh[0], hh[1], hh[2], hh[3]};
                        o0 = __builtin_amdgcn_mfma_f32_32x32x16_bf16(pa, vfr, o0, 0, 0, 0); }
                    { const s16x4 lo = tr_read(vb + 4096 + ks * 1024), hh = tr_read(vb + 4096 + ks * 1024 + 512); const bf16x8 vfr = (bf16x8){lo[0], lo[1], lo[2], lo[3], hh[0], hh[1], hh[2], hh[3]};
                        o1 = __builtin_amdgcn_mfma_f32_32x32x16_bf16(pa, vfr, o1, 0, 0, 0); } }
            }
            if (s + 1 < 12) { const int sl = ((s + 1) & 1) * 8192; *(LAS v4u*)(lds + AT_K + sl + sch * 1024 + srow * 16) = kreg; *(LAS v4u*)(lds + AT_V + sl + (sch >> 2) * 4096 + srow * 64 + (sch & 3) * 16) = vreg; }
        }
        lrun += __shfl_xor(lrun, 32);
        if (hi == 0) wsf[32 + r32] = lrun;
        { LAS bf16* stg = (LAS bf16*)(lds + AT_OST) + wave * 2048;
#pragma unroll
            for (int r = 0; r < 16; ++r) { const int orow = crow(r, hi); const float rl = __builtin_amdgcn_rcpf(wsf[32 + orow]);
                stg[orow * 64 + r32] = (bf16)(pk2(o0[r] * rl, 0.f) & 0xffffu); stg[orow * 64 + 32 + r32] = (bf16)(pk2(o1[r] * rl, 0.f) & 0xffffu); }
            bf16* Ow = (DRY ? P.xb : Q) + qrow * D + h * HD;
#pragma unroll
            for (int i = 0; i < 4; ++i) { const int row = i * 8 + (lane >> 3), ch = lane & 7; const v4u v = *(const LAS v4u*)(stg + row * 64 + ch * 8); pg8::store16(Ow + (size_t)row * D + ch * 8, v); } }
        __syncthreads();
    }
}

__device__ __forceinline__ void final_phase(const Ptrs& P, int vcu, int G, int wave, int lane) {
    const int gw = vcu * NWAVES + wave, NGW = G * NWAVES;
    f32x4 gn[4];
#pragma unroll
    for (int j = 0; j < 4; ++j) gn[j] = ((const f32x4*)P.final_g)[lane + 64 * j];
    for (int m = gw; m < M; m += NGW) {
        const f32x4 sv = *(const f32x4*)(P.xss + (size_t)m * pg8::NSLOT_X + (lane & 3) * 4);
        float s = (sv[0] + sv[1]) + (sv[2] + sv[3]); s += __shfl_xor(s, 1); s += __shfl_xor(s, 2);
        const float r = __builtin_amdgcn_rsqf(s * (1.0f / D) + EPS);
        GAS f32x4* xr = (GAS f32x4*)(P.out + (size_t)m * D) + lane;
#pragma unroll
        for (int j = 0; j < 4; ++j) { const f32x4 v = xr[64 * j]; xr[64 * j] = v * r * gn[j]; }
    }
}

struct Args { const float* in[15]; float* out; unsigned char* ws; int ph_lo, ph_hi; };
static_assert(sizeof(Args) == 17 * 8 + 8, "Args has no padding");
__global__ void __launch_bounds__(NWAVES * 64, 2) trunk_fwd(Args args) {
    extern __shared__ __attribute__((aligned(16))) unsigned char lds_raw[];
    LAS unsigned char* lds = (LAS unsigned char*)lds_raw;
    volatile LAS unsigned* MISC = (volatile LAS unsigned*)(lds + MISC_OFF);
    const int tid = threadIdx.x, lane = tid & 63, wave = __builtin_amdgcn_readfirstlane(tid >> 6);
    const int G = gridDim.x; const int bx = blockIdx.x; const int vcu = (G % 8 == 0) ? (bx % 8) * (G / 8) + bx / 8 : bx;
    unsigned char* ws = args.ws;
    gu32* ctl = (gu32*)(ws + WS_CTL);
    Ptrs P;
    P.x = args.in[0]; P.norm_mix_g = args.in[1]; P.norm_ffn_g = args.in[2]; P.final_g = args.in[3]; P.a_w_in = args.in[4]; P.a_v_gain = args.in[5]; P.a_w_s = args.in[6]; P.a_b_s = args.in[7];
    P.a_w_out = args.in[8]; P.b_w_qkv = args.in[9]; P.b_rel_bias = args.in[10]; P.b_w_out = args.in[11]; P.ffn_w_gate = args.in[12]; P.ffn_w_up = args.in[13]; P.ffn_w_down = args.in[14];
    P.out = args.out; P.wt = (bf16*)(ws + WS_W); P.xb = (bf16*)(ws + WS_XB); P.act = (bf16*)(ws + WS_ACT); P.xss = (float*)(ws + WS_XSS); P.vss = (float*)(ws + WS_VSS);
    for (int u = tid; u < (LDS_BYTES - LDSCTL_OFF) / 4; u += NWAVES * 64) ((LAS unsigned*)(lds + LDSCTL_OFF))[u] = 0u;
    __syncthreads();
    XcdBarrier bar; bar.bar = (unsigned*)(ctl + CW_BAR); bar.x = 0; bar.st = nullptr;
    if (!MK_PER_PHASE) bar = xcd_barrier_post((unsigned*)(ctl + CW_BAR), MISC + 8);
    const int lo = args.ph_lo, hi = args.ph_hi;
#ifndef DBG_MASK
#define DBG_MASK 0xff
#endif
#define IN(k) (lo <= (k) && (k) < hi)
#define SEAM(k) do { if (IN(k) && IN((k) + 1)) { xcd_barrier(bar); if (PROBE == 1) xcd_barrier(bar); } } while (0)

    if ((DBG_MASK & 1) && IN(0)) { p0_prologue(P, lds, vcu, G, wave, lane); if (PROBE == 2) { __syncthreads(); p0_prologue(P, lds, vcu, G, wave, lane); } }
    SEAM(0);
#pragma unroll 1
    for (int layer = 0; layer < DEPTH; ++layer) {
        const int j = layer >> 1, ph = 1 + 5 * layer;
        const bf16* wgu = P.wt + WO_GU + (size_t)layer * D * FF2; const bf16* wdn = P.wt + WO_DN + (size_t)layer * FF * D;
        if ((layer & 1) == 0) {
            if ((DBG_MASK & 2) && IN(ph)) { pg8::Gemm g{P.xb, P.wt + WO_IN + (size_t)j * D * GH2, M, GH2, D, D}; pg8::StaticOrder S; S.init(M, GH2, G, bx);
                pg8::EpiGeluStats E{P.act, GH2, P.xss, P.vss, GH / 256, EPS};
                pg8::gemm_phase<pg8::EpiGeluStats, pg8::StaticOrder, true, true>(lds + RING_OFF, g, S, E);
                if (PROBE == 5) { __syncthreads(); pg8::gemm_phase<pg8::EpiGeluStats, pg8::StaticOrder, true, true>(lds + RING_OFF, g, S, E); } }
            SEAM(ph);
            if ((DBG_MASK & 4) && IN(ph + 1)) { if (PROBE == 4) spatial_phase<true>(P, j, lds, vcu, G, tid, wave, lane); spatial_phase<false>(P, j, lds, vcu, G, tid, wave, lane); }
            SEAM(ph + 1);
            if ((DBG_MASK & 8) && IN(ph + 2)) { pg8::Gemm g{P.act, P.wt + WO_AOUT + (size_t)j * GH * D, M, D, GH, GH2}; pg8::StaticOrder S; S.init(M, D, G, bx);
                pg8::EpiResid E{layer == 0 ? P.x : P.out, P.out, P.xb, P.xss, D};
                pg8::gemm_phase<pg8::EpiResid, pg8::StaticOrder, false, true>(lds + RING_OFF, g, S, E); }
            SEAM(ph + 2);
        } else {
            if ((DBG_MASK & 16) && IN(ph)) { pg8::Gemm g{P.xb, P.wt + WO_QKV + (size_t)j * D * 3 * D, M, 3 * D, D, D}; pg8::StaticOrder S; S.init(M, 3 * D, G, bx);
                pg8::EpiQkv E{P.act, D, (size_t)M * D, P.xss, EPS, QSCALE};
                pg8::gemm_phase<pg8::EpiQkv, pg8::StaticOrder, true, true>(lds + RING_OFF, g, S, E);
                if (PROBE == 7) { __syncthreads(); pg8::gemm_phase<pg8::EpiQkv, pg8::StaticOrder, true, true>(lds + RING_OFF, g, S, E); } }
            SEAM(ph);
            if ((DBG_MASK & 32) && IN(ph + 1)) { if (PROBE == 3) attn_phase<true>(P, j, lds, vcu, G, tid, wave, lane); attn_phase<false>(P, j, lds, vcu, G, tid, wave, lane); }
            SEAM(ph + 1);
            if ((DBG_MASK & 8) && IN(ph + 2)) { pg8::Gemm g{P.act, P.wt + WO_BOUT + (size_t)j * D * D, M, D, D, D}; pg8::StaticOrder S; S.init(M, D, G, bx);
                pg8::EpiResid E{P.out, P.out, P.xb, P.xss, D};
                pg8::gemm_phase<pg8::EpiResid, pg8::StaticOrder, false, true>(lds + RING_OFF, g, S, E); }
            SEAM(ph + 2);
        }
        if ((DBG_MASK & 64) && IN(ph + 3)) { pg8::Gemm g{P.xb, wgu, M, FF2, D, D}; pg8::StaticOrder S; S.init(M, FF2, G, bx);
            pg8::EpiSwiglu E{P.act, FF, P.xss, EPS};
            pg8::gemm_phase<pg8::EpiSwiglu, pg8::StaticOrder, true, true>(lds + RING_OFF, g, S, E);
            if (PROBE == 6) { __syncthreads(); pg8::gemm_phase<pg8::EpiSwiglu, pg8::StaticOrder, true, true>(lds + RING_OFF, g, S, E); } }
        SEAM(ph + 3);
        if ((DBG_MASK & 8) && IN(ph + 4)) { pg8::Gemm g{P.act, wdn, M, D, FF, FF}; pg8::StaticOrder S; S.init(M, D, G, bx);
            pg8::EpiResid E{P.out, P.out, P.xb, P.xss, D};
            pg8::gemm_phase<pg8::EpiResid, pg8::StaticOrder, false, true>(lds + RING_OFF, g, S, E); }
        SEAM(ph + 4);
    }
    if ((DBG_MASK & 128) && IN(N_PHASES - 1)) final_phase(P, vcu, G, wave, lane);
#undef IN
#undef SEAM
}

extern "C" void kernel_launch(void* const* d_in, const int* in_sizes, int n_in, void* d_out, int out_size, void* d_ws, size_t ws_size, hipStream_t stream) {
    static int grid = 0;
    if (grid == 0) {
        if (n_in != 15 || in_sizes[0] != M * D || out_size != M * D || ws_size < WS_END) { fprintf(stderr, "kernel_launch: unexpected shapes (n_in %d, in0 %d, out %d, ws %zu < %zu); nothing launched\n", n_in, n_in > 0 ? in_sizes[0] : -1, out_size, ws_size, (size_t)WS_END); grid = -1; return; }
        int dev = 0, cus = 0, per_cu = 0;
        if (hipGetDevice(&dev) != hipSuccess || hipDeviceGetAttribute(&cus, hipDeviceAttributeMultiprocessorCount, dev) != hipSuccess) { grid = -1; return; }
        if (hipFuncSetAttribute((const void*)trunk_fwd, hipFuncAttributeMaxDynamicSharedMemorySize, LDS_BYTES) != hipSuccess) { fprintf(stderr, "kernel_launch: hipFuncSetAttribute failed\n"); grid = -1; return; }
        if (hipOccupancyMaxActiveBlocksPerMultiprocessor(&per_cu, (const void*)trunk_fwd, NWAVES * 64, LDS_BYTES) != hipSuccess || per_cu < 1) { fprintf(stderr, "kernel_launch: occupancy query reports %d workgroups per CU; nothing launched\n", per_cu); (void)hipGetLastError(); grid = -1; return; }
        grid = cus;
    }
    if (grid < 0) return;
    if (hipMemsetAsync((char*)d_ws + WS_CTL, 0, CTL_ZERO_BYTES, stream) != hipSuccess) return;
    Args a{};
    for (int i = 0; i < 15; ++i) a.in[i] = (const float*)d_in[i];
    a.out = (float*)d_out; a.ws = (unsigned char*)d_ws;
#if MK_PER_PHASE
    for (int p = 0; p < N_PHASES; ++p) { a.ph_lo = p; a.ph_hi = p + 1; hipLaunchKernelGGL(trunk_fwd, dim3(grid), dim3(NWAVES * 64), LDS_BYTES, stream, a); }
#else
    a.ph_lo = 0; a.ph_hi = N_PHASES;
    hipLaunchKernelGGL(trunk_fwd, dim3(grid), dim3(NWAVES * 64), LDS_BYTES, stream, a);
#endif
}
```

```cpp
#include <hip/hip_runtime.h>
#include <cstdio>
#include <cstdint>
#ifndef PROBE
#define PROBE 0
#endif
namespace pg8 {
#define PG8_LAS __attribute__((address_space(3)))
typedef unsigned short bf16_t;
typedef short bf16x8 __attribute__((ext_vector_type(8)));
typedef float f32x4 __attribute__((ext_vector_type(4)));
typedef unsigned u32x4 __attribute__((ext_vector_type(4)));
constexpr int BM = 256, BK = 64, HALF = 128, HTB = HALF * BK * 2  , STAGE_BYTES = 8 * HTB, NXCD = 8, WGM = 8;

__host__ __device__ __forceinline__ int lds_byte(int r, int c) { const int st = (r >> 4) * 2 + (c >> 5), rr = r & 15, cc = c & 31, ob = rr * 64 + cc * 2; return st * 1024 + (ob ^ (((ob >> 9) & 1) << 5)); }
__host__ __device__ __forceinline__ void stage_rc(int b, int& R, int& C) { const int st = b / 1024, sb = b % 1024, swz = sb ^ (((sb >> 9) & 1) << 5); R = (st >> 1) * 16 + swz / 64; C = (st & 1) * 32 + (swz % 64) / 2; }
__host__ __device__ __forceinline__ int perm32(int rho) { const int n = rho >> 4, i = rho & 15; return 8 * (i >> 2) + 4 * n + (i & 3); }

struct Unit { int pm, pn; };
struct Gemm { const bf16_t* A; const bf16_t* Bt; int M, N, K, lda; };

struct StaticOrder {
    int nM, nN, nwg, G, c;
    __host__ __device__ void init(int M, int N, int G_, int c_) { nM = M / BM; nN = N / BM; nwg = nM * nN; G = G_; c = c_; }
    __host__ __device__ bool next(int i, Unit& u) const {
        const long L = (long)i * G + c; if (L >= nwg) return false;
        int wgid = (int)L; { const int q = nwg / NXCD, r = nwg % NXCD, xcd = wgid % NXCD, off = wgid / NXCD; wgid = (xcd < r ? xcd * (q + 1) : r * (q + 1) + (xcd - r) * q) + off; }
        const int nig = WGM * nN, gid = wgid / nig, fm = gid * WGM, gsz = (nM - fm) < WGM ? (nM - fm) : WGM;
        u.pm = fm + ((wgid % nig) % gsz); u.pn = (wgid % nig) / gsz; return true;
    }
    __device__ __forceinline__ void a_ready(const Unit&) const {}
    __device__ __forceinline__ void done(const Unit&) const {}
};

__device__ __forceinline__ unsigned cvt_pk_bf16(float lo, float hi) { unsigned r; asm volatile("v_cvt_pk_bf16_f32 %0, %1, %2" : "=v"(r) : "v"(lo), "v"(hi)); return r; }
typedef float f32x2 __attribute__((ext_vector_type(2)));
#ifndef STORE_WT
#define STORE_WT 1
#endif
__device__ __forceinline__ void store16(void* p, u32x4 v) {
#if STORE_WT
    asm volatile("global_store_dwordx4 %0, %1, off sc1\n\ts_nop 1" :: "v"(p), "v"(v) : "memory");
#else
    *(u32x4*)p = v;
#endif
}
__device__ __forceinline__ void store16f(void* p, f32x4 v) {
#if STORE_WT
    asm volatile("global_store_dwordx4 %0, %1, off sc1\n\ts_nop 1" :: "v"(p), "v"(v) : "memory");
#else
    *(f32x4*)p = v;
#endif
}
typedef unsigned u32x2 __attribute__((ext_vector_type(2)));
__device__ __forceinline__ void store8(void* p, u32x2 v) {
#if STORE_WT
    asm volatile("global_store_dwordx2 %0, %1, off sc1\n\ts_nop 1" :: "v"(p), "v"(v) : "memory");
#else
    *(u32x2*)p = v;
#endif
}
constexpr int NSLOT_X = 16;
constexpr int NSLOT_V = 32;
__device__ __forceinline__ void row_scales(const float* ss, int row0, int fq, float inv_n, float eps, float (&rs)[2][4]) {
#pragma unroll
    for (int ai = 0; ai < 2; ++ai)
#pragma unroll
        for (int m = 0; m < 4; ++m) {
            const f32x4 v = *(const f32x4*)(ss + (size_t)(row0 + ai * HALF + m * 16) * NSLOT_X + fq * 4);
            float s = (v[0] + v[1]) + (v[2] + v[3]);
            s += __shfl_xor(s, 16); s += __shfl_xor(s, 32);
            rs[ai][m] = __builtin_amdgcn_rsqf(s * inv_n + eps);
        }
}
__device__ __forceinline__ float gelu_tanh(float x) {
    const float t = x * x, u2 = x * (2.302208198f + 0.1029432398f * t);
    const float e = __builtin_amdgcn_exp2f(-u2);
    return x * __builtin_amdgcn_rcpf(1.0f + e);
}
__device__ __forceinline__ float silu_mul(float g, float u) {
    const float e = __builtin_amdgcn_exp2f(g * -1.4426950408889634f);
    return (g * u) * __builtin_amdgcn_rcpf(1.0f + e);
}
struct EpiGeluStats {
    static constexpr bool PERM = true, AFTER_DRAIN = false, PROBE_TWICE = false;
    bf16_t* O; int ldc; const float* xss; float* vss; int vtile0; float eps;
    __device__ __forceinline__ void operator()(const f32x4 (&acc)[2][2][4][2], const Unit& u, int wr, int wc, int fr, int fq) const {
        const int row0 = u.pm * BM + wr * 64 + fr, col0 = u.pn * BM + wc * 32 + 8 * fq;
        float rs[2][4]; row_scales(xss, row0, fq, 1.0f / 1024.0f, eps, rs);
        const bool isv = u.pn >= vtile0;
#pragma unroll
        for (int ai = 0; ai < 2; ++ai)
#pragma unroll
            for (int m = 0; m < 4; ++m) { const int row = row0 + ai * HALF + m * 16; bf16_t* rowp = O + (size_t)row * ldc + col0; const float r = rs[ai][m]; float ssq = 0.f;
#pragma unroll
                for (int bj = 0; bj < 2; ++bj) { f32x4 v0 = acc[ai][bj][m][0] * r, v1 = acc[ai][bj][m][1] * r;
#pragma unroll
                    for (int e = 0; e < 4; ++e) { v0[e] = gelu_tanh(v0[e]); v1[e] = gelu_tanh(v1[e]); }
                    ssq += (v0[0] * v0[0] + v0[1] * v0[1]) + (v0[2] * v0[2] + v0[3] * v0[3]) + (v1[0] * v1[0] + v1[1] * v1[1]) + (v1[2] * v1[2] + v1[3] * v1[3]);
                    u32x4 w; w.x = cvt_pk_bf16(v0[0], v0[1]); w.y = cvt_pk_bf16(v0[2], v0[3]); w.z = cvt_pk_bf16(v1[0], v1[1]); w.w = cvt_pk_bf16(v1[2], v1[3]);
                    store16(rowp + bj * HALF, w); }
                if (isv) { ssq += __shfl_xor(ssq, 16); ssq += __shfl_xor(ssq, 32); if (fq == 0) vss[(size_t)row * NSLOT_V + (u.pn - vtile0) * 4 + wc] = ssq; } }
    }
};
struct EpiSwiglu {
    static constexpr bool PERM = true, AFTER_DRAIN = false, PROBE_TWICE = true;
    bf16_t* O; int ldc; const float* xss; float eps;
    __device__ __forceinline__ void operator()(const f32x4 (&acc)[2][2][4][2], const Unit& u, int wr, int wc, int fr, int fq) const {
        const int row0 = u.pm * BM + wr * 64 + fr, col0 = u.pn * HALF + wc * 32 + 8 * fq;
        float rs[2][4]; row_scales(xss, row0, fq, 1.0f / 1024.0f, eps, rs);
#pragma unroll
        for (int ai = 0; ai < 2; ++ai)
#pragma unroll
            for (int m = 0; m < 4; ++m) { const int row = row0 + ai * HALF + m * 16; const float r = rs[ai][m] * (PROBE == 9 ? 0.5f : 1.0f);
                const f32x4 g0 = acc[ai][0][m][0] * r, g1 = acc[ai][0][m][1] * r, u0 = acc[ai][1][m][0] * r, u1 = acc[ai][1][m][1] * r;
                float o[8];
#pragma unroll
                for (int e = 0; e < 4; ++e) { o[e] = silu_mul(g0[e], u0[e]); o[4 + e] = silu_mul(g1[e], u1[e]); }
                u32x4 w; w.x = cvt_pk_bf16(o[0], o[1]); w.y = cvt_pk_bf16(o[2], o[3]); w.z = cvt_pk_bf16(o[4], o[5]); w.w = cvt_pk_bf16(o[6], o[7]);
                store16(O + (size_t)row * ldc + col0, w); }
    }
};
struct EpiQkv {
    static constexpr bool PERM = true, AFTER_DRAIN = false, PROBE_TWICE = false;
    bf16_t* O; int ldc; size_t split_stride; const float* xss; float eps; float scale0;
    __device__ __forceinline__ void operator()(const f32x4 (&acc)[2][2][4][2], const Unit& u, int wr, int wc, int fr, int fq) const {
        const int t = u.pn >> 2; bf16_t* base = O + (size_t)t * split_stride; const float sc = (t == 0) ? scale0 : 1.0f;
        const int row0 = u.pm * BM + wr * 64 + fr, col0 = (u.pn & 3) * BM + wc * 32 + 8 * fq;
        float rs[2][4]; row_scales(xss, row0, fq, 1.0f / 1024.0f, eps, rs);
#pragma unroll
        for (int ai = 0; ai < 2; ++ai)
#pragma unroll
            for (int m = 0; m < 4; ++m) { const int row = row0 + ai * HALF + m * 16; bf16_t* rowp = base + (size_t)row * ldc + col0; const float r = rs[ai][m] * sc;
#pragma unroll
                for (int bj = 0; bj < 2; ++bj) { const f32x4 v0 = acc[ai][bj][m][0] * r, v1 = acc[ai][bj][m][1] * r;
                    u32x4 w; w.x = cvt_pk_bf16(v0[0], v0[1]); w.y = cvt_pk_bf16(v0[2], v0[3]); w.z = cvt_pk_bf16(v1[0], v1[1]); w.w = cvt_pk_bf16(v1[2], v1[3]);
                    store16(rowp + bj * HALF, w); } }
    }
};
struct EpiResid {
    static constexpr bool PERM = false, AFTER_DRAIN = false, PROBE_TWICE = false;
    const float* base; float* out; bf16_t* xb; float* xss; int ldc;
    __device__ __forceinline__ void operator()(const f32x4 (&acc)[2][2][4][2], const Unit& u, int wr, int wc, int fr, int fq) const {
        typedef unsigned u32x2v __attribute__((ext_vector_type(2)));
        asm volatile("" : "+v"(fr), "+v"(fq));
        const int row0 = u.pm * BM + wr * 64 + fr, col0 = u.pn * BM + wc * 32 + 4 * fq;
#pragma unroll
        for (int ai = 0; ai < 2; ++ai)
#pragma unroll
            for (int m = 0; m < 4; ++m) { const int row = row0 + ai * HALF + m * 16; const size_t off = (size_t)row * ldc + col0; float ssq = 0.f;
#pragma unroll
                for (int bj = 0; bj < 2; ++bj)
#pragma unroll
                    for (int n = 0; n < 2; ++n) { const f32x4 bs = *(const f32x4*)(base + off + bj * HALF + n * 16); const f32x4 o = bs + acc[ai][bj][m][n];
                        *(f32x4*)(out + off + bj * HALF + n * 16) = o; ssq += (o[0] * o[0] + o[1] * o[1]) + (o[2] * o[2] + o[3] * o[3]);
                        u32x2 w; w.x = cvt_pk_bf16(o[0], o[1]); w.y = cvt_pk_bf16(o[2], o[3]); *(u32x2*)(xb + off + bj * HALF + n * 16) = w; }
                ssq += __shfl_xor(ssq, 16); ssq += __shfl_xor(ssq, 32);
                if (fq == 0) xss[(size_t)row * NSLOT_X + u.pn * 4 + wc] = ssq;
                if (m & 1) asm volatile("" ::: "memory"); }
    }
};
template <class Epi, class Sched, bool ALIGN_EPI = false, bool SP2 = false>
__device__ __forceinline__ void gemm_phase(PG8_LAS unsigned char* lds, const Gemm g, const Sched& S, const Epi& E) {
    int tid_ = threadIdx.x; asm volatile("" : "+v"(tid_));
    const int tid = tid_, wid = __builtin_amdgcn_readfirstlane(tid >> 6), lane = tid & 63, wr = wid >> 2, wc = wid & 3, fr = lane & 15, fq = lane >> 4;
    const int K = g.K, nt = K / BK;
    unsigned voffA[2], voffB[2];
#pragma unroll
    for (int i = 0; i < 2; ++i) { int R, C; stage_rc(tid * 16 + i * 8192, R, C); const int Rb = Epi::PERM ? ((R & ~31) + perm32(R & 31)) : R;
        voffA[i] = (unsigned)(R * g.lda + C) * 2u; voffB[i] = (unsigned)(Rb * K + C) * 2u; }
    const size_t kstep = (size_t)(BK * 2);
    const size_t hstep = (size_t)HALF * K * 2;
    const size_t tstep = 2 * hstep; const size_t hstepA = (size_t)HALF * g.lda * 2, tstepA = 2 * hstepA;
    const unsigned ldsw = (unsigned)wid * 1024u;
    const int aoff = lds_byte(wr * 64 + fr, fq * 8), boff = lds_byte(wc * 32 + fr, fq * 8);
#define PG8_SA(b, h) (((b) * 2 + (h)) * HTB)
#define PG8_SB(b, h) ((4 + (b) * 2 + (h)) * HTB)
#define PG8_STAGE(bufoff, gbase, voff) do { _Pragma("unroll") for (int _i = 0; _i < 2; ++_i) \
        __builtin_amdgcn_global_load_lds((const unsigned*)((const char*)(gbase) + (voff)[_i]), (PG8_LAS unsigned*)(lds + (bufoff) + ldsw + _i * 8192), 16, 0, 0); } while (0)
#define PG8_LDA(dst, b, h) do { _Pragma("unroll") for (int m = 0; m < 4; ++m) _Pragma("unroll") for (int k = 0; k < 2; ++k) dst[m][k] = *(const PG8_LAS bf16x8*)(lds + PG8_SA(b, h) + aoff + m * 2048 + k * 1024); } while (0)
#define PG8_LDB(dst, b, h) do { _Pragma("unroll") for (int n = 0; n < 2; ++n) _Pragma("unroll") for (int k = 0; k < 2; ++k) dst[n][k] = *(const PG8_LAS bf16x8*)(lds + PG8_SB(b, h) + boff + n * 2048 + k * 1024); } while (0)
#define PG8_MMA(ai, bj, At, Bt) do { __builtin_amdgcn_s_setprio(1); _Pragma("unroll") for (int m = 0; m < 4; ++m) _Pragma("unroll") for (int n = 0; n < 2; ++n) _Pragma("unroll") for (int k = 0; k < 2; ++k) \
        acc[ai][bj][m][n] = __builtin_amdgcn_mfma_f32_16x16x32_bf16(Bt[n][k], At[m][k], acc[ai][bj][m][n], 0, 0, 0); __builtin_amdgcn_s_setprio(0); } while (0)
#define PG8_WAIT_V(n) asm volatile("s_waitcnt vmcnt(" #n ")" ::: "memory")
#define PG8_WAIT_L(n) asm volatile("s_waitcnt lgkmcnt(" #n ")" ::: "memory")
#define PG8_BAR __builtin_amdgcn_s_barrier()
#define PG8_SCHED __builtin_amdgcn_sched_barrier(0)
    Unit cur, nxt; int ui = 0;
    if (!S.next(0, cur)) return;
    f32x4 acc[2][2][4][2];
#pragma unroll
    for (int a = 0; a < 2; ++a)
#pragma unroll
        for (int b = 0; b < 2; ++b)
#pragma unroll
            for (int m = 0; m < 4; ++m)
#pragma unroll
                for (int n = 0; n < 2; ++n) acc[a][b][m][n] = (f32x4){0.f, 0.f, 0.f, 0.f};
    bf16x8 At[4][2], B0[2][2], B1[2][2];
    const char* cA = (const char*)g.A + (size_t)cur.pm * tstepA; const char* cB = (const char*)g.Bt + (size_t)cur.pn * tstep;
    S.a_ready(cur);
    if constexpr (SP2) {
        PG8_STAGE(PG8_SB(0, 0), cB, voffB); PG8_STAGE(PG8_SB(0, 1), cB + hstep, voffB); PG8_STAGE(PG8_SA(0, 0), cA, voffA); PG8_STAGE(PG8_SA(0, 1), cA + hstepA, voffA);
        if (wr == 1) PG8_BAR;
        PG8_WAIT_V(2); PG8_BAR;
        PG8_STAGE(PG8_SB(1, 0), cB + kstep, voffB); PG8_STAGE(PG8_SA(1, 0), cA + kstep, voffA); PG8_STAGE(PG8_SB(1, 1), cB + hstep + kstep, voffB);
        PG8_WAIT_V(6); PG8_BAR;
    } else {
        PG8_STAGE(PG8_SB(0, 0), cB, voffB); PG8_STAGE(PG8_SA(0, 0), cA, voffA); PG8_STAGE(PG8_SB(0, 1), cB + hstep, voffB); PG8_STAGE(PG8_SA(0, 1), cA + hstepA, voffA);
        if (wr == 1) PG8_BAR;
        PG8_WAIT_V(4); PG8_BAR;
        PG8_STAGE(PG8_SB(1, 0), cB + kstep, voffB); PG8_STAGE(PG8_SA(1, 0), cA + kstep, voffA); PG8_STAGE(PG8_SB(1, 1), cB + hstep + kstep, voffB);
        PG8_WAIT_V(6); PG8_BAR;
    }
    for (;;) {
        const bool has_next = S.next(ui + 1, nxt);
        const char* nA = has_next ? (const char*)g.A + (size_t)nxt.pm * tstepA : cA; const char* nB = has_next ? (const char*)g.Bt + (size_t)nxt.pn * tstep : cB;
        const int ntl = (PROBE == 9 && Epi::PROBE_TWICE) ? 2 * nt : nt;
        for (int t = 0; t < ntl; t += 2) {
            const bool last = (t == ntl - 2);
            const int t1 = (t + 1 >= nt) ? t + 1 - nt : t + 1, t2 = (t + 2 >= nt) ? t + 2 - nt : t + 2;
            const char* a1 = cA + (size_t)t1 * kstep;
            const char* a2 = last ? nA : cA + (size_t)t2 * kstep; const char* b2 = last ? nB : cB + (size_t)t2 * kstep;
            const char* a3 = a2 + kstep; const char* b3 = b2 + kstep;
            if (last && has_next) S.a_ready(nxt);
            if constexpr (SP2) {
            PG8_LDB(B0, 0, 0); PG8_LDB(B1, 0, 1); PG8_SCHED; PG8_LDA(At, 0, 0); PG8_STAGE(PG8_SA(1, 1), a1 + hstepA, voffA);
            PG8_WAIT_V(8); PG8_WAIT_L(0); PG8_BAR; PG8_MMA(0, 0, At, B0); PG8_MMA(0, 1, At, B1); PG8_BAR; PG8_SCHED;
            PG8_LDA(At, 0, 1); PG8_STAGE(PG8_SB(0, 0), b2, voffB); PG8_STAGE(PG8_SB(0, 1), b2 + hstep, voffB); PG8_STAGE(PG8_SA(0, 0), a2, voffA);
            PG8_WAIT_V(8); PG8_WAIT_L(0); PG8_BAR; PG8_MMA(1, 0, At, B0); PG8_MMA(1, 1, At, B1); PG8_BAR; PG8_SCHED;
            PG8_LDB(B0, 1, 0); PG8_LDB(B1, 1, 1); PG8_SCHED; PG8_LDA(At, 1, 0); PG8_STAGE(PG8_SA(0, 1), a2 + hstepA, voffA);
            PG8_WAIT_V(8); PG8_WAIT_L(0); PG8_BAR; PG8_MMA(0, 0, At, B0); PG8_MMA(0, 1, At, B1); PG8_BAR; PG8_SCHED;
            PG8_LDA(At, 1, 1); PG8_STAGE(PG8_SB(1, 0), b3, voffB); PG8_STAGE(PG8_SB(1, 1), b3 + hstep, voffB); PG8_STAGE(PG8_SA(1, 0), a3, voffA);
            PG8_WAIT_V(8); PG8_WAIT_L(0); PG8_BAR; PG8_MMA(1, 0, At, B0); PG8_MMA(1, 1, At, B1); PG8_BAR; PG8_SCHED;
            } else {
            PG8_LDB(B0, 0, 0); PG8_SCHED; PG8_LDA(At, 0, 0); PG8_STAGE(PG8_SA(1, 1), a1 + hstepA, voffA);
            PG8_WAIT_L(8); PG8_BAR; PG8_WAIT_L(0); PG8_MMA(0, 0, At, B0); PG8_BAR; PG8_SCHED;
            PG8_LDB(B1, 0, 1); PG8_STAGE(PG8_SB(0, 0), b2, voffB);
            PG8_BAR; PG8_WAIT_L(0); PG8_MMA(0, 1, At, B1); PG8_BAR;
            PG8_LDA(At, 0, 1); PG8_STAGE(PG8_SA(0, 0), a2, voffA);
            PG8_BAR; PG8_WAIT_L(0); PG8_MMA(1, 0, At, B0); PG8_BAR; PG8_SCHED;
            PG8_STAGE(PG8_SB(0, 1), b2 + hstep, voffB);
            PG8_WAIT_V(6); PG8_BAR; PG8_MMA(1, 1, At, B1); PG8_BAR;
            PG8_LDB(B0, 1, 0); PG8_SCHED; PG8_LDA(At, 1, 0); PG8_STAGE(PG8_SA(0, 1), a2 + hstepA, voffA);
            PG8_WAIT_L(8); PG8_BAR; PG8_WAIT_L(0); PG8_MMA(0, 0, At, B0); PG8_BAR; PG8_SCHED;
            PG8_LDB(B1, 1, 1); PG8_STAGE(PG8_SB(1, 0), b3, voffB);
            PG8_BAR; PG8_WAIT_L(0); PG8_MMA(0, 1, At, B1); PG8_BAR;
            PG8_LDA(At, 1, 1); PG8_STAGE(PG8_SA(1, 0), a3, voffA);
            PG8_BAR; PG8_WAIT_L(0); PG8_MMA(1, 0, At, B0); PG8_BAR; PG8_SCHED;
            PG8_STAGE(PG8_SB(1, 1), b3 + hstep, voffB);
            PG8_WAIT_V(6); PG8_BAR; PG8_MMA(1, 1, At, B1); PG8_BAR;
            }
        }
        if constexpr (ALIGN_EPI) { if (wr == 0) PG8_BAR; }
        if constexpr (!Epi::AFTER_DRAIN) { E(acc, cur, wr, wc, fr, fq); if (PROBE == 8 && Epi::PROBE_TWICE) { asm volatile("" ::: "memory"); E(acc, cur, wr, wc, fr, fq); } S.done(cur); }
        if (!has_next) break;
#pragma unroll
        for (int a = 0; a < 2; ++a)
#pragma unroll
            for (int b = 0; b < 2; ++b)
#pragma unroll
                for (int m = 0; m < 4; ++m)
#pragma unroll
                    for (int n = 0; n < 2; ++n) acc[a][b][m][n] = (f32x4){0.f, 0.f, 0.f, 0.f};
        cur = nxt; cA = nA; cB = nB; ++ui;
        if constexpr (ALIGN_EPI) { if (wr == 1) PG8_BAR; }
    }
    PG8_WAIT_V(0);
    if constexpr (!ALIGN_EPI) { if (wr == 0) PG8_BAR; }
    PG8_BAR;
    if constexpr (Epi::AFTER_DRAIN) { E.fused(acc, cur, wr, wc, fr, fq, lds, wid, lane); S.done(cur); }
#undef PG8_SA
#undef PG8_SB
#undef PG8_STAGE
#undef PG8_LDA
#undef PG8_LDB
#undef PG8_MMA
#undef PG8_WAIT_V
#undef PG8_WAIT_L
#undef PG8_BAR
#undef PG8_SCHED
}
}

constexpr int NWAVES = 8;
constexpr int BATCH = 2, SEQ = 8192, D = 1024, DEPTH = 4, M = BATCH * SEQ;
constexpr int GH = 2048, GH2 = 4096, SGU_G = 8, SGU_P = 128, SGU_C = 256;
constexpr int NH = 16, HD = 64, NREL = 192, CHUNK = 64;
constexpr int FF = 2816, FF2 = 5632;
constexpr float EPS = 1e-6f;
constexpr float LOG2E = 1.4426950408889634f;
constexpr float QSCALE = 0.125f * LOG2E;

#ifndef MK_PER_PHASE
#define MK_PER_PHASE 0
#endif
constexpr int N_PHASES = 22;

constexpr size_t MiB = 1u << 20;
constexpr size_t WS_CTL = 0, CTL_ZERO_BYTES = 64 * 1024;
constexpr size_t WS_XSS = 1 * MiB;
constexpr size_t WS_VSS = 2 * MiB;
constexpr size_t WS_W = 4 * MiB;
constexpr size_t WS_XB = 110 * MiB;
constexpr size_t WS_ACT = 142 * MiB;
constexpr size_t WS_END = 270 * MiB;
constexpr size_t WO_IN = 0, WO_AOUT = 8388608, WO_QKV = 12582912, WO_BOUT = 18874368, WO_GU = 20971520, WO_DN = 44040192, WO_END = 55574528;
static_assert(WS_W + WO_END * 2 <= WS_XB && WS_XB + (size_t)M * D * 2 <= WS_ACT && WS_ACT + (size_t)M * GH2 * 2 <= WS_END, "d_ws map");
constexpr int CW_BAR = 1024;

constexpr int RING_OFF = 0, RING_BYTES = 131072;
constexpr int LDSCTL_OFF = RING_BYTES, MISC_OFF = LDSCTL_OFF + 320;
constexpr int LDS_BYTES = 147456;
static_assert(MISC_OFF + 128 <= LDS_BYTES, "LDS map");

#define GAS __attribute__((address_space(1)))
#define LAS __attribute__((address_space(3)))
typedef unsigned short bf16;
typedef unsigned v4u __attribute__((ext_vector_type(4)));
typedef unsigned v2u __attribute__((ext_vector_type(2)));
typedef float f32x4 __attribute__((ext_vector_type(4)));
typedef float f32x16 __attribute__((ext_vector_type(16)));
typedef short bf16x8 __attribute__((ext_vector_type(8)));
typedef short s16x4 __attribute__((ext_vector_type(4)));
typedef GAS unsigned gu32;
#define RLX_AGENT __ATOMIC_RELAXED, __HIP_MEMORY_SCOPE_AGENT
#define LDS_WAIT() asm volatile("s_waitcnt lgkmcnt(0)" ::: "memory")
#define VM_WAIT() asm volatile("s_waitcnt vmcnt(0)" ::: "memory")
__device__ __forceinline__ unsigned pk2(float lo, float hi) { return pg8::cvt_pk_bf16(lo, hi); }
__device__ __forceinline__ float bf_lo(unsigned w) { return __uint_as_float(w << 16); }
__device__ __forceinline__ float bf_hi(unsigned w) { return __uint_as_float(w & 0xffff0000u); }
__device__ __forceinline__ float wave_sum(float v) {
#pragma unroll
    for (int o = 1; o < 64; o <<= 1) v += __shfl_xor(v, o);
    return v;
}
#define XB_TMO      128
#define XB_XCNT(j)  (256  + 64 * (j))
#define XB_XSUB(j)  (1280 + 64 * (j))
#define XB_XGEN(j)  (2304 + 64 * (j))
#define XB_TOP      3328
#define XB_TOPGEN   3392
#define XCD_BAR_WORDS 3456
#define XB_SPIN_CAP (1u << 18)

__device__ __forceinline__ unsigned xb_ld(unsigned* p)              { return __hip_atomic_load(p, __ATOMIC_RELAXED, __HIP_MEMORY_SCOPE_AGENT); }
__device__ __forceinline__ unsigned xb_add(unsigned* p, unsigned v) { return __hip_atomic_fetch_add(p, v, __ATOMIC_RELAXED, __HIP_MEMORY_SCOPE_AGENT); }
__device__ __forceinline__ unsigned xb_xcc_id() { return (unsigned)__builtin_amdgcn_s_getreg((3 << 11) | 20) & 0xFu; }
#define XB_SPIN(cond, bar) do { unsigned _sp = 0; while (cond) { __builtin_amdgcn_s_sleep(1); \
    if ((++_sp & 255u) == 0u) { if (xb_ld(&(bar)[XB_TMO])) break; if (_sp > XB_SPIN_CAP) { atomicAdd(&(bar)[XB_TMO], 1u); break; } } } } while (0)

struct XcdBarrier {
    unsigned* bar; unsigned x;
    volatile LAS unsigned* st;
};

__device__ __forceinline__ XcdBarrier xcd_barrier_post(unsigned* bar, volatile LAS unsigned* st) {
    XcdBarrier b; b.bar = bar; b.x = xb_xcc_id(); b.st = st;
    if (threadIdx.x == 0) (void)xb_add(&bar[XB_XCNT(b.x)], 1u);
    return b;
}
__device__ __forceinline__ void xcd_barrier_complete(unsigned* bar, unsigned x, unsigned& nloc, unsigned& nx) {
    const unsigned G = gridDim.x * gridDim.y * gridDim.z;
    unsigned sum, cnt, mine, sp = 0u;
    for (;;) {
        sum = 0u; cnt = 0u; mine = 0u;
#pragma unroll
        for (unsigned j = 0; j < 16; ++j) { const unsigned c = xb_ld(&bar[XB_XCNT(j)]); sum += c; cnt += (c > 0u) ? 1u : 0u; mine = (j == x) ? c : mine; }
        if (sum == G) break;
        __builtin_amdgcn_s_sleep(1);
        if ((++sp & 255u) == 0u) { if (xb_ld(&bar[XB_TMO])) break; if (sp > XB_SPIN_CAP) { atomicAdd(&bar[XB_TMO], 1u); break; } }
    }
    nloc = mine > 0u ? mine : 1u; nx = cnt > 0u ? cnt : 1u;
}

__device__ __forceinline__ void xcd_barrier(const XcdBarrier& b) {
    asm volatile("s_waitcnt vmcnt(0)" ::: "memory");
    __syncthreads();
    if (threadIdx.x == 0) {
        unsigned* bar = b.bar;
        __builtin_amdgcn_s_waitcnt(0);
        unsigned nloc = b.st[0], nx = b.st[1];
        if (nloc == 0u) { xcd_barrier_complete(bar, b.x, nloc, nx); b.st[0] = nloc; b.st[1] = nx; }
        const unsigned old = xb_add(&bar[XB_XSUB(b.x)], 1u);
        const unsigned gen = old / nloc;
        if (old + 1u == (gen + 1u) * nloc) {
            __builtin_amdgcn_fence(__ATOMIC_RELEASE, "agent");
            asm volatile("s_waitcnt vmcnt(0)" ::: "memory");
            const unsigned og = xb_add(&bar[XB_TOP], 1u);
            const unsigned tg = og / nx;
            if (og + 1u == (tg + 1u) * nx) xb_add(&bar[XB_TOPGEN], 1u);
            else XB_SPIN(xb_ld(&bar[XB_TOPGEN]) == tg, bar);
            __builtin_amdgcn_fence(__ATOMIC_ACQUIRE, "agent");
            xb_add(&bar[XB_XGEN(b.x)], 1u);
            asm volatile("s_waitcnt vmcnt(0)" ::: "memory");
        } else {
            XB_SPIN(xb_ld(&bar[XB_XGEN(b.x)]) == gen, bar);
            __builtin_amdgcn_fence(__ATOMIC_ACQUIRE, "agent");
            asm volatile("s_waitcnt vmcnt(0)" ::: "memory");
        }
    }
    __syncthreads();
}

__device__ __forceinline__ void p0_transpose_item(const float* W, const float* gain, int K, int N, bf16* WT, int drow0, int k0, int n0, LAS unsigned* scr, int lane) {
    const int kp = lane >> 4, n4 = lane & 15;
    f32x4 w[8][2];
    const float* src = W + (size_t)(k0 + 2 * kp) * N + n0 + 4 * n4;
#pragma unroll
    for (int i = 0; i < 8; ++i) { w[i][0] = *(const f32x4*)(src + (size_t)(8 * i) * N); w[i][1] = *(const f32x4*)(src + (size_t)(8 * i + 1) * N); }
    if (gain) {
#pragma unroll
        for (int i = 0; i < 8; ++i) { const float g0 = gain[k0 + 8 * i + 2 * kp], g1 = gain[k0 + 8 * i + 2 * kp + 1]; w[i][0] = w[i][0] * g0; w[i][1] = w[i][1] * g1; }
    }
#pragma unroll
    for (int i = 0; i < 8; ++i)
#pragma unroll
        for (int e = 0; e < 4; ++e) scr[(4 * n4 + e) * 33 + 4 * i + kp] = pk2(w[i][0][e], w[i][1][e]);
    LDS_WAIT(); asm volatile("" ::: "memory");
    const int c = lane & 7;
#pragma unroll
    for (int jn = 0; jn < 8; ++jn) { const int n = (lane >> 3) + 8 * jn; const LAS unsigned* s = scr + n * 33 + 4 * c;
        v4u o; o.x = s[0]; o.y = s[1]; o.z = s[2]; o.w = s[3];
        pg8::store16(WT + (size_t)(drow0 + n) * K + k0 + 8 * c, o); }
    LDS_WAIT(); asm volatile("" ::: "memory");
}
struct Ptrs {
    const float *x, *norm_mix_g, *norm_ffn_g, *final_g, *a_w_in, *a_v_gain, *a_w_s, *a_b_s, *a_w_out, *b_w_qkv, *b_rel_bias, *b_w_out, *ffn_w_gate, *ffn_w_up, *ffn_w_down;
    float* out; bf16* wt; bf16* xb; bf16* act; float* xss; float* vss;
};
__device__ __forceinline__ void p0_prologue(const Ptrs& P, LAS unsigned char* lds, int vcu, int G, int wave, int lane) {
    LAS unsigned* scr = (LAS unsigned*)(lds + RING_OFF + wave * 16384);
    const int gw = vcu * NWAVES + wave, NGW = G * NWAVES;
    constexpr int I_IN = 16 * 64, I_AOUT = 32 * 16, I_QKV = 16 * 48, I_BOUT = 16 * 16, I_GU = 16 * 44, I_DN = 44 * 16;
    constexpr int NITEMS = 2 * I_IN + 2 * I_AOUT + 2 * I_QKV + 2 * I_BOUT + 8 * I_GU + 4 * I_DN;
    for (int it = gw; it < NITEMS; it += NGW) {
        int r = it; const float* W; const float* gain = nullptr; bf16* dst; int K, N, mode = 0;
        if (r < 2 * I_IN) { const int j = r / I_IN; r -= j * I_IN; W = P.a_w_in + (size_t)j * D * GH2; gain = P.norm_mix_g + (2 * j) * D; K = D; N = GH2; dst = P.wt + WO_IN + (size_t)j * D * GH2; }
        else if ((r -= 2 * I_IN) < 2 * I_AOUT) { const int j = r / I_AOUT; r -= j * I_AOUT; W = P.a_w_out + (size_t)j * GH * D; K = GH; N = D; dst = P.wt + WO_AOUT + (size_t)j * GH * D; }
        else if ((r -= 2 * I_AOUT) < 2 * I_QKV) { const int j = r / I_QKV; r -= j * I_QKV; W = P.b_w_qkv + (size_t)j * D * 3 * D; gain = P.norm_mix_g + (2 * j + 1) * D; K = D; N = 3 * D; dst = P.wt + WO_QKV + (size_t)j * D * 3 * D; }
        else if ((r -= 2 * I_QKV) < 2 * I_BOUT) { const int j = r / I_BOUT; r -= j * I_BOUT; W = P.b_w_out + (size_t)j * D * D; K = D; N = D; dst = P.wt + WO_BOUT + (size_t)j * D * D; }
        else if ((r -= 2 * I_BOUT) < 4 * I_GU) { const int i = r / I_GU; r -= i * I_GU; W = P.ffn_w_gate + (size_t)i * D * FF; gain = P.norm_ffn_g + i * D; K = D; N = FF; dst = P.wt + WO_GU + (size_t)i * D * FF2; mode = 1; }
        else if ((r -= 4 * I_GU) < 4 * I_GU) { const int i = r / I_GU; r -= i * I_GU; W = P.ffn_w_up + (size_t)i * D * FF; gain = P.norm_ffn_g + i * D; K = D; N = FF; dst = P.wt + WO_GU + (size_t)i * D * FF2; mode = 2; }
        else { r -= 4 * I_GU; const int i = r / I_DN; r -= i * I_DN; W = P.ffn_w_down + (size_t)i * FF * D; K = FF; N = D; dst = P.wt + WO_DN + (size_t)i * FF * D; }
        const int nblk = N / 64, kb = r / nblk, nb = r % nblk, k0 = 64 * kb, n0 = 64 * nb;
        const int drow0 = (mode == 0) ? n0 : ((n0 >> 7) * 256 + (n0 & 127) + (mode == 2 ? 128 : 0));
        p0_transpose_item(W, gain, K, N, dst, drow0, k0, n0, scr, lane);
    }
    for (int m = gw; m < M; m += 2 * NGW) {
        const int m2 = (m + NGW < M) ? m + NGW : m;
        const GAS f32x4* xr = (const GAS f32x4*)(P.x + (size_t)m * D) + lane; const GAS f32x4* xr2 = (const GAS f32x4*)(P.x + (size_t)m2 * D) + lane; f32x4 v[4], v2[4]; float s = 0.f, s2 = 0.f;
#pragma unroll
        for (int j = 0; j < 4; ++j) { v[j] = xr[64 * j]; v2[j] = xr2[64 * j]; }
#pragma unroll
        for (int j = 0; j < 4; ++j) { s += (v[j].x * v[j].x + v[j].y * v[j].y) + (v[j].z * v[j].z + v[j].w * v[j].w); s2 += (v2[j].x * v2[j].x + v2[j].y * v2[j].y) + (v2[j].z * v2[j].z + v2[j].w * v2[j].w); }
        s = wave_sum(s); s2 = wave_sum(s2);
        GAS unsigned long long* o8 = (GAS unsigned long long*)(P.xb + (size_t)m * D) + lane; GAS unsigned long long* o82 = (GAS unsigned long long*)(P.xb + (size_t)m2 * D) + lane;
#pragma unroll
        for (int j = 0; j < 4; ++j) { o8[64 * j] = (unsigned long long)pk2(v[j].x, v[j].y) | ((unsigned long long)pk2(v[j].z, v[j].w) << 32);
            o82[64 * j] = (unsigned long long)pk2(v2[j].x, v2[j].y) | ((unsigned long long)pk2(v2[j].z, v2[j].w) << 32); }
        if (lane < pg8::NSLOT_X) { P.xss[(size_t)m * pg8::NSLOT_X + lane] = (lane == 0) ? s : 0.f; P.xss[(size_t)m2 * pg8::NSLOT_X + lane] = (lane == 0) ? s2 : 0.f; }
    }
}

constexpr int SP_A_PITCH = 272, SP_V_PITCH = 528;
constexpr int SP_A_OFF = 0, SP_V_OFF = 36864, SP_R_OFF = 106496;
typedef short v4i16_t __attribute__((ext_vector_type(4)));
__device__ __forceinline__ s16x4 tr_read(const LAS unsigned char* p) { return __builtin_bit_cast(s16x4, __builtin_amdgcn_ds_read_tr16_b64_v4i16((LAS v4i16_t*)p)); }
template <bool DRY> __device__ __forceinline__ void spatial_phase(const Ptrs& P, int j, LAS unsigned char* lds, int vcu, int G, int tid, int wave, int lane) {
    asm volatile("" : "+v"(tid), "+v"(lane));
    bf16* uv = P.act;
    LAS unsigned char* Aimg = lds + SP_A_OFF; LAS unsigned char* Vimg = lds + SP_V_OFF; LAS float* rsL = (LAS float*)(lds + SP_R_OFF);
    const int fr = lane & 15, fq = lane >> 4;
    for (int unit = vcu; unit < (M / SGU_P) * SGU_G; unit += G) {
        const int nb = unit >> 3, g = unit & 7, row0 = nb * SGU_P;
        if (tid < SGU_P) { const f32x4* p = (const f32x4*)(P.vss + (size_t)(row0 + tid) * pg8::NSLOT_V); float s = 0.f;
#pragma unroll
            for (int k = 0; k < 8; ++k) { const f32x4 v = p[k]; s += (v[0] + v[1]) + (v[2] + v[3]); }
            rsL[tid] = __builtin_amdgcn_rsqf(s * (1.0f / GH) + EPS); }
        { v4u t[8];
#pragma unroll
            for (int i = 0; i < 8; ++i) { const int pc = tid + 512 * i, q = pc >> 5, ch = pc & 31; t[i] = *(const v4u*)(uv + (size_t)(row0 + q) * GH2 + GH + g * SGU_C + ch * 8); }
#pragma unroll
            for (int i = 0; i < 8; ++i) { const int pc = tid + 512 * i, q = pc >> 5, ch = pc & 31; *(LAS v4u*)(Vimg + q * SP_V_PITCH + ch * 16) = t[i]; } }
        __syncthreads();
        { const float* ws = P.a_w_s + ((size_t)j * SGU_G + g) * SGU_P * SGU_P;
#pragma unroll
            for (int i = 0; i < 4; ++i) { const int e = tid + 512 * i, p = e >> 4, q0 = (e & 15) * 8;
                const f32x4 w0 = *(const f32x4*)(ws + p * SGU_P + q0), w1 = *(const f32x4*)(ws + p * SGU_P + q0 + 4);
                const f32x4 r0 = *(const LAS f32x4*)(rsL + q0), r1 = *(const LAS f32x4*)(rsL + q0 + 4);
                v4u o; o.x = pk2(w0[0] * r0[0], w0[1] * r0[1]); o.y = pk2(w0[2] * r0[2], w0[3] * r0[3]); o.z = pk2(w1[0] * r1[0], w1[1] * r1[1]); o.w = pk2(w1[2] * r1[2], w1[3] * r1[3]);
                *(LAS v4u*)(Aimg + p * SP_A_PITCH + q0 * 2) = o; } }
        __syncthreads();
        bf16x8 vf[2][4];
        { const LAS unsigned char* vb = Vimg + (8 * fq + ((lane & 15) >> 2)) * SP_V_PITCH + (32 * wave + 8 * (lane & 3)) * 2;
#pragma unroll
            for (int ks = 0; ks < 4; ++ks)
#pragma unroll
                for (int n = 0; n < 2; ++n) { const s16x4 lo = tr_read(vb + ks * 32 * SP_V_PITCH + n * 8), hi = tr_read(vb + ks * 32 * SP_V_PITCH + 4 * SP_V_PITCH + n * 8);
                    vf[n][ks] = (bf16x8){lo[0], lo[1], lo[2], lo[3], hi[0], hi[1], hi[2], hi[3]}; } }
        const int cc = g * SGU_C + 32 * wave + 8 * fq;
        const f32x4 gn0 = *(const f32x4*)(P.a_v_gain + (size_t)j * GH + cc), gn1 = *(const f32x4*)(P.a_v_gain + (size_t)j * GH + cc + 4);
#pragma unroll
        for (int pt = 0; pt < 8; ++pt) {
            f32x4 a0 = {0.f, 0.f, 0.f, 0.f}, a1 = {0.f, 0.f, 0.f, 0.f};
            const LAS unsigned char* ab = Aimg + (16 * pt + fr) * SP_A_PITCH + (8 * fq) * 2;
#pragma unroll
            for (int ks = 0; ks < 4; ++ks) if (ks < (pt < 4 ? 2 : 4)) { const bf16x8 af = *(const LAS bf16x8*)(ab + ks * 64);
                a0 = __builtin_amdgcn_mfma_f32_16x16x32_bf16(vf[0][ks], af, a0, 0, 0, 0); a1 = __builtin_amdgcn_mfma_f32_16x16x32_bf16(vf[1][ks], af, a1, 0, 0, 0); }
            const int p = 16 * pt + fr; bf16* up = uv + (size_t)(row0 + p) * GH2 + cc;
            const float b = P.a_b_s[((size_t)j * SGU_G + g) * SGU_P + p];
            const v4u u8 = *(const v4u*)up;
            v4u o;
            o.x = pk2(bf_lo(u8.x) * (gn0[0] * a0[0] + b), bf_hi(u8.x) * (gn0[1] * a0[1] + b)); o.y = pk2(bf_lo(u8.y) * (gn0[2] * a0[2] + b), bf_hi(u8.y) * (gn0[3] * a0[3] + b));
            o.z = pk2(bf_lo(u8.z) * (gn1[0] * a1[0] + b), bf_hi(u8.z) * (gn1[1] * a1[1] + b)); o.w = pk2(bf_lo(u8.w) * (gn1[2] * a1[2] + b), bf_hi(u8.w) * (gn1[3] * a1[3] + b));
            if (DRY) *(v4u*)(P.xb + (size_t)(row0 + p) * D + (g & 3) * SGU_C + 32 * wave + 8 * fq) = o; else pg8::store16(up, o);
        }
        __syncthreads();
    }
}

constexpr int AT_K = 0, AT_V = 16384, AT_BT = 32768, AT_WS = 33792, AT_OST = 36864;
constexpr float ATT_THR = 8.0f;
__device__ __forceinline__ int crow(int r, int hi) { return (r & 3) + 8 * (r >> 2) + 4 * hi; }
#define MX3(a, b, c) __builtin_fmaxf(__builtin_fmaxf((a), (b)), (c))
template <bool DRY> __device__ __forceinline__ void attn_phase(const Ptrs& P, int j, LAS unsigned char* lds, int vcu, int G, int tid, int wave, int lane) {
    asm volatile("" : "+v"(tid), "+v"(lane));
    bf16* Q = P.act; const bf16* Kt = P.act + (size_t)M * D; const bf16* Vt = P.act + (size_t)2 * M * D;
    const int r32 = lane & 31, hi = lane >> 5, ci = wave >> 1, qh = wave & 1;
    LAS float* bt = (LAS float*)(lds + AT_BT); LAS float* wsf = (LAS float*)(lds + AT_WS) + wave * 64;
    for (int unit = vcu; unit < BATCH * NH * (SEQ / 256); unit += G) {
        const int bh = unit >> 5, cq = unit & 31, b = bh >> 4, h = bh & 15;
        const size_t rowbase = (size_t)b * SEQ;
        if (tid < NREL) bt[tid] = P.b_rel_bias[((size_t)j * NH + h) * NREL + tid] * LOG2E;
        const size_t qrow = rowbase + (size_t)(4 * cq + ci) * CHUNK + 32 * qh;
        const int s_lo = (4 * cq >= 8) ? 0 : 8 - 4 * cq;
        const long trow0 = (long)rowbase + (long)(4 * cq - 8) * CHUNK;
        const bf16* ksrc = Kt + (trow0 + lane) * D + h * HD + wave * 8;
        const bf16* vsrc = Vt + (trow0 + 16 * (wave & 3) + (lane >> 2)) * D + h * HD + (wave >> 2) * 32 + (lane & 3) * 8;
#define ATT_DMA(t) do { const int sl_ = ((t) & 1) * 8192; \
            __builtin_amdgcn_global_load_lds((const unsigned*)(ksrc + (long)(t) * CHUNK * D), (LAS unsigned*)(lds + AT_K + sl_ + wave * 1024), 16, 0, 0); \
            __builtin_amdgcn_global_load_lds((const unsigned*)(vsrc + (long)(t) * CHUNK * D), (LAS unsigned*)(lds + AT_V + sl_ + wave * 1024), 16, 0, 0); } while (0)
        ATT_DMA(s_lo);
        bf16x8 qr[4];
#pragma unroll
        for (int d0 = 0; d0 < 4; ++d0) qr[d0] = *(const bf16x8*)(Q + (qrow + r32) * D + h * HD + d0 * 16 + hi * 8);
        float mhat = 0.f, lrun = 0.f; f32x16 o0 = {}, o1 = {};
        const int s_first = (ci > s_lo) ? ci : s_lo;
        for (int s = s_lo; s < 12; ++s) {
            asm volatile("s_waitcnt vmcnt(0)" ::: "memory");
            __syncthreads();
            if (s + 1 < 12) ATT_DMA(s + 1);
            const int delta = ci + 8 - s;
            if (delta >= 0 && delta <= 8) {
                const LAS unsigned char* Ks = lds + AT_K + (s & 1) * 8192; const LAS unsigned char* Vs = lds + AT_V + (s & 1) * 8192;
                f32x16 p0, p1;
                { const float c0 = ((delta >= 3) ? bt[NREL - 1] : 0.f) - mhat;
#pragma unroll
                    for (int r = 0; r < 16; ++r) { p0[r] = c0; p1[r] = c0; } }
                { const LAS unsigned char* kb = Ks + hi * 1024 + r32 * 16;
#pragma unroll
                    for (int d0 = 0; d0 < 4; ++d0) { const bf16x8 k0 = *(const LAS bf16x8*)(kb + d0 * 2048), k1 = *(const LAS bf16x8*)(kb + d0 * 2048 + 512);
                        p0 = __builtin_amdgcn_mfma_f32_32x32x16_bf16(k0, qr[d0], p0, 0, 0, 0); p1 = __builtin_amdgcn_mfma_f32_32x32x16_bf16(k1, qr[d0], p1, 0, 0, 0); } }
                if (delta < 3) {
                    const int base = 64 * delta + 32 * qh + r32 + 63;
#pragma unroll
                    for (int r = 0; r < 16; ++r) { const int k0 = crow(r, hi); int i0 = base - k0, i1 = base - k0 - 32; i0 = i0 > NREL - 1 ? NREL - 1 : i0; i1 = i1 > NREL - 1 ? NREL - 1 : i1; i0 = i0 < 0 ? 0 : i0; i1 = i1 < 0 ? 0 : i1;
                        p0[r] += bt[i0]; p1[r] += bt[i1]; }
                }
                float rm;
                { float a = MX3(p0[0], p0[1], p1[0]), c = MX3(p0[2], p0[3], p1[1]); a = MX3(a, p1[2], p1[3]);
#pragma unroll
                    for (int r = 4; r < 16; r += 4) { a = MX3(a, p0[r], p0[r + 1]); c = MX3(c, p0[r + 2], p0[r + 3]); a = MX3(a, p1[r], p1[r + 1]); c = MX3(c, p1[r + 2], p1[r + 3]); }
                    rm = __builtin_fmaxf(a, c);
                    auto rr = __builtin_amdgcn_permlane32_swap(__float_as_uint(rm), __float_as_uint(rm), false, false); rm = __builtin_fmaxf(__uint_as_float(rr[0]), __uint_as_float(rr[1])); }
                if (s == s_first) {
                    mhat = rm;
#pragma unroll
                    for (int r = 0; r < 16; ++r) { p0[r] -= rm; p1[r] -= rm; }
                } else if (__any(rm > ATT_THR)) {
                    const float dl = __builtin_fmaxf(rm, 0.f); mhat += dl;
#pragma unroll
                    for (int r = 0; r < 16; ++r) { p0[r] -= dl; p1[r] -= dl; }
                    const float f = __builtin_amdgcn_exp2f(-dl); lrun *= f;
                    if (hi == 0) wsf[r32] = f;
#pragma unroll
                    for (int r = 0; r < 16; ++r) { const float fr_ = wsf[crow(r, hi)]; o0[r] *= fr_; o1[r] *= fr_; }
                }
                float psum = 0.f;
#pragma unroll
                for (int r = 0; r < 16; ++r) { p0[r] = __builtin_amdgcn_exp2f(p0[r]); p1[r] = __builtin_amdgcn_exp2f(p1[r]); psum += p0[r] + p1[r]; }
                lrun += psum;
                v4u pw[4];
                pw[0] = (v4u){pk2(p0[0], p0[1]), pk2(p0[2], p0[3]), pk2(p0[4], p0[5]), pk2(p0[6], p0[7])};
                pw[1] = (v4u){pk2(p0[8], p0[9]), pk2(p0[10], p0[11]), pk2(p0[12], p0[13]), pk2(p0[14], p0[15])};
                pw[2] = (v4u){pk2(p1[0], p1[1]), pk2(p1[2], p1[3]), pk2(p1[4], p1[5]), pk2(p1[6], p1[7])};
                pw[3] = (v4u){pk2(p1[8], p1[9]), pk2(p1[10], p1[11]), pk2(p1[12], p1[13]), pk2(p1[14], p1[15])};
                const LAS unsigned char* vb = Vs + ((lane >> 4) & 1) * 32 + (lane & 3) * 8 + (4 * hi + ((lane & 15) >> 2)) * 64;
#pragma unroll
                for (int ks = 0; ks < 4; ++ks) { const bf16x8 pa = __builtin_bit_cast(bf16x8, pw[ks]);
                    { const s16x4 lo = tr_read(vb + ks * 1024), hh = tr_read(vb + ks * 1024 + 512); const bf16x8 vfr = (bf16x8){lo[0], lo[1], lo[2], lo[3], hh[0], hh[1], hh[2], hh[3]};
                        o0 = __builtin_amdgcn_mfma_f32_32x32x16_bf16(pa, vfr, o0, 0, 0, 0); }
                    { const s16x4 lo = tr_read(vb + 4096 + ks * 1024), hh = tr_read(vb + 4096 + ks * 1024 + 512); const bf16x8 vfr = (bf16x8){lo[0], lo[1], lo[2], lo[3], hh[0], hh[1], hh[2], hh[3]};
                        o1 = __builtin_amdgcn_mfma_f32_32x32x16_bf16(pa, vfr, o1, 0, 0, 0); } }
            }
        }
#undef ATT_DMA
        { auto rr = __builtin_amdgcn_permlane32_swap(__float_as_uint(lrun), __float_as_uint(lrun), false, false); lrun = __uint_as_float(rr[0]) + __uint_as_float(rr[1]); }
        if (hi == 0) wsf[32 + r32] = lrun;
        { LAS bf16* stg = (LAS bf16*)(lds + AT_OST) + wave * 2048;
#pragma unroll
            for (int r = 0; r < 16; ++r) { const int orow = crow(r, hi); const float rl = __builtin_amdgcn_rcpf(wsf[32 + orow]);
                stg[orow * 64 + r32] = (bf16)(pk2(o0[r] * rl, 0.f) & 0xffffu); stg[orow * 64 + 32 + r32] = (bf16)(pk2(o1[r] * rl, 0.f) & 0xffffu); }
            bf16* Ow = (DRY ? P.xb : Q) + qrow * D + h * HD;
#pragma unroll
            for (int i = 0; i < 4; ++i) { const int row = i * 8 + (lane >> 3), ch = lane & 7; const v4u v = *(const LAS v4u*)(stg + row * 64 + ch * 8); *(v4u*)(Ow + (size_t)row * D + ch * 8) = v; } }
        __syncthreads();
    }
}
#undef MX3

__device__ __forceinline__ void final_phase(const Ptrs& P, int vcu, int G, int wave, int lane) {
    const int gw = vcu * NWAVES + wave, NGW = G * NWAVES;
    f32x4 gn[4];
#pragma unroll
    for (int j = 0; j < 4; ++j) gn[j] = ((const f32x4*)P.final_g)[lane + 64 * j];
    for (int m = gw; m < M; m += NGW) {
        const f32x4 sv = *(const f32x4*)(P.xss + (size_t)m * pg8::NSLOT_X + (lane & 3) * 4);
        float s = (sv[0] + sv[1]) + (sv[2] + sv[3]); s += __shfl_xor(s, 1); s += __shfl_xor(s, 2);
        const float r = __builtin_amdgcn_rsqf(s * (1.0f / D) + EPS);
        GAS f32x4* xr = (GAS f32x4*)(P.out + (size_t)m * D) + lane;
#pragma unroll
        for (int j = 0; j < 4; ++j) { const f32x4 v = xr[64 * j]; xr[64 * j] = v * r * gn[j]; }
    }
}

struct Args { const float* in[15]; float* out; unsigned char* ws; int ph_lo, ph_hi; };
static_assert(sizeof(Args) == 17 * 8 + 8, "Args has no padding");
__global__ void __launch_bounds__(NWAVES * 64, 2) trunk_fwd(Args args) {
    extern __shared__ __attribute__((aligned(16))) unsigned char lds_raw[];
    LAS unsigned char* lds = (LAS unsigned char*)lds_raw;
    volatile LAS unsigned* MISC = (volatile LAS unsigned*)(lds + MISC_OFF);
    const int tid = threadIdx.x, lane = tid & 63, wave = __builtin_amdgcn_readfirstlane(tid >> 6);
    const int G = gridDim.x; const int bx = blockIdx.x; const int vcu = (G % 8 == 0) ? (bx % 8) * (G / 8) + bx / 8 : bx;
    unsigned char* ws = args.ws;
    gu32* ctl = (gu32*)(ws + WS_CTL);
    Ptrs P;
    P.x = args.in[0]; P.norm_mix_g = args.in[1]; P.norm_ffn_g = args.in[2]; P.final_g = args.in[3]; P.a_w_in = args.in[4]; P.a_v_gain = args.in[5]; P.a_w_s = args.in[6]; P.a_b_s = args.in[7];
    P.a_w_out = args.in[8]; P.b_w_qkv = args.in[9]; P.b_rel_bias = args.in[10]; P.b_w_out = args.in[11]; P.ffn_w_gate = args.in[12]; P.ffn_w_up = args.in[13]; P.ffn_w_down = args.in[14];
    P.out = args.out; P.wt = (bf16*)(ws + WS_W); P.xb = (bf16*)(ws + WS_XB); P.act = (bf16*)(ws + WS_ACT); P.xss = (float*)(ws + WS_XSS); P.vss = (float*)(ws + WS_VSS);
    for (int u = tid; u < (LDS_BYTES - LDSCTL_OFF) / 4; u += NWAVES * 64) ((LAS unsigned*)(lds + LDSCTL_OFF))[u] = 0u;
    __syncthreads();
    XcdBarrier bar; bar.bar = (unsigned*)(ctl + CW_BAR); bar.x = 0; bar.st = nullptr;
    if (!MK_PER_PHASE) bar = xcd_barrier_post((unsigned*)(ctl + CW_BAR), MISC + 8);
    const int lo = args.ph_lo, hi = args.ph_hi;
#ifndef DBG_MASK
#define DBG_MASK 0xff
#endif
#define IN(k) (lo <= (k) && (k) < hi)
#define SEAM(k) do { if (IN(k) && IN((k) + 1)) { xcd_barrier(bar); if (PROBE == 1) xcd_barrier(bar); } } while (0)

    if ((DBG_MASK & 1) && IN(0)) { p0_prologue(P, lds, vcu, G, wave, lane); if (PROBE == 2) { __syncthreads(); p0_prologue(P, lds, vcu, G, wave, lane); } }
    SEAM(0);
#pragma unroll 1
    for (int layer = 0; layer < DEPTH; ++layer) {
        const int j = layer >> 1, ph = 1 + 5 * layer;
        const bf16* wgu = P.wt + WO_GU + (size_t)layer * D * FF2; const bf16* wdn = P.wt + WO_DN + (size_t)layer * FF * D;
        if ((layer & 1) == 0) {
            if ((DBG_MASK & 2) && IN(ph)) { pg8::Gemm g{P.xb, P.wt + WO_IN + (size_t)j * D * GH2, M, GH2, D, D}; pg8::StaticOrder S; S.init(M, GH2, G, bx);
                pg8::EpiGeluStats E{P.act, GH2, P.xss, P.vss, GH / 256, EPS};
                pg8::gemm_phase<pg8::EpiGeluStats, pg8::StaticOrder, true, true>(lds + RING_OFF, g, S, E);
                if (PROBE == 5) { __syncthreads(); pg8::gemm_phase<pg8::EpiGeluStats, pg8::StaticOrder, true, true>(lds + RING_OFF, g, S, E); } }
            SEAM(ph);
            if ((DBG_MASK & 4) && IN(ph + 1)) { if (PROBE == 4) spatial_phase<true>(P, j, lds, vcu, G, tid, wave, lane); spatial_phase<false>(P, j, lds, vcu, G, tid, wave, lane); }
            SEAM(ph + 1);
            if ((DBG_MASK & 8) && IN(ph + 2)) { pg8::Gemm g{P.act, P.wt + WO_AOUT + (size_t)j * GH * D, M, D, GH, GH2}; pg8::StaticOrder S; S.init(M, D, G, bx);
                pg8::EpiResid E{layer == 0 ? P.x : P.out, P.out, P.xb, P.xss, D};
                pg8::gemm_phase<pg8::EpiResid, pg8::StaticOrder, false, true>(lds + RING_OFF, g, S, E); }
            SEAM(ph + 2);
        } else {
            if ((DBG_MASK & 16) && IN(ph)) { pg8::Gemm g{P.xb, P.wt + WO_QKV + (size_t)j * D * 3 * D, M, 3 * D, D, D}; pg8::StaticOrder S; S.init(M, 3 * D, G, bx);
                pg8::EpiQkv E{P.act, D, (size_t)M * D, P.xss, EPS, QSCALE};
                pg8::gemm_phase<pg8::EpiQkv, pg8::StaticOrder, true, true>(lds + RING_OFF, g, S, E);
                if (PROBE == 7) { __syncthreads(); pg8::gemm_phase<pg8::EpiQkv, pg8::StaticOrder, true, true>(lds + RING_OFF, g, S, E); } }
            SEAM(ph);
            if ((DBG_MASK & 32) && IN(ph + 1)) { if (PROBE == 3) attn_phase<true>(P, j, lds, vcu, G, tid, wave, lane); attn_phase<false>(P, j, lds, vcu, G, tid, wave, lane); }
            SEAM(ph + 1);
            if ((DBG_MASK & 8) && IN(ph + 2)) { pg8::Gemm g{P.act, P.wt + WO_BOUT + (size_t)j * D * D, M, D, D, D}; pg8::StaticOrder S; S.init(M, D, G, bx);
                pg8::EpiResid E{P.out, P.out, P.xb, P.xss, D};
                pg8::gemm_phase<pg8::EpiResid, pg8::StaticOrder, false, true>(lds + RING_OFF, g, S, E); }
            SEAM(ph + 2);
        }
        if ((DBG_MASK & 64) && IN(ph + 3)) { pg8::Gemm g{P.xb, wgu, M, FF2, D, D}; pg8::StaticOrder S; S.init(M, FF2, G, bx);
            pg8::EpiSwiglu E{P.act, FF, P.xss, EPS};
            pg8::gemm_phase<pg8::EpiSwiglu, pg8::StaticOrder, true, true>(lds + RING_OFF, g, S, E);
            if (PROBE == 6) { __syncthreads(); pg8::gemm_phase<pg8::EpiSwiglu, pg8::StaticOrder, true, true>(lds + RING_OFF, g, S, E); } }
        SEAM(ph + 3);
        if ((DBG_MASK & 8) && IN(ph + 4)) { pg8::Gemm g{P.act, wdn, M, D, FF, FF}; pg8::StaticOrder S; S.init(M, D, G, bx);
            pg8::EpiResid E{P.out, P.out, P.xb, P.xss, D};
            pg8::gemm_phase<pg8::EpiResid, pg8::StaticOrder, false, true>(lds + RING_OFF, g, S, E); }
        SEAM(ph + 4);
    }
    if ((DBG_MASK & 128) && IN(N_PHASES - 1)) final_phase(P, vcu, G, wave, lane);
#undef IN
#undef SEAM
}

extern "C" void kernel_launch(void* const* d_in, const int* in_sizes, int n_in, void* d_out, int out_size, void* d_ws, size_t ws_size, hipStream_t stream) {
    static int grid = 0;
    if (grid == 0) {
        if (n_in != 15 || in_sizes[0] != M * D || out_size != M * D || ws_size < WS_END) { fprintf(stderr, "kernel_launch: unexpected shapes (n_in %d, in0 %d, out %d, ws %zu < %zu); nothing launched\n", n_in, n_in > 0 ? in_sizes[0] : -1, out_size, ws_size, (size_t)WS_END); grid = -1; return; }
        int dev = 0, cus = 0, per_cu = 0;
        if (hipGetDevice(&dev) != hipSuccess || hipDeviceGetAttribute(&cus, hipDeviceAttributeMultiprocessorCount, dev) != hipSuccess) { grid = -1; return; }
        if (hipFuncSetAttribute((const void*)trunk_fwd, hipFuncAttributeMaxDynamicSharedMemorySize, LDS_BYTES) != hipSuccess) { fprintf(stderr, "kernel_launch: hipFuncSetAttribute failed\n"); grid = -1; return; }
        if (hipOccupancyMaxActiveBlocksPerMultiprocessor(&per_cu, (const void*)trunk_fwd, NWAVES * 64, LDS_BYTES) != hipSuccess || per_cu < 1) { fprintf(stderr, "kernel_launch: occupancy query reports %d workgroups per CU; nothing launched\n", per_cu); (void)hipGetLastError(); grid = -1; return; }
        grid = cus;
    }
    if (grid < 0) return;
    if (hipMemsetAsync((char*)d_ws + WS_CTL, 0, CTL_ZERO_BYTES, stream) != hipSuccess) return;
    Args a{};
    for (int i = 0; i < 15; ++i) a.in[i] = (const float*)d_in[i];
    a.out = (float*)d_out; a.ws = (unsigned char*)d_ws;
#if MK_PER_PHASE
    for (int p = 0; p < N_PHASES; ++p) { a.ph_lo = p; a.ph_hi = p + 1; hipLaunchKernelGGL(trunk_fwd, dim3(grid), dim3(NWAVES * 64), LDS_BYTES, stream, a); }
#else
    a.ph_lo = 0; a.ph_hi = N_PHASES;
    hipLaunchKernelGGL(trunk_fwd, dim3(grid), dim3(NWAVES * 64), LDS_BYTES, stream, a);
#endif
}
```

```cpp
#include <hip/hip_runtime.h>
#include <cstdio>
#include <cstdint>
#ifndef PROBE
#define PROBE 0
#endif
namespace pg8 {
#define PG8_LAS __attribute__((address_space(3)))
typedef unsigned short bf16_t;
typedef short bf16x8 __attribute__((ext_vector_type(8)));
typedef float f32x4 __attribute__((ext_vector_type(4)));
typedef unsigned u32x4 __attribute__((ext_vector_type(4)));
constexpr int BM = 256, BK = 64, HALF = 128, HTB = HALF * BK * 2  , STAGE_BYTES = 8 * HTB, NXCD = 8, WGM = 8;

__host__ __device__ __forceinline__ int lds_byte(int r, int c) { const int st = (r >> 4) * 2 + (c >> 5), rr = r & 15, cc = c & 31, ob = rr * 64 + cc * 2; return st * 1024 + (ob ^ (((ob >> 9) & 1) << 5)); }
__host__ __device__ __forceinline__ void stage_rc(int b, int& R, int& C) { const int st = b / 1024, sb = b % 1024, swz = sb ^ (((sb >> 9) & 1) << 5); R = (st >> 1) * 16 + swz / 64; C = (st & 1) * 32 + (swz % 64) / 2; }
__host__ __device__ __forceinline__ int perm32(int rho) { const int n = rho >> 4, i = rho & 15; return 8 * (i >> 2) + 4 * n + (i & 3); }

struct Unit { int pm, pn; };
struct Gemm { const bf16_t* A; const bf16_t* Bt; int M, N, K, lda; };

struct StaticOrder {
    int nM, nN, nwg, G, c;
    __host__ __device__ void init(int M, int N, int G_, int c_) { nM = M / BM; nN = N / BM; nwg = nM * nN; G = G_; c = c_; }
    __host__ __device__ bool next(int i, Unit& u) const {
        const long L = (long)i * G + c; if (L >= nwg) return false;
        int wgid = (int)L; { const int q = nwg / NXCD, r = nwg % NXCD, xcd = wgid % NXCD, off = wgid / NXCD; wgid = (xcd < r ? xcd * (q + 1) : r * (q + 1) + (xcd - r) * q) + off; }
        const int nig = WGM * nN, gid = wgid / nig, fm = gid * WGM, gsz = (nM - fm) < WGM ? (nM - fm) : WGM;
        u.pm = fm + ((wgid % nig) % gsz); u.pn = (wgid % nig) / gsz; return true;
    }
    __device__ __forceinline__ void a_ready(const Unit&) const {}
    __device__ __forceinline__ void done(const Unit&) const {}
};

__device__ __forceinline__ unsigned cvt_pk_bf16(float lo, float hi) { unsigned r; asm volatile("v_cvt_pk_bf16_f32 %0, %1, %2" : "=v"(r) : "v"(lo), "v"(hi)); return r; }
typedef float f32x2 __attribute__((ext_vector_type(2)));
#ifndef STORE_WT
#define STORE_WT 1
#endif
__device__ __forceinline__ void store16(void* p, u32x4 v) {
#if STORE_WT
    asm volatile("global_store_dwordx4 %0, %1, off sc1\n\ts_nop 1" :: "v"(p), "v"(v) : "memory");
#else
    *(u32x4*)p = v;
#endif
}
__device__ __forceinline__ void store16f(void* p, f32x4 v) {
#if STORE_WT
    asm volatile("global_store_dwordx4 %0, %1, off sc1\n\ts_nop 1" :: "v"(p), "v"(v) : "memory");
#else
    *(f32x4*)p = v;
#endif
}
typedef unsigned u32x2 __attribute__((ext_vector_type(2)));
__device__ __forceinline__ void store8(void* p, u32x2 v) {
#if STORE_WT
    asm volatile("global_store_dwordx2 %0, %1, off sc1\n\ts_nop 1" :: "v"(p), "v"(v) : "memory");
#else
    *(u32x2*)p = v;
#endif
}
constexpr int NSLOT_X = 16;
constexpr int NSLOT_V = 32;
__device__ __forceinline__ void row_scales(const float* ss, int row0, int fq, float inv_n, float eps, float (&rs)[2][4]) {
#pragma unroll
    for (int ai = 0; ai < 2; ++ai)
#pragma unroll
        for (int m = 0; m < 4; ++m) {
            const f32x4 v = *(const f32x4*)(ss + (size_t)(row0 + ai * HALF + m * 16) * NSLOT_X + fq * 4);
            float s = (v[0] + v[1]) + (v[2] + v[3]);
            s += __shfl_xor(s, 16); s += __shfl_xor(s, 32);
            rs[ai][m] = __builtin_amdgcn_rsqf(s * inv_n + eps);
        }
}
__device__ __forceinline__ float gelu_tanh(float x) {
    const float t = x * x, u2 = x * (2.302208198f + 0.1029432398f * t);
    const float e = __builtin_amdgcn_exp2f(-u2);
    return x * __builtin_amdgcn_rcpf(1.0f + e);
}
__device__ __forceinline__ float silu_mul(float g, float u) {
    const float e = __builtin_amdgcn_exp2f(g * -1.4426950408889634f);
    return (g * u) * __builtin_amdgcn_rcpf(1.0f + e);
}
struct EpiGeluStats {
    static constexpr bool PERM = true, AFTER_DRAIN = false, PROBE_TWICE = false;
    bf16_t* O; int ldc; const float* xss; float* vss; int vtile0; float eps;
    __device__ __forceinline__ void operator()(const f32x4 (&acc)[2][2][4][2], const Unit& u, int wr, int wc, int fr, int fq) const {
        const int row0 = u.pm * BM + wr * 64 + fr, col0 = u.pn * BM + wc * 32 + 8 * fq;
        float rs[2][4]; row_scales(xss, row0, fq, 1.0f / 1024.0f, eps, rs);
        const bool isv = u.pn >= vtile0;
#pragma unroll
        for (int ai = 0; ai < 2; ++ai)
#pragma unroll
            for (int m = 0; m < 4; ++m) { const int row = row0 + ai * HALF + m * 16; bf16_t* rowp = O + (size_t)row * ldc + col0; const float r = rs[ai][m]; float ssq = 0.f;
#pragma unroll
                for (int bj = 0; bj < 2; ++bj) { f32x4 v0 = acc[ai][bj][m][0] * r, v1 = acc[ai][bj][m][1] * r;
#pragma unroll
                    for (int e = 0; e < 4; ++e) { v0[e] = gelu_tanh(v0[e]); v1[e] = gelu_tanh(v1[e]); }
                    ssq += (v0[0] * v0[0] + v0[1] * v0[1]) + (v0[2] * v0[2] + v0[3] * v0[3]) + (v1[0] * v1[0] + v1[1] * v1[1]) + (v1[2] * v1[2] + v1[3] * v1[3]);
                    u32x4 w; w.x = cvt_pk_bf16(v0[0], v0[1]); w.y = cvt_pk_bf16(v0[2], v0[3]); w.z = cvt_pk_bf16(v1[0], v1[1]); w.w = cvt_pk_bf16(v1[2], v1[3]);
                    store16(rowp + bj * HALF, w); }
                if (isv) { ssq += __shfl_xor(ssq, 16); ssq += __shfl_xor(ssq, 32); if (fq == 0) vss[(size_t)row * NSLOT_V + (u.pn - vtile0) * 4 + wc] = ssq; } }
    }
};
struct EpiSwiglu {
    static constexpr bool PERM = true, AFTER_DRAIN = false, PROBE_TWICE = true;
    bf16_t* O; int ldc; const float* xss; float eps;
    __device__ __forceinline__ void operator()(const f32x4 (&acc)[2][2][4][2], const Unit& u, int wr, int wc, int fr, int fq) const {
        const int row0 = u.pm * BM + wr * 64 + fr, col0 = u.pn * HALF + wc * 32 + 8 * fq;
        float rs[2][4]; row_scales(xss, row0, fq, 1.0f / 1024.0f, eps, rs);
#pragma unroll
        for (int ai = 0; ai < 2; ++ai)
#pragma unroll
            for (int m = 0; m < 4; ++m) { const int row = row0 + ai * HALF + m * 16; const float r = rs[ai][m] * (PROBE == 9 ? 0.5f : 1.0f);
                const f32x4 g0 = acc[ai][0][m][0] * r, g1 = acc[ai][0][m][1] * r, u0 = acc[ai][1][m][0] * r, u1 = acc[ai][1][m][1] * r;
                float o[8];
#pragma unroll
                for (int e = 0; e < 4; ++e) { o[e] = silu_mul(g0[e], u0[e]); o[4 + e] = silu_mul(g1[e], u1[e]); }
                u32x4 w; w.x = cvt_pk_bf16(o[0], o[1]); w.y = cvt_pk_bf16(o[2], o[3]); w.z = cvt_pk_bf16(o[4], o[5]); w.w = cvt_pk_bf16(o[6], o[7]);
                store16(O + (size_t)row * ldc + col0, w); }
    }
};
struct EpiQkv {
    static constexpr bool PERM = true, AFTER_DRAIN = false, PROBE_TWICE = false;
    bf16_t* O; int ldc; size_t split_stride; const float* xss; float eps; float scale0;
    __device__ __forceinline__ void operator()(const f32x4 (&acc)[2][2][4][2], const Unit& u, int wr, int wc, int fr, int fq) const {
        const int t = u.pn >> 2; bf16_t* base = O + (size_t)t * split_stride; const float sc = (t == 0) ? scale0 : 1.0f;
        const int row0 = u.pm * BM + wr * 64 + fr, col0 = (u.pn & 3) * BM + wc * 32 + 8 * fq;
        float rs[2][4]; row_scales(xss, row0, fq, 1.0f / 1024.0f, eps, rs);
#pragma unroll
        for (int ai = 0; ai < 2; ++ai)
#pragma unroll
            for (int m = 0; m < 4; ++m) { const int row = row0 + ai * HALF + m * 16; bf16_t* rowp = base + (size_t)row * ldc + col0; const float r = rs[ai][m] * sc;
#pragma unroll
                for (int bj = 0; bj < 2; ++bj) { const f32x4 v0 = acc[ai][bj][m][0] * r, v1 = acc[ai][bj][m][1] * r;
                    u32x4 w; w.x = cvt_pk_bf16(v0[0], v0[1]); w.y = cvt_pk_bf16(v0[2], v0[3]); w.z = cvt_pk_bf16(v1[0], v1[1]); w.w = cvt_pk_bf16(v1[2], v1[3]);
                    store16(rowp + bj * HALF, w); } }
    }
};
struct EpiResid {
    static constexpr bool PERM = true, AFTER_DRAIN = false, PROBE_TWICE = false;
    bf16_t* xb; float* xss; int ldc;
    __device__ __forceinline__ void operator()(const f32x4 (&acc)[2][2][4][2], const Unit& u, int wr, int wc, int fr, int fq) const {
        asm volatile("" : "+v"(fr), "+v"(fq));
        const int row0 = u.pm * BM + wr * 64 + fr, col0 = u.pn * BM + wc * 32 + 8 * fq;
        u32x4 pre[2][4][2];
#pragma unroll
        for (int ai = 0; ai < 2; ++ai)
#pragma unroll
            for (int m = 0; m < 4; ++m)
#pragma unroll
                for (int bj = 0; bj < 2; ++bj) pre[ai][m][bj] = *(const u32x4*)(xb + (size_t)(row0 + ai * HALF + m * 16) * ldc + col0 + bj * HALF);
#pragma unroll
        for (int ai = 0; ai < 2; ++ai)
#pragma unroll
            for (int m = 0; m < 4; ++m) { const int row = row0 + ai * HALF + m * 16; bf16_t* rowp = xb + (size_t)row * ldc + col0; float ssq = 0.f;
#pragma unroll
                for (int bj = 0; bj < 2; ++bj) { const u32x4 b = pre[ai][m][bj]; const f32x4 a0 = acc[ai][bj][m][0], a1 = acc[ai][bj][m][1];
                    float o[8];
                    o[0] = __uint_as_float(b.x << 16) + a0[0]; o[1] = __uint_as_float(b.x & 0xffff0000u) + a0[1]; o[2] = __uint_as_float(b.y << 16) + a0[2]; o[3] = __uint_as_float(b.y & 0xffff0000u) + a0[3];
                    o[4] = __uint_as_float(b.z << 16) + a1[0]; o[5] = __uint_as_float(b.z & 0xffff0000u) + a1[1]; o[6] = __uint_as_float(b.w << 16) + a1[2]; o[7] = __uint_as_float(b.w & 0xffff0000u) + a1[3];
                    ssq += ((o[0] * o[0] + o[1] * o[1]) + (o[2] * o[2] + o[3] * o[3])) + ((o[4] * o[4] + o[5] * o[5]) + (o[6] * o[6] + o[7] * o[7]));
                    u32x4 w; w.x = cvt_pk_bf16(o[0], o[1]); w.y = cvt_pk_bf16(o[2], o[3]); w.z = cvt_pk_bf16(o[4], o[5]); w.w = cvt_pk_bf16(o[6], o[7]);
                    store16(rowp + bj * HALF, w); }
                ssq += __shfl_xor(ssq, 16); ssq += __shfl_xor(ssq, 32);
                if (fq == 0) xss[(size_t)row * NSLOT_X + u.pn * 4 + wc] = ssq; }
    }
};

template <class Epi, class Sched, bool ALIGN_EPI = false, bool SP2 = false>
__device__ __forceinline__ void gemm_phase(PG8_LAS unsigned char* lds, const Gemm g, const Sched& S, const Epi& E) {
    int tid_ = threadIdx.x; asm volatile("" : "+v"(tid_));
    const int tid = tid_, wid = __builtin_amdgcn_readfirstlane(tid >> 6), lane = tid & 63, wr = wid >> 2, wc = wid & 3, fr = lane & 15, fq = lane >> 4;
    const int K = g.K, nt = K / BK;
    unsigned voffA[2], voffB[2];
#pragma unroll
    for (int i = 0; i < 2; ++i) { int R, C; stage_rc(tid * 16 + i * 8192, R, C); const int Rb = Epi::PERM ? ((R & ~31) + perm32(R & 31)) : R;
        voffA[i] = (unsigned)(R * g.lda + C) * 2u; voffB[i] = (unsigned)(Rb * K + C) * 2u; }
    const size_t kstep = (size_t)(BK * 2);
    const size_t hstep = (size_t)HALF * K * 2;
    const size_t tstep = 2 * hstep; const size_t hstepA = (size_t)HALF * g.lda * 2, tstepA = 2 * hstepA;
    const unsigned ldsw = (unsigned)wid * 1024u;
    const int aoff = lds_byte(wr * 64 + fr, fq * 8), boff = lds_byte(wc * 32 + fr, fq * 8);
#define PG8_SA(b, h) (((b) * 2 + (h)) * HTB)
#define PG8_SB(b, h) ((4 + (b) * 2 + (h)) * HTB)
#define PG8_STAGE(bufoff, gbase, voff) do { _Pragma("unroll") for (int _i = 0; _i < 2; ++_i) \
        __builtin_amdgcn_global_load_lds((const unsigned*)((const char*)(gbase) + (voff)[_i]), (PG8_LAS unsigned*)(lds + (bufoff) + ldsw + _i * 8192), 16, 0, 0); } while (0)
#define PG8_LDA(dst, b, h) do { _Pragma("unroll") for (int m = 0; m < 4; ++m) _Pragma("unroll") for (int k = 0; k < 2; ++k) dst[m][k] = *(const PG8_LAS bf16x8*)(lds + PG8_SA(b, h) + aoff + m * 2048 + k * 1024); } while (0)
#define PG8_LDB(dst, b, h) do { _Pragma("unroll") for (int n = 0; n < 2; ++n) _Pragma("unroll") for (int k = 0; k < 2; ++k) dst[n][k] = *(const PG8_LAS bf16x8*)(lds + PG8_SB(b, h) + boff + n * 2048 + k * 1024); } while (0)
#define PG8_MMA(ai, bj, At, Bt) do { __builtin_amdgcn_s_setprio(1); _Pragma("unroll") for (int m = 0; m < 4; ++m) _Pragma("unroll") for (int n = 0; n < 2; ++n) _Pragma("unroll") for (int k = 0; k < 2; ++k) \
        acc[ai][bj][m][n] = __builtin_amdgcn_mfma_f32_16x16x32_bf16(Bt[n][k], At[m][k], acc[ai][bj][m][n], 0, 0, 0); __builtin_amdgcn_s_setprio(0); } while (0)
#define PG8_WAIT_V(n) asm volatile("s_waitcnt vmcnt(" #n ")" ::: "memory")
#define PG8_WAIT_L(n) asm volatile("s_waitcnt lgkmcnt(" #n ")" ::: "memory")
#define PG8_BAR __builtin_amdgcn_s_barrier()
#define PG8_SCHED __builtin_amdgcn_sched_barrier(0)
    Unit cur, nxt; int ui = 0;
    if (!S.next(0, cur)) return;
    f32x4 acc[2][2][4][2];
#pragma unroll
    for (int a = 0; a < 2; ++a)
#pragma unroll
        for (int b = 0; b < 2; ++b)
#pragma unroll
            for (int m = 0; m < 4; ++m)
#pragma unroll
                for (int n = 0; n < 2; ++n) acc[a][b][m][n] = (f32x4){0.f, 0.f, 0.f, 0.f};
    bf16x8 At[4][2], B0[2][2], B1[2][2];
    const char* cA = (const char*)g.A + (size_t)cur.pm * tstepA; const char* cB = (const char*)g.Bt + (size_t)cur.pn * tstep;
    S.a_ready(cur);
    if constexpr (SP2) {
        PG8_STAGE(PG8_SB(0, 0), cB, voffB); PG8_STAGE(PG8_SB(0, 1), cB + hstep, voffB); PG8_STAGE(PG8_SA(0, 0), cA, voffA); PG8_STAGE(PG8_SA(0, 1), cA + hstepA, voffA);
        if (wr == 1) PG8_BAR;
        PG8_WAIT_V(2); PG8_BAR;
        PG8_STAGE(PG8_SB(1, 0), cB + kstep, voffB); PG8_STAGE(PG8_SA(1, 0), cA + kstep, voffA); PG8_STAGE(PG8_SB(1, 1), cB + hstep + kstep, voffB);
        PG8_WAIT_V(6); PG8_BAR;
    } else {
        PG8_STAGE(PG8_SB(0, 0), cB, voffB); PG8_STAGE(PG8_SA(0, 0), cA, voffA); PG8_STAGE(PG8_SB(0, 1), cB + hstep, voffB); PG8_STAGE(PG8_SA(0, 1), cA + hstepA, voffA);
        if (wr == 1) PG8_BAR;
        PG8_WAIT_V(4); PG8_BAR;
        PG8_STAGE(PG8_SB(1, 0), cB + kstep, voffB); PG8_STAGE(PG8_SA(1, 0), cA + kstep, voffA); PG8_STAGE(PG8_SB(1, 1), cB + hstep + kstep, voffB);
        PG8_WAIT_V(6); PG8_BAR;
    }
    for (;;) {
        const bool has_next = S.next(ui + 1, nxt);
        const char* nA = has_next ? (const char*)g.A + (size_t)nxt.pm * tstepA : cA; const char* nB = has_next ? (const char*)g.Bt + (size_t)nxt.pn * tstep : cB;
        const int ntl = (PROBE == 9 && Epi::PROBE_TWICE) ? 2 * nt : nt;
        for (int t = 0; t < ntl; t += 2) {
            const bool last = (t == ntl - 2);
            const int t1 = (t + 1 >= nt) ? t + 1 - nt : t + 1, t2 = (t + 2 >= nt) ? t + 2 - nt : t + 2;
            const char* a1 = cA + (size_t)t1 * kstep;
            const char* a2 = last ? nA : cA + (size_t)t2 * kstep; const char* b2 = last ? nB : cB + (size_t)t2 * kstep;
            const char* a3 = a2 + kstep; const char* b3 = b2 + kstep;
            if (last && has_next) S.a_ready(nxt);
            if constexpr (SP2) {
            PG8_LDB(B0, 0, 0); PG8_LDB(B1, 0, 1); PG8_SCHED; PG8_LDA(At, 0, 0); PG8_STAGE(PG8_SA(1, 1), a1 + hstepA, voffA);
            PG8_WAIT_V(8); PG8_WAIT_L(0); PG8_BAR; PG8_MMA(0, 0, At, B0); PG8_MMA(0, 1, At, B1); PG8_BAR; PG8_SCHED;
            PG8_LDA(At, 0, 1); PG8_STAGE(PG8_SB(0, 0), b2, voffB); PG8_STAGE(PG8_SB(0, 1), b2 + hstep, voffB); PG8_STAGE(PG8_SA(0, 0), a2, voffA);
            PG8_WAIT_V(8); PG8_WAIT_L(0); PG8_BAR; PG8_MMA(1, 0, At, B0); PG8_MMA(1, 1, At, B1); PG8_BAR; PG8_SCHED;
            PG8_LDB(B0, 1, 0); PG8_LDB(B1, 1, 1); PG8_SCHED; PG8_LDA(At, 1, 0); PG8_STAGE(PG8_SA(0, 1), a2 + hstepA, voffA);
            PG8_WAIT_V(8); PG8_WAIT_L(0); PG8_BAR; PG8_MMA(0, 0, At, B0); PG8_MMA(0, 1, At, B1); PG8_BAR; PG8_SCHED;
            PG8_LDA(At, 1, 1); PG8_STAGE(PG8_SB(1, 0), b3, voffB); PG8_STAGE(PG8_SB(1, 1), b3 + hstep, voffB); PG8_STAGE(PG8_SA(1, 0), a3, voffA);
            PG8_WAIT_V(8); PG8_WAIT_L(0); PG8_BAR; PG8_MMA(1, 0, At, B0); PG8_MMA(1, 1, At, B1); PG8_BAR; PG8_SCHED;
            } else {
            PG8_LDB(B0, 0, 0); PG8_SCHED; PG8_LDA(At, 0, 0); PG8_STAGE(PG8_SA(1, 1), a1 + hstepA, voffA);
            PG8_WAIT_L(8); PG8_BAR; PG8_WAIT_L(0); PG8_MMA(0, 0, At, B0); PG8_BAR; PG8_SCHED;
            PG8_LDB(B1, 0, 1); PG8_STAGE(PG8_SB(0, 0), b2, voffB);
            PG8_BAR; PG8_WAIT_L(0); PG8_MMA(0, 1, At, B1); PG8_BAR;
            PG8_LDA(At, 0, 1); PG8_STAGE(PG8_SA(0, 0), a2, voffA);
            PG8_BAR; PG8_WAIT_L(0); PG8_MMA(1, 0, At, B0); PG8_BAR; PG8_SCHED;
            PG8_STAGE(PG8_SB(0, 1), b2 + hstep, voffB);
            PG8_WAIT_V(6); PG8_BAR; PG8_MMA(1, 1, At, B1); PG8_BAR;
            PG8_LDB(B0, 1, 0); PG8_SCHED; PG8_LDA(At, 1, 0); PG8_STAGE(PG8_SA(0, 1), a2 + hstepA, voffA);
            PG8_WAIT_L(8); PG8_BAR; PG8_WAIT_L(0); PG8_MMA(0, 0, At, B0); PG8_BAR; PG8_SCHED;
            PG8_LDB(B1, 1, 1); PG8_STAGE(PG8_SB(1, 0), b3, voffB);
            PG8_BAR; PG8_WAIT_L(0); PG8_MMA(0, 1, At, B1); PG8_BAR;
            PG8_LDA(At, 1, 1); PG8_STAGE(PG8_SA(1, 0), a3, voffA);
            PG8_BAR; PG8_WAIT_L(0); PG8_MMA(1, 0, At, B0); PG8_BAR; PG8_SCHED;
            PG8_STAGE(PG8_SB(1, 1), b3 + hstep, voffB);
            PG8_WAIT_V(6); PG8_BAR; PG8_MMA(1, 1, At, B1); PG8_BAR;
            }
        }
        if constexpr (ALIGN_EPI) { if (wr == 0) PG8_BAR; }
        if constexpr (!Epi::AFTER_DRAIN) { E(acc, cur, wr, wc, fr, fq); if (PROBE == 8 && Epi::PROBE_TWICE) { asm volatile("" ::: "memory"); E(acc, cur, wr, wc, fr, fq); } S.done(cur); }
        if (!has_next) break;
#pragma unroll
        for (int a = 0; a < 2; ++a)
#pragma unroll
            for (int b = 0; b < 2; ++b)
#pragma unroll
                for (int m = 0; m < 4; ++m)
#pragma unroll
                    for (int n = 0; n < 2; ++n) acc[a][b][m][n] = (f32x4){0.f, 0.f, 0.f, 0.f};
        cur = nxt; cA = nA; cB = nB; ++ui;
        if constexpr (ALIGN_EPI) { if (wr == 1) PG8_BAR; }
    }
    PG8_WAIT_V(0);
    if constexpr (!ALIGN_EPI) { if (wr == 0) PG8_BAR; }
    PG8_BAR;
    if constexpr (Epi::AFTER_DRAIN) { E.fused(acc, cur, wr, wc, fr, fq, lds, wid, lane); S.done(cur); }
#undef PG8_SA
#undef PG8_SB
#undef PG8_STAGE
#undef PG8_LDA
#undef PG8_LDB
#undef PG8_MMA
#undef PG8_WAIT_V
#undef PG8_WAIT_L
#undef PG8_BAR
#undef PG8_SCHED
}
}

constexpr int NWAVES = 8;
constexpr int BATCH = 2, SEQ = 8192, D = 1024, DEPTH = 4, M = BATCH * SEQ;
constexpr int GH = 2048, GH2 = 4096, SGU_G = 8, SGU_P = 128, SGU_C = 256;
constexpr int NH = 16, HD = 64, NREL = 192, CHUNK = 64;
constexpr int FF = 2816, FF2 = 5632;
constexpr float EPS = 1e-6f;
constexpr float LOG2E = 1.4426950408889634f;
constexpr float QSCALE = 0.125f * LOG2E;

#ifndef MK_PER_PHASE
#define MK_PER_PHASE 0
#endif
constexpr int N_PHASES = 22;

constexpr size_t MiB = 1u << 20;
constexpr size_t WS_CTL = 0, CTL_ZERO_BYTES = 64 * 1024;
constexpr size_t WS_XSS = 1 * MiB;
constexpr size_t WS_VSS = 2 * MiB;
constexpr size_t WS_W = 4 * MiB;
constexpr size_t WS_XB = 110 * MiB;
constexpr size_t WS_ACT = 142 * MiB;
constexpr size_t WS_END = 270 * MiB;
constexpr size_t WO_IN = 0, WO_AOUT = 8388608, WO_QKV = 12582912, WO_BOUT = 18874368, WO_GU = 20971520, WO_DN = 44040192, WO_END = 55574528;
static_assert(WS_W + WO_END * 2 <= WS_XB && WS_XB + (size_t)M * D * 2 <= WS_ACT && WS_ACT + (size_t)M * GH2 * 2 <= WS_END, "d_ws map");
constexpr int CW_BAR = 1024;

constexpr int RING_OFF = 0, RING_BYTES = 131072;
constexpr int LDSCTL_OFF = RING_BYTES, MISC_OFF = LDSCTL_OFF + 320;
constexpr int LDS_BYTES = 147456;
static_assert(MISC_OFF + 128 <= LDS_BYTES, "LDS map");

#define GAS __attribute__((address_space(1)))
#define LAS __attribute__((address_space(3)))
typedef unsigned short bf16;
typedef unsigned v4u __attribute__((ext_vector_type(4)));
typedef unsigned v2u __attribute__((ext_vector_type(2)));
typedef float f32x4 __attribute__((ext_vector_type(4)));
typedef float f32x16 __attribute__((ext_vector_type(16)));
typedef short bf16x8 __attribute__((ext_vector_type(8)));
typedef short s16x4 __attribute__((ext_vector_type(4)));
typedef GAS unsigned gu32;
#define RLX_AGENT __ATOMIC_RELAXED, __HIP_MEMORY_SCOPE_AGENT
#define LDS_WAIT() asm volatile("s_waitcnt lgkmcnt(0)" ::: "memory")
#define VM_WAIT() asm volatile("s_waitcnt vmcnt(0)" ::: "memory")
__device__ __forceinline__ unsigned pk2(float lo, float hi) { return pg8::cvt_pk_bf16(lo, hi); }
__device__ __forceinline__ float bf_lo(unsigned w) { return __uint_as_float(w << 16); }
__device__ __forceinline__ float bf_hi(unsigned w) { return __uint_as_float(w & 0xffff0000u); }
__device__ __forceinline__ float wave_sum(float v) {
#pragma unroll
    for (int o = 1; o < 64; o <<= 1) v += __shfl_xor(v, o);
    return v;
}
#define XB_TMO      128
#define XB_XCNT(j)  (256  + 64 * (j))
#define XB_XSUB(j)  (1280 + 64 * (j))
#define XB_XGEN(j)  (2304 + 64 * (j))
#define XB_TOP      3328
#define XB_TOPGEN   3392
#define XCD_BAR_WORDS 3456
#define XB_SPIN_CAP (1u << 18)

__device__ __forceinline__ unsigned xb_ld(unsigned* p)              { return __hip_atomic_load(p, __ATOMIC_RELAXED, __HIP_MEMORY_SCOPE_AGENT); }
__device__ __forceinline__ unsigned xb_add(unsigned* p, unsigned v) { return __hip_atomic_fetch_add(p, v, __ATOMIC_RELAXED, __HIP_MEMORY_SCOPE_AGENT); }
__device__ __forceinline__ unsigned xb_xcc_id() { return (unsigned)__builtin_amdgcn_s_getreg((3 << 11) | 20) & 0xFu; }
#define XB_SPIN(cond, bar) do { unsigned _sp = 0; while (cond) { __builtin_amdgcn_s_sleep(1); \
    if ((++_sp & 255u) == 0u) { if (xb_ld(&(bar)[XB_TMO])) break; if (_sp > XB_SPIN_CAP) { atomicAdd(&(bar)[XB_TMO], 1u); break; } } } } while (0)

struct XcdBarrier {
    unsigned* bar; unsigned x;
    volatile LAS unsigned* st;
};

__device__ __forceinline__ XcdBarrier xcd_barrier_post(unsigned* bar, volatile LAS unsigned* st) {
    XcdBarrier b; b.bar = bar; b.x = xb_xcc_id(); b.st = st;
    if (threadIdx.x == 0) (void)xb_add(&bar[XB_XCNT(b.x)], 1u);
    return b;
}
__device__ __forceinline__ void xcd_barrier_complete(unsigned* bar, unsigned x, unsigned& nloc, unsigned& nx) {
    const unsigned G = gridDim.x * gridDim.y * gridDim.z;
    unsigned sum, cnt, mine, sp = 0u;
    for (;;) {
        sum = 0u; cnt = 0u; mine = 0u;
#pragma unroll
        for (unsigned j = 0; j < 16; ++j) { const unsigned c = xb_ld(&bar[XB_XCNT(j)]); sum += c; cnt += (c > 0u) ? 1u : 0u; mine = (j == x) ? c : mine; }
        if (sum == G) break;
        __builtin_amdgcn_s_sleep(1);
        if ((++sp & 255u) == 0u) { if (xb_ld(&bar[XB_TMO])) break; if (sp > XB_SPIN_CAP) { atomicAdd(&bar[XB_TMO], 1u); break; } }
    }
    nloc = mine > 0u ? mine : 1u; nx = cnt > 0u ? cnt : 1u;
}

__device__ __forceinline__ void xcd_barrier(const XcdBarrier& b) {
    asm volatile("s_waitcnt vmcnt(0)" ::: "memory");
    __syncthreads();
    if (threadIdx.x == 0) {
        unsigned* bar = b.bar;
        __builtin_amdgcn_s_waitcnt(0);
        unsigned nloc = b.st[0], nx = b.st[1];
        if (nloc == 0u) { xcd_barrier_complete(bar, b.x, nloc, nx); b.st[0] = nloc; b.st[1] = nx; }
        const unsigned old = xb_add(&bar[XB_XSUB(b.x)], 1u);
        const unsigned gen = old / nloc;
        if (old + 1u == (gen + 1u) * nloc) {
            __builtin_amdgcn_fence(__ATOMIC_RELEASE, "agent");
            asm volatile("s_waitcnt vmcnt(0)" ::: "memory");
            const unsigned og = xb_add(&bar[XB_TOP], 1u);
            const unsigned tg = og / nx;
            if (og + 1u == (tg + 1u) * nx) xb_add(&bar[XB_TOPGEN], 1u);
            else XB_SPIN(xb_ld(&bar[XB_TOPGEN]) == tg, bar);
            __builtin_amdgcn_fence(__ATOMIC_ACQUIRE, "agent");
            xb_add(&bar[XB_XGEN(b.x)], 1u);
            asm volatile("s_waitcnt vmcnt(0)" ::: "memory");
        } else {
            XB_SPIN(xb_ld(&bar[XB_XGEN(b.x)]) == gen, bar);
            __builtin_amdgcn_fence(__ATOMIC_ACQUIRE, "agent");
            asm volatile("s_waitcnt vmcnt(0)" ::: "memory");
        }
    }
    __syncthreads();
}

__device__ __forceinline__ void p0_transpose_item(const float* W, const float* gain, int K, int N, bf16* WT, int drow0, int k0, int n0, LAS unsigned* scr, int lane) {
    const int kp = lane >> 4, n4 = lane & 15;
    f32x4 w[8][2];
    const float* src = W + (size_t)(k0 + 2 * kp) * N + n0 + 4 * n4;
#pragma unroll
    for (int i = 0; i < 8; ++i) { w[i][0] = *(const f32x4*)(src + (size_t)(8 * i) * N); w[i][1] = *(const f32x4*)(src + (size_t)(8 * i + 1) * N); }
    if (gain) {
#pragma unroll
        for (int i = 0; i < 8; ++i) { const float g0 = gain[k0 + 8 * i + 2 * kp], g1 = gain[k0 + 8 * i + 2 * kp + 1]; w[i][0] = w[i][0] * g0; w[i][1] = w[i][1] * g1; }
    }
#pragma unroll
    for (int i = 0; i < 8; ++i)
#pragma unroll
        for (int e = 0; e < 4; ++e) scr[(4 * n4 + e) * 33 + 4 * i + kp] = pk2(w[i][0][e], w[i][1][e]);
    LDS_WAIT(); asm volatile("" ::: "memory");
    const int c = lane & 7;
#pragma unroll
    for (int jn = 0; jn < 8; ++jn) { const int n = (lane >> 3) + 8 * jn; const LAS unsigned* s = scr + n * 33 + 4 * c;
        v4u o; o.x = s[0]; o.y = s[1]; o.z = s[2]; o.w = s[3];
        pg8::store16(WT + (size_t)(drow0 + n) * K + k0 + 8 * c, o); }
    LDS_WAIT(); asm volatile("" ::: "memory");
}
struct Ptrs {
    const float *x, *norm_mix_g, *norm_ffn_g, *final_g, *a_w_in, *a_v_gain, *a_w_s, *a_b_s, *a_w_out, *b_w_qkv, *b_rel_bias, *b_w_out, *ffn_w_gate, *ffn_w_up, *ffn_w_down;
    float* out; bf16* wt; bf16* xb; bf16* act; float* xss; float* vss;
};
__device__ __forceinline__ void p0_prologue(const Ptrs& P, LAS unsigned char* lds, int vcu, int G, int wave, int lane) {
    LAS unsigned* scr = (LAS unsigned*)(lds + RING_OFF + wave * 16384);
    const int gw = vcu * NWAVES + wave, NGW = G * NWAVES;
    constexpr int I_IN = 16 * 64, I_AOUT = 32 * 16, I_QKV = 16 * 48, I_BOUT = 16 * 16, I_GU = 16 * 44, I_DN = 44 * 16;
    constexpr int NITEMS = 2 * I_IN + 2 * I_AOUT + 2 * I_QKV + 2 * I_BOUT + 8 * I_GU + 4 * I_DN;
    for (int it = gw; it < NITEMS; it += NGW) {
        int r = it; const float* W; const float* gain = nullptr; bf16* dst; int K, N, mode = 0;
        if (r < 2 * I_IN) { const int j = r / I_IN; r -= j * I_IN; W = P.a_w_in + (size_t)j * D * GH2; gain = P.norm_mix_g + (2 * j) * D; K = D; N = GH2; dst = P.wt + WO_IN + (size_t)j * D * GH2; }
        else if ((r -= 2 * I_IN) < 2 * I_AOUT) { const int j = r / I_AOUT; r -= j * I_AOUT; W = P.a_w_out + (size_t)j * GH * D; K = GH; N = D; dst = P.wt + WO_AOUT + (size_t)j * GH * D; }
        else if ((r -= 2 * I_AOUT) < 2 * I_QKV) { const int j = r / I_QKV; r -= j * I_QKV; W = P.b_w_qkv + (size_t)j * D * 3 * D; gain = P.norm_mix_g + (2 * j + 1) * D; K = D; N = 3 * D; dst = P.wt + WO_QKV + (size_t)j * D * 3 * D; }
        else if ((r -= 2 * I_QKV) < 2 * I_BOUT) { const int j = r / I_BOUT; r -= j * I_BOUT; W = P.b_w_out + (size_t)j * D * D; K = D; N = D; dst = P.wt + WO_BOUT + (size_t)j * D * D; }
        else if ((r -= 2 * I_BOUT) < 4 * I_GU) { const int i = r / I_GU; r -= i * I_GU; W = P.ffn_w_gate + (size_t)i * D * FF; gain = P.norm_ffn_g + i * D; K = D; N = FF; dst = P.wt + WO_GU + (size_t)i * D * FF2; mode = 1; }
        else if ((r -= 4 * I_GU) < 4 * I_GU) { const int i = r / I_GU; r -= i * I_GU; W = P.ffn_w_up + (size_t)i * D * FF; gain = P.norm_ffn_g + i * D; K = D; N = FF; dst = P.wt + WO_GU + (size_t)i * D * FF2; mode = 2; }
        else { r -= 4 * I_GU; const int i = r / I_DN; r -= i * I_DN; W = P.ffn_w_down + (size_t)i * FF * D; K = FF; N = D; dst = P.wt + WO_DN + (size_t)i * FF * D; }
        const int nblk = N / 64, kb = r / nblk, nb = r % nblk, k0 = 64 * kb, n0 = 64 * nb;
        const int drow0 = (mode == 0) ? n0 : ((n0 >> 7) * 256 + (n0 & 127) + (mode == 2 ? 128 : 0));
        p0_transpose_item(W, gain, K, N, dst, drow0, k0, n0, scr, lane);
    }
    for (int m = gw; m < M; m += 2 * NGW) {
        const int m2 = (m + NGW < M) ? m + NGW : m;
        const GAS f32x4* xr = (const GAS f32x4*)(P.x + (size_t)m * D) + lane; const GAS f32x4* xr2 = (const GAS f32x4*)(P.x + (size_t)m2 * D) + lane; f32x4 v[4], v2[4]; float s = 0.f, s2 = 0.f;
#pragma unroll
        for (int j = 0; j < 4; ++j) { v[j] = xr[64 * j]; v2[j] = xr2[64 * j]; }
#pragma unroll
        for (int j = 0; j < 4; ++j) { s += (v[j].x * v[j].x + v[j].y * v[j].y) + (v[j].z * v[j].z + v[j].w * v[j].w); s2 += (v2[j].x * v2[j].x + v2[j].y * v2[j].y) + (v2[j].z * v2[j].z + v2[j].w * v2[j].w); }
        s = wave_sum(s); s2 = wave_sum(s2);
        GAS unsigned long long* o8 = (GAS unsigned long long*)(P.xb + (size_t)m * D) + lane; GAS unsigned long long* o82 = (GAS unsigned long long*)(P.xb + (size_t)m2 * D) + lane;
#pragma unroll
        for (int j = 0; j < 4; ++j) { o8[64 * j] = (unsigned long long)pk2(v[j].x, v[j].y) | ((unsigned long long)pk2(v[j].z, v[j].w) << 32);
            o82[64 * j] = (unsigned long long)pk2(v2[j].x, v2[j].y) | ((unsigned long long)pk2(v2[j].z, v2[j].w) << 32); }
        if (lane < pg8::NSLOT_X) { P.xss[(size_t)m * pg8::NSLOT_X + lane] = (lane == 0) ? s : 0.f; P.xss[(size_t)m2 * pg8::NSLOT_X + lane] = (lane == 0) ? s2 : 0.f; }
    }
}

constexpr int SP_A_PITCH = 272, SP_V_PITCH = 528;
constexpr int SP_A_OFF = 0, SP_V_OFF = 36864, SP_R_OFF = 106496;
typedef short v4i16_t __attribute__((ext_vector_type(4)));
__device__ __forceinline__ s16x4 tr_read(const LAS unsigned char* p) { return __builtin_bit_cast(s16x4, __builtin_amdgcn_ds_read_tr16_b64_v4i16((LAS v4i16_t*)p)); }
template <bool DRY> __device__ __forceinline__ void spatial_phase(const Ptrs& P, int j, LAS unsigned char* lds, int vcu, int G, int tid, int wave, int lane) {
    asm volatile("" : "+v"(tid), "+v"(lane));
    bf16* uv = P.act;
    LAS unsigned char* Aimg = lds + SP_A_OFF; LAS unsigned char* Vimg = lds + SP_V_OFF; LAS float* rsL = (LAS float*)(lds + SP_R_OFF);
    const int fr = lane & 15, fq = lane >> 4;
    for (int unit = vcu; unit < (M / SGU_P) * SGU_G; unit += G) {
        const int nb = unit >> 3, g = unit & 7, row0 = nb * SGU_P;
        if (tid < SGU_P) { const f32x4* p = (const f32x4*)(P.vss + (size_t)(row0 + tid) * pg8::NSLOT_V); float s = 0.f;
#pragma unroll
            for (int k = 0; k < 8; ++k) { const f32x4 v = p[k]; s += (v[0] + v[1]) + (v[2] + v[3]); }
            rsL[tid] = __builtin_amdgcn_rsqf(s * (1.0f / GH) + EPS); }
        { v4u t[8];
#pragma unroll
            for (int i = 0; i < 8; ++i) { const int pc = tid + 512 * i, q = pc >> 5, ch = pc & 31; t[i] = *(const v4u*)(uv + (size_t)(row0 + q) * GH2 + GH + g * SGU_C + ch * 8); }
#pragma unroll
            for (int i = 0; i < 8; ++i) { const int pc = tid + 512 * i, q = pc >> 5, ch = pc & 31; *(LAS v4u*)(Vimg + q * SP_V_PITCH + ch * 16) = t[i]; } }
        __syncthreads();
        { const float* ws = P.a_w_s + ((size_t)j * SGU_G + g) * SGU_P * SGU_P;
#pragma unroll
            for (int i = 0; i < 4; ++i) { const int e = tid + 512 * i, p = e >> 4, q0 = (e & 15) * 8;
                const f32x4 w0 = *(const f32x4*)(ws + p * SGU_P + q0), w1 = *(const f32x4*)(ws + p * SGU_P + q0 + 4);
                const f32x4 r0 = *(const LAS f32x4*)(rsL + q0), r1 = *(const LAS f32x4*)(rsL + q0 + 4);
                v4u o; o.x = pk2(w0[0] * r0[0], w0[1] * r0[1]); o.y = pk2(w0[2] * r0[2], w0[3] * r0[3]); o.z = pk2(w1[0] * r1[0], w1[1] * r1[1]); o.w = pk2(w1[2] * r1[2], w1[3] * r1[3]);
                *(LAS v4u*)(Aimg + p * SP_A_PITCH + q0 * 2) = o; } }
        __syncthreads();
        bf16x8 vf[2][4];
        { const LAS unsigned char* vb = Vimg + (8 * fq + ((lane & 15) >> 2)) * SP_V_PITCH + (32 * wave + 8 * (lane & 3)) * 2;
#pragma unroll
            for (int ks = 0; ks < 4; ++ks)
#pragma unroll
                for (int n = 0; n < 2; ++n) { const s16x4 lo = tr_read(vb + ks * 32 * SP_V_PITCH + n * 8), hi = tr_read(vb + ks * 32 * SP_V_PITCH + 4 * SP_V_PITCH + n * 8);
                    vf[n][ks] = (bf16x8){lo[0], lo[1], lo[2], lo[3], hi[0], hi[1], hi[2], hi[3]}; } }
        const int cc = g * SGU_C + 32 * wave + 8 * fq;
        const f32x4 gn0 = *(const f32x4*)(P.a_v_gain + (size_t)j * GH + cc), gn1 = *(const f32x4*)(P.a_v_gain + (size_t)j * GH + cc + 4);
#pragma unroll
        for (int pt = 0; pt < 8; ++pt) {
            f32x4 a0 = {0.f, 0.f, 0.f, 0.f}, a1 = {0.f, 0.f, 0.f, 0.f};
            const LAS unsigned char* ab = Aimg + (16 * pt + fr) * SP_A_PITCH + (8 * fq) * 2;
#pragma unroll
            for (int ks = 0; ks < 4; ++ks) if (ks < (pt < 4 ? 2 : 4)) { const bf16x8 af = *(const LAS bf16x8*)(ab + ks * 64);
                a0 = __builtin_amdgcn_mfma_f32_16x16x32_bf16(vf[0][ks], af, a0, 0, 0, 0); a1 = __builtin_amdgcn_mfma_f32_16x16x32_bf16(vf[1][ks], af, a1, 0, 0, 0); }
            const int p = 16 * pt + fr; bf16* up = uv + (size_t)(row0 + p) * GH2 + cc;
            const float b = P.a_b_s[((size_t)j * SGU_G + g) * SGU_P + p];
            const v4u u8 = *(const v4u*)up;
            v4u o;
            o.x = pk2(bf_lo(u8.x) * (gn0[0] * a0[0] + b), bf_hi(u8.x) * (gn0[1] * a0[1] + b)); o.y = pk2(bf_lo(u8.y) * (gn0[2] * a0[2] + b), bf_hi(u8.y) * (gn0[3] * a0[3] + b));
            o.z = pk2(bf_lo(u8.z) * (gn1[0] * a1[0] + b), bf_hi(u8.z) * (gn1[1] * a1[1] + b)); o.w = pk2(bf_lo(u8.w) * (gn1[2] * a1[2] + b), bf_hi(u8.w) * (gn1[3] * a1[3] + b));
            if (DRY) *(v4u*)(P.xb + (size_t)(row0 + p) * D + (g & 3) * SGU_C + 32 * wave + 8 * fq) = o; else pg8::store16(up, o);
        }
        __syncthreads();
    }
}

constexpr int AT_K = 0, AT_V = 16384, AT_BT = 32768, AT_WS = 33792, AT_OST = 36864;
constexpr float ATT_THR = 8.0f;
__device__ __forceinline__ int crow(int r, int hi) { return (r & 3) + 8 * (r >> 2) + 4 * hi; }
#define MX3(a, b, c) __builtin_fmaxf(__builtin_fmaxf((a), (b)), (c))
template <bool DRY> __device__ __forceinline__ void attn_phase(const Ptrs& P, int j, LAS unsigned char* lds, int vcu, int G, int tid, int wave, int lane) {
    asm volatile("" : "+v"(tid), "+v"(lane));
    bf16* Q = P.act; const bf16* Kt = P.act + (size_t)M * D; const bf16* Vt = P.act + (size_t)2 * M * D;
    const int r32 = lane & 31, hi = lane >> 5, ci = wave >> 1, qh = wave & 1;
    LAS float* bt = (LAS float*)(lds + AT_BT); LAS float* wsf = (LAS float*)(lds + AT_WS) + wave * 64;
    for (int unit = vcu; unit < BATCH * NH * (SEQ / 256); unit += G) {
        const int bh = unit >> 5, cq = unit & 31, b = bh >> 4, h = bh & 15;
        const size_t rowbase = (size_t)b * SEQ;
        if (tid < NREL) bt[tid] = P.b_rel_bias[((size_t)j * NH + h) * NREL + tid] * LOG2E;
        const size_t qrow = rowbase + (size_t)(4 * cq + ci) * CHUNK + 32 * qh;
        const int s_lo = (4 * cq >= 8) ? 0 : 8 - 4 * cq;
        const long trow0 = (long)rowbase + (long)(4 * cq - 8) * CHUNK;
        const bf16* ksrc = Kt + (trow0 + lane) * D + h * HD + wave * 8;
        const bf16* vsrc = Vt + (trow0 + 16 * (wave & 3) + (lane >> 2)) * D + h * HD + (wave >> 2) * 32 + (lane & 3) * 8;
#define ATT_DMA(t) do { const int sl_ = ((t) & 1) * 8192; \
            __builtin_amdgcn_global_load_lds((const unsigned*)(ksrc + (long)(t) * CHUNK * D), (LAS unsigned*)(lds + AT_K + sl_ + wave * 1024), 16, 0, 0); \
            __builtin_amdgcn_global_load_lds((const unsigned*)(vsrc + (long)(t) * CHUNK * D), (LAS unsigned*)(lds + AT_V + sl_ + wave * 1024), 16, 0, 0); } while (0)
        ATT_DMA(s_lo);
        bf16x8 qr[4];
#pragma unroll
        for (int d0 = 0; d0 < 4; ++d0) qr[d0] = *(const bf16x8*)(Q + (qrow + r32) * D + h * HD + d0 * 16 + hi * 8);
        float mhat = 0.f, lrun = 0.f; f32x16 o0 = {}, o1 = {};
        const int s_first = (ci > s_lo) ? ci : s_lo;
        for (int s = s_lo; s < 12; ++s) {
            asm volatile("s_waitcnt vmcnt(0)" ::: "memory");
            __syncthreads();
            if (s + 1 < 12) ATT_DMA(s + 1);
            const int delta = ci + 8 - s;
            if (delta >= 0 && delta <= 8) {
                const LAS unsigned char* Ks = lds + AT_K + (s & 1) * 8192; const LAS unsigned char* Vs = lds + AT_V + (s & 1) * 8192;
                f32x16 p0, p1;
                { const float c0 = ((delta >= 3) ? bt[NREL - 1] : 0.f) - mhat;
#pragma unroll
                    for (int r = 0; r < 16; ++r) { p0[r] = c0; p1[r] = c0; } }
                { const LAS unsigned char* kb = Ks + hi * 1024 + r32 * 16;
#pragma unroll
                    for (int d0 = 0; d0 < 4; ++d0) { const bf16x8 k0 = *(const LAS bf16x8*)(kb + d0 * 2048), k1 = *(const LAS bf16x8*)(kb + d0 * 2048 + 512);
                        p0 = __builtin_amdgcn_mfma_f32_32x32x16_bf16(k0, qr[d0], p0, 0, 0, 0); p1 = __builtin_amdgcn_mfma_f32_32x32x16_bf16(k1, qr[d0], p1, 0, 0, 0); } }
                if (delta < 3) {
                    const int base = 64 * delta + 32 * qh + r32 + 63;
#pragma unroll
                    for (int r = 0; r < 16; ++r) { const int k0 = crow(r, hi); int i0 = base - k0, i1 = base - k0 - 32; i0 = i0 > NREL - 1 ? NREL - 1 : i0; i1 = i1 > NREL - 1 ? NREL - 1 : i1; i0 = i0 < 0 ? 0 : i0; i1 = i1 < 0 ? 0 : i1;
                        p0[r] += bt[i0]; p1[r] += bt[i1]; }
                }
                float rm;
                { float a = MX3(p0[0], p0[1], p1[0]), c = MX3(p0[2], p0[3], p1[1]); a = MX3(a, p1[2], p1[3]);
#pragma unroll
                    for (int r = 4; r < 16; r += 4) { a = MX3(a, p0[r], p0[r + 1]); c = MX3(c, p0[r + 2], p0[r + 3]); a = MX3(a, p1[r], p1[r + 1]); c = MX3(c, p1[r + 2], p1[r + 3]); }
                    rm = __builtin_fmaxf(a, c);
                    auto rr = __builtin_amdgcn_permlane32_swap(__float_as_uint(rm), __float_as_uint(rm), false, false); rm = __builtin_fmaxf(__uint_as_float(rr[0]), __uint_as_float(rr[1])); }
                if (s == s_first) {
                    mhat = rm;
#pragma unroll
                    for (int r = 0; r < 16; ++r) { p0[r] -= rm; p1[r] -= rm; }
                } else if (__any(rm > ATT_THR)) {
                    const float dl = __builtin_fmaxf(rm, 0.f); mhat += dl;
#pragma unroll
                    for (int r = 0; r < 16; ++r) { p0[r] -= dl; p1[r] -= dl; }
                    const float f = __builtin_amdgcn_exp2f(-dl); lrun *= f;
                    if (hi == 0) wsf[r32] = f;
#pragma unroll
                    for (int r = 0; r < 16; ++r) { const float fr_ = wsf[crow(r, hi)]; o0[r] *= fr_; o1[r] *= fr_; }
                }
                float psum = 0.f;
#pragma unroll
                for (int r = 0; r < 16; ++r) { p0[r] = __builtin_amdgcn_exp2f(p0[r]); p1[r] = __builtin_amdgcn_exp2f(p1[r]); psum += p0[r] + p1[r]; }
                lrun += psum;
                v4u pw[4];
                pw[0] = (v4u){pk2(p0[0], p0[1]), pk2(p0[2], p0[3]), pk2(p0[4], p0[5]), pk2(p0[6], p0[7])};
                pw[1] = (v4u){pk2(p0[8], p0[9]), pk2(p0[10], p0[11]), pk2(p0[12], p0[13]), pk2(p0[14], p0[15])};
                pw[2] = (v4u){pk2(p1[0], p1[1]), pk2(p1[2], p1[3]), pk2(p1[4], p1[5]), pk2(p1[6], p1[7])};
                pw[3] = (v4u){pk2(p1[8], p1[9]), pk2(p1[10], p1[11]), pk2(p1[12], p1[13]), pk2(p1[14], p1[15])};
                const LAS unsigned char* vb = Vs + ((lane >> 4) & 1) * 32 + (lane & 3) * 8 + (4 * hi + ((lane & 15) >> 2)) * 64;
#pragma unroll
                for (int ks = 0; ks < 4; ++ks) { const bf16x8 pa = __builtin_bit_cast(bf16x8, pw[ks]);
                    { const s16x4 lo = tr_read(vb + ks * 1024), hh = tr_read(vb + ks * 1024 + 512); const bf16x8 vfr = (bf16x8){lo[0], lo[1], lo[2], lo[3], hh[0], hh[1], hh[2], hh[3]};
                        o0 = __builtin_amdgcn_mfma_f32_32x32x16_bf16(pa, vfr, o0, 0, 0, 0); }
                    { const s16x4 lo = tr_read(vb + 4096 + ks * 1024), hh = tr_read(vb + 4096 + ks * 1024 + 512); const bf16x8 vfr = (bf16x8){lo[0], lo[1], lo[2], lo[3], hh[0], hh[1], hh[2], hh[3]};
                        o1 = __builtin_amdgcn_mfma_f32_32x32x16_bf16(pa, vfr, o1, 0, 0, 0); } }
            }
        }
#undef ATT_DMA
        { auto rr = __builtin_amdgcn_permlane32_swap(__float_as_uint(lrun), __float_as_uint(lrun), false, false); lrun = __uint_as_float(rr[0]) + __uint_as_float(rr[1]); }
        if (hi == 0) wsf[32 + r32] = lrun;
        { LAS bf16* stg = (LAS bf16*)(lds + AT_OST) + wave * 2048;
#pragma unroll
            for (int r = 0; r < 16; ++r) { const int orow = crow(r, hi); const float rl = __builtin_amdgcn_rcpf(wsf[32 + orow]);
                stg[orow * 64 + r32] = (bf16)(pk2(o0[r] * rl, 0.f) & 0xffffu); stg[orow * 64 + 32 + r32] = (bf16)(pk2(o1[r] * rl, 0.f) & 0xffffu); }
            bf16* Ow = (DRY ? P.xb : Q) + qrow * D + h * HD;
#pragma unroll
            for (int i = 0; i < 4; ++i) { const int row = i * 8 + (lane >> 3), ch = lane & 7; const v4u v = *(const LAS v4u*)(stg + row * 64 + ch * 8); *(v4u*)(Ow + (size_t)row * D + ch * 8) = v; } }
        __syncthreads();
    }
}
#undef MX3

__device__ __forceinline__ void final_phase(const Ptrs& P, int vcu, int G, int wave, int lane) {
    const int gw = vcu * NWAVES + wave, NGW = G * NWAVES;
    f32x4 gn[4];
#pragma unroll
    for (int j = 0; j < 4; ++j) gn[j] = ((const f32x4*)P.final_g)[lane + 64 * j];
    for (int m = gw; m < M; m += NGW) {
        const f32x4 sv = *(const f32x4*)(P.xss + (size_t)m * pg8::NSLOT_X + (lane & 3) * 4);
        float s = (sv[0] + sv[1]) + (sv[2] + sv[3]); s += __shfl_xor(s, 1); s += __shfl_xor(s, 2);
        const float r = __builtin_amdgcn_rsqf(s * (1.0f / D) + EPS);
        const GAS v2u* xr = (const GAS v2u*)(P.xb + (size_t)m * D) + lane;
        GAS f32x4* orow = (GAS f32x4*)(P.out + (size_t)m * D) + lane;
#pragma unroll
        for (int j = 0; j < 4; ++j) { const v2u w = xr[64 * j]; const f32x4 v = {bf_lo(w.x), bf_hi(w.x), bf_lo(w.y), bf_hi(w.y)}; orow[64 * j] = v * r * gn[j]; }
    }
}

struct Args { const float* in[15]; float* out; unsigned char* ws; int ph_lo, ph_hi; };
static_assert(sizeof(Args) == 17 * 8 + 8, "Args has no padding");
__global__ void __launch_bounds__(NWAVES * 64, 2) trunk_fwd(Args args) {
    extern __shared__ __attribute__((aligned(16))) unsigned char lds_raw[];
    LAS unsigned char* lds = (LAS unsigned char*)lds_raw;
    volatile LAS unsigned* MISC = (volatile LAS unsigned*)(lds + MISC_OFF);
    const int tid = threadIdx.x, lane = tid & 63, wave = __builtin_amdgcn_readfirstlane(tid >> 6);
    const int G = gridDim.x; const int bx = blockIdx.x; const int vcu = (G % 8 == 0) ? (bx % 8) * (G / 8) + bx / 8 : bx;
    unsigned char* ws = args.ws;
    gu32* ctl = (gu32*)(ws + WS_CTL);
    Ptrs P;
    P.x = args.in[0]; P.norm_mix_g = args.in[1]; P.norm_ffn_g = args.in[2]; P.final_g = args.in[3]; P.a_w_in = args.in[4]; P.a_v_gain = args.in[5]; P.a_w_s = args.in[6]; P.a_b_s = args.in[7];
    P.a_w_out = args.in[8]; P.b_w_qkv = args.in[9]; P.b_rel_bias = args.in[10]; P.b_w_out = args.in[11]; P.ffn_w_gate = args.in[12]; P.ffn_w_up = args.in[13]; P.ffn_w_down = args.in[14];
    P.out = args.out; P.wt = (bf16*)(ws + WS_W); P.xb = (bf16*)(ws + WS_XB); P.act = (bf16*)(ws + WS_ACT); P.xss = (float*)(ws + WS_XSS); P.vss = (float*)(ws + WS_VSS);
    for (int u = tid; u < (LDS_BYTES - LDSCTL_OFF) / 4; u += NWAVES * 64) ((LAS unsigned*)(lds + LDSCTL_OFF))[u] = 0u;
    __syncthreads();
    XcdBarrier bar; bar.bar = (unsigned*)(ctl + CW_BAR); bar.x = 0; bar.st = nullptr;
    if (!MK_PER_PHASE) bar = xcd_barrier_post((unsigned*)(ctl + CW_BAR), MISC + 8);
    const int lo = args.ph_lo, hi = args.ph_hi;
#ifndef DBG_MASK
#define DBG_MASK 0xff
#endif
#define IN(k) (lo <= (k) && (k) < hi)
#define SEAM(k) do { if (IN(k) && IN((k) + 1)) { xcd_barrier(bar); if (PROBE == 1) xcd_barrier(bar); } } while (0)

    if ((DBG_MASK & 1) && IN(0)) { p0_prologue(P, lds, vcu, G, wave, lane); if (PROBE == 2) { __syncthreads(); p0_prologue(P, lds, vcu, G, wave, lane); } }
    SEAM(0);
#pragma unroll 1
    for (int layer = 0; layer < DEPTH; ++layer) {
        const int j = layer >> 1, ph = 1 + 5 * layer;
        const bf16* wgu = P.wt + WO_GU + (size_t)layer * D * FF2; const bf16* wdn = P.wt + WO_DN + (size_t)layer * FF * D;
        if ((layer & 1) == 0) {
            if ((DBG_MASK & 2) && IN(ph)) { pg8::Gemm g{P.xb, P.wt + WO_IN + (size_t)j * D * GH2, M, GH2, D, D}; pg8::StaticOrder S; S.init(M, GH2, G, bx);
                pg8::EpiGeluStats E{P.act, GH2, P.xss, P.vss, GH / 256, EPS};
                pg8::gemm_phase<pg8::EpiGeluStats, pg8::StaticOrder, true, true>(lds + RING_OFF, g, S, E);
                if (PROBE == 5) { __syncthreads(); pg8::gemm_phase<pg8::EpiGeluStats, pg8::StaticOrder, true, true>(lds + RING_OFF, g, S, E); } }
            SEAM(ph);
            if ((DBG_MASK & 4) && IN(ph + 1)) { if (PROBE == 4) spatial_phase<true>(P, j, lds, vcu, G, tid, wave, lane); spatial_phase<false>(P, j, lds, vcu, G, tid, wave, lane); }
            SEAM(ph + 1);
            if ((DBG_MASK & 8) && IN(ph + 2)) { pg8::Gemm g{P.act, P.wt + WO_AOUT + (size_t)j * GH * D, M, D, GH, GH2}; pg8::StaticOrder S; S.init(M, D, G, bx);
                pg8::EpiResid E{P.xb, P.xss, D};
                pg8::gemm_phase<pg8::EpiResid, pg8::StaticOrder, false, true>(lds + RING_OFF, g, S, E); }
            SEAM(ph + 2);
        } else {
            if ((DBG_MASK & 16) && IN(ph)) { pg8::Gemm g{P.xb, P.wt + WO_QKV + (size_t)j * D * 3 * D, M, 3 * D, D, D}; pg8::StaticOrder S; S.init(M, 3 * D, G, bx);
                pg8::EpiQkv E{P.act, D, (size_t)M * D, P.xss, EPS, QSCALE};
                pg8::gemm_phase<pg8::EpiQkv, pg8::StaticOrder, true, true>(lds + RING_OFF, g, S, E);
                if (PROBE == 7) { __syncthreads(); pg8::gemm_phase<pg8::EpiQkv, pg8::StaticOrder, true, true>(lds + RING_OFF, g, S, E); } }
            SEAM(ph);
            if ((DBG_MASK & 32) && IN(ph + 1)) { if (PROBE == 3) attn_phase<true>(P, j, lds, vcu, G, tid, wave, lane); attn_phase<false>(P, j, lds, vcu, G, tid, wave, lane); }
            SEAM(ph + 1);
            if ((DBG_MASK & 8) && IN(ph + 2)) { pg8::Gemm g{P.act, P.wt + WO_BOUT + (size_t)j * D * D, M, D, D, D}; pg8::StaticOrder S; S.init(M, D, G, bx);
                pg8::EpiResid E{P.xb, P.xss, D};
                pg8::gemm_phase<pg8::EpiResid, pg8::StaticOrder, false, true>(lds + RING_OFF, g, S, E); }
            SEAM(ph + 2);
        }
        if ((DBG_MASK & 64) && IN(ph + 3)) { pg8::Gemm g{P.xb, wgu, M, FF2, D, D}; pg8::StaticOrder S; S.init(M, FF2, G, bx);
            pg8::EpiSwiglu E{P.act, FF, P.xss, EPS};
            pg8::gemm_phase<pg8::EpiSwiglu, pg8::StaticOrder, true, true>(lds + RING_OFF, g, S, E);
            if (PROBE == 6) { __syncthreads(); pg8::gemm_phase<pg8::EpiSwiglu, pg8::StaticOrder, true, true>(lds + RING_OFF, g, S, E); } }
        SEAM(ph + 3);
        if ((DBG_MASK & 8) && IN(ph + 4)) { pg8::Gemm g{P.act, wdn, M, D, FF, FF}; pg8::StaticOrder S; S.init(M, D, G, bx);
            pg8::EpiResid E{P.xb, P.xss, D};
            pg8::gemm_phase<pg8::EpiResid, pg8::StaticOrder, false, true>(lds + RING_OFF, g, S, E); }
        SEAM(ph + 4);
    }
    if ((DBG_MASK & 128) && IN(N_PHASES - 1)) final_phase(P, vcu, G, wave, lane);
#undef IN
#undef SEAM
}

extern "C" void kernel_launch(void* const* d_in, const int* in_sizes, int n_in, void* d_out, int out_size, void* d_ws, size_t ws_size, hipStream_t stream) {
    static int grid = 0;
    if (grid == 0) {
        if (n_in != 15 || in_sizes[0] != M * D || out_size != M * D || ws_size < WS_END) { fprintf(stderr, "kernel_launch: unexpected shapes (n_in %d, in0 %d, out %d, ws %zu < %zu); nothing launched\n", n_in, n_in > 0 ? in_sizes[0] : -1, out_size, ws_size, (size_t)WS_END); grid = -1; return; }
        int dev = 0, cus = 0, per_cu = 0;
        if (hipGetDevice(&dev) != hipSuccess || hipDeviceGetAttribute(&cus, hipDeviceAttributeMultiprocessorCount, dev) != hipSuccess) { grid = -1; return; }
        if (hipFuncSetAttribute((const void*)trunk_fwd, hipFuncAttributeMaxDynamicSharedMemorySize, LDS_BYTES) != hipSuccess) { fprintf(stderr, "kernel_launch: hipFuncSetAttribute failed\n"); grid = -1; return; }
        if (hipOccupancyMaxActiveBlocksPerMultiprocessor(&per_cu, (const void*)trunk_fwd, NWAVES * 64, LDS_BYTES) != hipSuccess || per_cu < 1) { fprintf(stderr, "kernel_launch: occupancy query reports %d workgroups per CU; nothing launched\n", per_cu); (void)hipGetLastError(); grid = -1; return; }
        grid = cus;
    }
    if (grid < 0) return;
    if (hipMemsetAsync((char*)d_ws + WS_CTL, 0, CTL_ZERO_BYTES, stream) != hipSuccess) return;
    Args a{};
    for (int i = 0; i < 15; ++i) a.in[i] = (const float*)d_in[i];
    a.out = (float*)d_out; a.ws = (unsigned char*)d_ws;
#if MK_PER_PHASE
    for (int p = 0; p < N_PHASES; ++p) { a.ph_lo = p; a.ph_hi = p + 1; hipLaunchKernelGGL(trunk_fwd, dim3(grid), dim3(NWAVES * 64), LDS_BYTES, stream, a); }
#else
    a.ph_lo = 0; a.ph_hi = N_PHASES;
    hipLaunchKernelGGL(trunk_fwd, dim3(grid), dim3(NWAVES * 64), LDS_BYTES, stream, a);
#endif
}
```

```cpp
#include <hip/hip_runtime.h>
#include <cstdio>
#include <cstdint>
#ifndef PROBE
#define PROBE 0
#endif
namespace pg8 {
#define PG8_LAS __attribute__((address_space(3)))
typedef unsigned short bf16_t;
typedef short bf16x8 __attribute__((ext_vector_type(8)));
typedef float f32x4 __attribute__((ext_vector_type(4)));
typedef unsigned u32x4 __attribute__((ext_vector_type(4)));
constexpr int BM = 256, BK = 64, HALF = 128, HTB = HALF * BK * 2  , STAGE_BYTES = 8 * HTB, NXCD = 8, WGM = 8;

__host__ __device__ __forceinline__ int lds_byte(int r, int c) { const int st = (r >> 4) * 2 + (c >> 5), rr = r & 15, cc = c & 31, ob = rr * 64 + cc * 2; return st * 1024 + (ob ^ (((ob >> 9) & 1) << 5)); }
__host__ __device__ __forceinline__ void stage_rc(int b, int& R, int& C) { const int st = b / 1024, sb = b % 1024, swz = sb ^ (((sb >> 9) & 1) << 5); R = (st >> 1) * 16 + swz / 64; C = (st & 1) * 32 + (swz % 64) / 2; }
__host__ __device__ __forceinline__ int perm32(int rho) { const int n = rho >> 4, i = rho & 15; return 8 * (i >> 2) + 4 * n + (i & 3); }

struct Unit { int pm, pn; };
struct Gemm { const bf16_t* A; const bf16_t* Bt; int M, N, K, lda; };

struct StaticOrder {
    int nM, nN, nwg, G, c;
    __host__ __device__ void init(int M, int N, int G_, int c_) { nM = M / BM; nN = N / BM; nwg = nM * nN; G = G_; c = c_; }
    __host__ __device__ bool next(int i, Unit& u) const {
        const long L = (long)i * G + c; if (L >= nwg) return false;
        int wgid = (int)L; { const int q = nwg / NXCD, r = nwg % NXCD, xcd = wgid % NXCD, off = wgid / NXCD; wgid = (xcd < r ? xcd * (q + 1) : r * (q + 1) + (xcd - r) * q) + off; }
        const int nig = WGM * nN, gid = wgid / nig, fm = gid * WGM, gsz = (nM - fm) < WGM ? (nM - fm) : WGM;
        u.pm = fm + ((wgid % nig) % gsz); u.pn = (wgid % nig) / gsz; return true;
    }
    __device__ __forceinline__ void a_ready(const Unit&) const {}
    __device__ __forceinline__ void done(const Unit&) const {}
};

__device__ __forceinline__ unsigned cvt_pk_bf16(float lo, float hi) { unsigned r; asm volatile("v_cvt_pk_bf16_f32 %0, %1, %2" : "=v"(r) : "v"(lo), "v"(hi)); return r; }
typedef float f32x2 __attribute__((ext_vector_type(2)));
#ifndef STORE_WT
#define STORE_WT 1
#endif
__device__ __forceinline__ void store16(void* p, u32x4 v) {
#if STORE_WT
    asm volatile("global_store_dwordx4 %0, %1, off sc1\n\ts_nop 1" :: "v"(p), "v"(v) : "memory");
#else
    *(u32x4*)p = v;
#endif
}
__device__ __forceinline__ void store16f(void* p, f32x4 v) {
#if STORE_WT
    asm volatile("global_store_dwordx4 %0, %1, off sc1\n\ts_nop 1" :: "v"(p), "v"(v) : "memory");
#else
    *(f32x4*)p = v;
#endif
}
typedef unsigned u32x2 __attribute__((ext_vector_type(2)));
__device__ __forceinline__ void store8(void* p, u32x2 v) {
#if STORE_WT
    asm volatile("global_store_dwordx2 %0, %1, off sc1\n\ts_nop 1" :: "v"(p), "v"(v) : "memory");
#else
    *(u32x2*)p = v;
#endif
}
constexpr int NSLOT_X = 16;
constexpr int NSLOT_V = 32;
struct RsTab { const PG8_LAS float* t; int pm; };
__device__ __forceinline__ void row_scales(const float* ss, const RsTab& T, int pm, int wr, int fr, int fq, float inv_n, float eps, float (&rs)[2][4]) {
    if (pm == T.pm) {
#pragma unroll
        for (int ai = 0; ai < 2; ++ai)
#pragma unroll
            for (int m = 0; m < 4; ++m) rs[ai][m] = T.t[wr * 64 + fr + ai * HALF + m * 16];
    } else {
        const int row0 = pm * BM + wr * 64 + fr;
#pragma unroll
        for (int ai = 0; ai < 2; ++ai)
#pragma unroll
            for (int m = 0; m < 4; ++m) {
                const f32x4 v = *(const f32x4*)(ss + (size_t)(row0 + ai * HALF + m * 16) * NSLOT_X + fq * 4);
                float s = (v[0] + v[1]) + (v[2] + v[3]);
                s += __shfl_xor(s, 16); s += __shfl_xor(s, 32);
                rs[ai][m] = __builtin_amdgcn_rsqf(s * inv_n + eps);
            }
    }
}
__device__ __forceinline__ void build_rs_table(const float* ss, int pm, PG8_LAS float* t, int tid, float inv_n, float eps) {
    asm volatile("" : "+v"(tid));
    const int row = tid >> 1, half = tid & 1;
    const f32x4 a = *(const f32x4*)(ss + (size_t)(pm * BM + row) * NSLOT_X + half * 8), b = *(const f32x4*)(ss + (size_t)(pm * BM + row) * NSLOT_X + half * 8 + 4);
    float s = ((a[0] + a[1]) + (a[2] + a[3])) + ((b[0] + b[1]) + (b[2] + b[3]));
    s += __shfl_xor(s, 1);
    if (half == 0) t[row] = __builtin_amdgcn_rsqf(s * inv_n + eps);
    asm volatile("s_waitcnt lgkmcnt(0)" ::: "memory"); __syncthreads();
}
__device__ __forceinline__ float gelu_tanh(float x) {
    const float t = x * x, u2 = x * (2.302208198f + 0.1029432398f * t);
    const float e = __builtin_amdgcn_exp2f(-u2);
    return x * __builtin_amdgcn_rcpf(1.0f + e);
}
__device__ __forceinline__ float silu_mul(float g, float u) {
    const float e = __builtin_amdgcn_exp2f(g * -1.4426950408889634f);
    return (g * u) * __builtin_amdgcn_rcpf(1.0f + e);
}
struct EpiGeluStats {
    static constexpr bool PERM = true, AFTER_DRAIN = false, PROBE_TWICE = false;
    bf16_t* O; int ldc; const float* xss; float* vss; int vtile0; float eps; RsTab rt;
    __device__ __forceinline__ void operator()(const f32x4 (&acc)[2][2][4][2], const Unit& u, int wr, int wc, int fr, int fq) const {
        const int row0 = u.pm * BM + wr * 64 + fr, col0 = u.pn * BM + wc * 32 + 8 * fq;
        float rs[2][4]; row_scales(xss, rt, u.pm, wr, fr, fq, 1.0f / 1024.0f, eps, rs);
        const bool isv = u.pn >= vtile0;
#pragma unroll
        for (int ai = 0; ai < 2; ++ai)
#pragma unroll
            for (int m = 0; m < 4; ++m) { const int row = row0 + ai * HALF + m * 16; bf16_t* rowp = O + (size_t)row * ldc + col0; const float r = rs[ai][m]; float ssq = 0.f;
#pragma unroll
                for (int bj = 0; bj < 2; ++bj) { f32x4 v0 = acc[ai][bj][m][0] * r, v1 = acc[ai][bj][m][1] * r;
#pragma unroll
                    for (int e = 0; e < 4; ++e) { v0[e] = gelu_tanh(v0[e]); v1[e] = gelu_tanh(v1[e]); }
                    ssq += (v0[0] * v0[0] + v0[1] * v0[1]) + (v0[2] * v0[2] + v0[3] * v0[3]) + (v1[0] * v1[0] + v1[1] * v1[1]) + (v1[2] * v1[2] + v1[3] * v1[3]);
                    u32x4 w; w.x = cvt_pk_bf16(v0[0], v0[1]); w.y = cvt_pk_bf16(v0[2], v0[3]); w.z = cvt_pk_bf16(v1[0], v1[1]); w.w = cvt_pk_bf16(v1[2], v1[3]);
                    store16(rowp + bj * HALF, w); }
                if (isv) { ssq += __shfl_xor(ssq, 16); ssq += __shfl_xor(ssq, 32); if (fq == 0) vss[(size_t)row * NSLOT_V + (u.pn - vtile0) * 4 + wc] = ssq; } }
    }
};
struct EpiSwiglu {
    static constexpr bool PERM = true, AFTER_DRAIN = false, PROBE_TWICE = true;
    bf16_t* O; int ldc; const float* xss; float eps; RsTab rt;
    __device__ __forceinline__ void operator()(const f32x4 (&acc)[2][2][4][2], const Unit& u, int wr, int wc, int fr, int fq) const {
        const int row0 = u.pm * BM + wr * 64 + fr, col0 = u.pn * HALF + wc * 32 + 8 * fq;
        float rs[2][4]; row_scales(xss, rt, u.pm, wr, fr, fq, 1.0f / 1024.0f, eps, rs);
#pragma unroll
        for (int ai = 0; ai < 2; ++ai)
#pragma unroll
            for (int m = 0; m < 4; ++m) { const int row = row0 + ai * HALF + m * 16; const float r = rs[ai][m] * (PROBE == 9 ? 0.5f : 1.0f);
                const f32x4 g0 = acc[ai][0][m][0] * r, g1 = acc[ai][0][m][1] * r, u0 = acc[ai][1][m][0] * r, u1 = acc[ai][1][m][1] * r;
                float o[8];
#pragma unroll
                for (int e = 0; e < 4; ++e) { o[e] = silu_mul(g0[e], u0[e]); o[4 + e] = silu_mul(g1[e], u1[e]); }
                u32x4 w; w.x = cvt_pk_bf16(o[0], o[1]); w.y = cvt_pk_bf16(o[2], o[3]); w.z = cvt_pk_bf16(o[4], o[5]); w.w = cvt_pk_bf16(o[6], o[7]);
                store16(O + (size_t)row * ldc + col0, w); }
    }
};
struct EpiQkv {
    static constexpr bool PERM = true, AFTER_DRAIN = false, PROBE_TWICE = false;
    bf16_t* O; int ldc; size_t split_stride; const float* xss; float eps; float scale0; RsTab rt;
    __device__ __forceinline__ void operator()(const f32x4 (&acc)[2][2][4][2], const Unit& u, int wr, int wc, int fr, int fq) const {
        const int t = u.pn >> 2; bf16_t* base = O + (size_t)t * split_stride; const float sc = (t == 0) ? scale0 : 1.0f;
        const int row0 = u.pm * BM + wr * 64 + fr, col0 = (u.pn & 3) * BM + wc * 32 + 8 * fq;
        float rs[2][4]; row_scales(xss, rt, u.pm, wr, fr, fq, 1.0f / 1024.0f, eps, rs);
#pragma unroll
        for (int ai = 0; ai < 2; ++ai)
#pragma unroll
            for (int m = 0; m < 4; ++m) { const int row = row0 + ai * HALF + m * 16; bf16_t* rowp = base + (size_t)row * ldc + col0; const float r = rs[ai][m] * sc;
#pragma unroll
                for (int bj = 0; bj < 2; ++bj) { const f32x4 v0 = acc[ai][bj][m][0] * r, v1 = acc[ai][bj][m][1] * r;
                    u32x4 w; w.x = cvt_pk_bf16(v0[0], v0[1]); w.y = cvt_pk_bf16(v0[2], v0[3]); w.z = cvt_pk_bf16(v1[0], v1[1]); w.w = cvt_pk_bf16(v1[2], v1[3]);
                    store16(rowp + bj * HALF, w); } }
    }
};
struct EpiResid {
    static constexpr bool PERM = true, AFTER_DRAIN = false, PROBE_TWICE = false;
    bf16_t* xb; float* xss; int ldc;
    __device__ __forceinline__ void operator()(const f32x4 (&acc)[2][2][4][2], const Unit& u, int wr, int wc, int fr, int fq) const {
        asm volatile("" : "+v"(fr), "+v"(fq));
        const int row0 = u.pm * BM + wr * 64 + fr, col0 = u.pn * BM + wc * 32 + 8 * fq;
        u32x4 pre[2][4][2];
#pragma unroll
        for (int ai = 0; ai < 2; ++ai)
#pragma unroll
            for (int m = 0; m < 4; ++m)
#pragma unroll
                for (int bj = 0; bj < 2; ++bj) pre[ai][m][bj] = *(const u32x4*)(xb + (size_t)(row0 + ai * HALF + m * 16) * ldc + col0 + bj * HALF);
#pragma unroll
        for (int ai = 0; ai < 2; ++ai)
#pragma unroll
            for (int m = 0; m < 4; ++m) { const int row = row0 + ai * HALF + m * 16; bf16_t* rowp = xb + (size_t)row * ldc + col0; float ssq = 0.f;
#pragma unroll
                for (int bj = 0; bj < 2; ++bj) { const u32x4 b = pre[ai][m][bj]; const f32x4 a0 = acc[ai][bj][m][0], a1 = acc[ai][bj][m][1];
                    float o[8];
                    o[0] = __uint_as_float(b.x << 16) + a0[0]; o[1] = __uint_as_float(b.x & 0xffff0000u) + a0[1]; o[2] = __uint_as_float(b.y << 16) + a0[2]; o[3] = __uint_as_float(b.y & 0xffff0000u) + a0[3];
                    o[4] = __uint_as_float(b.z << 16) + a1[0]; o[5] = __uint_as_float(b.z & 0xffff0000u) + a1[1]; o[6] = __uint_as_float(b.w << 16) + a1[2]; o[7] = __uint_as_float(b.w & 0xffff0000u) + a1[3];
                    ssq += ((o[0] * o[0] + o[1] * o[1]) + (o[2] * o[2] + o[3] * o[3])) + ((o[4] * o[4] + o[5] * o[5]) + (o[6] * o[6] + o[7] * o[7]));
                    u32x4 w; w.x = cvt_pk_bf16(o[0], o[1]); w.y = cvt_pk_bf16(o[2], o[3]); w.z = cvt_pk_bf16(o[4], o[5]); w.w = cvt_pk_bf16(o[6], o[7]);
                    store16(rowp + bj * HALF, w); }
                ssq += __shfl_xor(ssq, 16); ssq += __shfl_xor(ssq, 32);
                if (fq == 0) xss[(size_t)row * NSLOT_X + u.pn * 4 + wc] = ssq; }
    }
};

template <class Epi, class Sched, bool ALIGN_EPI = false, bool SP2 = false>
__device__ __forceinline__ void gemm_phase(PG8_LAS unsigned char* lds, const Gemm g, const Sched& S, const Epi& E) {
    int tid_ = threadIdx.x; asm volatile("" : "+v"(tid_));
    const int tid = tid_, wid = __builtin_amdgcn_readfirstlane(tid >> 6), lane = tid & 63, wr = wid >> 2, wc = wid & 3, fr = lane & 15, fq = lane >> 4;
    const int K = g.K, nt = K / BK;
    unsigned voffA[2], voffB[2];
#pragma unroll
    for (int i = 0; i < 2; ++i) { int R, C; stage_rc(tid * 16 + i * 8192, R, C); const int Rb = Epi::PERM ? ((R & ~31) + perm32(R & 31)) : R;
        voffA[i] = (unsigned)(R * g.lda + C) * 2u; voffB[i] = (unsigned)(Rb * K + C) * 2u; }
    const size_t kstep = (size_t)(BK * 2);
    const size_t hstep = (size_t)HALF * K * 2;
    const size_t tstep = 2 * hstep; const size_t hstepA = (size_t)HALF * g.lda * 2, tstepA = 2 * hstepA;
    const unsigned ldsw = (unsigned)wid * 1024u;
    const int aoff = lds_byte(wr * 64 + fr, fq * 8), boff = lds_byte(wc * 32 + fr, fq * 8);
#define PG8_SA(b, h) (((b) * 2 + (h)) * HTB)
#define PG8_SB(b, h) ((4 + (b) * 2 + (h)) * HTB)
#define PG8_STAGE(bufoff, gbase, voff) do { _Pragma("unroll") for (int _i = 0; _i < 2; ++_i) \
        __builtin_amdgcn_global_load_lds((const unsigned*)((const char*)(gbase) + (voff)[_i]), (PG8_LAS unsigned*)(lds + (bufoff) + ldsw + _i * 8192), 16, 0, 0); } while (0)
#define PG8_LDA(dst, b, h) do { _Pragma("unroll") for (int m = 0; m < 4; ++m) _Pragma("unroll") for (int k = 0; k < 2; ++k) dst[m][k] = *(const PG8_LAS bf16x8*)(lds + PG8_SA(b, h) + aoff + m * 2048 + k * 1024); } while (0)
#define PG8_LDB(dst, b, h) do { _Pragma("unroll") for (int n = 0; n < 2; ++n) _Pragma("unroll") for (int k = 0; k < 2; ++k) dst[n][k] = *(const PG8_LAS bf16x8*)(lds + PG8_SB(b, h) + boff + n * 2048 + k * 1024); } while (0)
#define PG8_MMA(ai, bj, At, Bt) do { __builtin_amdgcn_s_setprio(1); _Pragma("unroll") for (int m = 0; m < 4; ++m) _Pragma("unroll") for (int n = 0; n < 2; ++n) _Pragma("unroll") for (int k = 0; k < 2; ++k) \
        acc[ai][bj][m][n] = __builtin_amdgcn_mfma_f32_16x16x32_bf16(Bt[n][k], At[m][k], acc[ai][bj][m][n], 0, 0, 0); __builtin_amdgcn_s_setprio(0); } while (0)
#define PG8_WAIT_V(n) asm volatile("s_waitcnt vmcnt(" #n ")" ::: "memory")
#define PG8_WAIT_L(n) asm volatile("s_waitcnt lgkmcnt(" #n ")" ::: "memory")
#define PG8_BAR __builtin_amdgcn_s_barrier()
#define PG8_SCHED __builtin_amdgcn_sched_barrier(0)
    Unit cur, nxt; int ui = 0;
    if (!S.next(0, cur)) return;
    f32x4 acc[2][2][4][2];
#pragma unroll
    for (int a = 0; a < 2; ++a)
#pragma unroll
        for (int b = 0; b < 2; ++b)
#pragma unroll
            for (int m = 0; m < 4; ++m)
#pragma unroll
                for (int n = 0; n < 2; ++n) acc[a][b][m][n] = (f32x4){0.f, 0.f, 0.f, 0.f};
    bf16x8 At[4][2], B0[2][2], B1[2][2];
    const char* cA = (const char*)g.A + (size_t)cur.pm * tstepA; const char* cB = (const char*)g.Bt + (size_t)cur.pn * tstep;
    S.a_ready(cur);
    if constexpr (SP2) {
        PG8_STAGE(PG8_SB(0, 0), cB, voffB); PG8_STAGE(PG8_SB(0, 1), cB + hstep, voffB); PG8_STAGE(PG8_SA(0, 0), cA, voffA); PG8_STAGE(PG8_SA(0, 1), cA + hstepA, voffA);
        if (wr == 1) PG8_BAR;
        PG8_WAIT_V(2); PG8_BAR;
        PG8_STAGE(PG8_SB(1, 0), cB + kstep, voffB); PG8_STAGE(PG8_SA(1, 0), cA + kstep, voffA); PG8_STAGE(PG8_SB(1, 1), cB + hstep + kstep, voffB);
        PG8_WAIT_V(6); PG8_BAR;
    } else {
        PG8_STAGE(PG8_SB(0, 0), cB, voffB); PG8_STAGE(PG8_SA(0, 0), cA, voffA); PG8_STAGE(PG8_SB(0, 1), cB + hstep, voffB); PG8_STAGE(PG8_SA(0, 1), cA + hstepA, voffA);
        if (wr == 1) PG8_BAR;
        PG8_WAIT_V(4); PG8_BAR;
        PG8_STAGE(PG8_SB(1, 0), cB + kstep, voffB); PG8_STAGE(PG8_SA(1, 0), cA + kstep, voffA); PG8_STAGE(PG8_SB(1, 1), cB + hstep + kstep, voffB);
        PG8_WAIT_V(6); PG8_BAR;
    }
    for (;;) {
        const bool has_next = S.next(ui + 1, nxt);
        const char* nA = has_next ? (const char*)g.A + (size_t)nxt.pm * tstepA : cA; const char* nB = has_next ? (const char*)g.Bt + (size_t)nxt.pn * tstep : cB;
        const int ntl = (PROBE == 9 && Epi::PROBE_TWICE) ? 2 * nt : nt;
        for (int t = 0; t < ntl; t += 2) {
            const bool last = (t == ntl - 2);
            const int t1 = (t + 1 >= nt) ? t + 1 - nt : t + 1, t2 = (t + 2 >= nt) ? t + 2 - nt : t + 2;
            const char* a1 = cA + (size_t)t1 * kstep;
            const char* a2 = last ? nA : cA + (size_t)t2 * kstep; const char* b2 = last ? nB : cB + (size_t)t2 * kstep;
            const char* a3 = a2 + kstep; const char* b3 = b2 + kstep;
            if (last && has_next) S.a_ready(nxt);
            if constexpr (SP2) {
            PG8_LDB(B0, 0, 0); PG8_LDB(B1, 0, 1); PG8_SCHED; PG8_LDA(At, 0, 0); PG8_STAGE(PG8_SA(1, 1), a1 + hstepA, voffA);
            PG8_WAIT_V(8); PG8_WAIT_L(0); PG8_BAR; PG8_MMA(0, 0, At, B0); PG8_MMA(0, 1, At, B1); PG8_BAR; PG8_SCHED;
            PG8_LDA(At, 0, 1); PG8_STAGE(PG8_SB(0, 0), b2, voffB); PG8_STAGE(PG8_SB(0, 1), b2 + hstep, voffB); PG8_STAGE(PG8_SA(0, 0), a2, voffA);
            PG8_WAIT_V(8); PG8_WAIT_L(0); PG8_BAR; PG8_MMA(1, 0, At, B0); PG8_MMA(1, 1, At, B1); PG8_BAR; PG8_SCHED;
            PG8_LDB(B0, 1, 0); PG8_LDB(B1, 1, 1); PG8_SCHED; PG8_LDA(At, 1, 0); PG8_STAGE(PG8_SA(0, 1), a2 + hstepA, voffA);
            PG8_WAIT_V(8); PG8_WAIT_L(0); PG8_BAR; PG8_MMA(0, 0, At, B0); PG8_MMA(0, 1, At, B1); PG8_BAR; PG8_SCHED;
            PG8_LDA(At, 1, 1); PG8_STAGE(PG8_SB(1, 0), b3, voffB); PG8_STAGE(PG8_SB(1, 1), b3 + hstep, voffB); PG8_STAGE(PG8_SA(1, 0), a3, voffA);
            PG8_WAIT_V(8); PG8_WAIT_L(0); PG8_BAR; PG8_MMA(1, 0, At, B0); PG8_MMA(1, 1, At, B1); PG8_BAR; PG8_SCHED;
            } else {
            PG8_LDB(B0, 0, 0); PG8_SCHED; PG8_LDA(At, 0, 0); PG8_STAGE(PG8_SA(1, 1), a1 + hstepA, voffA);
            PG8_WAIT_L(8); PG8_BAR; PG8_WAIT_L(0); PG8_MMA(0, 0, At, B0); PG8_BAR; PG8_SCHED;
            PG8_LDB(B1, 0, 1); PG8_STAGE(PG8_SB(0, 0), b2, voffB);
            PG8_BAR; PG8_WAIT_L(0); PG8_MMA(0, 1, At, B1); PG8_BAR;
            PG8_LDA(At, 0, 1); PG8_STAGE(PG8_SA(0, 0), a2, voffA);
            PG8_BAR; PG8_WAIT_L(0); PG8_MMA(1, 0, At, B0); PG8_BAR; PG8_SCHED;
            PG8_STAGE(PG8_SB(0, 1), b2 + hstep, voffB);
            PG8_WAIT_V(6); PG8_BAR; PG8_MMA(1, 1, At, B1); PG8_BAR;
            PG8_LDB(B0, 1, 0); PG8_SCHED; PG8_LDA(At, 1, 0); PG8_STAGE(PG8_SA(0, 1), a2 + hstepA, voffA);
            PG8_WAIT_L(8); PG8_BAR; PG8_WAIT_L(0); PG8_MMA(0, 0, At, B0); PG8_BAR; PG8_SCHED;
            PG8_LDB(B1, 1, 1); PG8_STAGE(PG8_SB(1, 0), b3, voffB);
            PG8_BAR; PG8_WAIT_L(0); PG8_MMA(0, 1, At, B1); PG8_BAR;
            PG8_LDA(At, 1, 1); PG8_STAGE(PG8_SA(1, 0), a3, voffA);
            PG8_BAR; PG8_WAIT_L(0); PG8_MMA(1, 0, At, B0); PG8_BAR; PG8_SCHED;
            PG8_STAGE(PG8_SB(1, 1), b3 + hstep, voffB);
            PG8_WAIT_V(6); PG8_BAR; PG8_MMA(1, 1, At, B1); PG8_BAR;
            }
        }
        if constexpr (ALIGN_EPI) { if (wr == 0) PG8_BAR; }
        if constexpr (!Epi::AFTER_DRAIN) { E(acc, cur, wr, wc, fr, fq); if (PROBE == 8 && Epi::PROBE_TWICE) { asm volatile("" ::: "memory"); E(acc, cur, wr, wc, fr, fq); } S.done(cur); }
        if (!has_next) break;
#pragma unroll
        for (int a = 0; a < 2; ++a)
#pragma unroll
            for (int b = 0; b < 2; ++b)
#pragma unroll
                for (int m = 0; m < 4; ++m)
#pragma unroll
                    for (int n = 0; n < 2; ++n) acc[a][b][m][n] = (f32x4){0.f, 0.f, 0.f, 0.f};
        cur = nxt; cA = nA; cB = nB; ++ui;
        if constexpr (ALIGN_EPI) { if (wr == 1) PG8_BAR; }
    }
    PG8_WAIT_V(0);
    if constexpr (!ALIGN_EPI) { if (wr == 0) PG8_BAR; }
    PG8_BAR;
    if constexpr (Epi::AFTER_DRAIN) { E.fused(acc, cur, wr, wc, fr, fq, lds, wid, lane); S.done(cur); }
#undef PG8_SA
#undef PG8_SB
#undef PG8_STAGE
#undef PG8_LDA
#undef PG8_LDB
#undef PG8_MMA
#undef PG8_WAIT_V
#undef PG8_WAIT_L
#undef PG8_BAR
#undef PG8_SCHED
}
}

constexpr int NWAVES = 8;
constexpr int BATCH = 2, SEQ = 8192, D = 1024, DEPTH = 4, M = BATCH * SEQ;
constexpr int GH = 2048, GH2 = 4096, SGU_G = 8, SGU_P = 128, SGU_C = 256;
constexpr int NH = 16, HD = 64, NREL = 192, CHUNK = 64;
constexpr int FF = 2816, FF2 = 5632;
constexpr float EPS = 1e-6f;
constexpr float LOG2E = 1.4426950408889634f;
constexpr float QSCALE = 0.125f * LOG2E;

#ifndef MK_PER_PHASE
#define MK_PER_PHASE 0
#endif
constexpr int N_PHASES = 22;

constexpr size_t MiB = 1u << 20;
constexpr size_t WS_CTL = 0, CTL_ZERO_BYTES = 64 * 1024;
constexpr size_t WS_XSS = 1 * MiB;
constexpr size_t WS_VSS = 2 * MiB;
constexpr size_t WS_W = 4 * MiB;
constexpr size_t WS_XB = 110 * MiB;
constexpr size_t WS_ACT = 142 * MiB;
constexpr size_t WS_END = 270 * MiB;
constexpr size_t WO_IN = 0, WO_AOUT = 8388608, WO_QKV = 12582912, WO_BOUT = 18874368, WO_GU = 20971520, WO_DN = 44040192, WO_END = 55574528;
static_assert(WS_W + WO_END * 2 <= WS_XB && WS_XB + (size_t)M * D * 2 <= WS_ACT && WS_ACT + (size_t)M * GH2 * 2 <= WS_END, "d_ws map");
constexpr int CW_BAR = 1024;

constexpr int RING_OFF = 0, RING_BYTES = 131072;
constexpr int LDSCTL_OFF = RING_BYTES, MISC_OFF = LDSCTL_OFF + 320, RSTAB_OFF = LDSCTL_OFF + 1024;
constexpr int LDS_BYTES = 147456;
static_assert(MISC_OFF + 128 <= LDS_BYTES, "LDS map");

#define GAS __attribute__((address_space(1)))
#define LAS __attribute__((address_space(3)))
typedef unsigned short bf16;
typedef unsigned v4u __attribute__((ext_vector_type(4)));
typedef unsigned v2u __attribute__((ext_vector_type(2)));
typedef float f32x4 __attribute__((ext_vector_type(4)));
typedef float f32x16 __attribute__((ext_vector_type(16)));
typedef short bf16x8 __attribute__((ext_vector_type(8)));
typedef short s16x4 __attribute__((ext_vector_type(4)));
typedef GAS unsigned gu32;
#define RLX_AGENT __ATOMIC_RELAXED, __HIP_MEMORY_SCOPE_AGENT
#define LDS_WAIT() asm volatile("s_waitcnt lgkmcnt(0)" ::: "memory")
#define VM_WAIT() asm volatile("s_waitcnt vmcnt(0)" ::: "memory")
__device__ __forceinline__ unsigned pk2(float lo, float hi) { return pg8::cvt_pk_bf16(lo, hi); }
__device__ __forceinline__ float bf_lo(unsigned w) { return __uint_as_float(w << 16); }
__device__ __forceinline__ float bf_hi(unsigned w) { return __uint_as_float(w & 0xffff0000u); }
__device__ __forceinline__ float wave_sum(float v) {
#pragma unroll
    for (int o = 1; o < 64; o <<= 1) v += __shfl_xor(v, o);
    return v;
}
#define XB_TMO      128
#define XB_XCNT(j)  (256  + 64 * (j))
#define XB_XSUB(j)  (1280 + 64 * (j))
#define XB_XGEN(j)  (2304 + 64 * (j))
#define XB_TOP      3328
#define XB_TOPGEN   3392
#define XCD_BAR_WORDS 3456
#define XB_SPIN_CAP (1u << 18)

__device__ __forceinline__ unsigned xb_ld(unsigned* p)              { return __hip_atomic_load(p, __ATOMIC_RELAXED, __HIP_MEMORY_SCOPE_AGENT); }
__device__ __forceinline__ unsigned xb_add(unsigned* p, unsigned v) { return __hip_atomic_fetch_add(p, v, __ATOMIC_RELAXED, __HIP_MEMORY_SCOPE_AGENT); }
__device__ __forceinline__ unsigned xb_xcc_id() { return (unsigned)__builtin_amdgcn_s_getreg((3 << 11) | 20) & 0xFu; }
#define XB_SPIN(cond, bar) do { unsigned _sp = 0; while (cond) { __builtin_amdgcn_s_sleep(1); \
    if ((++_sp & 255u) == 0u) { if (xb_ld(&(bar)[XB_TMO])) break; if (_sp > XB_SPIN_CAP) { atomicAdd(&(bar)[XB_TMO], 1u); break; } } } } while (0)

struct XcdBarrier {
    unsigned* bar; unsigned x;
    volatile LAS unsigned* st;
};

__device__ __forceinline__ XcdBarrier xcd_barrier_post(unsigned* bar, volatile LAS unsigned* st) {
    XcdBarrier b; b.bar = bar; b.x = xb_xcc_id(); b.st = st;
    if (threadIdx.x == 0) (void)xb_add(&bar[XB_XCNT(b.x)], 1u);
    return b;
}
__device__ __forceinline__ void xcd_barrier_complete(unsigned* bar, unsigned x, unsigned& nloc, unsigned& nx) {
    const unsigned G = gridDim.x * gridDim.y * gridDim.z;
    unsigned sum, cnt, mine, sp = 0u;
    for (;;) {
        sum = 0u; cnt = 0u; mine = 0u;
#pragma unroll
        for (unsigned j = 0; j < 16; ++j) { const unsigned c = xb_ld(&bar[XB_XCNT(j)]); sum += c; cnt += (c > 0u) ? 1u : 0u; mine = (j == x) ? c : mine; }
        if (sum == G) break;
        __builtin_amdgcn_s_sleep(1);
        if ((++sp & 255u) == 0u) { if (xb_ld(&bar[XB_TMO])) break; if (sp > XB_SPIN_CAP) { atomicAdd(&bar[XB_TMO], 1u); break; } }
    }
    nloc = mine > 0u ? mine : 1u; nx = cnt > 0u ? cnt : 1u;
}

__device__ __forceinline__ void xcd_barrier(const XcdBarrier& b) {
    asm volatile("s_waitcnt vmcnt(0)" ::: "memory");
    __syncthreads();
    if (threadIdx.x == 0) {
        const unsigned bx_ = xb_xcc_id();
        unsigned* bar = b.bar; asm volatile("" : "+s"(bar));
        __builtin_amdgcn_s_waitcnt(0);
        unsigned nloc = b.st[0], nx = b.st[1];
        if (nloc == 0u) { xcd_barrier_complete(bar, bx_, nloc, nx); b.st[0] = nloc; b.st[1] = nx; }
        const unsigned old = xb_add(&bar[XB_XSUB(bx_)], 1u);
        const unsigned gen = old / nloc;
        if (old + 1u == (gen + 1u) * nloc) {
            __builtin_amdgcn_fence(__ATOMIC_RELEASE, "agent");
            asm volatile("s_waitcnt vmcnt(0)" ::: "memory");
            const unsigned og = xb_add(&bar[XB_TOP], 1u);
            const unsigned tg = og / nx;
            if (og + 1u == (tg + 1u) * nx) xb_add(&bar[XB_TOPGEN], 1u);
            else XB_SPIN(xb_ld(&bar[XB_TOPGEN]) == tg, bar);
            __builtin_amdgcn_fence(__ATOMIC_ACQUIRE, "agent");
            xb_add(&bar[XB_XGEN(bx_)], 1u);
            asm volatile("s_waitcnt vmcnt(0)" ::: "memory");
        } else {
            XB_SPIN(xb_ld(&bar[XB_XGEN(bx_)]) == gen, bar);
            __builtin_amdgcn_fence(__ATOMIC_ACQUIRE, "agent");
            asm volatile("s_waitcnt vmcnt(0)" ::: "memory");
        }
    }
    __syncthreads();
}

__device__ __forceinline__ void p0_transpose_item(const float* W, const float* gain, int K, int N, bf16* WT, int drow0, int k0, int n0, LAS unsigned* scr, int lane) {
    const int kp = lane >> 4, n4 = lane & 15;
    f32x4 w[8][2];
    const float* src = W + (size_t)(k0 + 2 * kp) * N + n0 + 4 * n4;
#pragma unroll
    for (int i = 0; i < 8; ++i) { w[i][0] = *(const f32x4*)(src + (size_t)(8 * i) * N); w[i][1] = *(const f32x4*)(src + (size_t)(8 * i + 1) * N); }
    if (gain) {
#pragma unroll
        for (int i = 0; i < 8; ++i) { const float g0 = gain[k0 + 8 * i + 2 * kp], g1 = gain[k0 + 8 * i + 2 * kp + 1]; w[i][0] = w[i][0] * g0; w[i][1] = w[i][1] * g1; }
    }
#pragma unroll
    for (int i = 0; i < 8; ++i)
#pragma unroll
        for (int e = 0; e < 4; ++e) scr[(4 * n4 + e) * 33 + 4 * i + kp] = pk2(w[i][0][e], w[i][1][e]);
    LDS_WAIT(); asm volatile("" ::: "memory");
    const int c = lane & 7;
#pragma unroll
    for (int jn = 0; jn < 8; ++jn) { const int n = (lane >> 3) + 8 * jn; const LAS unsigned* s = scr + n * 33 + 4 * c;
        v4u o; o.x = s[0]; o.y = s[1]; o.z = s[2]; o.w = s[3];
        pg8::store16(WT + (size_t)(drow0 + n) * K + k0 + 8 * c, o); }
    LDS_WAIT(); asm volatile("" ::: "memory");
}
struct Ptrs {
    const float *x, *norm_mix_g, *norm_ffn_g, *final_g, *a_w_in, *a_v_gain, *a_w_s, *a_b_s, *a_w_out, *b_w_qkv, *b_rel_bias, *b_w_out, *ffn_w_gate, *ffn_w_up, *ffn_w_down;
    float* out; bf16* wt; bf16* xb; bf16* act; float* xss; float* vss;
};
__device__ __forceinline__ void p0_prologue(const Ptrs& P, LAS unsigned char* lds, int vcu, int G, int wave, int lane) {
    LAS unsigned* scr = (LAS unsigned*)(lds + RING_OFF + wave * 16384);
    const int gw = vcu * NWAVES + wave, NGW = G * NWAVES;
    constexpr int I_IN = 16 * 64, I_AOUT = 32 * 16, I_QKV = 16 * 48, I_BOUT = 16 * 16, I_GU = 16 * 44, I_DN = 44 * 16;
    constexpr int NITEMS = 2 * I_IN + 2 * I_AOUT + 2 * I_QKV + 2 * I_BOUT + 8 * I_GU + 4 * I_DN;
    for (int it = gw; it < NITEMS; it += NGW) {
        int r = it; const float* W; const float* gain = nullptr; bf16* dst; int K, N, mode = 0;
        if (r < 2 * I_IN) { const int j = r / I_IN; r -= j * I_IN; W = P.a_w_in + (size_t)j * D * GH2; gain = P.norm_mix_g + (2 * j) * D; K = D; N = GH2; dst = P.wt + WO_IN + (size_t)j * D * GH2; }
        else if ((r -= 2 * I_IN) < 2 * I_AOUT) { const int j = r / I_AOUT; r -= j * I_AOUT; W = P.a_w_out + (size_t)j * GH * D; K = GH; N = D; dst = P.wt + WO_AOUT + (size_t)j * GH * D; }
        else if ((r -= 2 * I_AOUT) < 2 * I_QKV) { const int j = r / I_QKV; r -= j * I_QKV; W = P.b_w_qkv + (size_t)j * D * 3 * D; gain = P.norm_mix_g + (2 * j + 1) * D; K = D; N = 3 * D; dst = P.wt + WO_QKV + (size_t)j * D * 3 * D; }
        else if ((r -= 2 * I_QKV) < 2 * I_BOUT) { const int j = r / I_BOUT; r -= j * I_BOUT; W = P.b_w_out + (size_t)j * D * D; K = D; N = D; dst = P.wt + WO_BOUT + (size_t)j * D * D; }
        else if ((r -= 2 * I_BOUT) < 4 * I_GU) { const int i = r / I_GU; r -= i * I_GU; W = P.ffn_w_gate + (size_t)i * D * FF; gain = P.norm_ffn_g + i * D; K = D; N = FF; dst = P.wt + WO_GU + (size_t)i * D * FF2; mode = 1; }
        else if ((r -= 4 * I_GU) < 4 * I_GU) { const int i = r / I_GU; r -= i * I_GU; W = P.ffn_w_up + (size_t)i * D * FF; gain = P.norm_ffn_g + i * D; K = D; N = FF; dst = P.wt + WO_GU + (size_t)i * D * FF2; mode = 2; }
        else { r -= 4 * I_GU; const int i = r / I_DN; r -= i * I_DN; W = P.ffn_w_down + (size_t)i * FF * D; K = FF; N = D; dst = P.wt + WO_DN + (size_t)i * FF * D; }
        const int nblk = N / 64, kb = r / nblk, nb = r % nblk, k0 = 64 * kb, n0 = 64 * nb;
        const int drow0 = (mode == 0) ? n0 : ((n0 >> 7) * 256 + (n0 & 127) + (mode == 2 ? 128 : 0));
        p0_transpose_item(W, gain, K, N, dst, drow0, k0, n0, scr, lane);
    }
    for (int m = gw; m < M; m += 2 * NGW) {
        const int m2 = (m + NGW < M) ? m + NGW : m;
        const GAS f32x4* xr = (const GAS f32x4*)(P.x + (size_t)m * D) + lane; const GAS f32x4* xr2 = (const GAS f32x4*)(P.x + (size_t)m2 * D) + lane; f32x4 v[4], v2[4]; float s = 0.f, s2 = 0.f;
#pragma unroll
        for (int j = 0; j < 4; ++j) { v[j] = xr[64 * j]; v2[j] = xr2[64 * j]; }
#pragma unroll
        for (int j = 0; j < 4; ++j) { s += (v[j].x * v[j].x + v[j].y * v[j].y) + (v[j].z * v[j].z + v[j].w * v[j].w); s2 += (v2[j].x * v2[j].x + v2[j].y * v2[j].y) + (v2[j].z * v2[j].z + v2[j].w * v2[j].w); }
        s = wave_sum(s); s2 = wave_sum(s2);
        GAS unsigned long long* o8 = (GAS unsigned long long*)(P.xb + (size_t)m * D) + lane; GAS unsigned long long* o82 = (GAS unsigned long long*)(P.xb + (size_t)m2 * D) + lane;
#pragma unroll
        for (int j = 0; j < 4; ++j) { o8[64 * j] = (unsigned long long)pk2(v[j].x, v[j].y) | ((unsigned long long)pk2(v[j].z, v[j].w) << 32);
            o82[64 * j] = (unsigned long long)pk2(v2[j].x, v2[j].y) | ((unsigned long long)pk2(v2[j].z, v2[j].w) << 32); }
        if (lane < pg8::NSLOT_X) { P.xss[(size_t)m * pg8::NSLOT_X + lane] = (lane == 0) ? s : 0.f; P.xss[(size_t)m2 * pg8::NSLOT_X + lane] = (lane == 0) ? s2 : 0.f; }
    }
}

constexpr int SP_A_PITCH = 272, SP_V_PITCH = 528;
constexpr int SP_A_OFF = 0, SP_V_OFF = 36864, SP_R_OFF = 106496;
typedef short v4i16_t __attribute__((ext_vector_type(4)));
__device__ __forceinline__ s16x4 tr_read(const LAS unsigned char* p) { return __builtin_bit_cast(s16x4, __builtin_amdgcn_ds_read_tr16_b64_v4i16((LAS v4i16_t*)p)); }
template <bool DRY> __device__ __forceinline__ void spatial_phase(const Ptrs& P, int j, LAS unsigned char* lds, int vcu, int G, int tid, int wave, int lane) {
    asm volatile("" : "+v"(tid), "+v"(lane));
    bf16* uv = P.act;
    LAS unsigned char* Aimg = lds + SP_A_OFF; LAS unsigned char* Vimg = lds + SP_V_OFF; LAS float* rsL = (LAS float*)(lds + SP_R_OFF);
    const int fr = lane & 15, fq = lane >> 4;
    for (int unit = vcu; unit < (M / SGU_P) * SGU_G; unit += G) {
        const int nb = unit >> 3, g = unit & 7, row0 = nb * SGU_P;
        if (tid < SGU_P) { const f32x4* p = (const f32x4*)(P.vss + (size_t)(row0 + tid) * pg8::NSLOT_V); float s = 0.f;
#pragma unroll
            for (int k = 0; k < 8; ++k) { const f32x4 v = p[k]; s += (v[0] + v[1]) + (v[2] + v[3]); }
            rsL[tid] = __builtin_amdgcn_rsqf(s * (1.0f / GH) + EPS); }
        { v4u t[8];
#pragma unroll
            for (int i = 0; i < 8; ++i) { const int pc = tid + 512 * i, q = pc >> 5, ch = pc & 31; t[i] = *(const v4u*)(uv + (size_t)(row0 + q) * GH2 + GH + g * SGU_C + ch * 8); }
#pragma unroll
            for (int i = 0; i < 8; ++i) { const int pc = tid + 512 * i, q = pc >> 5, ch = pc & 31; *(LAS v4u*)(Vimg + q * SP_V_PITCH + ch * 16) = t[i]; } }
        __syncthreads();
        { const float* ws = P.a_w_s + ((size_t)j * SGU_G + g) * SGU_P * SGU_P;
#pragma unroll
            for (int i = 0; i < 4; ++i) { const int e = tid + 512 * i, p = e >> 4, q0 = (e & 15) * 8;
                const f32x4 w0 = *(const f32x4*)(ws + p * SGU_P + q0), w1 = *(const f32x4*)(ws + p * SGU_P + q0 + 4);
                const f32x4 r0 = *(const LAS f32x4*)(rsL + q0), r1 = *(const LAS f32x4*)(rsL + q0 + 4);
                v4u o; o.x = pk2(w0[0] * r0[0], w0[1] * r0[1]); o.y = pk2(w0[2] * r0[2], w0[3] * r0[3]); o.z = pk2(w1[0] * r1[0], w1[1] * r1[1]); o.w = pk2(w1[2] * r1[2], w1[3] * r1[3]);
                *(LAS v4u*)(Aimg + p * SP_A_PITCH + q0 * 2) = o; } }
        __syncthreads();
        bf16x8 vf[2][4];
        { const LAS unsigned char* vb = Vimg + (8 * fq + ((lane & 15) >> 2)) * SP_V_PITCH + (32 * wave + 8 * (lane & 3)) * 2;
#pragma unroll
            for (int ks = 0; ks < 4; ++ks)
#pragma unroll
                for (int n = 0; n < 2; ++n) { const s16x4 lo = tr_read(vb + ks * 32 * SP_V_PITCH + n * 8), hi = tr_read(vb + ks * 32 * SP_V_PITCH + 4 * SP_V_PITCH + n * 8);
                    vf[n][ks] = (bf16x8){lo[0], lo[1], lo[2], lo[3], hi[0], hi[1], hi[2], hi[3]}; } }
        const int cc = g * SGU_C + 32 * wave + 8 * fq;
        const f32x4 gn0 = *(const f32x4*)(P.a_v_gain + (size_t)j * GH + cc), gn1 = *(const f32x4*)(P.a_v_gain + (size_t)j * GH + cc + 4);
#pragma unroll
        for (int pt = 0; pt < 8; ++pt) {
            f32x4 a0 = {0.f, 0.f, 0.f, 0.f}, a1 = {0.f, 0.f, 0.f, 0.f};
            const LAS unsigned char* ab = Aimg + (16 * pt + fr) * SP_A_PITCH + (8 * fq) * 2;
#pragma unroll
            for (int ks = 0; ks < 4; ++ks) if (ks < (pt < 4 ? 2 : 4)) { const bf16x8 af = *(const LAS bf16x8*)(ab + ks * 64);
                a0 = __builtin_amdgcn_mfma_f32_16x16x32_bf16(vf[0][ks], af, a0, 0, 0, 0); a1 = __builtin_amdgcn_mfma_f32_16x16x32_bf16(vf[1][ks], af, a1, 0, 0, 0); }
            const int p = 16 * pt + fr; bf16* up = uv + (size_t)(row0 + p) * GH2 + cc;
            const float b = P.a_b_s[((size_t)j * SGU_G + g) * SGU_P + p];
            const v4u u8 = *(const v4u*)up;
            v4u o;
            o.x = pk2(bf_lo(u8.x) * (gn0[0] * a0[0] + b), bf_hi(u8.x) * (gn0[1] * a0[1] + b)); o.y = pk2(bf_lo(u8.y) * (gn0[2] * a0[2] + b), bf_hi(u8.y) * (gn0[3] * a0[3] + b));
            o.z = pk2(bf_lo(u8.z) * (gn1[0] * a1[0] + b), bf_hi(u8.z) * (gn1[1] * a1[1] + b)); o.w = pk2(bf_lo(u8.w) * (gn1[2] * a1[2] + b), bf_hi(u8.w) * (gn1[3] * a1[3] + b));
            if (DRY) *(v4u*)(P.xb + (size_t)(row0 + p) * D + (g & 3) * SGU_C + 32 * wave + 8 * fq) = o; else pg8::store16(up, o);
        }
        __syncthreads();
    }
}

constexpr int AT_K = 0, AT_V = 16384, AT_BT = 32768, AT_WS = 33792, AT_OST = 36864;
constexpr float ATT_THR = 8.0f;
__device__ __forceinline__ int crow(int r, int hi) { return (r & 3) + 8 * (r >> 2) + 4 * hi; }
#define MX3(a, b, c) __builtin_fmaxf(__builtin_fmaxf((a), (b)), (c))
template <bool DRY> __device__ __forceinline__ void attn_phase(const Ptrs& P, int j, LAS unsigned char* lds, int vcu, int G, int tid, int wave, int lane) {
    asm volatile("" : "+v"(tid), "+v"(lane));
    bf16* Q = P.act; const bf16* Kt = P.act + (size_t)M * D; const bf16* Vt = P.act + (size_t)2 * M * D;
    const int r32 = lane & 31, hi = lane >> 5, ci = wave >> 1, qh = wave & 1;
    LAS float* bt = (LAS float*)(lds + AT_BT); LAS float* wsf = (LAS float*)(lds + AT_WS) + wave * 64;
    for (int unit = vcu; unit < BATCH * NH * (SEQ / 256); unit += G) {
        const int bh = unit >> 5, cq = unit & 31, b = bh >> 4, h = bh & 15;
        const size_t rowbase = (size_t)b * SEQ;
        if (tid < NREL) bt[tid] = P.b_rel_bias[((size_t)j * NH + h) * NREL + tid] * LOG2E;
        const size_t qrow = rowbase + (size_t)(4 * cq + ci) * CHUNK + 32 * qh;
        const int s_lo = (4 * cq >= 8) ? 0 : 8 - 4 * cq;
        const long trow0 = (long)rowbase + (long)(4 * cq - 8) * CHUNK;
        const bf16* ksrc = Kt + (trow0 + lane) * D + h * HD + wave * 8;
        const bf16* vsrc = Vt + (trow0 + 16 * (wave & 3) + (lane >> 2)) * D + h * HD + (wave >> 2) * 32 + (lane & 3) * 8;
#define ATT_DMA(t) do { const int sl_ = ((t) & 1) * 8192; \
            __builtin_amdgcn_global_load_lds((const unsigned*)(ksrc + (long)(t) * CHUNK * D), (LAS unsigned*)(lds + AT_K + sl_ + wave * 1024), 16, 0, 0); \
            __builtin_amdgcn_global_load_lds((const unsigned*)(vsrc + (long)(t) * CHUNK * D), (LAS unsigned*)(lds + AT_V + sl_ + wave * 1024), 16, 0, 0); } while (0)
        ATT_DMA(s_lo);
        bf16x8 qr[4];
#pragma unroll
        for (int d0 = 0; d0 < 4; ++d0) qr[d0] = *(const bf16x8*)(Q + (qrow + r32) * D + h * HD + d0 * 16 + hi * 8);
        float mhat = 0.f, lrun = 0.f; f32x16 o0 = {}, o1 = {};
        const int s_first = (ci > s_lo) ? ci : s_lo;
        for (int s = s_lo; s < 12; ++s) {
            asm volatile("s_waitcnt vmcnt(0)" ::: "memory");
            __syncthreads();
            if (s + 1 < 12) ATT_DMA(s + 1);
            const int delta = ci + 8 - s;
            if (delta >= 0 && delta <= 8) {
                const LAS unsigned char* Ks = lds + AT_K + (s & 1) * 8192; const LAS unsigned char* Vs = lds + AT_V + (s & 1) * 8192;
                f32x16 p0, p1;
                { const float c0 = ((delta >= 3) ? bt[NREL - 1] : 0.f) - mhat;
#pragma unroll
                    for (int r = 0; r < 16; ++r) { p0[r] = c0; p1[r] = c0; } }
                { const LAS unsigned char* kb = Ks + hi * 1024 + r32 * 16;
#pragma unroll
                    for (int d0 = 0; d0 < 4; ++d0) { const bf16x8 k0 = *(const LAS bf16x8*)(kb + d0 * 2048), k1 = *(const LAS bf16x8*)(kb + d0 * 2048 + 512);
                        p0 = __builtin_amdgcn_mfma_f32_32x32x16_bf16(k0, qr[d0], p0, 0, 0, 0); p1 = __builtin_amdgcn_mfma_f32_32x32x16_bf16(k1, qr[d0], p1, 0, 0, 0); } }
                if (delta < 3) {
                    const int base = 64 * delta + 32 * qh + r32 + 63;
#pragma unroll
                    for (int r = 0; r < 16; ++r) { const int k0 = crow(r, hi); int i0 = base - k0, i1 = base - k0 - 32; i0 = i0 > NREL - 1 ? NREL - 1 : i0; i1 = i1 > NREL - 1 ? NREL - 1 : i1; i0 = i0 < 0 ? 0 : i0; i1 = i1 < 0 ? 0 : i1;
                        p0[r] += bt[i0]; p1[r] += bt[i1]; }
                }
                float rm;
                { float a = MX3(p0[0], p0[1], p1[0]), c = MX3(p0[2], p0[3], p1[1]); a = MX3(a, p1[2], p1[3]);
#pragma unroll
                    for (int r = 4; r < 16; r += 4) { a = MX3(a, p0[r], p0[r + 1]); c = MX3(c, p0[r + 2], p0[r + 3]); a = MX3(a, p1[r], p1[r + 1]); c = MX3(c, p1[r + 2], p1[r + 3]); }
                    rm = __builtin_fmaxf(a, c);
                    auto rr = __builtin_amdgcn_permlane32_swap(__float_as_uint(rm), __float_as_uint(rm), false, false); rm = __builtin_fmaxf(__uint_as_float(rr[0]), __uint_as_float(rr[1])); }
                if (s == s_first) {
                    mhat = rm;
#pragma unroll
                    for (int r = 0; r < 16; ++r) { p0[r] -= rm; p1[r] -= rm; }
                } else if (__any(rm > ATT_THR)) {
                    const float dl = __builtin_fmaxf(rm, 0.f); mhat += dl;
#pragma unroll
                    for (int r = 0; r < 16; ++r) { p0[r] -= dl; p1[r] -= dl; }
                    const float f = __builtin_amdgcn_exp2f(-dl); lrun *= f;
                    if (hi == 0) wsf[r32] = f;
#pragma unroll
                    for (int r = 0; r < 16; ++r) { const float fr_ = wsf[crow(r, hi)]; o0[r] *= fr_; o1[r] *= fr_; }
                }
                float psum = 0.f;
#pragma unroll
                for (int r = 0; r < 16; ++r) { p0[r] = __builtin_amdgcn_exp2f(p0[r]); p1[r] = __builtin_amdgcn_exp2f(p1[r]); psum += p0[r] + p1[r]; }
                lrun += psum;
                v4u pw[4];
                pw[0] = (v4u){pk2(p0[0], p0[1]), pk2(p0[2], p0[3]), pk2(p0[4], p0[5]), pk2(p0[6], p0[7])};
                pw[1] = (v4u){pk2(p0[8], p0[9]), pk2(p0[10], p0[11]), pk2(p0[12], p0[13]), pk2(p0[14], p0[15])};
                pw[2] = (v4u){pk2(p1[0], p1[1]), pk2(p1[2], p1[3]), pk2(p1[4], p1[5]), pk2(p1[6], p1[7])};
                pw[3] = (v4u){pk2(p1[8], p1[9]), pk2(p1[10], p1[11]), pk2(p1[12], p1[13]), pk2(p1[14], p1[15])};
                const LAS unsigned char* vb = Vs + ((lane >> 4) & 1) * 32 + (lane & 3) * 8 + (4 * hi + ((lane & 15) >> 2)) * 64;
#pragma unroll
                for (int ks = 0; ks < 4; ++ks) { const bf16x8 pa = __builtin_bit_cast(bf16x8, pw[ks]);
                    { const s16x4 lo = tr_read(vb + ks * 1024), hh = tr_read(vb + ks * 1024 + 512); const bf16x8 vfr = (bf16x8){lo[0], lo[1], lo[2], lo[3], hh[0], hh[1], hh[2], hh[3]};
                        o0 = __builtin_amdgcn_mfma_f32_32x32x16_bf16(pa, vfr, o0, 0, 0, 0); }
                    { const s16x4 lo = tr_read(vb + 4096 + ks * 1024), hh = tr_read(vb + 4096 + ks * 1024 + 512); const bf16x8 vfr = (bf16x8){lo[0], lo[1], lo[2], lo[3], hh[0], hh[1], hh[2], hh[3]};
                        o1 = __builtin_amdgcn_mfma_f32_32x32x16_bf16(pa, vfr, o1, 0, 0, 0); } }
            }
        }
#undef ATT_DMA
        { auto rr = __builtin_amdgcn_permlane32_swap(__float_as_uint(lrun), __float_as_uint(lrun), false, false); lrun = __uint_as_float(rr[0]) + __uint_as_float(rr[1]); }
        if (hi == 0) wsf[32 + r32] = lrun;
        { LAS bf16* stg = (LAS bf16*)(lds + AT_OST) + wave * 2048;
#pragma unroll
            for (int r = 0; r < 16; ++r) { const int orow = crow(r, hi); const float rl = __builtin_amdgcn_rcpf(wsf[32 + orow]);
                stg[orow * 64 + r32] = (bf16)(pk2(o0[r] * rl, 0.f) & 0xffffu); stg[orow * 64 + 32 + r32] = (bf16)(pk2(o1[r] * rl, 0.f) & 0xffffu); }
            bf16* Ow = (DRY ? P.xb : Q) + qrow * D + h * HD;
#pragma unroll
            for (int i = 0; i < 4; ++i) { const int row = i * 8 + (lane >> 3), ch = lane & 7; const v4u v = *(const LAS v4u*)(stg + row * 64 + ch * 8); *(v4u*)(Ow + (size_t)row * D + ch * 8) = v; } }
        __syncthreads();
    }
}
#undef MX3

__device__ __forceinline__ void final_phase(const Ptrs& P, int vcu, int G, int wave, int lane) {
    asm volatile("" : "+v"(lane));
    const int gw = vcu * NWAVES + wave, NGW = G * NWAVES;
    f32x4 gn[4];
#pragma unroll
    for (int j = 0; j < 4; ++j) gn[j] = ((const f32x4*)P.final_g)[lane + 64 * j];
    for (int m = gw; m < M; m += NGW) {
        const f32x4 sv = *(const f32x4*)(P.xss + (size_t)m * pg8::NSLOT_X + (lane & 3) * 4);
        float s = (sv[0] + sv[1]) + (sv[2] + sv[3]); s += __shfl_xor(s, 1); s += __shfl_xor(s, 2);
        const float r = __builtin_amdgcn_rsqf(s * (1.0f / D) + EPS);
        const GAS v2u* xr = (const GAS v2u*)(P.xb + (size_t)m * D) + lane;
        GAS f32x4* orow = (GAS f32x4*)(P.out + (size_t)m * D) + lane;
#pragma unroll
        for (int j = 0; j < 4; ++j) { const v2u w = xr[64 * j]; const f32x4 v = {bf_lo(w.x), bf_hi(w.x), bf_lo(w.y), bf_hi(w.y)}; orow[64 * j] = v * r * gn[j]; }
    }
}

struct Args { const float* in[15]; float* out; unsigned char* ws; int ph_lo, ph_hi; };
static_assert(sizeof(Args) == 17 * 8 + 8, "Args has no padding");
__global__ void __launch_bounds__(NWAVES * 64, 2) trunk_fwd(Args args) {
    extern __shared__ __attribute__((aligned(16))) unsigned char lds_raw[];
    LAS unsigned char* lds = (LAS unsigned char*)lds_raw;
    volatile LAS unsigned* MISC = (volatile LAS unsigned*)(lds + MISC_OFF);
    const int tid = threadIdx.x, lane = tid & 63, wave = __builtin_amdgcn_readfirstlane(tid >> 6);
    const int G = gridDim.x; const int bx = blockIdx.x; const int vcu = (G % 8 == 0) ? (bx % 8) * (G / 8) + bx / 8 : bx;
    unsigned char* ws = args.ws;
    gu32* ctl = (gu32*)(ws + WS_CTL);
    Ptrs P;
    P.x = args.in[0]; P.norm_mix_g = args.in[1]; P.norm_ffn_g = args.in[2]; P.final_g = args.in[3]; P.a_w_in = args.in[4]; P.a_v_gain = args.in[5]; P.a_w_s = args.in[6]; P.a_b_s = args.in[7];
    P.a_w_out = args.in[8]; P.b_w_qkv = args.in[9]; P.b_rel_bias = args.in[10]; P.b_w_out = args.in[11]; P.ffn_w_gate = args.in[12]; P.ffn_w_up = args.in[13]; P.ffn_w_down = args.in[14];
    P.out = args.out; P.wt = (bf16*)(ws + WS_W); P.xb = (bf16*)(ws + WS_XB); P.act = (bf16*)(ws + WS_ACT); P.xss = (float*)(ws + WS_XSS); P.vss = (float*)(ws + WS_VSS);
    for (int u = tid; u < (LDS_BYTES - LDSCTL_OFF) / 4; u += NWAVES * 64) ((LAS unsigned*)(lds + LDSCTL_OFF))[u] = 0u;
    __syncthreads();
    XcdBarrier bar; bar.bar = (unsigned*)(ctl + CW_BAR); bar.x = 0; bar.st = nullptr;
    if (!MK_PER_PHASE) bar = xcd_barrier_post((unsigned*)(ctl + CW_BAR), MISC + 8);
    const int lo = args.ph_lo, hi = args.ph_hi;
#define RS_TABLE(S) pg8::RsTab rt{(const LAS float*)(lds + RSTAB_OFF), -1}; { pg8::Unit u0_; if (S.next(0, u0_)) { rt.pm = u0_.pm; pg8::build_rs_table(P.xss, u0_.pm, (LAS float*)(lds + RSTAB_OFF), tid, 1.0f / D, EPS); } }
#ifndef DBG_MASK
#define DBG_MASK 0xff
#endif
#if MK_PER_PHASE
#define IN(k) (lo <= (k) && (k) < hi)
#else
#define IN(k) true
#endif
#define SEAM(k) do { if (IN(k) && IN((k) + 1)) { xcd_barrier(bar); if (PROBE == 1) xcd_barrier(bar); } } while (0)

    if ((DBG_MASK & 1) && IN(0)) { p0_prologue(P, lds, vcu, G, wave, lane); if (PROBE == 2) { __syncthreads(); p0_prologue(P, lds, vcu, G, wave, lane); } }
    SEAM(0);
#pragma unroll 1
    for (int layer = 0; layer < DEPTH; ++layer) {
        const int j = layer >> 1, ph = 1 + 5 * layer;
        const bf16* wgu = P.wt + WO_GU + (size_t)layer * D * FF2; const bf16* wdn = P.wt + WO_DN + (size_t)layer * FF * D;
        if ((layer & 1) == 0) {
            if ((DBG_MASK & 2) && IN(ph)) { pg8::Gemm g{P.xb, P.wt + WO_IN + (size_t)j * D * GH2, M, GH2, D, D}; pg8::StaticOrder S; S.init(M, GH2, G, bx);
                RS_TABLE(S);
                pg8::EpiGeluStats E{P.act, GH2, P.xss, P.vss, GH / 256, EPS, rt};
                pg8::gemm_phase<pg8::EpiGeluStats, pg8::StaticOrder, true, true>(lds + RING_OFF, g, S, E);
                if (PROBE == 5) { __syncthreads(); pg8::gemm_phase<pg8::EpiGeluStats, pg8::StaticOrder, true, true>(lds + RING_OFF, g, S, E); } }
            SEAM(ph);
            if ((DBG_MASK & 4) && IN(ph + 1)) { if (PROBE == 4) spatial_phase<true>(P, j, lds, vcu, G, tid, wave, lane); spatial_phase<false>(P, j, lds, vcu, G, tid, wave, lane); }
            SEAM(ph + 1);
            if ((DBG_MASK & 8) && IN(ph + 2)) { pg8::Gemm g{P.act, P.wt + WO_AOUT + (size_t)j * GH * D, M, D, GH, GH2}; pg8::StaticOrder S; S.init(M, D, G, bx);
                pg8::EpiResid E{P.xb, P.xss, D};
                pg8::gemm_phase<pg8::EpiResid, pg8::StaticOrder, false, true>(lds + RING_OFF, g, S, E); }
            SEAM(ph + 2);
        } else {
            if ((DBG_MASK & 16) && IN(ph)) { pg8::Gemm g{P.xb, P.wt + WO_QKV + (size_t)j * D * 3 * D, M, 3 * D, D, D}; pg8::StaticOrder S; S.init(M, 3 * D, G, bx);
                RS_TABLE(S);
                pg8::EpiQkv E{P.act, D, (size_t)M * D, P.xss, EPS, QSCALE, rt};
                pg8::gemm_phase<pg8::EpiQkv, pg8::StaticOrder, true, true>(lds + RING_OFF, g, S, E);
                if (PROBE == 7) { __syncthreads(); pg8::gemm_phase<pg8::EpiQkv, pg8::StaticOrder, true, true>(lds + RING_OFF, g, S, E); } }
            SEAM(ph);
            if ((DBG_MASK & 32) && IN(ph + 1)) { if (PROBE == 3) attn_phase<true>(P, j, lds, vcu, G, tid, wave, lane); attn_phase<false>(P, j, lds, vcu, G, tid, wave, lane); }
            SEAM(ph + 1);
            if ((DBG_MASK & 8) && IN(ph + 2)) { pg8::Gemm g{P.act, P.wt + WO_BOUT + (size_t)j * D * D, M, D, D, D}; pg8::StaticOrder S; S.init(M, D, G, bx);
                pg8::EpiResid E{P.xb, P.xss, D};
                pg8::gemm_phase<pg8::EpiResid, pg8::StaticOrder, false, true>(lds + RING_OFF, g, S, E); }
            SEAM(ph + 2);
        }
        if ((DBG_MASK & 64) && IN(ph + 3)) { pg8::Gemm g{P.xb, wgu, M, FF2, D, D}; pg8::StaticOrder S; S.init(M, FF2, G, bx);
            RS_TABLE(S);
            pg8::EpiSwiglu E{P.act, FF, P.xss, EPS, rt};
            pg8::gemm_phase<pg8::EpiSwiglu, pg8::StaticOrder, true, true>(lds + RING_OFF, g, S, E);
            if (PROBE == 6) { __syncthreads(); pg8::gemm_phase<pg8::EpiSwiglu, pg8::StaticOrder, true, true>(lds + RING_OFF, g, S, E); } }
        SEAM(ph + 3);
        if ((DBG_MASK & 8) && IN(ph + 4)) { pg8::Gemm g{P.act, wdn, M, D, FF, FF}; pg8::StaticOrder S; S.init(M, D, G, bx);
            pg8::EpiResid E{P.xb, P.xss, D};
            pg8::gemm_phase<pg8::EpiResid, pg8::StaticOrder, false, true>(lds + RING_OFF, g, S, E); }
        SEAM(ph + 4);
    }
    if ((DBG_MASK & 128) && IN(N_PHASES - 1)) final_phase(P, vcu, G, wave, lane);
#undef IN
#undef SEAM
}

extern "C" void kernel_launch(void* const* d_in, const int* in_sizes, int n_in, void* d_out, int out_size, void* d_ws, size_t ws_size, hipStream_t stream) {
    static int grid = 0;
    if (grid == 0) {
        if (n_in != 15 || in_sizes[0] != M * D || out_size != M * D || ws_size < WS_END) { fprintf(stderr, "kernel_launch: unexpected shapes (n_in %d, in0 %d, out %d, ws %zu < %zu); nothing launched\n", n_in, n_in > 0 ? in_sizes[0] : -1, out_size, ws_size, (size_t)WS_END); grid = -1; return; }
        int dev = 0, cus = 0, per_cu = 0;
        if (hipGetDevice(&dev) != hipSuccess || hipDeviceGetAttribute(&cus, hipDeviceAttributeMultiprocessorCount, dev) != hipSuccess) { grid = -1; return; }
        if (hipFuncSetAttribute((const void*)trunk_fwd, hipFuncAttributeMaxDynamicSharedMemorySize, LDS_BYTES) != hipSuccess) { fprintf(stderr, "kernel_launch: hipFuncSetAttribute failed\n"); grid = -1; return; }
        if (hipOccupancyMaxActiveBlocksPerMultiprocessor(&per_cu, (const void*)trunk_fwd, NWAVES * 64, LDS_BYTES) != hipSuccess || per_cu < 1) { fprintf(stderr, "kernel_launch: occupancy query reports %d workgroups per CU; nothing launched\n", per_cu); (void)hipGetLastError(); grid = -1; return; }
        grid = cus;
    }
    if (grid < 0) return;
    if (hipMemsetAsync((char*)d_ws + WS_CTL, 0, CTL_ZERO_BYTES, stream) != hipSuccess) return;
    Args a{};
    for (int i = 0; i < 15; ++i) a.in[i] = (const float*)d_in[i];
    a.out = (float*)d_out; a.ws = (unsigned char*)d_ws;
#if MK_PER_PHASE
    for (int p = 0; p < N_PHASES; ++p) { a.ph_lo = p; a.ph_hi = p + 1; hipLaunchKernelGGL(trunk_fwd, dim3(grid), dim3(NWAVES * 64), LDS_BYTES, stream, a); }
#else
    a.ph_lo = 0; a.ph_hi = N_PHASES;
    hipLaunchKernelGGL(trunk_fwd, dim3(grid), dim3(NWAVES * 64), LDS_BYTES, stream, a);
#endif
}
```

```cpp
#include <hip/hip_runtime.h>
#include <cstdio>
#include <cstdint>
#ifndef PROBE
#define PROBE 0
#endif
namespace pg8 {
#define PG8_LAS __attribute__((address_space(3)))
typedef unsigned short bf16_t;
typedef short bf16x8 __attribute__((ext_vector_type(8)));
typedef float f32x4 __attribute__((ext_vector_type(4)));
typedef unsigned u32x4 __attribute__((ext_vector_type(4)));
constexpr int BM = 256, BK = 64, HALF = 128, HTB = HALF * BK * 2  , STAGE_BYTES = 8 * HTB, NXCD = 8, WGM = 8;

__host__ __device__ __forceinline__ int lds_byte(int r, int c) { const int st = (r >> 4) * 2 + (c >> 5), rr = r & 15, cc = c & 31, ob = rr * 64 + cc * 2; return st * 1024 + (ob ^ (((ob >> 9) & 1) << 5)); }
__host__ __device__ __forceinline__ void stage_rc(int b, int& R, int& C) { const int st = b / 1024, sb = b % 1024, swz = sb ^ (((sb >> 9) & 1) << 5); R = (st >> 1) * 16 + swz / 64; C = (st & 1) * 32 + (swz % 64) / 2; }
__host__ __device__ __forceinline__ int perm32(int rho) { const int n = rho >> 4, i = rho & 15; return 8 * (i >> 2) + 4 * n + (i & 3); }

struct Unit { int pm, pn, hf; };
struct Gemm { const bf16_t* A; const bf16_t* Bt; int M, N, K, lda; };

struct StaticOrder {
    int nM, nN, nwg, G, c;
    __host__ __device__ void init(int M, int N, int G_, int c_) { nM = M / BM; nN = N / BM; nwg = nM * nN; G = G_; c = c_; }
    __host__ __device__ bool next(int i, Unit& u) const {
        const long L = (long)i * G + c; if (L >= nwg) return false;
        int wgid = (int)L; { const int q = nwg / NXCD, r = nwg % NXCD, xcd = wgid % NXCD, off = wgid / NXCD; wgid = (xcd < r ? xcd * (q + 1) : r * (q + 1) + (xcd - r) * q) + off; }
        const int nig = WGM * nN, gid = wgid / nig, fm = gid * WGM, gsz = (nM - fm) < WGM ? (nM - fm) : WGM;
        u.pm = fm + ((wgid % nig) % gsz); u.pn = (wgid % nig) / gsz; u.hf = 0; return true;
    }
    static constexpr bool HAS_HALF = false;
    __host__ __device__ int brow(const Unit& u) const { return u.pn * BM; }
    __device__ __forceinline__ void a_ready(const Unit&) const {}
    __device__ __forceinline__ void done(const Unit&) const {}
};

__device__ __forceinline__ unsigned cvt_pk_bf16(float lo, float hi) { unsigned r; asm volatile("v_cvt_pk_bf16_f32 %0, %1, %2" : "=v"(r) : "v"(lo), "v"(hi)); return r; }
typedef float f32x2 __attribute__((ext_vector_type(2)));
struct FfnOrder {
    StaticOrder so; int nfull_rounds, G, c, NFULL;
    static constexpr bool HAS_HALF = true;
    __host__ __device__ void init(int M, int NFULL_, int G_, int c_) { NFULL = NFULL_; so.init(M, NFULL_ * BM, G_, c_); G = G_; c = c_; nfull_rounds = (c_ < so.nwg) ? (so.nwg - c_ + G_ - 1) / G_ : 0; }
    __host__ __device__ bool next(int i, Unit& u) const {
        if (i < nfull_rounds) return so.next(i, u);
        const int k = i - nfull_rounds;
        const int nh = so.nM * 4; const int hu = k * G + c; if (hu >= nh) return false;
        if (G == 256 && so.nM == 64) { Unit f; so.next(0, f); u.pm = f.pm; u.pn = f.pn & 3; }
        else { u.pm = hu % so.nM; u.pn = hu / so.nM; }
        u.hf = 1; return true;
    }
    __host__ __device__ int brow(const Unit& u) const { return u.hf ? NFULL * BM + u.pn * HALF : u.pn * BM; }
    __device__ __forceinline__ void a_ready(const Unit&) const {}
    __device__ __forceinline__ void done(const Unit&) const {}
};

#ifndef STORE_WT
#define STORE_WT 1
#endif
__device__ __forceinline__ void store16(void* p, u32x4 v) {
#if STORE_WT
    asm volatile("global_store_dwordx4 %0, %1, off sc1\n\ts_nop 1" :: "v"(p), "v"(v) : "memory");
#else
    *(u32x4*)p = v;
#endif
}
__device__ __forceinline__ void store16f(void* p, f32x4 v) {
#if STORE_WT
    asm volatile("global_store_dwordx4 %0, %1, off sc1\n\ts_nop 1" :: "v"(p), "v"(v) : "memory");
#else
    *(f32x4*)p = v;
#endif
}
typedef unsigned u32x2 __attribute__((ext_vector_type(2)));
__device__ __forceinline__ void store8(void* p, u32x2 v) {
#if STORE_WT
    asm volatile("global_store_dwordx2 %0, %1, off sc1\n\ts_nop 1" :: "v"(p), "v"(v) : "memory");
#else
    *(u32x2*)p = v;
#endif
}
constexpr int NSLOT_X = 16;
constexpr int NSLOT_V = 32;
struct RsTab { const PG8_LAS float* t; int pm; };
__device__ __forceinline__ void row_scales(const float* ss, const RsTab& T, int pm, int wr, int fr, int fq, float inv_n, float eps, float (&rs)[2][4]) {
    if (pm == T.pm) {
#pragma unroll
        for (int ai = 0; ai < 2; ++ai)
#pragma unroll
            for (int m = 0; m < 4; ++m) rs[ai][m] = T.t[wr * 64 + fr + ai * HALF + m * 16];
    } else {
        const int row0 = pm * BM + wr * 64 + fr;
#pragma unroll
        for (int ai = 0; ai < 2; ++ai)
#pragma unroll
            for (int m = 0; m < 4; ++m) {
                const f32x4 v = *(const f32x4*)(ss + (size_t)(row0 + ai * HALF + m * 16) * NSLOT_X + fq * 4);
                float s = (v[0] + v[1]) + (v[2] + v[3]);
                s += __shfl_xor(s, 16); s += __shfl_xor(s, 32);
                rs[ai][m] = __builtin_amdgcn_rsqf(s * inv_n + eps);
            }
    }
}
__device__ __forceinline__ void build_rs_table(const float* ss, int pm, PG8_LAS float* t, int tid, float inv_n, float eps) {
    asm volatile("" : "+v"(tid));
    const int row = tid >> 1, half = tid & 1;
    const f32x4 a = *(const f32x4*)(ss + (size_t)(pm * BM + row) * NSLOT_X + half * 8), b = *(const f32x4*)(ss + (size_t)(pm * BM + row) * NSLOT_X + half * 8 + 4);
    float s = ((a[0] + a[1]) + (a[2] + a[3])) + ((b[0] + b[1]) + (b[2] + b[3]));
    s += __shfl_xor(s, 1);
    if (half == 0) t[row] = __builtin_amdgcn_rsqf(s * inv_n + eps);
    asm volatile("s_waitcnt lgkmcnt(0)" ::: "memory"); __syncthreads();
}
__device__ __forceinline__ float gelu_tanh(float x) {
    const float t = x * x, u2 = x * (2.302208198f + 0.1029432398f * t);
    const float e = __builtin_amdgcn_exp2f(-u2);
    return x * __builtin_amdgcn_rcpf(1.0f + e);
}
__device__ __forceinline__ float silu_mul(float g, float u) {
    const float e = __builtin_amdgcn_exp2f(g * -1.4426950408889634f);
    return (g * u) * __builtin_amdgcn_rcpf(1.0f + e);
}
struct EpiGeluStats {
    static constexpr bool PERM = true, AFTER_DRAIN = false, PROBE_TWICE = false;
    bf16_t* O; int ldc; const float* xss; float* vss; int vtile0; float eps; RsTab rt;
    __device__ __forceinline__ void operator()(const f32x4 (&acc)[2][2][4][2], const Unit& u, int wr, int wc, int fr, int fq) const {
        const int row0 = u.pm * BM + wr * 64 + fr, col0 = u.pn * BM + wc * 32 + 8 * fq;
        float rs[2][4]; row_scales(xss, rt, u.pm, wr, fr, fq, 1.0f / 1024.0f, eps, rs);
        const bool isv = u.pn >= vtile0;
#pragma unroll
        for (int ai = 0; ai < 2; ++ai)
#pragma unroll
            for (int m = 0; m < 4; ++m) { const int row = row0 + ai * HALF + m * 16; bf16_t* rowp = O + (size_t)row * ldc + col0; const float r = rs[ai][m]; float ssq = 0.f;
#pragma unroll
                for (int bj = 0; bj < 2; ++bj) { f32x4 v0 = acc[ai][bj][m][0] * r, v1 = acc[ai][bj][m][1] * r;
#pragma unroll
                    for (int e = 0; e < 4; ++e) { v0[e] = gelu_tanh(v0[e]); v1[e] = gelu_tanh(v1[e]); }
                    ssq += (v0[0] * v0[0] + v0[1] * v0[1]) + (v0[2] * v0[2] + v0[3] * v0[3]) + (v1[0] * v1[0] + v1[1] * v1[1]) + (v1[2] * v1[2] + v1[3] * v1[3]);
                    u32x4 w; w.x = cvt_pk_bf16(v0[0], v0[1]); w.y = cvt_pk_bf16(v0[2], v0[3]); w.z = cvt_pk_bf16(v1[0], v1[1]); w.w = cvt_pk_bf16(v1[2], v1[3]);
                    store16(rowp + bj * HALF, w); }
                if (isv) { ssq += __shfl_xor(ssq, 16); ssq += __shfl_xor(ssq, 32); if (fq == 0) vss[(size_t)row * NSLOT_V + (u.pn - vtile0) * 4 + wc] = ssq; } }
    }
};
struct EpiSwiglu {
    static constexpr bool PERM = true, AFTER_DRAIN = false, PROBE_TWICE = true;
    bf16_t* O; int ldc; const float* xss; float eps; RsTab rt;
    int half_col0;
    __device__ __forceinline__ void operator()(const f32x4 (&acc)[2][2][4][2], const Unit& u, int wr, int wc, int fr, int fq) const {
        const int row0 = u.pm * BM + wr * 64 + fr, col0 = u.pn * HALF + wc * 32 + 8 * fq;
        float rs[2][4]; row_scales(xss, rt, u.pm, wr, fr, fq, 1.0f / 1024.0f, eps, rs);
        if (u.hf) {
            const int hc = half_col0 + u.pn * 64 + wc * 16 + 4 * fq;
#pragma unroll
            for (int ai = 0; ai < 2; ++ai)
#pragma unroll
                for (int m = 0; m < 4; ++m) { const int row = row0 + ai * HALF + m * 16; const float r = rs[ai][m];
                    const f32x4 g0 = acc[ai][0][m][0] * r, u0 = acc[ai][0][m][1] * r;
                    u32x2 w; w.x = cvt_pk_bf16(silu_mul(g0[0], u0[0]), silu_mul(g0[1], u0[1])); w.y = cvt_pk_bf16(silu_mul(g0[2], u0[2]), silu_mul(g0[3], u0[3]));
                    *(u32x2*)(O + (size_t)row * ldc + hc) = w; }
            return;
        }
#pragma unroll
        for (int ai = 0; ai < 2; ++ai)
#pragma unroll
            for (int m = 0; m < 4; ++m) { const int row = row0 + ai * HALF + m * 16; const float r = rs[ai][m] * (PROBE == 9 ? 0.5f : 1.0f);
                const f32x4 g0 = acc[ai][0][m][0] * r, g1 = acc[ai][0][m][1] * r, u0 = acc[ai][1][m][0] * r, u1 = acc[ai][1][m][1] * r;
                float o[8];
#pragma unroll
                for (int e = 0; e < 4; ++e) { o[e] = silu_mul(g0[e], u0[e]); o[4 + e] = silu_mul(g1[e], u1[e]); }
                u32x4 w; w.x = cvt_pk_bf16(o[0], o[1]); w.y = cvt_pk_bf16(o[2], o[3]); w.z = cvt_pk_bf16(o[4], o[5]); w.w = cvt_pk_bf16(o[6], o[7]);
                store16(O + (size_t)row * ldc + col0, w); }
    }
};
struct EpiQkv {
    static constexpr bool PERM = true, AFTER_DRAIN = false, PROBE_TWICE = false;
    bf16_t* O; int ldc; size_t split_stride; const float* xss; float eps; float scale0; RsTab rt;
    __device__ __forceinline__ void operator()(const f32x4 (&acc)[2][2][4][2], const Unit& u, int wr, int wc, int fr, int fq) const {
        const int t = u.pn >> 2; bf16_t* base = O + (size_t)t * split_stride; const float sc = (t == 0) ? scale0 : 1.0f;
        const int row0 = u.pm * BM + wr * 64 + fr, col0 = (u.pn & 3) * BM + wc * 32 + 8 * fq;
        float rs[2][4]; row_scales(xss, rt, u.pm, wr, fr, fq, 1.0f / 1024.0f, eps, rs);
#pragma unroll
        for (int ai = 0; ai < 2; ++ai)
#pragma unroll
            for (int m = 0; m < 4; ++m) { const int row = row0 + ai * HALF + m * 16; bf16_t* rowp = base + (size_t)row * ldc + col0; const float r = rs[ai][m] * sc;
#pragma unroll
                for (int bj = 0; bj < 2; ++bj) { const f32x4 v0 = acc[ai][bj][m][0] * r, v1 = acc[ai][bj][m][1] * r;
                    u32x4 w; w.x = cvt_pk_bf16(v0[0], v0[1]); w.y = cvt_pk_bf16(v0[2], v0[3]); w.z = cvt_pk_bf16(v1[0], v1[1]); w.w = cvt_pk_bf16(v1[2], v1[3]);
                    store16(rowp + bj * HALF, w); } }
    }
};
struct EpiResid {
    static constexpr bool PERM = true, AFTER_DRAIN = false, PROBE_TWICE = false;
    bf16_t* xb; float* xss; int ldc;
    __device__ __forceinline__ void operator()(const f32x4 (&acc)[2][2][4][2], const Unit& u, int wr, int wc, int fr, int fq) const {
        asm volatile("" : "+v"(fr), "+v"(fq));
        const int row0 = u.pm * BM + wr * 64 + fr, col0 = u.pn * BM + wc * 32 + 8 * fq;
        u32x4 pre[2][4][2];
#pragma unroll
        for (int ai = 0; ai < 2; ++ai)
#pragma unroll
            for (int m = 0; m < 4; ++m)
#pragma unroll
                for (int bj = 0; bj < 2; ++bj) pre[ai][m][bj] = *(const u32x4*)(xb + (size_t)(row0 + ai * HALF + m * 16) * ldc + col0 + bj * HALF);
#pragma unroll
        for (int ai = 0; ai < 2; ++ai)
#pragma unroll
            for (int m = 0; m < 4; ++m) { const int row = row0 + ai * HALF + m * 16; bf16_t* rowp = xb + (size_t)row * ldc + col0; float ssq = 0.f;
#pragma unroll
                for (int bj = 0; bj < 2; ++bj) { const u32x4 b = pre[ai][m][bj]; const f32x4 a0 = acc[ai][bj][m][0], a1 = acc[ai][bj][m][1];
                    float o[8];
                    o[0] = __uint_as_float(b.x << 16) + a0[0]; o[1] = __uint_as_float(b.x & 0xffff0000u) + a0[1]; o[2] = __uint_as_float(b.y << 16) + a0[2]; o[3] = __uint_as_float(b.y & 0xffff0000u) + a0[3];
                    o[4] = __uint_as_float(b.z << 16) + a1[0]; o[5] = __uint_as_float(b.z & 0xffff0000u) + a1[1]; o[6] = __uint_as_float(b.w << 16) + a1[2]; o[7] = __uint_as_float(b.w & 0xffff0000u) + a1[3];
                    ssq += ((o[0] * o[0] + o[1] * o[1]) + (o[2] * o[2] + o[3] * o[3])) + ((o[4] * o[4] + o[5] * o[5]) + (o[6] * o[6] + o[7] * o[7]));
                    u32x4 w; w.x = cvt_pk_bf16(o[0], o[1]); w.y = cvt_pk_bf16(o[2], o[3]); w.z = cvt_pk_bf16(o[4], o[5]); w.w = cvt_pk_bf16(o[6], o[7]);
                    store16(rowp + bj * HALF, w); }
                ssq += __shfl_xor(ssq, 16); ssq += __shfl_xor(ssq, 32);
                if (fq == 0) xss[(size_t)row * NSLOT_X + u.pn * 4 + wc] = ssq; }
    }
};

template <class Epi, class Sched, bool ALIGN_EPI = false, bool SP2 = false>
__device__ __forceinline__ void gemm_phase(PG8_LAS unsigned char* lds, const Gemm g, const Sched& S, const Epi& E) {
    int tid_ = threadIdx.x; asm volatile("" : "+v"(tid_));
    const int tid = tid_, wid = __builtin_amdgcn_readfirstlane(tid >> 6), lane = tid & 63, wr = wid >> 2, wc = wid & 3, fr = lane & 15, fq = lane >> 4;
    const int K = g.K, nt = K / BK;
    unsigned voffA[2], voffB[2];
#pragma unroll
    for (int i = 0; i < 2; ++i) { int R, C; stage_rc(tid * 16 + i * 8192, R, C); const int Rb = Epi::PERM ? ((R & ~31) + perm32(R & 31)) : R;
        voffA[i] = (unsigned)(R * g.lda + C) * 2u; voffB[i] = (unsigned)(Rb * K + C) * 2u; }
    const size_t kstep = (size_t)(BK * 2);
    const size_t hstep = (size_t)HALF * K * 2;
    const size_t tstep = 2 * hstep; const size_t hstepA = (size_t)HALF * g.lda * 2, tstepA = 2 * hstepA;
    const unsigned ldsw = (unsigned)wid * 1024u;
    const int aoff = lds_byte(wr * 64 + fr, fq * 8), boff = lds_byte(wc * 32 + fr, fq * 8);
#define PG8_SA(b, h) (((b) * 2 + (h)) * HTB)
#define PG8_SB(b, h) ((4 + (b) * 2 + (h)) * HTB)
#define PG8_STAGE(bufoff, gbase, voff) do { _Pragma("unroll") for (int _i = 0; _i < 2; ++_i) \
        __builtin_amdgcn_global_load_lds((const unsigned*)((const char*)(gbase) + (voff)[_i]), (PG8_LAS unsigned*)(lds + (bufoff) + ldsw + _i * 8192), 16, 0, 0); } while (0)
#define PG8_LDA(dst, b, h) do { _Pragma("unroll") for (int m = 0; m < 4; ++m) _Pragma("unroll") for (int k = 0; k < 2; ++k) dst[m][k] = *(const PG8_LAS bf16x8*)(lds + PG8_SA(b, h) + aoff + m * 2048 + k * 1024); } while (0)
#define PG8_LDB(dst, b, h) do { _Pragma("unroll") for (int n = 0; n < 2; ++n) _Pragma("unroll") for (int k = 0; k < 2; ++k) dst[n][k] = *(const PG8_LAS bf16x8*)(lds + PG8_SB(b, h) + boff + n * 2048 + k * 1024); } while (0)
#define PG8_MMA(ai, bj, At, Bt) do { __builtin_amdgcn_s_setprio(1); _Pragma("unroll") for (int m = 0; m < 4; ++m) _Pragma("unroll") for (int n = 0; n < 2; ++n) _Pragma("unroll") for (int k = 0; k < 2; ++k) \
        acc[ai][bj][m][n] = __builtin_amdgcn_mfma_f32_16x16x32_bf16(Bt[n][k], At[m][k], acc[ai][bj][m][n], 0, 0, 0); __builtin_amdgcn_s_setprio(0); } while (0)
#define PG8_WAIT_V(n) asm volatile("s_waitcnt vmcnt(" #n ")" ::: "memory")
#define PG8_WAIT_L(n) asm volatile("s_waitcnt lgkmcnt(" #n ")" ::: "memory")
#define PG8_BAR __builtin_amdgcn_s_barrier()
#define PG8_SCHED __builtin_amdgcn_sched_barrier(0)
    Unit cur, nxt; int ui = 0;
    if (!S.next(0, cur)) return;
    f32x4 acc[2][2][4][2];
#pragma unroll
    for (int a = 0; a < 2; ++a)
#pragma unroll
        for (int b = 0; b < 2; ++b)
#pragma unroll
            for (int m = 0; m < 4; ++m)
#pragma unroll
                for (int n = 0; n < 2; ++n) acc[a][b][m][n] = (f32x4){0.f, 0.f, 0.f, 0.f};
    bf16x8 At[4][2], B0[2][2], B1[2][2];
    const char* cA = (const char*)g.A + (size_t)cur.pm * tstepA; const char* cB = (const char*)g.Bt + (size_t)S.brow(cur) * K * 2;
    S.a_ready(cur);
    if constexpr (SP2) {
        PG8_STAGE(PG8_SB(0, 0), cB, voffB); PG8_STAGE(PG8_SB(0, 1), cB + hstep, voffB); PG8_STAGE(PG8_SA(0, 0), cA, voffA); PG8_STAGE(PG8_SA(0, 1), cA + hstepA, voffA);
        if (wr == 1) PG8_BAR;
        PG8_WAIT_V(2); PG8_BAR;
        PG8_STAGE(PG8_SB(1, 0), cB + kstep, voffB); PG8_STAGE(PG8_SA(1, 0), cA + kstep, voffA); PG8_STAGE(PG8_SB(1, 1), cB + hstep + kstep, voffB);
        PG8_WAIT_V(6); PG8_BAR;
    } else {
        PG8_STAGE(PG8_SB(0, 0), cB, voffB); PG8_STAGE(PG8_SA(0, 0), cA, voffA); PG8_STAGE(PG8_SB(0, 1), cB + hstep, voffB); PG8_STAGE(PG8_SA(0, 1), cA + hstepA, voffA);
        if (wr == 1) PG8_BAR;
        PG8_WAIT_V(4); PG8_BAR;
        PG8_STAGE(PG8_SB(1, 0), cB + kstep, voffB); PG8_STAGE(PG8_SA(1, 0), cA + kstep, voffA); PG8_STAGE(PG8_SB(1, 1), cB + hstep + kstep, voffB);
        PG8_WAIT_V(6); PG8_BAR;
    }
    for (;;) {
        const bool has_next = S.next(ui + 1, nxt);
        const char* nA = has_next ? (const char*)g.A + (size_t)nxt.pm * tstepA : cA; const char* nB = has_next ? (const char*)g.Bt + (size_t)S.brow(nxt) * K * 2 : cB;
        const bool full = !(Sched::HAS_HALF && cur.hf);
        const int ntl = (PROBE == 9 && Epi::PROBE_TWICE) ? 2 * nt : nt;
        for (int t = 0; t < ntl; t += 2) {
            const bool last = (t == ntl - 2);
            const int t1 = (t + 1 >= nt) ? t + 1 - nt : t + 1, t2 = (t + 2 >= nt) ? t + 2 - nt : t + 2;
            const char* a1 = cA + (size_t)t1 * kstep;
            const char* a2 = last ? nA : cA + (size_t)t2 * kstep; const char* b2 = last ? nB : cB + (size_t)t2 * kstep;
            const char* a3 = a2 + kstep; const char* b3 = b2 + kstep;
            if (last && has_next) S.a_ready(nxt);
            if constexpr (SP2) {
            PG8_LDB(B0, 0, 0); if (full) PG8_LDB(B1, 0, 1); PG8_SCHED; PG8_LDA(At, 0, 0); PG8_STAGE(PG8_SA(1, 1), a1 + hstepA, voffA);
            PG8_WAIT_V(8); PG8_WAIT_L(0); PG8_BAR; PG8_MMA(0, 0, At, B0); if (full) PG8_MMA(0, 1, At, B1); PG8_BAR; PG8_SCHED;
            PG8_LDA(At, 0, 1); PG8_STAGE(PG8_SB(0, 0), b2, voffB); PG8_STAGE(PG8_SB(0, 1), b2 + hstep, voffB); PG8_STAGE(PG8_SA(0, 0), a2, voffA);
            PG8_WAIT_V(8); PG8_WAIT_L(0); PG8_BAR; PG8_MMA(1, 0, At, B0); if (full) PG8_MMA(1, 1, At, B1); PG8_BAR; PG8_SCHED;
            PG8_LDB(B0, 1, 0); if (full) PG8_LDB(B1, 1, 1); PG8_SCHED; PG8_LDA(At, 1, 0); PG8_STAGE(PG8_SA(0, 1), a2 + hstepA, voffA);
            PG8_WAIT_V(8); PG8_WAIT_L(0); PG8_BAR; PG8_MMA(0, 0, At, B0); if (full) PG8_MMA(0, 1, At, B1); PG8_BAR; PG8_SCHED;
            PG8_LDA(At, 1, 1); PG8_STAGE(PG8_SB(1, 0), b3, voffB); PG8_STAGE(PG8_SB(1, 1), b3 + hstep, voffB); PG8_STAGE(PG8_SA(1, 0), a3, voffA);
            PG8_WAIT_V(8); PG8_WAIT_L(0); PG8_BAR; PG8_MMA(1, 0, At, B0); if (full) PG8_MMA(1, 1, At, B1); PG8_BAR; PG8_SCHED;
            } else {
            PG8_LDB(B0, 0, 0); PG8_SCHED; PG8_LDA(At, 0, 0); PG8_STAGE(PG8_SA(1, 1), a1 + hstepA, voffA);
            PG8_WAIT_L(8); PG8_BAR; PG8_WAIT_L(0); PG8_MMA(0, 0, At, B0); PG8_BAR; PG8_SCHED;
            PG8_LDB(B1, 0, 1); PG8_STAGE(PG8_SB(0, 0), b2, voffB);
            PG8_BAR; PG8_WAIT_L(0); if (full) PG8_MMA(0, 1, At, B1); PG8_BAR;
            PG8_LDA(At, 0, 1); PG8_STAGE(PG8_SA(0, 0), a2, voffA);
            PG8_BAR; PG8_WAIT_L(0); PG8_MMA(1, 0, At, B0); PG8_BAR; PG8_SCHED;
            PG8_STAGE(PG8_SB(0, 1), b2 + hstep, voffB);
            PG8_WAIT_V(6); PG8_BAR; if (full) PG8_MMA(1, 1, At, B1); PG8_BAR;
            PG8_LDB(B0, 1, 0); PG8_SCHED; PG8_LDA(At, 1, 0); PG8_STAGE(PG8_SA(0, 1), a2 + hstepA, voffA);
            PG8_WAIT_L(8); PG8_BAR; PG8_WAIT_L(0); PG8_MMA(0, 0, At, B0); PG8_BAR; PG8_SCHED;
            PG8_LDB(B1, 1, 1); PG8_STAGE(PG8_SB(1, 0), b3, voffB);
            PG8_BAR; PG8_WAIT_L(0); if (full) PG8_MMA(0, 1, At, B1); PG8_BAR;
            PG8_LDA(At, 1, 1); PG8_STAGE(PG8_SA(1, 0), a3, voffA);
            PG8_BAR; PG8_WAIT_L(0); PG8_MMA(1, 0, At, B0); PG8_BAR; PG8_SCHED;
            PG8_STAGE(PG8_SB(1, 1), b3 + hstep, voffB);
            PG8_WAIT_V(6); PG8_BAR; if (full) PG8_MMA(1, 1, At, B1); PG8_BAR;
            }
        }
        if constexpr (ALIGN_EPI) { if (wr == 0) PG8_BAR; }
        if constexpr (!Epi::AFTER_DRAIN) { E(acc, cur, wr, wc, fr, fq); if (PROBE == 8 && Epi::PROBE_TWICE) { asm volatile("" ::: "memory"); E(acc, cur, wr, wc, fr, fq); } S.done(cur); }
        if (!has_next) break;
#pragma unroll
        for (int a = 0; a < 2; ++a)
#pragma unroll
            for (int b = 0; b < 2; ++b)
#pragma unroll
                for (int m = 0; m < 4; ++m)
#pragma unroll
                    for (int n = 0; n < 2; ++n) acc[a][b][m][n] = (f32x4){0.f, 0.f, 0.f, 0.f};
        cur = nxt; cA = nA; cB = nB; ++ui;
        if constexpr (ALIGN_EPI) { if (wr == 1) PG8_BAR; }
    }
    PG8_WAIT_V(0);
    if constexpr (!ALIGN_EPI) { if (wr == 0) PG8_BAR; }
    PG8_BAR;
    if constexpr (Epi::AFTER_DRAIN) { E.fused(acc, cur, wr, wc, fr, fq, lds, wid, lane); S.done(cur); }
#undef PG8_SA
#undef PG8_SB
#undef PG8_STAGE
#undef PG8_LDA
#undef PG8_LDB
#undef PG8_MMA
#undef PG8_WAIT_V
#undef PG8_WAIT_L
#undef PG8_BAR
#undef PG8_SCHED
}
}

constexpr int NWAVES = 8;
constexpr int BATCH = 2, SEQ = 8192, D = 1024, DEPTH = 4, M = BATCH * SEQ;
constexpr int GH = 2048, GH2 = 4096, SGU_G = 8, SGU_P = 128, SGU_C = 256;
constexpr int NH = 16, HD = 64, NREL = 192, CHUNK = 64;
constexpr int FF = 2816, FF2 = 5632, FF_NFULL = 20;
constexpr float EPS = 1e-6f;
constexpr float LOG2E = 1.4426950408889634f;
constexpr float QSCALE = 0.125f * LOG2E;

#ifndef MK_PER_PHASE
#define MK_PER_PHASE 0
#endif
constexpr int N_PHASES = 22;

constexpr size_t MiB = 1u << 20;
constexpr size_t WS_CTL = 0, CTL_ZERO_BYTES = 64 * 1024;
constexpr size_t WS_XSS = 1 * MiB;
constexpr size_t WS_VSS = 2 * MiB;
constexpr size_t WS_W = 4 * MiB;
constexpr size_t WS_XB = 110 * MiB;
constexpr size_t WS_ACT = 142 * MiB;
constexpr size_t WS_END = 270 * MiB;
constexpr size_t WO_IN = 0, WO_AOUT = 8388608, WO_QKV = 12582912, WO_BOUT = 18874368, WO_GU = 20971520, WO_DN = 44040192, WO_END = 55574528;
static_assert(WS_W + WO_END * 2 <= WS_XB && WS_XB + (size_t)M * D * 2 <= WS_ACT && WS_ACT + (size_t)M * GH2 * 2 <= WS_END, "d_ws map");
constexpr int CW_BAR = 1024;

constexpr int RING_OFF = 0, RING_BYTES = 131072;
constexpr int LDSCTL_OFF = RING_BYTES, MISC_OFF = LDSCTL_OFF + 320, RSTAB_OFF = LDSCTL_OFF + 1024;
constexpr int LDS_BYTES = 147456;
static_assert(MISC_OFF + 128 <= LDS_BYTES, "LDS map");

#define GAS __attribute__((address_space(1)))
#define LAS __attribute__((address_space(3)))
typedef unsigned short bf16;
typedef unsigned v4u __attribute__((ext_vector_type(4)));
typedef unsigned v2u __attribute__((ext_vector_type(2)));
typedef float f32x4 __attribute__((ext_vector_type(4)));
typedef float f32x16 __attribute__((ext_vector_type(16)));
typedef short bf16x8 __attribute__((ext_vector_type(8)));
typedef short s16x4 __attribute__((ext_vector_type(4)));
typedef GAS unsigned gu32;
#define RLX_AGENT __ATOMIC_RELAXED, __HIP_MEMORY_SCOPE_AGENT
#define LDS_WAIT() asm volatile("s_waitcnt lgkmcnt(0)" ::: "memory")
#define VM_WAIT() asm volatile("s_waitcnt vmcnt(0)" ::: "memory")
__device__ __forceinline__ unsigned pk2(float lo, float hi) { return pg8::cvt_pk_bf16(lo, hi); }
__device__ __forceinline__ float bf_lo(unsigned w) { return __uint_as_float(w << 16); }
__device__ __forceinline__ float bf_hi(unsigned w) { return __uint_as_float(w & 0xffff0000u); }
__device__ __forceinline__ float wave_sum(float v) {
#pragma unroll
    for (int o = 1; o < 64; o <<= 1) v += __shfl_xor(v, o);
    return v;
}
#define XB_TMO      128
#define XB_XCNT(j)  (256  + 64 * (j))
#define XB_XSUB(j)  (1280 + 64 * (j))
#define XB_XGEN(j)  (2304 + 64 * (j))
#define XB_TOP      3328
#define XB_TOPGEN   3392
#define XCD_BAR_WORDS 3456
#define XB_SPIN_CAP (1u << 18)

__device__ __forceinline__ unsigned xb_ld(unsigned* p)              { return __hip_atomic_load(p, __ATOMIC_RELAXED, __HIP_MEMORY_SCOPE_AGENT); }
__device__ __forceinline__ unsigned xb_add(unsigned* p, unsigned v) { return __hip_atomic_fetch_add(p, v, __ATOMIC_RELAXED, __HIP_MEMORY_SCOPE_AGENT); }
__device__ __forceinline__ unsigned xb_xcc_id() { return (unsigned)__builtin_amdgcn_s_getreg((3 << 11) | 20) & 0xFu; }
#define XB_SPIN(cond, bar) do { unsigned _sp = 0; while (cond) { __builtin_amdgcn_s_sleep(1); \
    if ((++_sp & 255u) == 0u) { if (xb_ld(&(bar)[XB_TMO])) break; if (_sp > XB_SPIN_CAP) { atomicAdd(&(bar)[XB_TMO], 1u); break; } } } } while (0)

struct XcdBarrier {
    unsigned* bar; unsigned x;
    volatile LAS unsigned* st;
};

__device__ __forceinline__ XcdBarrier xcd_barrier_post(unsigned* bar, volatile LAS unsigned* st) {
    XcdBarrier b; b.bar = bar; b.x = xb_xcc_id(); b.st = st;
    if (threadIdx.x == 0) (void)xb_add(&bar[XB_XCNT(b.x)], 1u);
    return b;
}
__device__ __forceinline__ void xcd_barrier_complete(unsigned* bar, unsigned x, unsigned& nloc, unsigned& nx) {
    const unsigned G = gridDim.x * gridDim.y * gridDim.z;
    unsigned sum, cnt, mine, sp = 0u;
    for (;;) {
        sum = 0u; cnt = 0u; mine = 0u;
#pragma unroll
        for (unsigned j = 0; j < 16; ++j) { const unsigned c = xb_ld(&bar[XB_XCNT(j)]); sum += c; cnt += (c > 0u) ? 1u : 0u; mine = (j == x) ? c : mine; }
        if (sum == G) break;
        __builtin_amdgcn_s_sleep(1);
        if ((++sp & 255u) == 0u) { if (xb_ld(&bar[XB_TMO])) break; if (sp > XB_SPIN_CAP) { atomicAdd(&bar[XB_TMO], 1u); break; } }
    }
    nloc = mine > 0u ? mine : 1u; nx = cnt > 0u ? cnt : 1u;
}

__device__ __forceinline__ void xcd_barrier(const XcdBarrier& b) {
    asm volatile("s_waitcnt vmcnt(0)" ::: "memory");
    __syncthreads();
    if (threadIdx.x == 0) {
        const unsigned bx_ = xb_xcc_id();
        unsigned* bar = b.bar; asm volatile("" : "+s"(bar));
        __builtin_amdgcn_s_waitcnt(0);
        unsigned nloc = b.st[0], nx = b.st[1];
        if (nloc == 0u) { xcd_barrier_complete(bar, bx_, nloc, nx); b.st[0] = nloc; b.st[1] = nx; }
        const unsigned old = xb_add(&bar[XB_XSUB(bx_)], 1u);
        const unsigned gen = old / nloc;
        if (old + 1u == (gen + 1u) * nloc) {
            __builtin_amdgcn_fence(__ATOMIC_RELEASE, "agent");
            asm volatile("s_waitcnt vmcnt(0)" ::: "memory");
            const unsigned og = xb_add(&bar[XB_TOP], 1u);
            const unsigned tg = og / nx;
            if (og + 1u == (tg + 1u) * nx) xb_add(&bar[XB_TOPGEN], 1u);
            else XB_SPIN(xb_ld(&bar[XB_TOPGEN]) == tg, bar);
            __builtin_amdgcn_fence(__ATOMIC_ACQUIRE, "agent");
            xb_add(&bar[XB_XGEN(bx_)], 1u);
            asm volatile("s_waitcnt vmcnt(0)" ::: "memory");
        } else {
            XB_SPIN(xb_ld(&bar[XB_XGEN(bx_)]) == gen, bar);
            __builtin_amdgcn_fence(__ATOMIC_ACQUIRE, "agent");
            asm volatile("s_waitcnt vmcnt(0)" ::: "memory");
        }
    }
    __syncthreads();
}

__device__ __forceinline__ void p0_transpose_item(const float* W, const float* gain, int K, int N, bf16* WT, int drow0, bool sp, int k0, int n0, LAS unsigned* scr, int lane) {
    const int kp = lane >> 4, n4 = lane & 15;
    f32x4 w[8][2];
    const float* src = W + (size_t)(k0 + 2 * kp) * N + n0 + 4 * n4;
#pragma unroll
    for (int i = 0; i < 8; ++i) { w[i][0] = *(const f32x4*)(src + (size_t)(8 * i) * N); w[i][1] = *(const f32x4*)(src + (size_t)(8 * i + 1) * N); }
    if (gain) {
#pragma unroll
        for (int i = 0; i < 8; ++i) { const float g0 = gain[k0 + 8 * i + 2 * kp], g1 = gain[k0 + 8 * i + 2 * kp + 1]; w[i][0] = w[i][0] * g0; w[i][1] = w[i][1] * g1; }
    }
#pragma unroll
    for (int i = 0; i < 8; ++i)
#pragma unroll
        for (int e = 0; e < 4; ++e) scr[(4 * n4 + e) * 33 + 4 * i + kp] = pk2(w[i][0][e], w[i][1][e]);
    LDS_WAIT(); asm volatile("" ::: "memory");
    const int c = lane & 7;
#pragma unroll
    for (int jn = 0; jn < 8; ++jn) { const int n = (lane >> 3) + 8 * jn; const LAS unsigned* s = scr + n * 33 + 4 * c;
        v4u o; o.x = s[0]; o.y = s[1]; o.z = s[2]; o.w = s[3];
        const int dr = sp ? ((n >> 4) * 32 + ((n & 15) >> 2) * 8 + (n & 3)) : n;
        pg8::store16(WT + (size_t)(drow0 + dr) * K + k0 + 8 * c, o); }
    LDS_WAIT(); asm volatile("" ::: "memory");
}
struct Ptrs {
    const float *x, *norm_mix_g, *norm_ffn_g, *final_g, *a_w_in, *a_v_gain, *a_w_s, *a_b_s, *a_w_out, *b_w_qkv, *b_rel_bias, *b_w_out, *ffn_w_gate, *ffn_w_up, *ffn_w_down;
    float* out; bf16* wt; bf16* xb; bf16* act; float* xss; float* vss;
};
__device__ __forceinline__ void p0_prologue(const Ptrs& P, LAS unsigned char* lds, int vcu, int G, int wave, int lane) {
    LAS unsigned* scr = (LAS unsigned*)(lds + RING_OFF + wave * 16384);
    const int gw = vcu * NWAVES + wave, NGW = G * NWAVES;
    constexpr int I_IN = 16 * 64, I_AOUT = 32 * 16, I_QKV = 16 * 48, I_BOUT = 16 * 16, I_GU = 16 * 44, I_DN = 44 * 16;
    constexpr int NITEMS = 2 * I_IN + 2 * I_AOUT + 2 * I_QKV + 2 * I_BOUT + 8 * I_GU + 4 * I_DN;
    for (int it = gw; it < NITEMS; it += NGW) {
        int r = it; const float* W; const float* gain = nullptr; bf16* dst; int K, N, mode = 0;
        if (r < 2 * I_IN) { const int j = r / I_IN; r -= j * I_IN; W = P.a_w_in + (size_t)j * D * GH2; gain = P.norm_mix_g + (2 * j) * D; K = D; N = GH2; dst = P.wt + WO_IN + (size_t)j * D * GH2; }
        else if ((r -= 2 * I_IN) < 2 * I_AOUT) { const int j = r / I_AOUT; r -= j * I_AOUT; W = P.a_w_out + (size_t)j * GH * D; K = GH; N = D; dst = P.wt + WO_AOUT + (size_t)j * GH * D; }
        else if ((r -= 2 * I_AOUT) < 2 * I_QKV) { const int j = r / I_QKV; r -= j * I_QKV; W = P.b_w_qkv + (size_t)j * D * 3 * D; gain = P.norm_mix_g + (2 * j + 1) * D; K = D; N = 3 * D; dst = P.wt + WO_QKV + (size_t)j * D * 3 * D; }
        else if ((r -= 2 * I_QKV) < 2 * I_BOUT) { const int j = r / I_BOUT; r -= j * I_BOUT; W = P.b_w_out + (size_t)j * D * D; K = D; N = D; dst = P.wt + WO_BOUT + (size_t)j * D * D; }
        else if ((r -= 2 * I_BOUT) < 4 * I_GU) { const int i = r / I_GU; r -= i * I_GU; W = P.ffn_w_gate + (size_t)i * D * FF; gain = P.norm_ffn_g + i * D; K = D; N = FF; dst = P.wt + WO_GU + (size_t)i * D * FF2; mode = 1; }
        else if ((r -= 4 * I_GU) < 4 * I_GU) { const int i = r / I_GU; r -= i * I_GU; W = P.ffn_w_up + (size_t)i * D * FF; gain = P.norm_ffn_g + i * D; K = D; N = FF; dst = P.wt + WO_GU + (size_t)i * D * FF2; mode = 2; }
        else { r -= 4 * I_GU; const int i = r / I_DN; r -= i * I_DN; W = P.ffn_w_down + (size_t)i * FF * D; K = FF; N = D; dst = P.wt + WO_DN + (size_t)i * FF * D; }
        const int nblk = N / 64, kb = r / nblk, nb = r % nblk, k0 = 64 * kb, n0 = 64 * nb;
        const bool sp = (mode != 0) && (n0 >= FF_NFULL * 128);
        const int drow0 = (mode == 0) ? n0 : sp ? (FF_NFULL * 256 + ((n0 - FF_NFULL * 128) >> 6) * 128 + (mode == 2 ? 4 : 0)) : ((n0 >> 7) * 256 + (n0 & 127) + (mode == 2 ? 128 : 0));
        p0_transpose_item(W, gain, K, N, dst, drow0, sp, k0, n0, scr, lane);
    }
    for (int m = gw; m < M; m += 2 * NGW) {
        const int m2 = (m + NGW < M) ? m + NGW : m;
        const GAS f32x4* xr = (const GAS f32x4*)(P.x + (size_t)m * D) + lane; const GAS f32x4* xr2 = (const GAS f32x4*)(P.x + (size_t)m2 * D) + lane; f32x4 v[4], v2[4]; float s = 0.f, s2 = 0.f;
#pragma unroll
        for (int j = 0; j < 4; ++j) { v[j] = xr[64 * j]; v2[j] = xr2[64 * j]; }
#pragma unroll
        for (int j = 0; j < 4; ++j) { s += (v[j].x * v[j].x + v[j].y * v[j].y) + (v[j].z * v[j].z + v[j].w * v[j].w); s2 += (v2[j].x * v2[j].x + v2[j].y * v2[j].y) + (v2[j].z * v2[j].z + v2[j].w * v2[j].w); }
        s = wave_sum(s); s2 = wave_sum(s2);
        GAS unsigned long long* o8 = (GAS unsigned long long*)(P.xb + (size_t)m * D) + lane; GAS unsigned long long* o82 = (GAS unsigned long long*)(P.xb + (size_t)m2 * D) + lane;
#pragma unroll
        for (int j = 0; j < 4; ++j) { o8[64 * j] = (unsigned long long)pk2(v[j].x, v[j].y) | ((unsigned long long)pk2(v[j].z, v[j].w) << 32);
            o82[64 * j] = (unsigned long long)pk2(v2[j].x, v2[j].y) | ((unsigned long long)pk2(v2[j].z, v2[j].w) << 32); }
        if (lane < pg8::NSLOT_X) { P.xss[(size_t)m * pg8::NSLOT_X + lane] = (lane == 0) ? s : 0.f; P.xss[(size_t)m2 * pg8::NSLOT_X + lane] = (lane == 0) ? s2 : 0.f; }
    }
}

constexpr int SP_A_PITCH = 272, SP_V_PITCH = 528;
constexpr int SP_A_OFF = 0, SP_V_OFF = 36864, SP_R_OFF = 106496;
typedef short v4i16_t __attribute__((ext_vector_type(4)));
__device__ __forceinline__ s16x4 tr_read(const LAS unsigned char* p) { return __builtin_bit_cast(s16x4, __builtin_amdgcn_ds_read_tr16_b64_v4i16((LAS v4i16_t*)p)); }
template <bool DRY> __device__ __forceinline__ void spatial_phase(const Ptrs& P, int j, LAS unsigned char* lds, int vcu, int G, int tid, int wave, int lane) {
    asm volatile("" : "+v"(tid), "+v"(lane));
    bf16* uv = P.act;
    LAS unsigned char* Aimg = lds + SP_A_OFF; LAS unsigned char* Vimg = lds + SP_V_OFF; LAS float* rsL = (LAS float*)(lds + SP_R_OFF);
    const int fr = lane & 15, fq = lane >> 4;
    for (int unit = vcu; unit < (M / SGU_P) * SGU_G; unit += G) {
        const int nb = unit >> 3, g = unit & 7, row0 = nb * SGU_P;
        if (tid < SGU_P) { const f32x4* p = (const f32x4*)(P.vss + (size_t)(row0 + tid) * pg8::NSLOT_V); float s = 0.f;
#pragma unroll
            for (int k = 0; k < 8; ++k) { const f32x4 v = p[k]; s += (v[0] + v[1]) + (v[2] + v[3]); }
            rsL[tid] = __builtin_amdgcn_rsqf(s * (1.0f / GH) + EPS); }
        { v4u t[8];
#pragma unroll
            for (int i = 0; i < 8; ++i) { const int pc = tid + 512 * i, q = pc >> 5, ch = pc & 31; t[i] = *(const v4u*)(uv + (size_t)(row0 + q) * GH2 + GH + g * SGU_C + ch * 8); }
#pragma unroll
            for (int i = 0; i < 8; ++i) { const int pc = tid + 512 * i, q = pc >> 5, ch = pc & 31; *(LAS v4u*)(Vimg + q * SP_V_PITCH + ch * 16) = t[i]; } }
        __syncthreads();
        { const float* ws = P.a_w_s + ((size_t)j * SGU_G + g) * SGU_P * SGU_P;
#pragma unroll
            for (int i = 0; i < 4; ++i) { const int e = tid + 512 * i, p = e >> 4, q0 = (e & 15) * 8;
                const f32x4 w0 = *(const f32x4*)(ws + p * SGU_P + q0), w1 = *(const f32x4*)(ws + p * SGU_P + q0 + 4);
                const f32x4 r0 = *(const LAS f32x4*)(rsL + q0), r1 = *(const LAS f32x4*)(rsL + q0 + 4);
                v4u o; o.x = pk2(w0[0] * r0[0], w0[1] * r0[1]); o.y = pk2(w0[2] * r0[2], w0[3] * r0[3]); o.z = pk2(w1[0] * r1[0], w1[1] * r1[1]); o.w = pk2(w1[2] * r1[2], w1[3] * r1[3]);
                *(LAS v4u*)(Aimg + p * SP_A_PITCH + q0 * 2) = o; } }
        __syncthreads();
        bf16x8 vf[2][4];
        { const LAS unsigned char* vb = Vimg + (8 * fq + ((lane & 15) >> 2)) * SP_V_PITCH + (32 * wave + 8 * (lane & 3)) * 2;
#pragma unroll
            for (int ks = 0; ks < 4; ++ks)
#pragma unroll
                for (int n = 0; n < 2; ++n) { const s16x4 lo = tr_read(vb + ks * 32 * SP_V_PITCH + n * 8), hi = tr_read(vb + ks * 32 * SP_V_PITCH + 4 * SP_V_PITCH + n * 8);
                    vf[n][ks] = (bf16x8){lo[0], lo[1], lo[2], lo[3], hi[0], hi[1], hi[2], hi[3]}; } }
        const int cc = g * SGU_C + 32 * wave + 8 * fq;
        const f32x4 gn0 = *(const f32x4*)(P.a_v_gain + (size_t)j * GH + cc), gn1 = *(const f32x4*)(P.a_v_gain + (size_t)j * GH + cc + 4);
#pragma unroll
        for (int pt = 0; pt < 8; ++pt) {
            f32x4 a0 = {0.f, 0.f, 0.f, 0.f}, a1 = {0.f, 0.f, 0.f, 0.f};
            const LAS unsigned char* ab = Aimg + (16 * pt + fr) * SP_A_PITCH + (8 * fq) * 2;
#pragma unroll
            for (int ks = 0; ks < 4; ++ks) if (ks < (pt < 4 ? 2 : 4)) { const bf16x8 af = *(const LAS bf16x8*)(ab + ks * 64);
                a0 = __builtin_amdgcn_mfma_f32_16x16x32_bf16(vf[0][ks], af, a0, 0, 0, 0); a1 = __builtin_amdgcn_mfma_f32_16x16x32_bf16(vf[1][ks], af, a1, 0, 0, 0); }
            const int p = 16 * pt + fr; bf16* up = uv + (size_t)(row0 + p) * GH2 + cc;
            const float b = P.a_b_s[((size_t)j * SGU_G + g) * SGU_P + p];
            const v4u u8 = *(const v4u*)up;
            v4u o;
            o.x = pk2(bf_lo(u8.x) * (gn0[0] * a0[0] + b), bf_hi(u8.x) * (gn0[1] * a0[1] + b)); o.y = pk2(bf_lo(u8.y) * (gn0[2] * a0[2] + b), bf_hi(u8.y) * (gn0[3] * a0[3] + b));
            o.z = pk2(bf_lo(u8.z) * (gn1[0] * a1[0] + b), bf_hi(u8.z) * (gn1[1] * a1[1] + b)); o.w = pk2(bf_lo(u8.w) * (gn1[2] * a1[2] + b), bf_hi(u8.w) * (gn1[3] * a1[3] + b));
            if (DRY) *(v4u*)(P.xb + (size_t)(row0 + p) * D + (g & 3) * SGU_C + 32 * wave + 8 * fq) = o; else pg8::store16(up, o);
        }
        __syncthreads();
    }
}

constexpr int AT_K = 0, AT_V = 16384, AT_BT = 32768, AT_WS = 33792, AT_OST = 36864;
constexpr float ATT_THR = 8.0f;
__device__ __forceinline__ int crow(int r, int hi) { return (r & 3) + 8 * (r >> 2) + 4 * hi; }
#define MX3(a, b, c) __builtin_fmaxf(__builtin_fmaxf((a), (b)), (c))
template <bool DRY> __device__ __forceinline__ void attn_phase(const Ptrs& P, int j, LAS unsigned char* lds, int vcu, int G, int tid, int wave, int lane) {
    asm volatile("" : "+v"(tid), "+v"(lane));
    bf16* Q = P.act; const bf16* Kt = P.act + (size_t)M * D; const bf16* Vt = P.act + (size_t)2 * M * D;
    const int r32 = lane & 31, hi = lane >> 5, ci = wave >> 1, qh = wave & 1;
    LAS float* bt = (LAS float*)(lds + AT_BT); LAS float* wsf = (LAS float*)(lds + AT_WS) + wave * 64;
    for (int unit = vcu; unit < BATCH * NH * (SEQ / 256); unit += G) {
        const int bh = unit >> 5, cq = unit & 31, b = bh >> 4, h = bh & 15;
        const size_t rowbase = (size_t)b * SEQ;
        if (tid < NREL) bt[tid] = P.b_rel_bias[((size_t)j * NH + h) * NREL + tid] * LOG2E;
        const size_t qrow = rowbase + (size_t)(4 * cq + ci) * CHUNK + 32 * qh;
        const int s_lo = (4 * cq >= 8) ? 0 : 8 - 4 * cq;
        const long trow0 = (long)rowbase + (long)(4 * cq - 8) * CHUNK;
        const bf16* ksrc = Kt + (trow0 + lane) * D + h * HD + wave * 8;
        const bf16* vsrc = Vt + (trow0 + 16 * (wave & 3) + (lane >> 2)) * D + h * HD + (wave >> 2) * 32 + (lane & 3) * 8;
#define ATT_DMA(t) do { const int sl_ = ((t) & 1) * 8192; \
            __builtin_amdgcn_global_load_lds((const unsigned*)(ksrc + (long)(t) * CHUNK * D), (LAS unsigned*)(lds + AT_K + sl_ + wave * 1024), 16, 0, 0); \
            __builtin_amdgcn_global_load_lds((const unsigned*)(vsrc + (long)(t) * CHUNK * D), (LAS unsigned*)(lds + AT_V + sl_ + wave * 1024), 16, 0, 0); } while (0)
        ATT_DMA(s_lo);
        bf16x8 qr[4];
#pragma unroll
        for (int d0 = 0; d0 < 4; ++d0) qr[d0] = *(const bf16x8*)(Q + (qrow + r32) * D + h * HD + d0 * 16 + hi * 8);
        float mhat = 0.f, lrun = 0.f; f32x16 o0 = {}, o1 = {};
        const int s_first = (ci > s_lo) ? ci : s_lo;
        for (int s = s_lo; s < 12; ++s) {
            asm volatile("s_waitcnt vmcnt(0)" ::: "memory");
            __syncthreads();
            if (s + 1 < 12) ATT_DMA(s + 1);
            const int delta = ci + 8 - s;
            if (delta >= 0 && delta <= 8) {
                const LAS unsigned char* Ks = lds + AT_K + (s & 1) * 8192; const LAS unsigned char* Vs = lds + AT_V + (s & 1) * 8192;
                f32x16 p0, p1;
                { const float c0 = ((delta >= 3) ? bt[NREL - 1] : 0.f) - mhat;
#pragma unroll
                    for (int r = 0; r < 16; ++r) { p0[r] = c0; p1[r] = c0; } }
                { const LAS unsigned char* kb = Ks + hi * 1024 + r32 * 16;
#pragma unroll
                    for (int d0 = 0; d0 < 4; ++d0) { const bf16x8 k0 = *(const LAS bf16x8*)(kb + d0 * 2048), k1 = *(const LAS bf16x8*)(kb + d0 * 2048 + 512);
                        p0 = __builtin_amdgcn_mfma_f32_32x32x16_bf16(k0, qr[d0], p0, 0, 0, 0); p1 = __builtin_amdgcn_mfma_f32_32x32x16_bf16(k1, qr[d0], p1, 0, 0, 0); } }
                if (delta < 3) {
                    const int base = 64 * delta + 32 * qh + r32 + 63;
#pragma unroll
                    for (int r = 0; r < 16; ++r) { const int k0 = crow(r, hi); int i0 = base - k0, i1 = base - k0 - 32; i0 = i0 > NREL - 1 ? NREL - 1 : i0; i1 = i1 > NREL - 1 ? NREL - 1 : i1; i0 = i0 < 0 ? 0 : i0; i1 = i1 < 0 ? 0 : i1;
                        p0[r] += bt[i0]; p1[r] += bt[i1]; }
                }
                float rm;
                { float a = MX3(p0[0], p0[1], p1[0]), c = MX3(p0[2], p0[3], p1[1]); a = MX3(a, p1[2], p1[3]);
#pragma unroll
                    for (int r = 4; r < 16; r += 4) { a = MX3(a, p0[r], p0[r + 1]); c = MX3(c, p0[r + 2], p0[r + 3]); a = MX3(a, p1[r], p1[r + 1]); c = MX3(c, p1[r + 2], p1[r + 3]); }
                    rm = __builtin_fmaxf(a, c);
                    auto rr = __builtin_amdgcn_permlane32_swap(__float_as_uint(rm), __float_as_uint(rm), false, false); rm = __builtin_fmaxf(__uint_as_float(rr[0]), __uint_as_float(rr[1])); }
                if (s == s_first) {
                    mhat = rm;
#pragma unroll
                    for (int r = 0; r < 16; ++r) { p0[r] -= rm; p1[r] -= rm; }
                } else if (__any(rm > ATT_THR)) {
                    const float dl = __builtin_fmaxf(rm, 0.f); mhat += dl;
#pragma unroll
                    for (int r = 0; r < 16; ++r) { p0[r] -= dl; p1[r] -= dl; }
                    const float f = __builtin_amdgcn_exp2f(-dl); lrun *= f;
                    if (hi == 0) wsf[r32] = f;
#pragma unroll
                    for (int r = 0; r < 16; ++r) { const float fr_ = wsf[crow(r, hi)]; o0[r] *= fr_; o1[r] *= fr_; }
                }
                float psum = 0.f;
#pragma unroll
                for (int r = 0; r < 16; ++r) { p0[r] = __builtin_amdgcn_exp2f(p0[r]); p1[r] = __builtin_amdgcn_exp2f(p1[r]); psum += p0[r] + p1[r]; }
                lrun += psum;
                v4u pw[4];
                pw[0] = (v4u){pk2(p0[0], p0[1]), pk2(p0[2], p0[3]), pk2(p0[4], p0[5]), pk2(p0[6], p0[7])};
                pw[1] = (v4u){pk2(p0[8], p0[9]), pk2(p0[10], p0[11]), pk2(p0[12], p0[13]), pk2(p0[14], p0[15])};
                pw[2] = (v4u){pk2(p1[0], p1[1]), pk2(p1[2], p1[3]), pk2(p1[4], p1[5]), pk2(p1[6], p1[7])};
                pw[3] = (v4u){pk2(p1[8], p1[9]), pk2(p1[10], p1[11]), pk2(p1[12], p1[13]), pk2(p1[14], p1[15])};
                const LAS unsigned char* vb = Vs + ((lane >> 4) & 1) * 32 + (lane & 3) * 8 + (4 * hi + ((lane & 15) >> 2)) * 64;
#pragma unroll
                for (int ks = 0; ks < 4; ++ks) { const bf16x8 pa = __builtin_bit_cast(bf16x8, pw[ks]);
                    { const s16x4 lo = tr_read(vb + ks * 1024), hh = tr_read(vb + ks * 1024 + 512); const bf16x8 vfr = (bf16x8){lo[0], lo[1], lo[2], lo[3], hh[0], hh[1], hh[2], hh[3]};
                        o0 = __builtin_amdgcn_mfma_f32_32x32x16_bf16(pa, vfr, o0, 0, 0, 0); }
                    { const s16x4 lo = tr_read(vb + 4096 + ks * 1024), hh = tr_read(vb + 4096 + ks * 1024 + 512); const bf16x8 vfr = (bf16x8){lo[0], lo[1], lo[2], lo[3], hh[0], hh[1], hh[2], hh[3]};
                        o1 = __builtin_amdgcn_mfma_f32_32x32x16_bf16(pa, vfr, o1, 0, 0, 0); } }
            }
        }
#undef ATT_DMA
        { auto rr = __builtin_amdgcn_permlane32_swap(__float_as_uint(lrun), __float_as_uint(lrun), false, false); lrun = __uint_as_float(rr[0]) + __uint_as_float(rr[1]); }
        if (hi == 0) wsf[32 + r32] = lrun;
        { LAS bf16* stg = (LAS bf16*)(lds + AT_OST) + wave * 2048;
#pragma unroll
            for (int r = 0; r < 16; ++r) { const int orow = crow(r, hi); const float rl = __builtin_amdgcn_rcpf(wsf[32 + orow]);
                stg[orow * 64 + r32] = (bf16)(pk2(o0[r] * rl, 0.f) & 0xffffu); stg[orow * 64 + 32 + r32] = (bf16)(pk2(o1[r] * rl, 0.f) & 0xffffu); }
            bf16* Ow = (DRY ? P.xb : Q) + qrow * D + h * HD;
#pragma unroll
            for (int i = 0; i < 4; ++i) { const int row = i * 8 + (lane >> 3), ch = lane & 7; const v4u v = *(const LAS v4u*)(stg + row * 64 + ch * 8); *(v4u*)(Ow + (size_t)row * D + ch * 8) = v; } }
        __syncthreads();
    }
}
#undef MX3

__device__ __forceinline__ void final_phase(const Ptrs& P, int vcu, int G, int wave, int lane) {
    asm volatile("" : "+v"(lane));
    const int gw = vcu * NWAVES + wave, NGW = G * NWAVES;
    f32x4 gn[4];
#pragma unroll
    for (int j = 0; j < 4; ++j) gn[j] = ((const f32x4*)P.final_g)[lane + 64 * j];
    for (int m = gw; m < M; m += NGW) {
        const f32x4 sv = *(const f32x4*)(P.xss + (size_t)m * pg8::NSLOT_X + (lane & 3) * 4);
        float s = (sv[0] + sv[1]) + (sv[2] + sv[3]); s += __shfl_xor(s, 1); s += __shfl_xor(s, 2);
        const float r = __builtin_amdgcn_rsqf(s * (1.0f / D) + EPS);
        const GAS v2u* xr = (const GAS v2u*)(P.xb + (size_t)m * D) + lane;
        GAS f32x4* orow = (GAS f32x4*)(P.out + (size_t)m * D) + lane;
#pragma unroll
        for (int j = 0; j < 4; ++j) { const v2u w = xr[64 * j]; const f32x4 v = {bf_lo(w.x), bf_hi(w.x), bf_lo(w.y), bf_hi(w.y)}; orow[64 * j] = v * r * gn[j]; }
    }
}

__device__ __forceinline__ int launder_s(int x) { asm volatile("" : "+s"(x)); return x; }
struct Args { const float* in[15]; float* out; unsigned char* ws; int ph_lo, ph_hi; };
static_assert(sizeof(Args) == 17 * 8 + 8, "Args has no padding");
__global__ void __launch_bounds__(NWAVES * 64, 2) trunk_fwd(Args args) {
    extern __shared__ __attribute__((aligned(16))) unsigned char lds_raw[];
    LAS unsigned char* lds = (LAS unsigned char*)lds_raw;
    volatile LAS unsigned* MISC = (volatile LAS unsigned*)(lds + MISC_OFF);
    const int tid = threadIdx.x, lane = tid & 63, wave = __builtin_amdgcn_readfirstlane(tid >> 6);
    const int G = gridDim.x; const int bx = blockIdx.x; const int vcu = (G % 8 == 0) ? (bx % 8) * (G / 8) + bx / 8 : bx;
    unsigned char* ws = args.ws;
    gu32* ctl = (gu32*)(ws + WS_CTL);
    Ptrs P;
    P.x = args.in[0]; P.norm_mix_g = args.in[1]; P.norm_ffn_g = args.in[2]; P.final_g = args.in[3]; P.a_w_in = args.in[4]; P.a_v_gain = args.in[5]; P.a_w_s = args.in[6]; P.a_b_s = args.in[7];
    P.a_w_out = args.in[8]; P.b_w_qkv = args.in[9]; P.b_rel_bias = args.in[10]; P.b_w_out = args.in[11]; P.ffn_w_gate = args.in[12]; P.ffn_w_up = args.in[13]; P.ffn_w_down = args.in[14];
    P.out = args.out; P.wt = (bf16*)(ws + WS_W); P.xb = (bf16*)(ws + WS_XB); P.act = (bf16*)(ws + WS_ACT); P.xss = (float*)(ws + WS_XSS); P.vss = (float*)(ws + WS_VSS);
    for (int u = tid; u < (LDS_BYTES - LDSCTL_OFF) / 4; u += NWAVES * 64) ((LAS unsigned*)(lds + LDSCTL_OFF))[u] = 0u;
    __syncthreads();
    XcdBarrier bar; bar.bar = (unsigned*)(ctl + CW_BAR); bar.x = 0; bar.st = nullptr;
    if (!MK_PER_PHASE) bar = xcd_barrier_post((unsigned*)(ctl + CW_BAR), MISC + 8);
    const int lo = args.ph_lo, hi = args.ph_hi;
#define RS_TABLE(S) pg8::RsTab rt{(const LAS float*)(lds + RSTAB_OFF), -1}; { pg8::Unit u0_; if (S.next(0, u0_)) { rt.pm = u0_.pm; pg8::build_rs_table(P.xss, u0_.pm, (LAS float*)(lds + RSTAB_OFF), tid, 1.0f / D, EPS); } }
#ifndef DBG_MASK
#define DBG_MASK 0xff
#endif
#if MK_PER_PHASE
#define IN(k) (lo <= (k) && (k) < hi)
#else
#define IN(k) true
#endif
#define SEAM(k) do { if (IN(k) && IN((k) + 1)) { xcd_barrier(bar); if (PROBE == 1) xcd_barrier(bar); } } while (0)

    if ((DBG_MASK & 1) && IN(0)) { p0_prologue(P, lds, vcu, G, wave, lane); if (PROBE == 2) { __syncthreads(); p0_prologue(P, lds, vcu, G, wave, lane); } }
    SEAM(0);
#pragma unroll 1
    for (int layer = 0; layer < DEPTH; ++layer) {
        const int j = layer >> 1, ph = 1 + 5 * layer;
        const bf16* wgu = P.wt + WO_GU + (size_t)layer * D * FF2; const bf16* wdn = P.wt + WO_DN + (size_t)layer * FF * D;
        if ((layer & 1) == 0) {
            if ((DBG_MASK & 2) && IN(ph)) { pg8::Gemm g{P.xb, P.wt + WO_IN + (size_t)j * D * GH2, M, GH2, D, D}; pg8::StaticOrder S; S.init(M, GH2, G, launder_s(bx));
                RS_TABLE(S);
                pg8::EpiGeluStats E{P.act, GH2, P.xss, P.vss, GH / 256, EPS, rt};
                pg8::gemm_phase<pg8::EpiGeluStats, pg8::StaticOrder, true, true>(lds + RING_OFF, g, S, E);
                if (PROBE == 5) { __syncthreads(); pg8::gemm_phase<pg8::EpiGeluStats, pg8::StaticOrder, true, true>(lds + RING_OFF, g, S, E); } }
            SEAM(ph);
            if ((DBG_MASK & 4) && IN(ph + 1)) { if (PROBE == 4) spatial_phase<true>(P, j, lds, vcu, G, tid, wave, lane); spatial_phase<false>(P, j, lds, vcu, G, tid, wave, lane); }
            SEAM(ph + 1);
            if ((DBG_MASK & 8) && IN(ph + 2)) { pg8::Gemm g{P.act, P.wt + WO_AOUT + (size_t)j * GH * D, M, D, GH, GH2}; pg8::StaticOrder S; S.init(M, D, G, launder_s(bx));
                pg8::EpiResid E{P.xb, P.xss, D};
                pg8::gemm_phase<pg8::EpiResid, pg8::StaticOrder, false, true>(lds + RING_OFF, g, S, E); }
            SEAM(ph + 2);
        } else {
            if ((DBG_MASK & 16) && IN(ph)) { pg8::Gemm g{P.xb, P.wt + WO_QKV + (size_t)j * D * 3 * D, M, 3 * D, D, D}; pg8::StaticOrder S; S.init(M, 3 * D, G, launder_s(bx));
                RS_TABLE(S);
                pg8::EpiQkv E{P.act, D, (size_t)M * D, P.xss, EPS, QSCALE, rt};
                pg8::gemm_phase<pg8::EpiQkv, pg8::StaticOrder, true, true>(lds + RING_OFF, g, S, E);
                if (PROBE == 7) { __syncthreads(); pg8::gemm_phase<pg8::EpiQkv, pg8::StaticOrder, true, true>(lds + RING_OFF, g, S, E); } }
            SEAM(ph);
            if ((DBG_MASK & 32) && IN(ph + 1)) { if (PROBE == 3) attn_phase<true>(P, j, lds, vcu, G, tid, wave, lane); attn_phase<false>(P, j, lds, vcu, G, tid, wave, lane); }
            SEAM(ph + 1);
            if ((DBG_MASK & 8) && IN(ph + 2)) { pg8::Gemm g{P.act, P.wt + WO_BOUT + (size_t)j * D * D, M, D, D, D}; pg8::StaticOrder S; S.init(M, D, G, launder_s(bx));
                pg8::EpiResid E{P.xb, P.xss, D};
                pg8::gemm_phase<pg8::EpiResid, pg8::StaticOrder, false, true>(lds + RING_OFF, g, S, E); }
            SEAM(ph + 2);
        }
        if ((DBG_MASK & 64) && IN(ph + 3)) { pg8::Gemm g{P.xb, wgu, M, FF2, D, D}; pg8::FfnOrder S; S.init(M, FF_NFULL, G, launder_s(bx));
            RS_TABLE(S);
            pg8::EpiSwiglu E{P.act, FF, P.xss, EPS, rt, FF_NFULL * 128};
            pg8::gemm_phase<pg8::EpiSwiglu, pg8::FfnOrder, true, true>(lds + RING_OFF, g, S, E); }
        SEAM(ph + 3);
        if ((DBG_MASK & 8) && IN(ph + 4)) { pg8::Gemm g{P.act, wdn, M, D, FF, FF}; pg8::StaticOrder S; S.init(M, D, G, launder_s(bx));
            pg8::EpiResid E{P.xb, P.xss, D};
            pg8::gemm_phase<pg8::EpiResid, pg8::StaticOrder, false, true>(lds + RING_OFF, g, S, E); }
        SEAM(ph + 4);
    }
    if ((DBG_MASK & 128) && IN(N_PHASES - 1)) final_phase(P, vcu, G, wave, lane);
#undef IN
#undef SEAM
}

extern "C" void kernel_launch(void* const* d_in, const int* in_sizes, int n_in, void* d_out, int out_size, void* d_ws, size_t ws_size, hipStream_t stream) {
    static int grid = 0;
    if (grid == 0) {
        if (n_in != 15 || in_sizes[0] != M * D || out_size != M * D || ws_size < WS_END) { fprintf(stderr, "kernel_launch: unexpected shapes (n_in %d, in0 %d, out %d, ws %zu < %zu); nothing launched\n", n_in, n_in > 0 ? in_sizes[0] : -1, out_size, ws_size, (size_t)WS_END); grid = -1; return; }
        int dev = 0, cus = 0, per_cu = 0;
        if (hipGetDevice(&dev) != hipSuccess || hipDeviceGetAttribute(&cus, hipDeviceAttributeMultiprocessorCount, dev) != hipSuccess) { grid = -1; return; }
        if (hipFuncSetAttribute((const void*)trunk_fwd, hipFuncAttributeMaxDynamicSharedMemorySize, LDS_BYTES) != hipSuccess) { fprintf(stderr, "kernel_launch: hipFuncSetAttribute failed\n"); grid = -1; return; }
        if (hipOccupancyMaxActiveBlocksPerMultiprocessor(&per_cu, (const void*)trunk_fwd, NWAVES * 64, LDS_BYTES) != hipSuccess || per_cu < 1) { fprintf(stderr, "kernel_launch: occupancy query reports %d workgroups per CU; nothing launched\n", per_cu); (void)hipGetLastError(); grid = -1; return; }
        grid = cus;
    }
    if (grid < 0) return;
    if (hipMemsetAsync((char*)d_ws + WS_CTL, 0, CTL_ZERO_BYTES, stream) != hipSuccess) return;
    Args a{};
    for (int i = 0; i < 15; ++i) a.in[i] = (const float*)d_in[i];
    a.out = (float*)d_out; a.ws = (unsigned char*)d_ws;
#if MK_PER_PHASE
    for (int p = 0; p < N_PHASES; ++p) { a.ph_lo = p; a.ph_hi = p + 1; hipLaunchKernelGGL(trunk_fwd, dim3(grid), dim3(NWAVES * 64), LDS_BYTES, stream, a); }
#else
    a.ph_lo = 0; a.ph_hi = N_PHASES;
    hipLaunchKernelGGL(trunk_fwd, dim3(grid), dim3(NWAVES * 64), LDS_BYTES, stream, a);
#endif
}
```

```cpp
#include <hip/hip_runtime.h>
#include <cstdio>
#include <cstdint>
#ifndef PROBE
#define PROBE 0
#endif
namespace pg8 {
#define PG8_LAS __attribute__((address_space(3)))
typedef unsigned short bf16_t;
typedef short bf16x8 __attribute__((ext_vector_type(8)));
typedef float f32x4 __attribute__((ext_vector_type(4)));
typedef unsigned u32x4 __attribute__((ext_vector_type(4)));
constexpr int BM = 256, BK = 64, HALF = 128, HTB = HALF * BK * 2  , STAGE_BYTES = 8 * HTB, NXCD = 8, WGM = 8;

__host__ __device__ __forceinline__ int lds_byte(int r, int c) { const int st = (r >> 4) * 2 + (c >> 5), rr = r & 15, cc = c & 31, ob = rr * 64 + cc * 2; return st * 1024 + (ob ^ (((ob >> 9) & 1) << 5)); }
__host__ __device__ __forceinline__ void stage_rc(int b, int& R, int& C) { const int st = b / 1024, sb = b % 1024, swz = sb ^ (((sb >> 9) & 1) << 5); R = (st >> 1) * 16 + swz / 64; C = (st & 1) * 32 + (swz % 64) / 2; }
__host__ __device__ __forceinline__ int perm32(int rho) { const int n = rho >> 4, i = rho & 15; return 8 * (i >> 2) + 4 * n + (i & 3); }

struct Unit { int pm, pn, hf; };
struct Gemm { const bf16_t* A; const bf16_t* Bt; int M, N, K, lda; };

struct StaticOrder {
    int nM, nN, nwg, G, c;
    __host__ __device__ void init(int M, int N, int G_, int c_) { nM = M / BM; nN = N / BM; nwg = nM * nN; G = G_; c = c_; }
    __host__ __device__ bool next(int i, Unit& u) const {
        const long L = (long)i * G + c; if (L >= nwg) return false;
        int wgid = (int)L; { const int q = nwg / NXCD, r = nwg % NXCD, xcd = wgid % NXCD, off = wgid / NXCD; wgid = (xcd < r ? xcd * (q + 1) : r * (q + 1) + (xcd - r) * q) + off; }
        const int nig = WGM * nN, gid = wgid / nig, fm = gid * WGM, gsz = (nM - fm) < WGM ? (nM - fm) : WGM;
        u.pm = fm + ((wgid % nig) % gsz); u.pn = (wgid % nig) / gsz; u.hf = 0; return true;
    }
    static constexpr bool HAS_HALF = false;
    __host__ __device__ int brow(const Unit& u) const { return u.pn * BM; }
    __device__ __forceinline__ void a_ready(const Unit&) const {}
    __device__ __forceinline__ void done(const Unit&) const {}
};

__device__ __forceinline__ unsigned cvt_pk_bf16(float lo, float hi) { unsigned r; asm volatile("v_cvt_pk_bf16_f32 %0, %1, %2" : "=v"(r) : "v"(lo), "v"(hi)); return r; }
typedef float f32x2 __attribute__((ext_vector_type(2)));
struct FfnOrder {
    StaticOrder so; int nfull_rounds, G, c, NFULL;
    static constexpr bool HAS_HALF = true;
    __host__ __device__ void init(int M, int NFULL_, int G_, int c_) { NFULL = NFULL_; so.init(M, NFULL_ * BM, G_, c_); G = G_; c = c_; nfull_rounds = (c_ < so.nwg) ? (so.nwg - c_ + G_ - 1) / G_ : 0; }
    __host__ __device__ bool next(int i, Unit& u) const {
        if (i < nfull_rounds) return so.next(i, u);
        const int k = i - nfull_rounds;
        const int nh = so.nM * 4; const int hu = k * G + c; if (hu >= nh) return false;
        if (G == 256 && so.nM == 64) { Unit f; so.next(0, f); u.pm = f.pm; u.pn = f.pn & 3; }
        else { u.pm = hu % so.nM; u.pn = hu / so.nM; }
        u.hf = 1; return true;
    }
    __host__ __device__ int brow(const Unit& u) const { return u.hf ? NFULL * BM + u.pn * HALF : u.pn * BM; }
    __device__ __forceinline__ void a_ready(const Unit&) const {}
    __device__ __forceinline__ void done(const Unit&) const {}
};

#ifndef STORE_WT
#define STORE_WT 1
#endif
__device__ __forceinline__ void store16(void* p, u32x4 v) {
#if STORE_WT
    asm volatile("global_store_dwordx4 %0, %1, off sc1\n\ts_nop 1" :: "v"(p), "v"(v) : "memory");
#else
    *(u32x4*)p = v;
#endif
}
__device__ __forceinline__ void store16f(void* p, f32x4 v) {
#if STORE_WT
    asm volatile("global_store_dwordx4 %0, %1, off sc1\n\ts_nop 1" :: "v"(p), "v"(v) : "memory");
#else
    *(f32x4*)p = v;
#endif
}
typedef unsigned u32x2 __attribute__((ext_vector_type(2)));
__device__ __forceinline__ void store8(void* p, u32x2 v) {
#if STORE_WT
    asm volatile("global_store_dwordx2 %0, %1, off sc1\n\ts_nop 1" :: "v"(p), "v"(v) : "memory");
#else
    *(u32x2*)p = v;
#endif
}
constexpr int NSLOT_X = 16;
constexpr int NSLOT_V = 32;
struct RsTab { const PG8_LAS float* t; int pm; };
__device__ __forceinline__ void row_scales(const float* ss, const RsTab& T, int pm, int wr, int fr, int fq, float inv_n, float eps, float (&rs)[2][4]) {
    if (pm == T.pm) {
#pragma unroll
        for (int ai = 0; ai < 2; ++ai)
#pragma unroll
            for (int m = 0; m < 4; ++m) rs[ai][m] = T.t[wr * 64 + fr + ai * HALF + m * 16];
    } else {
        const int row0 = pm * BM + wr * 64 + fr;
#pragma unroll
        for (int ai = 0; ai < 2; ++ai)
#pragma unroll
            for (int m = 0; m < 4; ++m) {
                const f32x4 v = *(const f32x4*)(ss + (size_t)(row0 + ai * HALF + m * 16) * NSLOT_X + fq * 4);
                float s = (v[0] + v[1]) + (v[2] + v[3]);
                s += __shfl_xor(s, 16); s += __shfl_xor(s, 32);
                rs[ai][m] = __builtin_amdgcn_rsqf(s * inv_n + eps);
            }
    }
}
__device__ __forceinline__ void build_rs_table(const float* ss, int pm, PG8_LAS float* t, int tid, float inv_n, float eps) {
    asm volatile("" : "+v"(tid));
    const int row = tid >> 1, half = tid & 1;
    const f32x4 a = *(const f32x4*)(ss + (size_t)(pm * BM + row) * NSLOT_X + half * 8), b = *(const f32x4*)(ss + (size_t)(pm * BM + row) * NSLOT_X + half * 8 + 4);
    float s = ((a[0] + a[1]) + (a[2] + a[3])) + ((b[0] + b[1]) + (b[2] + b[3]));
    s += __shfl_xor(s, 1);
    if (half == 0) t[row] = __builtin_amdgcn_rsqf(s * inv_n + eps);
    asm volatile("s_waitcnt lgkmcnt(0)" ::: "memory"); __syncthreads();
}
__device__ __forceinline__ float gelu_tanh(float x) {
    const float t = x * x, u2 = x * (2.302208198f + 0.1029432398f * t);
    const float e = __builtin_amdgcn_exp2f(-u2);
    return x * __builtin_amdgcn_rcpf(1.0f + e);
}
__device__ __forceinline__ float silu_mul(float g, float u) {
    const float e = __builtin_amdgcn_exp2f(g * -1.4426950408889634f);
    return (g * u) * __builtin_amdgcn_rcpf(1.0f + e);
}
struct EpiGeluStats {
    static constexpr bool PERM = true, AFTER_DRAIN = false, PROBE_TWICE = false;
    bf16_t* O; int ldc; const float* xss; float* vss; int vtile0; float eps; RsTab rt;
    __device__ __forceinline__ void operator()(const f32x4 (&acc)[2][2][4][2], const Unit& u, int wr, int wc, int fr, int fq) const {
        const int row0 = u.pm * BM + wr * 64 + fr, col0 = u.pn * BM + wc * 32 + 8 * fq;
        float rs[2][4]; row_scales(xss, rt, u.pm, wr, fr, fq, 1.0f / 1024.0f, eps, rs);
        const bool isv = u.pn >= vtile0;
#pragma unroll
        for (int ai = 0; ai < 2; ++ai)
#pragma unroll
            for (int m = 0; m < 4; ++m) { const int row = row0 + ai * HALF + m * 16; bf16_t* rowp = O + (size_t)row * ldc + col0; const float r = rs[ai][m]; float ssq = 0.f;
#pragma unroll
                for (int bj = 0; bj < 2; ++bj) { f32x4 v0 = acc[ai][bj][m][0] * r, v1 = acc[ai][bj][m][1] * r;
#pragma unroll
                    for (int e = 0; e < 4; ++e) { v0[e] = gelu_tanh(v0[e]); v1[e] = gelu_tanh(v1[e]); }
                    ssq += (v0[0] * v0[0] + v0[1] * v0[1]) + (v0[2] * v0[2] + v0[3] * v0[3]) + (v1[0] * v1[0] + v1[1] * v1[1]) + (v1[2] * v1[2] + v1[3] * v1[3]);
                    u32x4 w; w.x = cvt_pk_bf16(v0[0], v0[1]); w.y = cvt_pk_bf16(v0[2], v0[3]); w.z = cvt_pk_bf16(v1[0], v1[1]); w.w = cvt_pk_bf16(v1[2], v1[3]);
                    store16(rowp + bj * HALF, w); }
                if (isv) { ssq += __shfl_xor(ssq, 16); ssq += __shfl_xor(ssq, 32); if (fq == 0) vss[(size_t)row * NSLOT_V + (u.pn - vtile0) * 4 + wc] = ssq; } }
    }
};
struct EpiSwiglu {
    static constexpr bool PERM = true, AFTER_DRAIN = false, PROBE_TWICE = true;
    bf16_t* O; int ldc; const float* xss; float eps; RsTab rt;
    int half_col0;
    __device__ __forceinline__ void operator()(const f32x4 (&acc)[2][2][4][2], const Unit& u, int wr, int wc, int fr, int fq) const {
        const int row0 = u.pm * BM + wr * 64 + fr, col0 = u.pn * HALF + wc * 32 + 8 * fq;
        float rs[2][4]; row_scales(xss, rt, u.pm, wr, fr, fq, 1.0f / 1024.0f, eps, rs);
        if (u.hf) {
            const int hc = half_col0 + u.pn * 64 + wc * 16 + 4 * fq;
#pragma unroll
            for (int ai = 0; ai < 2; ++ai)
#pragma unroll
                for (int m = 0; m < 4; ++m) { const int row = row0 + ai * HALF + m * 16; const float r = rs[ai][m];
                    const f32x4 g0 = acc[ai][0][m][0] * r, u0 = acc[ai][0][m][1] * r;
                    u32x2 w; w.x = cvt_pk_bf16(silu_mul(g0[0], u0[0]), silu_mul(g0[1], u0[1])); w.y = cvt_pk_bf16(silu_mul(g0[2], u0[2]), silu_mul(g0[3], u0[3]));
                    *(u32x2*)(O + (size_t)row * ldc + hc) = w; }
            return;
        }
#pragma unroll
        for (int ai = 0; ai < 2; ++ai)
#pragma unroll
            for (int m = 0; m < 4; ++m) { const int row = row0 + ai * HALF + m * 16; const float r = rs[ai][m] * (PROBE == 9 ? 0.5f : 1.0f);
                const f32x4 g0 = acc[ai][0][m][0] * r, g1 = acc[ai][0][m][1] * r, u0 = acc[ai][1][m][0] * r, u1 = acc[ai][1][m][1] * r;
                float o[8];
#pragma unroll
                for (int e = 0; e < 4; ++e) { o[e] = silu_mul(g0[e], u0[e]); o[4 + e] = silu_mul(g1[e], u1[e]); }
                u32x4 w; w.x = cvt_pk_bf16(o[0], o[1]); w.y = cvt_pk_bf16(o[2], o[3]); w.z = cvt_pk_bf16(o[4], o[5]); w.w = cvt_pk_bf16(o[6], o[7]);
                store16(O + (size_t)row * ldc + col0, w); }
    }
};
struct EpiQkv {
    static constexpr bool PERM = true, AFTER_DRAIN = false, PROBE_TWICE = false;
    bf16_t* O; int ldc; size_t split_stride; const float* xss; float eps; float scale0; RsTab rt;
    __device__ __forceinline__ void operator()(const f32x4 (&acc)[2][2][4][2], const Unit& u, int wr, int wc, int fr, int fq) const {
        const int t = u.pn >> 2; bf16_t* base = O + (size_t)t * split_stride; const float sc = (t == 0) ? scale0 : 1.0f;
        const int row0 = u.pm * BM + wr * 64 + fr, col0 = (u.pn & 3) * BM + wc * 32 + 8 * fq;
        float rs[2][4]; row_scales(xss, rt, u.pm, wr, fr, fq, 1.0f / 1024.0f, eps, rs);
#pragma unroll
        for (int ai = 0; ai < 2; ++ai)
#pragma unroll
            for (int m = 0; m < 4; ++m) { const int row = row0 + ai * HALF + m * 16; bf16_t* rowp = base + (size_t)row * ldc + col0; const float r = rs[ai][m] * sc;
#pragma unroll
                for (int bj = 0; bj < 2; ++bj) { const f32x4 v0 = acc[ai][bj][m][0] * r, v1 = acc[ai][bj][m][1] * r;
                    u32x4 w; w.x = cvt_pk_bf16(v0[0], v0[1]); w.y = cvt_pk_bf16(v0[2], v0[3]); w.z = cvt_pk_bf16(v1[0], v1[1]); w.w = cvt_pk_bf16(v1[2], v1[3]);
                    store16(rowp + bj * HALF, w); } }
    }
};
struct EpiResid {
    static constexpr bool PERM = true, AFTER_DRAIN = false, PROBE_TWICE = false;
    bf16_t* xb; float* xss; int ldc;
    __device__ __forceinline__ void operator()(const f32x4 (&acc)[2][2][4][2], const Unit& u, int wr, int wc, int fr, int fq) const {
        asm volatile("" : "+v"(fr), "+v"(fq));
        const int row0 = u.pm * BM + wr * 64 + fr, col0 = u.pn * BM + wc * 32 + 8 * fq;
        u32x4 pre[2][4][2];
#pragma unroll
        for (int ai = 0; ai < 2; ++ai)
#pragma unroll
            for (int m = 0; m < 4; ++m)
#pragma unroll
                for (int bj = 0; bj < 2; ++bj) pre[ai][m][bj] = *(const u32x4*)(xb + (size_t)(row0 + ai * HALF + m * 16) * ldc + col0 + bj * HALF);
#pragma unroll
        for (int ai = 0; ai < 2; ++ai)
#pragma unroll
            for (int m = 0; m < 4; ++m) { const int row = row0 + ai * HALF + m * 16; bf16_t* rowp = xb + (size_t)row * ldc + col0; float ssq = 0.f;
#pragma unroll
                for (int bj = 0; bj < 2; ++bj) { const u32x4 b = pre[ai][m][bj]; const f32x4 a0 = acc[ai][bj][m][0], a1 = acc[ai][bj][m][1];
                    float o[8];
                    o[0] = __uint_as_float(b.x << 16) + a0[0]; o[1] = __uint_as_float(b.x & 0xffff0000u) + a0[1]; o[2] = __uint_as_float(b.y << 16) + a0[2]; o[3] = __uint_as_float(b.y & 0xffff0000u) + a0[3];
                    o[4] = __uint_as_float(b.z << 16) + a1[0]; o[5] = __uint_as_float(b.z & 0xffff0000u) + a1[1]; o[6] = __uint_as_float(b.w << 16) + a1[2]; o[7] = __uint_as_float(b.w & 0xffff0000u) + a1[3];
                    ssq += ((o[0] * o[0] + o[1] * o[1]) + (o[2] * o[2] + o[3] * o[3])) + ((o[4] * o[4] + o[5] * o[5]) + (o[6] * o[6] + o[7] * o[7]));
                    u32x4 w; w.x = cvt_pk_bf16(o[0], o[1]); w.y = cvt_pk_bf16(o[2], o[3]); w.z = cvt_pk_bf16(o[4], o[5]); w.w = cvt_pk_bf16(o[6], o[7]);
                    store16(rowp + bj * HALF, w); }
                ssq += __shfl_xor(ssq, 16); ssq += __shfl_xor(ssq, 32);
                if (fq == 0) xss[(size_t)row * NSLOT_X + u.pn * 4 + wc] = ssq; }
    }
};

template <class Epi, class Sched, bool ALIGN_EPI = false, bool SP2 = false>
__device__ __forceinline__ void gemm_phase(PG8_LAS unsigned char* lds, const Gemm g, const Sched& S, const Epi& E) {
    int tid_ = threadIdx.x; asm volatile("" : "+v"(tid_));
    const int tid = tid_, wid = __builtin_amdgcn_readfirstlane(tid >> 6), lane = tid & 63, wr = wid >> 2, wc = wid & 3, fr = lane & 15, fq = lane >> 4;
    const int K = g.K, nt = K / BK;
    unsigned voffA[2], voffB[2];
#pragma unroll
    for (int i = 0; i < 2; ++i) { int R, C; stage_rc(tid * 16 + i * 8192, R, C); const int Rb = Epi::PERM ? ((R & ~31) + perm32(R & 31)) : R;
        voffA[i] = (unsigned)(R * g.lda + C) * 2u; voffB[i] = (unsigned)(Rb * K + C) * 2u; }
    const size_t kstep = (size_t)(BK * 2);
    const size_t hstep = (size_t)HALF * K * 2;
    const size_t tstep = 2 * hstep; const size_t hstepA = (size_t)HALF * g.lda * 2, tstepA = 2 * hstepA;
    const unsigned ldsw = (unsigned)wid * 1024u;
    const int aoff = lds_byte(wr * 64 + fr, fq * 8), boff = lds_byte(wc * 32 + fr, fq * 8);
#define PG8_SA(b, h) (((b) * 2 + (h)) * HTB)
#define PG8_SB(b, h) ((4 + (b) * 2 + (h)) * HTB)
#define PG8_STAGE(bufoff, gbase, voff) do { _Pragma("unroll") for (int _i = 0; _i < 2; ++_i) \
        __builtin_amdgcn_global_load_lds((const unsigned*)((const char*)(gbase) + (voff)[_i]), (PG8_LAS unsigned*)(lds + (bufoff) + ldsw + _i * 8192), 16, 0, 0); } while (0)
#define PG8_LDA(dst, b, h) do { _Pragma("unroll") for (int m = 0; m < 4; ++m) _Pragma("unroll") for (int k = 0; k < 2; ++k) dst[m][k] = *(const PG8_LAS bf16x8*)(lds + PG8_SA(b, h) + aoff + m * 2048 + k * 1024); } while (0)
#define PG8_LDB(dst, b, h) do { _Pragma("unroll") for (int n = 0; n < 2; ++n) _Pragma("unroll") for (int k = 0; k < 2; ++k) dst[n][k] = *(const PG8_LAS bf16x8*)(lds + PG8_SB(b, h) + boff + n * 2048 + k * 1024); } while (0)
#define PG8_MMA(ai, bj, At, Bt) do { __builtin_amdgcn_s_setprio(1); _Pragma("unroll") for (int m = 0; m < 4; ++m) _Pragma("unroll") for (int n = 0; n < 2; ++n) _Pragma("unroll") for (int k = 0; k < 2; ++k) \
        acc[ai][bj][m][n] = __builtin_amdgcn_mfma_f32_16x16x32_bf16(Bt[n][k], At[m][k], acc[ai][bj][m][n], 0, 0, 0); __builtin_amdgcn_s_setprio(0); } while (0)
#define PG8_WAIT_V(n) asm volatile("s_waitcnt vmcnt(" #n ")" ::: "memory")
#define PG8_WAIT_L(n) asm volatile("s_waitcnt lgkmcnt(" #n ")" ::: "memory")
#define PG8_BAR __builtin_amdgcn_s_barrier()
#define PG8_SCHED __builtin_amdgcn_sched_barrier(0)
    Unit cur, nxt; int ui = 0;
    if (!S.next(0, cur)) return;
    f32x4 acc[2][2][4][2];
#pragma unroll
    for (int a = 0; a < 2; ++a)
#pragma unroll
        for (int b = 0; b < 2; ++b)
#pragma unroll
            for (int m = 0; m < 4; ++m)
#pragma unroll
                for (int n = 0; n < 2; ++n) acc[a][b][m][n] = (f32x4){0.f, 0.f, 0.f, 0.f};
    bf16x8 At[4][2], B0[2][2], B1[2][2];
    const char* cA = (const char*)g.A + (size_t)cur.pm * tstepA; const char* cB = (const char*)g.Bt + (size_t)S.brow(cur) * K * 2;
    S.a_ready(cur);
    if constexpr (SP2) {
        PG8_STAGE(PG8_SB(0, 0), cB, voffB); PG8_STAGE(PG8_SB(0, 1), cB + hstep, voffB); PG8_STAGE(PG8_SA(0, 0), cA, voffA); PG8_STAGE(PG8_SA(0, 1), cA + hstepA, voffA);
        if (wr == 1) PG8_BAR;
        PG8_WAIT_V(2); PG8_BAR;
        PG8_STAGE(PG8_SB(1, 0), cB + kstep, voffB); PG8_STAGE(PG8_SA(1, 0), cA + kstep, voffA); PG8_STAGE(PG8_SB(1, 1), cB + hstep + kstep, voffB);
        PG8_WAIT_V(6); PG8_BAR;
    } else {
        PG8_STAGE(PG8_SB(0, 0), cB, voffB); PG8_STAGE(PG8_SA(0, 0), cA, voffA); PG8_STAGE(PG8_SB(0, 1), cB + hstep, voffB); PG8_STAGE(PG8_SA(0, 1), cA + hstepA, voffA);
        if (wr == 1) PG8_BAR;
        PG8_WAIT_V(4); PG8_BAR;
        PG8_STAGE(PG8_SB(1, 0), cB + kstep, voffB); PG8_STAGE(PG8_SA(1, 0), cA + kstep, voffA); PG8_STAGE(PG8_SB(1, 1), cB + hstep + kstep, voffB);
        PG8_WAIT_V(6); PG8_BAR;
    }
    for (;;) {
        const bool has_next = S.next(ui + 1, nxt);
        const char* nA = has_next ? (const char*)g.A + (size_t)nxt.pm * tstepA : cA; const char* nB = has_next ? (const char*)g.Bt + (size_t)S.brow(nxt) * K * 2 : cB;
        const bool full = !(Sched::HAS_HALF && cur.hf);
        const int ntl = (PROBE == 9 && Epi::PROBE_TWICE) ? 2 * nt : nt;
        for (int t = 0; t < ntl; t += 2) {
            const bool last = (t == ntl - 2);
            const int t1 = (t + 1 >= nt) ? t + 1 - nt : t + 1, t2 = (t + 2 >= nt) ? t + 2 - nt : t + 2;
            const char* a1 = cA + (size_t)t1 * kstep;
            const char* a2 = last ? nA : cA + (size_t)t2 * kstep; const char* b2 = last ? nB : cB + (size_t)t2 * kstep;
            const char* a3 = a2 + kstep; const char* b3 = b2 + kstep;
            if (last && has_next) S.a_ready(nxt);
            if constexpr (SP2) {
            PG8_LDB(B0, 0, 0); if (full) PG8_LDB(B1, 0, 1); PG8_SCHED; PG8_LDA(At, 0, 0); PG8_STAGE(PG8_SA(1, 1), a1 + hstepA, voffA);
            PG8_WAIT_V(8); PG8_WAIT_L(0); PG8_BAR; PG8_MMA(0, 0, At, B0); if (full) PG8_MMA(0, 1, At, B1); PG8_BAR; PG8_SCHED;
            PG8_LDA(At, 0, 1); PG8_STAGE(PG8_SB(0, 0), b2, voffB); PG8_STAGE(PG8_SB(0, 1), b2 + hstep, voffB); PG8_STAGE(PG8_SA(0, 0), a2, voffA);
            PG8_WAIT_V(8); PG8_WAIT_L(0); PG8_BAR; PG8_MMA(1, 0, At, B0); if (full) PG8_MMA(1, 1, At, B1); PG8_BAR; PG8_SCHED;
            PG8_LDB(B0, 1, 0); if (full) PG8_LDB(B1, 1, 1); PG8_SCHED; PG8_LDA(At, 1, 0); PG8_STAGE(PG8_SA(0, 1), a2 + hstepA, voffA);
            PG8_WAIT_V(8); PG8_WAIT_L(0); PG8_BAR; PG8_MMA(0, 0, At, B0); if (full) PG8_MMA(0, 1, At, B1); PG8_BAR; PG8_SCHED;
            PG8_LDA(At, 1, 1); PG8_STAGE(PG8_SB(1, 0), b3, voffB); PG8_STAGE(PG8_SB(1, 1), b3 + hstep, voffB); PG8_STAGE(PG8_SA(1, 0), a3, voffA);
            PG8_WAIT_V(8); PG8_WAIT_L(0); PG8_BAR; PG8_MMA(1, 0, At, B0); if (full) PG8_MMA(1, 1, At, B1); PG8_BAR; PG8_SCHED;
            } else {
            PG8_LDB(B0, 0, 0); PG8_SCHED; PG8_LDA(At, 0, 0); PG8_STAGE(PG8_SA(1, 1), a1 + hstepA, voffA);
            PG8_WAIT_L(8); PG8_BAR; PG8_WAIT_L(0); PG8_MMA(0, 0, At, B0); PG8_BAR; PG8_SCHED;
            PG8_LDB(B1, 0, 1); PG8_STAGE(PG8_SB(0, 0), b2, voffB);
            PG8_BAR; PG8_WAIT_L(0); if (full) PG8_MMA(0, 1, At, B1); PG8_BAR;
            PG8_LDA(At, 0, 1); PG8_STAGE(PG8_SA(0, 0), a2, voffA);
            PG8_BAR; PG8_WAIT_L(0); PG8_MMA(1, 0, At, B0); PG8_BAR; PG8_SCHED;
            PG8_STAGE(PG8_SB(0, 1), b2 + hstep, voffB);
            PG8_WAIT_V(6); PG8_BAR; if (full) PG8_MMA(1, 1, At, B1); PG8_BAR;
            PG8_LDB(B0, 1, 0); PG8_SCHED; PG8_LDA(At, 1, 0); PG8_STAGE(PG8_SA(0, 1), a2 + hstepA, voffA);
            PG8_WAIT_L(8); PG8_BAR; PG8_WAIT_L(0); PG8_MMA(0, 0, At, B0); PG8_BAR; PG8_SCHED;
            PG8_LDB(B1, 1, 1); PG8_STAGE(PG8_SB(1, 0), b3, voffB);
            PG8_BAR; PG8_WAIT_L(0); if (full) PG8_MMA(0, 1, At, B1); PG8_BAR;
            PG8_LDA(At, 1, 1); PG8_STAGE(PG8_SA(1, 0), a3, voffA);
            PG8_BAR; PG8_WAIT_L(0); PG8_MMA(1, 0, At, B0); PG8_BAR; PG8_SCHED;
            PG8_STAGE(PG8_SB(1, 1), b3 + hstep, voffB);
            PG8_WAIT_V(6); PG8_BAR; if (full) PG8_MMA(1, 1, At, B1); PG8_BAR;
            }
        }
        if constexpr (ALIGN_EPI) { if (wr == 0) PG8_BAR; }
        if constexpr (!Epi::AFTER_DRAIN) { E(acc, cur, wr, wc, fr, fq); if (PROBE == 8 && Epi::PROBE_TWICE) { asm volatile("" ::: "memory"); E(acc, cur, wr, wc, fr, fq); } S.done(cur); }
        if (!has_next) break;
#pragma unroll
        for (int a = 0; a < 2; ++a)
#pragma unroll
            for (int b = 0; b < 2; ++b)
#pragma unroll
                for (int m = 0; m < 4; ++m)
#pragma unroll
                    for (int n = 0; n < 2; ++n) acc[a][b][m][n] = (f32x4){0.f, 0.f, 0.f, 0.f};
        cur = nxt; cA = nA; cB = nB; ++ui;
        if constexpr (ALIGN_EPI) { if (wr == 1) PG8_BAR; }
    }
    PG8_WAIT_V(0);
    if constexpr (!ALIGN_EPI) { if (wr == 0) PG8_BAR; }
    PG8_BAR;
    if constexpr (Epi::AFTER_DRAIN) { E.fused(acc, cur, wr, wc, fr, fq, lds, wid, lane); S.done(cur); }
#undef PG8_SA
#undef PG8_SB
#undef PG8_STAGE
#undef PG8_LDA
#undef PG8_LDB
#undef PG8_MMA
#undef PG8_WAIT_V
#undef PG8_WAIT_L
#undef PG8_BAR
#undef PG8_SCHED
}
}

constexpr int NWAVES = 8;
constexpr int BATCH = 2, SEQ = 8192, D = 1024, DEPTH = 4, M = BATCH * SEQ;
constexpr int GH = 2048, GH2 = 4096, SGU_G = 8, SGU_P = 128, SGU_C = 256;
constexpr int NH = 16, HD = 64, NREL = 192, CHUNK = 64;
constexpr int FF = 2816, FF2 = 5632, FF_NFULL = 20;
constexpr float EPS = 1e-6f;
constexpr float LOG2E = 1.4426950408889634f;
constexpr float QSCALE = 0.125f * LOG2E;

#ifndef MK_PER_PHASE
#define MK_PER_PHASE 0
#endif
constexpr int N_PHASES = 22;

constexpr size_t MiB = 1u << 20;
constexpr size_t WS_CTL = 0, CTL_ZERO_BYTES = 64 * 1024;
constexpr size_t WS_XSS = 1 * MiB;
constexpr size_t WS_VSS = 2 * MiB;
constexpr size_t WS_W = 4 * MiB;
constexpr size_t WS_XB = 110 * MiB;
constexpr size_t WS_ACT = 142 * MiB;
constexpr size_t WS_END = 270 * MiB;
constexpr size_t WO_IN = 0, WO_AOUT = 8388608, WO_QKV = 12582912, WO_BOUT = 18874368, WO_GU = 20971520, WO_DN = 44040192, WO_END = 55574528;
static_assert(WS_W + WO_END * 2 <= WS_XB && WS_XB + (size_t)M * D * 2 <= WS_ACT && WS_ACT + (size_t)M * GH2 * 2 <= WS_END, "d_ws map");
constexpr int CW_BAR = 1024;

constexpr int RING_OFF = 0, RING_BYTES = 131072;
constexpr int LDSCTL_OFF = RING_BYTES, MISC_OFF = LDSCTL_OFF + 320, RSTAB_OFF = LDSCTL_OFF + 1024;
constexpr int LDS_BYTES = 147456;
static_assert(MISC_OFF + 128 <= LDS_BYTES, "LDS map");

#define GAS __attribute__((address_space(1)))
#define LAS __attribute__((address_space(3)))
typedef unsigned short bf16;
typedef unsigned v4u __attribute__((ext_vector_type(4)));
typedef unsigned v2u __attribute__((ext_vector_type(2)));
typedef float f32x4 __attribute__((ext_vector_type(4)));
typedef float f32x16 __attribute__((ext_vector_type(16)));
typedef short bf16x8 __attribute__((ext_vector_type(8)));
typedef short s16x4 __attribute__((ext_vector_type(4)));
typedef GAS unsigned gu32;
#define RLX_AGENT __ATOMIC_RELAXED, __HIP_MEMORY_SCOPE_AGENT
#define LDS_WAIT() asm volatile("s_waitcnt lgkmcnt(0)" ::: "memory")
#define VM_WAIT() asm volatile("s_waitcnt vmcnt(0)" ::: "memory")
__device__ __forceinline__ unsigned pk2(float lo, float hi) { return pg8::cvt_pk_bf16(lo, hi); }
__device__ __forceinline__ float bf_lo(unsigned w) { return __uint_as_float(w << 16); }
__device__ __forceinline__ float bf_hi(unsigned w) { return __uint_as_float(w & 0xffff0000u); }
__device__ __forceinline__ float wave_sum(float v) {
#pragma unroll
    for (int o = 1; o < 64; o <<= 1) v += __shfl_xor(v, o);
    return v;
}
#define XB_TMO      128
#define XB_XCNT(j)  (256  + 64 * (j))
#define XB_XSUB(j)  (1280 + 64 * (j))
#define XB_XGEN(j)  (2304 + 64 * (j))
#define XB_TOP      3328
#define XB_TOPGEN   3392
#define XCD_BAR_WORDS 3456
#define XB_SPIN_CAP (1u << 18)

__device__ __forceinline__ unsigned xb_ld(unsigned* p)              { return __hip_atomic_load(p, __ATOMIC_RELAXED, __HIP_MEMORY_SCOPE_AGENT); }
__device__ __forceinline__ unsigned xb_add(unsigned* p, unsigned v) { return __hip_atomic_fetch_add(p, v, __ATOMIC_RELAXED, __HIP_MEMORY_SCOPE_AGENT); }
__device__ __forceinline__ unsigned xb_xcc_id() { return (unsigned)__builtin_amdgcn_s_getreg((3 << 11) | 20) & 0xFu; }
#define XB_SPIN(cond, bar) do { unsigned _sp = 0; while (cond) { __builtin_amdgcn_s_sleep(1); \
    if ((++_sp & 255u) == 0u) { if (xb_ld(&(bar)[XB_TMO])) break; if (_sp > XB_SPIN_CAP) { atomicAdd(&(bar)[XB_TMO], 1u); break; } } } } while (0)

struct XcdBarrier {
    unsigned* bar; unsigned x;
    volatile LAS unsigned* st;
};

__device__ __forceinline__ XcdBarrier xcd_barrier_post(unsigned* bar, volatile LAS unsigned* st) {
    XcdBarrier b; b.bar = bar; b.x = xb_xcc_id(); b.st = st;
    if (threadIdx.x == 0) (void)xb_add(&bar[XB_XCNT(b.x)], 1u);
    return b;
}
__device__ __forceinline__ void xcd_barrier_complete(unsigned* bar, unsigned x, unsigned& nloc, unsigned& nx) {
    const unsigned G = gridDim.x * gridDim.y * gridDim.z;
    unsigned sum, cnt, mine, sp = 0u;
    for (;;) {
        sum = 0u; cnt = 0u; mine = 0u;
#pragma unroll
        for (unsigned j = 0; j < 16; ++j) { const unsigned c = xb_ld(&bar[XB_XCNT(j)]); sum += c; cnt += (c > 0u) ? 1u : 0u; mine = (j == x) ? c : mine; }
        if (sum == G) break;
        __builtin_amdgcn_s_sleep(1);
        if ((++sp & 255u) == 0u) { if (xb_ld(&bar[XB_TMO])) break; if (sp > XB_SPIN_CAP) { atomicAdd(&bar[XB_TMO], 1u); break; } }
    }
    nloc = mine > 0u ? mine : 1u; nx = cnt > 0u ? cnt : 1u;
}

__device__ __forceinline__ void xcd_barrier(const XcdBarrier& b) {
    asm volatile("s_waitcnt vmcnt(0)" ::: "memory");
    __syncthreads();
    if (threadIdx.x == 0) {
        const unsigned bx_ = xb_xcc_id();
        unsigned* bar = b.bar; asm volatile("" : "+s"(bar));
        __builtin_amdgcn_s_waitcnt(0);
        unsigned nloc = b.st[0], nx = b.st[1];
        if (nloc == 0u) { xcd_barrier_complete(bar, bx_, nloc, nx); b.st[0] = nloc; b.st[1] = nx; }
        const unsigned old = xb_add(&bar[XB_XSUB(bx_)], 1u);
        const unsigned gen = old / nloc;
        if (old + 1u == (gen + 1u) * nloc) {
            __builtin_amdgcn_fence(__ATOMIC_RELEASE, "agent");
            asm volatile("s_waitcnt vmcnt(0)" ::: "memory");
            const unsigned og = xb_add(&bar[XB_TOP], 1u);
            const unsigned tg = og / nx;
            if (og + 1u == (tg + 1u) * nx) xb_add(&bar[XB_TOPGEN], 1u);
            else XB_SPIN(xb_ld(&bar[XB_TOPGEN]) == tg, bar);
            __builtin_amdgcn_fence(__ATOMIC_ACQUIRE, "agent");
            xb_add(&bar[XB_XGEN(bx_)], 1u);
            asm volatile("s_waitcnt vmcnt(0)" ::: "memory");
        } else {
            XB_SPIN(xb_ld(&bar[XB_XGEN(bx_)]) == gen, bar);
            __builtin_amdgcn_fence(__ATOMIC_ACQUIRE, "agent");
            asm volatile("s_waitcnt vmcnt(0)" ::: "memory");
        }
    }
    __syncthreads();
}

__device__ __forceinline__ void p0_transpose_item(const float* W, const float* gain, int K, int N, bf16* WT, int drow0, bool sp, int k0, int n0, LAS unsigned* scr, int lane) {
    const int kp = lane >> 4, n4 = lane & 15;
    f32x4 w[8][2];
    const float* src = W + (size_t)(k0 + 2 * kp) * N + n0 + 4 * n4;
#pragma unroll
    for (int i = 0; i < 8; ++i) { w[i][0] = *(const f32x4*)(src + (size_t)(8 * i) * N); w[i][1] = *(const f32x4*)(src + (size_t)(8 * i + 1) * N); }
    if (gain) {
#pragma unroll
        for (int i = 0; i < 8; ++i) { const float g0 = gain[k0 + 8 * i + 2 * kp], g1 = gain[k0 + 8 * i + 2 * kp + 1]; w[i][0] = w[i][0] * g0; w[i][1] = w[i][1] * g1; }
    }
#pragma unroll
    for (int i = 0; i < 8; ++i)
#pragma unroll
        for (int e = 0; e < 4; ++e) scr[(4 * n4 + e) * 33 + 4 * i + kp] = pk2(w[i][0][e], w[i][1][e]);
    LDS_WAIT(); asm volatile("" ::: "memory");
    const int c = lane & 7;
#pragma unroll
    for (int jn = 0; jn < 8; ++jn) { const int n = (lane >> 3) + 8 * jn; const LAS unsigned* s = scr + n * 33 + 4 * c;
        v4u o; o.x = s[0]; o.y = s[1]; o.z = s[2]; o.w = s[3];
        const int dr = sp ? ((n >> 4) * 32 + ((n & 15) >> 2) * 8 + (n & 3)) : n;
        pg8::store16(WT + (size_t)(drow0 + dr) * K + k0 + 8 * c, o); }
    LDS_WAIT(); asm volatile("" ::: "memory");
}
struct Ptrs {
    const float *x, *norm_mix_g, *norm_ffn_g, *final_g, *a_w_in, *a_v_gain, *a_w_s, *a_b_s, *a_w_out, *b_w_qkv, *b_rel_bias, *b_w_out, *ffn_w_gate, *ffn_w_up, *ffn_w_down;
    float* out; bf16* wt; bf16* xb; bf16* act; float* xss; float* vss;
};
__device__ __forceinline__ void p0_prologue(const Ptrs& P, LAS unsigned char* lds, int vcu, int G, int wave, int lane) {
    LAS unsigned* scr = (LAS unsigned*)(lds + RING_OFF + wave * 16384);
    const int gw = vcu * NWAVES + wave, NGW = G * NWAVES;
    constexpr int I_IN = 16 * 64, I_AOUT = 32 * 16, I_QKV = 16 * 48, I_BOUT = 16 * 16, I_GU = 16 * 44, I_DN = 44 * 16;
    constexpr int NITEMS = 2 * I_IN + 2 * I_AOUT + 2 * I_QKV + 2 * I_BOUT + 8 * I_GU + 4 * I_DN;
    for (int it = gw; it < NITEMS; it += NGW) {
        int r = it; const float* W; const float* gain = nullptr; bf16* dst; int K, N, mode = 0;
        if (r < 2 * I_IN) { const int j = r / I_IN; r -= j * I_IN; W = P.a_w_in + (size_t)j * D * GH2; gain = P.norm_mix_g + (2 * j) * D; K = D; N = GH2; dst = P.wt + WO_IN + (size_t)j * D * GH2; }
        else if ((r -= 2 * I_IN) < 2 * I_AOUT) { const int j = r / I_AOUT; r -= j * I_AOUT; W = P.a_w_out + (size_t)j * GH * D; K = GH; N = D; dst = P.wt + WO_AOUT + (size_t)j * GH * D; }
        else if ((r -= 2 * I_AOUT) < 2 * I_QKV) { const int j = r / I_QKV; r -= j * I_QKV; W = P.b_w_qkv + (size_t)j * D * 3 * D; gain = P.norm_mix_g + (2 * j + 1) * D; K = D; N = 3 * D; dst = P.wt + WO_QKV + (size_t)j * D * 3 * D; }
        else if ((r -= 2 * I_QKV) < 2 * I_BOUT) { const int j = r / I_BOUT; r -= j * I_BOUT; W = P.b_w_out + (size_t)j * D * D; K = D; N = D; dst = P.wt + WO_BOUT + (size_t)j * D * D; }
        else if ((r -= 2 * I_BOUT) < 4 * I_GU) { const int i = r / I_GU; r -= i * I_GU; W = P.ffn_w_gate + (size_t)i * D * FF; gain = P.norm_ffn_g + i * D; K = D; N = FF; dst = P.wt + WO_GU + (size_t)i * D * FF2; mode = 1; }
        else if ((r -= 4 * I_GU) < 4 * I_GU) { const int i = r / I_GU; r -= i * I_GU; W = P.ffn_w_up + (size_t)i * D * FF; gain = P.norm_ffn_g + i * D; K = D; N = FF; dst = P.wt + WO_GU + (size_t)i * D * FF2; mode = 2; }
        else { r -= 4 * I_GU; const int i = r / I_DN; r -= i * I_DN; W = P.ffn_w_down + (size_t)i * FF * D; K = FF; N = D; dst = P.wt + WO_DN + (size_t)i * FF * D; }
        const int nblk = N / 64, kb = r / nblk, nb = r % nblk, k0 = 64 * kb, n0 = 64 * nb;
        const bool sp = (mode != 0) && (n0 >= FF_NFULL * 128);
        const int drow0 = (mode == 0) ? n0 : sp ? (FF_NFULL * 256 + ((n0 - FF_NFULL * 128) >> 6) * 128 + (mode == 2 ? 4 : 0)) : ((n0 >> 7) * 256 + (n0 & 127) + (mode == 2 ? 128 : 0));
        p0_transpose_item(W, gain, K, N, dst, drow0, sp, k0, n0, scr, lane);
    }
    for (int m = gw; m < M; m += 2 * NGW) {
        const int m2 = (m + NGW < M) ? m + NGW : m;
        const GAS f32x4* xr = (const GAS f32x4*)(P.x + (size_t)m * D) + lane; const GAS f32x4* xr2 = (const GAS f32x4*)(P.x + (size_t)m2 * D) + lane; f32x4 v[4], v2[4]; float s = 0.f, s2 = 0.f;
#pragma unroll
        for (int j = 0; j < 4; ++j) { v[j] = xr[64 * j]; v2[j] = xr2[64 * j]; }
#pragma unroll
        for (int j = 0; j < 4; ++j) { s += (v[j].x * v[j].x + v[j].y * v[j].y) + (v[j].z * v[j].z + v[j].w * v[j].w); s2 += (v2[j].x * v2[j].x + v2[j].y * v2[j].y) + (v2[j].z * v2[j].z + v2[j].w * v2[j].w); }
        s = wave_sum(s); s2 = wave_sum(s2);
        GAS unsigned long long* o8 = (GAS unsigned long long*)(P.xb + (size_t)m * D) + lane; GAS unsigned long long* o82 = (GAS unsigned long long*)(P.xb + (size_t)m2 * D) + lane;
#pragma unroll
        for (int j = 0; j < 4; ++j) { o8[64 * j] = (unsigned long long)pk2(v[j].x, v[j].y) | ((unsigned long long)pk2(v[j].z, v[j].w) << 32);
            o82[64 * j] = (unsigned long long)pk2(v2[j].x, v2[j].y) | ((unsigned long long)pk2(v2[j].z, v2[j].w) << 32); }
        if (lane < pg8::NSLOT_X) { P.xss[(size_t)m * pg8::NSLOT_X + lane] = (lane == 0) ? s : 0.f; P.xss[(size_t)m2 * pg8::NSLOT_X + lane] = (lane == 0) ? s2 : 0.f; }
    }
}

constexpr int SP_A_PITCH = 272, SP_V_PITCH = 528;
constexpr int SP_A_OFF = 0, SP_V_OFF = 36864, SP_R_OFF = 106496;
typedef short v4i16_t __attribute__((ext_vector_type(4)));
__device__ __forceinline__ s16x4 tr_read(const LAS unsigned char* p) { return __builtin_bit_cast(s16x4, __builtin_amdgcn_ds_read_tr16_b64_v4i16((LAS v4i16_t*)p)); }
template <bool DRY> __device__ __forceinline__ void spatial_phase(const Ptrs& P, int j, LAS unsigned char* lds, int vcu, int G, int wave) {
    int tid = threadIdx.x; asm volatile("" : "+v"(tid)); const int lane = tid & 63;
    bf16* uv = P.act;
    LAS unsigned char* Aimg = lds + SP_A_OFF; LAS unsigned char* Vimg = lds + SP_V_OFF; LAS float* rsL = (LAS float*)(lds + SP_R_OFF);
    const int fr = lane & 15, fq = lane >> 4;
    for (int unit = vcu; unit < (M / SGU_P) * SGU_G; unit += G) {
        const int nb = unit >> 3, g = unit & 7, row0 = nb * SGU_P;
        if (tid < SGU_P) { const f32x4* p = (const f32x4*)(P.vss + (size_t)(row0 + tid) * pg8::NSLOT_V); float s = 0.f;
#pragma unroll
            for (int k = 0; k < 8; ++k) { const f32x4 v = p[k]; s += (v[0] + v[1]) + (v[2] + v[3]); }
            rsL[tid] = __builtin_amdgcn_rsqf(s * (1.0f / GH) + EPS); }
        { v4u t[8];
#pragma unroll
            for (int i = 0; i < 8; ++i) { const int pc = tid + 512 * i, q = pc >> 5, ch = pc & 31; t[i] = *(const v4u*)(uv + (size_t)(row0 + q) * GH2 + GH + g * SGU_C + ch * 8); }
#pragma unroll
            for (int i = 0; i < 8; ++i) { const int pc = tid + 512 * i, q = pc >> 5, ch = pc & 31; *(LAS v4u*)(Vimg + q * SP_V_PITCH + ch * 16) = t[i]; } }
        __syncthreads();
        { const float* ws = P.a_w_s + ((size_t)j * SGU_G + g) * SGU_P * SGU_P;
#pragma unroll
            for (int i = 0; i < 4; ++i) { const int e = tid + 512 * i, p = e >> 4, q0 = (e & 15) * 8;
                const f32x4 w0 = *(const f32x4*)(ws + p * SGU_P + q0), w1 = *(const f32x4*)(ws + p * SGU_P + q0 + 4);
                const f32x4 r0 = *(const LAS f32x4*)(rsL + q0), r1 = *(const LAS f32x4*)(rsL + q0 + 4);
                v4u o; o.x = pk2(w0[0] * r0[0], w0[1] * r0[1]); o.y = pk2(w0[2] * r0[2], w0[3] * r0[3]); o.z = pk2(w1[0] * r1[0], w1[1] * r1[1]); o.w = pk2(w1[2] * r1[2], w1[3] * r1[3]);
                *(LAS v4u*)(Aimg + p * SP_A_PITCH + q0 * 2) = o; } }
        __syncthreads();
        bf16x8 vf[2][4];
        { const LAS unsigned char* vb = Vimg + (8 * fq + ((lane & 15) >> 2)) * SP_V_PITCH + (32 * wave + 8 * (lane & 3)) * 2;
#pragma unroll
            for (int ks = 0; ks < 4; ++ks)
#pragma unroll
                for (int n = 0; n < 2; ++n) { const s16x4 lo = tr_read(vb + ks * 32 * SP_V_PITCH + n * 8), hi = tr_read(vb + ks * 32 * SP_V_PITCH + 4 * SP_V_PITCH + n * 8);
                    vf[n][ks] = (bf16x8){lo[0], lo[1], lo[2], lo[3], hi[0], hi[1], hi[2], hi[3]}; } }
        const int cc = g * SGU_C + 32 * wave + 8 * fq;
        const f32x4 gn0 = *(const f32x4*)(P.a_v_gain + (size_t)j * GH + cc), gn1 = *(const f32x4*)(P.a_v_gain + (size_t)j * GH + cc + 4);
#pragma unroll
        for (int pt = 0; pt < 8; ++pt) {
            f32x4 a0 = {0.f, 0.f, 0.f, 0.f}, a1 = {0.f, 0.f, 0.f, 0.f};
            const LAS unsigned char* ab = Aimg + (16 * pt + fr) * SP_A_PITCH + (8 * fq) * 2;
#pragma unroll
            for (int ks = 0; ks < 4; ++ks) if (ks < (pt < 4 ? 2 : 4)) { const bf16x8 af = *(const LAS bf16x8*)(ab + ks * 64);
                a0 = __builtin_amdgcn_mfma_f32_16x16x32_bf16(vf[0][ks], af, a0, 0, 0, 0); a1 = __builtin_amdgcn_mfma_f32_16x16x32_bf16(vf[1][ks], af, a1, 0, 0, 0); }
            const int p = 16 * pt + fr; bf16* up = uv + (size_t)(row0 + p) * GH2 + cc;
            const float b = P.a_b_s[((size_t)j * SGU_G + g) * SGU_P + p];
            const v4u u8 = *(const v4u*)up;
            v4u o;
            o.x = pk2(bf_lo(u8.x) * (gn0[0] * a0[0] + b), bf_hi(u8.x) * (gn0[1] * a0[1] + b)); o.y = pk2(bf_lo(u8.y) * (gn0[2] * a0[2] + b), bf_hi(u8.y) * (gn0[3] * a0[3] + b));
            o.z = pk2(bf_lo(u8.z) * (gn1[0] * a1[0] + b), bf_hi(u8.z) * (gn1[1] * a1[1] + b)); o.w = pk2(bf_lo(u8.w) * (gn1[2] * a1[2] + b), bf_hi(u8.w) * (gn1[3] * a1[3] + b));
            if (DRY) *(v4u*)(P.xb + (size_t)(row0 + p) * D + (g & 3) * SGU_C + 32 * wave + 8 * fq) = o; else pg8::store16(up, o);
        }
        __syncthreads();
    }
}

constexpr int AT_NSL = 6, AT_K = 0, AT_V = AT_NSL * 8192, AT_BT = 2 * AT_NSL * 8192, AT_WS = AT_BT + 1024, AT_OST = AT_K;
constexpr float ATT_THR = 8.0f;
__device__ __forceinline__ int crow(int r, int hi) { return (r & 3) + 8 * (r >> 2) + 4 * hi; }
#define MX3(a, b, c) __builtin_fmaxf(__builtin_fmaxf((a), (b)), (c))
template <bool DRY> __device__ __forceinline__ void attn_phase(const Ptrs& P, int j, LAS unsigned char* lds, int vcu, int G, int wave) {
    int tid = threadIdx.x; asm volatile("" : "+v"(tid)); const int lane = tid & 63;
    bf16* Q = P.act; const bf16* Kt = P.act + (size_t)M * D; const bf16* Vt = P.act + (size_t)2 * M * D;
    const int r32 = lane & 31, hi = lane >> 5, ci = wave >> 1, qh = wave & 1;
    LAS float* bt = (LAS float*)(lds + AT_BT); LAS float* wsf = (LAS float*)(lds + AT_WS) + wave * 64;
    for (int unit = vcu; unit < BATCH * NH * (SEQ / 256); unit += G) {
        const int bh = unit >> 5, cq = unit & 31, b = bh >> 4, h = bh & 15;
        const size_t rowbase = (size_t)b * SEQ;
        if (tid < NREL) { const float* rb = P.b_rel_bias + ((size_t)j * NH + h) * NREL; bt[tid] = (rb[tid] - rb[NREL - 1]) * LOG2E; }
        const size_t qrow = rowbase + (size_t)(4 * cq + ci) * CHUNK + 32 * qh;
        const int s_lo = (4 * cq >= 8) ? 0 : 8 - 4 * cq;
        const long trow0 = (long)rowbase + (long)(4 * cq - 8) * CHUNK;
        const bf16* ksrc = Kt + (trow0 + lane) * D + h * HD + wave * 8;
        const bf16* vsrc = Vt + (trow0 + 16 * (wave & 3) + (lane >> 2)) * D + h * HD + (wave >> 2) * 32 + (lane & 3) * 8;
#define ATT_DMA(t) do { const int sl_ = ((t) % AT_NSL) * 8192; \
            __builtin_amdgcn_global_load_lds((const unsigned*)(ksrc + (long)(t) * CHUNK * D), (LAS unsigned*)(lds + AT_K + sl_ + wave * 1024), 16, 0, 0); \
            __builtin_amdgcn_global_load_lds((const unsigned*)(vsrc + (long)(t) * CHUNK * D), (LAS unsigned*)(lds + AT_V + sl_ + wave * 1024), 16, 0, 0); } while (0)
#pragma unroll
        for (int t = 0; t < 4; ++t) if (t >= s_lo) ATT_DMA(t);
        bf16x8 qr[4];
#pragma unroll
        for (int d0 = 0; d0 < 4; ++d0) qr[d0] = *(const bf16x8*)(Q + (qrow + r32) * D + h * HD + d0 * 16 + hi * 8);
        float mhat = 0.f, lrun = 0.f; f32x16 o0 = {}, o1 = {};
        const int j_first = (s_lo > ci) ? s_lo - ci : 0;
#pragma unroll 1
        for (int jj = 0; jj < 9; ++jj) {
            const int s = ci + jj;
            asm volatile("s_waitcnt vmcnt(0)" ::: "memory");
            __syncthreads();
            if (jj + 4 < 12 && jj + 4 >= s_lo) ATT_DMA(jj + 4);
            const int delta = 8 - jj;
            if (jj >= j_first) {
                const LAS unsigned char* Ks = lds + AT_K + (s % AT_NSL) * 8192; const LAS unsigned char* Vs = lds + AT_V + (s % AT_NSL) * 8192;
                f32x16 p0, p1;
                { const float c0 = -mhat;
#pragma unroll
                    for (int r = 0; r < 16; ++r) { p0[r] = c0; p1[r] = c0; } }
                { const LAS unsigned char* kb = Ks + hi * 1024 + r32 * 16;
#pragma unroll
                    for (int d0 = 0; d0 < 4; ++d0) { const bf16x8 k0 = *(const LAS bf16x8*)(kb + d0 * 2048), k1 = *(const LAS bf16x8*)(kb + d0 * 2048 + 512);
                        p0 = __builtin_amdgcn_mfma_f32_32x32x16_bf16(k0, qr[d0], p0, 0, 0, 0); p1 = __builtin_amdgcn_mfma_f32_32x32x16_bf16(k1, qr[d0], p1, 0, 0, 0); } }
                if (delta < 3) {
                    const int base = 64 * delta + 32 * qh + r32 + 63;
#pragma unroll
                    for (int r = 0; r < 16; ++r) { const int k0 = crow(r, hi); int i0 = base - k0, i1 = base - k0 - 32; i0 = i0 > NREL - 1 ? NREL - 1 : i0; i1 = i1 > NREL - 1 ? NREL - 1 : i1; i0 = i0 < 0 ? 0 : i0; i1 = i1 < 0 ? 0 : i1;
                        p0[r] += bt[i0]; p1[r] += bt[i1]; }
                }
                float rm;
                { float a = MX3(p0[0], p0[1], p1[0]), c = MX3(p0[2], p0[3], p1[1]); a = MX3(a, p1[2], p1[3]);
#pragma unroll
                    for (int r = 4; r < 16; r += 4) { a = MX3(a, p0[r], p0[r + 1]); c = MX3(c, p0[r + 2], p0[r + 3]); a = MX3(a, p1[r], p1[r + 1]); c = MX3(c, p1[r + 2], p1[r + 3]); }
                    rm = __builtin_fmaxf(a, c);
                    auto rr = __builtin_amdgcn_permlane32_swap(__float_as_uint(rm), __float_as_uint(rm), false, false); rm = __builtin_fmaxf(__uint_as_float(rr[0]), __uint_as_float(rr[1])); }
                if (jj == j_first) {
                    mhat = rm;
#pragma unroll
                    for (int r = 0; r < 16; ++r) { p0[r] -= rm; p1[r] -= rm; }
                } else if (__any(rm > ATT_THR)) {
                    const float dl = __builtin_fmaxf(rm, 0.f); mhat += dl;
#pragma unroll
                    for (int r = 0; r < 16; ++r) { p0[r] -= dl; p1[r] -= dl; }
                    const float f = __builtin_amdgcn_exp2f(-dl); lrun *= f;
                    if (hi == 0) wsf[r32] = f;
#pragma unroll
                    for (int r = 0; r < 16; ++r) { const float fr_ = wsf[crow(r, hi)]; o0[r] *= fr_; o1[r] *= fr_; }
                }
                float psum = 0.f;
#pragma unroll
                for (int r = 0; r < 16; ++r) { p0[r] = __builtin_amdgcn_exp2f(p0[r]); p1[r] = __builtin_amdgcn_exp2f(p1[r]); psum += p0[r] + p1[r]; }
                lrun += psum;
                v4u pw[4];
                pw[0] = (v4u){pk2(p0[0], p0[1]), pk2(p0[2], p0[3]), pk2(p0[4], p0[5]), pk2(p0[6], p0[7])};
                pw[1] = (v4u){pk2(p0[8], p0[9]), pk2(p0[10], p0[11]), pk2(p0[12], p0[13]), pk2(p0[14], p0[15])};
                pw[2] = (v4u){pk2(p1[0], p1[1]), pk2(p1[2], p1[3]), pk2(p1[4], p1[5]), pk2(p1[6], p1[7])};
                pw[3] = (v4u){pk2(p1[8], p1[9]), pk2(p1[10], p1[11]), pk2(p1[12], p1[13]), pk2(p1[14], p1[15])};
                const LAS unsigned char* vb = Vs + ((lane >> 4) & 1) * 32 + (lane & 3) * 8 + (4 * hi + ((lane & 15) >> 2)) * 64;
#pragma unroll
                for (int ks = 0; ks < 4; ++ks) { const bf16x8 pa = __builtin_bit_cast(bf16x8, pw[ks]);
                    { const s16x4 lo = tr_read(vb + ks * 1024), hh = tr_read(vb + ks * 1024 + 512); const bf16x8 vfr = (bf16x8){lo[0], lo[1], lo[2], lo[3], hh[0], hh[1], hh[2], hh[3]};
                        o0 = __builtin_amdgcn_mfma_f32_32x32x16_bf16(pa, vfr, o0, 0, 0, 0); }
                    { const s16x4 lo = tr_read(vb + 4096 + ks * 1024), hh = tr_read(vb + 4096 + ks * 1024 + 512); const bf16x8 vfr = (bf16x8){lo[0], lo[1], lo[2], lo[3], hh[0], hh[1], hh[2], hh[3]};
                        o1 = __builtin_amdgcn_mfma_f32_32x32x16_bf16(pa, vfr, o1, 0, 0, 0); } }
            }
        }
#undef ATT_DMA
        __syncthreads();
        { auto rr = __builtin_amdgcn_permlane32_swap(__float_as_uint(lrun), __float_as_uint(lrun), false, false); lrun = __uint_as_float(rr[0]) + __uint_as_float(rr[1]); }
        if (hi == 0) wsf[32 + r32] = lrun;
        { LAS bf16* stg = (LAS bf16*)(lds + AT_OST) + wave * 2048;
#pragma unroll
            for (int r = 0; r < 16; ++r) { const int orow = crow(r, hi); const float rl = __builtin_amdgcn_rcpf(wsf[32 + orow]);
                stg[orow * 64 + r32] = (bf16)(pk2(o0[r] * rl, 0.f) & 0xffffu); stg[orow * 64 + 32 + r32] = (bf16)(pk2(o1[r] * rl, 0.f) & 0xffffu); }
            bf16* Ow = (DRY ? P.xb : Q) + qrow * D + h * HD;
#pragma unroll
            for (int i = 0; i < 4; ++i) { const int row = i * 8 + (lane >> 3), ch = lane & 7; const v4u v = *(const LAS v4u*)(stg + row * 64 + ch * 8); *(v4u*)(Ow + (size_t)row * D + ch * 8) = v; } }
        __syncthreads();
    }
}
#undef MX3

__device__ __forceinline__ void final_phase(const Ptrs& P, int vcu, int G, int wave) {
    int tid_ = threadIdx.x; asm volatile("" : "+v"(tid_)); const int lane = tid_ & 63;
    const int gw = vcu * NWAVES + wave, NGW = G * NWAVES;
    f32x4 gn[4];
#pragma unroll
    for (int j = 0; j < 4; ++j) gn[j] = ((const f32x4*)P.final_g)[lane + 64 * j];
    for (int m = gw; m < M; m += NGW) {
        const f32x4 sv = *(const f32x4*)(P.xss + (size_t)m * pg8::NSLOT_X + (lane & 3) * 4);
        float s = (sv[0] + sv[1]) + (sv[2] + sv[3]); s += __shfl_xor(s, 1); s += __shfl_xor(s, 2);
        const float r = __builtin_amdgcn_rsqf(s * (1.0f / D) + EPS);
        const GAS v2u* xr = (const GAS v2u*)(P.xb + (size_t)m * D) + lane;
        GAS f32x4* orow = (GAS f32x4*)(P.out + (size_t)m * D) + lane;
#pragma unroll
        for (int j = 0; j < 4; ++j) { const v2u w = xr[64 * j]; const f32x4 v = {bf_lo(w.x), bf_hi(w.x), bf_lo(w.y), bf_hi(w.y)}; orow[64 * j] = v * r * gn[j]; }
    }
}

__device__ __forceinline__ int launder_s(int x) { asm volatile("" : "+s"(x)); return x; }
struct Args { const float* in[15]; float* out; unsigned char* ws; int ph_lo, ph_hi; };
static_assert(sizeof(Args) == 17 * 8 + 8, "Args has no padding");
__global__ void __launch_bounds__(NWAVES * 64, 2) trunk_fwd(Args args) {
    extern __shared__ __attribute__((aligned(16))) unsigned char lds_raw[];
    LAS unsigned char* lds = (LAS unsigned char*)lds_raw;
    volatile LAS unsigned* MISC = (volatile LAS unsigned*)(lds + MISC_OFF);
    const int tid = threadIdx.x, lane = tid & 63, wave = __builtin_amdgcn_readfirstlane(tid >> 6);
    const int G = gridDim.x; const int bx = blockIdx.x; const int vcu = (G % 8 == 0) ? (bx % 8) * (G / 8) + bx / 8 : bx;
    unsigned char* ws = args.ws;
    gu32* ctl = (gu32*)(ws + WS_CTL);
    Ptrs P;
    P.x = args.in[0]; P.norm_mix_g = args.in[1]; P.norm_ffn_g = args.in[2]; P.final_g = args.in[3]; P.a_w_in = args.in[4]; P.a_v_gain = args.in[5]; P.a_w_s = args.in[6]; P.a_b_s = args.in[7];
    P.a_w_out = args.in[8]; P.b_w_qkv = args.in[9]; P.b_rel_bias = args.in[10]; P.b_w_out = args.in[11]; P.ffn_w_gate = args.in[12]; P.ffn_w_up = args.in[13]; P.ffn_w_down = args.in[14];
    P.out = args.out; P.wt = (bf16*)(ws + WS_W); P.xb = (bf16*)(ws + WS_XB); P.act = (bf16*)(ws + WS_ACT); P.xss = (float*)(ws + WS_XSS); P.vss = (float*)(ws + WS_VSS);
    for (int u = tid; u < (LDS_BYTES - LDSCTL_OFF) / 4; u += NWAVES * 64) ((LAS unsigned*)(lds + LDSCTL_OFF))[u] = 0u;
    __syncthreads();
    XcdBarrier bar; bar.bar = (unsigned*)(ctl + CW_BAR); bar.x = 0; bar.st = nullptr;
    if (!MK_PER_PHASE) bar = xcd_barrier_post((unsigned*)(ctl + CW_BAR), MISC + 8);
    const int lo = args.ph_lo, hi = args.ph_hi;
#define RS_TABLE(S) pg8::RsTab rt{(const LAS float*)(lds + RSTAB_OFF), -1}; { pg8::Unit u0_; if (S.next(0, u0_)) { rt.pm = u0_.pm; pg8::build_rs_table(P.xss, u0_.pm, (LAS float*)(lds + RSTAB_OFF), tid, 1.0f / D, EPS); } }
#ifndef DBG_MASK
#define DBG_MASK 0xff
#endif
#if MK_PER_PHASE
#define IN(k) (lo <= (k) && (k) < hi)
#else
#define IN(k) true
#endif
#define SEAM(k) do { if (IN(k) && IN((k) + 1)) { xcd_barrier(bar); if (PROBE == 1) xcd_barrier(bar); } } while (0)

    if ((DBG_MASK & 1) && IN(0)) { p0_prologue(P, lds, vcu, G, wave, lane); if (PROBE == 2) { __syncthreads(); p0_prologue(P, lds, vcu, G, wave, lane); } }
    SEAM(0);
#pragma unroll 1
    for (int layer = 0; layer < DEPTH; ++layer) {
        const int j = layer >> 1, ph = 1 + 5 * layer;
        const bf16* wgu = P.wt + WO_GU + (size_t)layer * D * FF2; const bf16* wdn = P.wt + WO_DN + (size_t)layer * FF * D;
        if ((layer & 1) == 0) {
            if ((DBG_MASK & 2) && IN(ph)) { pg8::Gemm g{P.xb, P.wt + WO_IN + (size_t)j * D * GH2, M, GH2, D, D}; pg8::StaticOrder S; S.init(M, GH2, G, launder_s(bx));
                RS_TABLE(S);
                pg8::EpiGeluStats E{P.act, GH2, P.xss, P.vss, GH / 256, EPS, rt};
                pg8::gemm_phase<pg8::EpiGeluStats, pg8::StaticOrder, true, true>(lds + RING_OFF, g, S, E);
                if (PROBE == 5) { __syncthreads(); pg8::gemm_phase<pg8::EpiGeluStats, pg8::StaticOrder, true, true>(lds + RING_OFF, g, S, E); } }
            SEAM(ph);
            if ((DBG_MASK & 4) && IN(ph + 1)) { if (PROBE == 4) spatial_phase<true>(P, j, lds, vcu, G, wave); spatial_phase<false>(P, j, lds, vcu, G, wave); }
            SEAM(ph + 1);
            if ((DBG_MASK & 8) && IN(ph + 2)) { pg8::Gemm g{P.act, P.wt + WO_AOUT + (size_t)j * GH * D, M, D, GH, GH2}; pg8::StaticOrder S; S.init(M, D, G, launder_s(bx));
                pg8::EpiResid E{P.xb, P.xss, D};
                pg8::gemm_phase<pg8::EpiResid, pg8::StaticOrder, false, true>(lds + RING_OFF, g, S, E); }
            SEAM(ph + 2);
        } else {
            if ((DBG_MASK & 16) && IN(ph)) { pg8::Gemm g{P.xb, P.wt + WO_QKV + (size_t)j * D * 3 * D, M, 3 * D, D, D}; pg8::StaticOrder S; S.init(M, 3 * D, G, launder_s(bx));
                RS_TABLE(S);
                pg8::EpiQkv E{P.act, D, (size_t)M * D, P.xss, EPS, QSCALE, rt};
                pg8::gemm_phase<pg8::EpiQkv, pg8::StaticOrder, true, true>(lds + RING_OFF, g, S, E);
                if (PROBE == 7) { __syncthreads(); pg8::gemm_phase<pg8::EpiQkv, pg8::StaticOrder, true, true>(lds + RING_OFF, g, S, E); } }
            SEAM(ph);
            if ((DBG_MASK & 32) && IN(ph + 1)) { if (PROBE == 3) attn_phase<true>(P, j, lds, vcu, G, wave); attn_phase<false>(P, j, lds, vcu, G, wave); }
            SEAM(ph + 1);
            if ((DBG_MASK & 8) && IN(ph + 2)) { pg8::Gemm g{P.act, P.wt + WO_BOUT + (size_t)j * D * D, M, D, D, D}; pg8::StaticOrder S; S.init(M, D, G, launder_s(bx));
                pg8::EpiResid E{P.xb, P.xss, D};
                pg8::gemm_phase<pg8::EpiResid, pg8::StaticOrder, false, true>(lds + RING_OFF, g, S, E); }
            SEAM(ph + 2);
        }
        if ((DBG_MASK & 64) && IN(ph + 3)) { pg8::Gemm g{P.xb, wgu, M, FF2, D, D}; pg8::FfnOrder S; S.init(M, FF_NFULL, G, launder_s(bx));
            RS_TABLE(S);
            pg8::EpiSwiglu E{P.act, FF, P.xss, EPS, rt, FF_NFULL * 128};
            pg8::gemm_phase<pg8::EpiSwiglu, pg8::FfnOrder, true, true>(lds + RING_OFF, g, S, E); }
        SEAM(ph + 3);
        if ((DBG_MASK & 8) && IN(ph + 4)) { pg8::Gemm g{P.act, wdn, M, D, FF, FF}; pg8::StaticOrder S; S.init(M, D, G, launder_s(bx));
            pg8::EpiResid E{P.xb, P.xss, D};
            pg8::gemm_phase<pg8::EpiResid, pg8::StaticOrder, false, true>(lds + RING_OFF, g, S, E); }
        SEAM(ph + 4);
    }
    if ((DBG_MASK & 128) && IN(N_PHASES - 1)) final_phase(P, vcu, G, wave);
#undef IN
#undef SEAM
}

extern "C" void kernel_launch(void* const* d_in, const int* in_sizes, int n_in, void* d_out, int out_size, void* d_ws, size_t ws_size, hipStream_t stream) {
    static int grid = 0;
    if (grid == 0) {
        if (n_in != 15 || in_sizes[0] != M * D || out_size != M * D || ws_size < WS_END) { fprintf(stderr, "kernel_launch: unexpected shapes (n_in %d, in0 %d, out %d, ws %zu < %zu); nothing launched\n", n_in, n_in > 0 ? in_sizes[0] : -1, out_size, ws_size, (size_t)WS_END); grid = -1; return; }
        int dev = 0, cus = 0, per_cu = 0;
        if (hipGetDevice(&dev) != hipSuccess || hipDeviceGetAttribute(&cus, hipDeviceAttributeMultiprocessorCount, dev) != hipSuccess) { grid = -1; return; }
        if (hipFuncSetAttribute((const void*)trunk_fwd, hipFuncAttributeMaxDynamicSharedMemorySize, LDS_BYTES) != hipSuccess) { fprintf(stderr, "kernel_launch: hipFuncSetAttribute failed\n"); grid = -1; return; }
        if (hipOccupancyMaxActiveBlocksPerMultiprocessor(&per_cu, (const void*)trunk_fwd, NWAVES * 64, LDS_BYTES) != hipSuccess || per_cu < 1) { fprintf(stderr, "kernel_launch: occupancy query reports %d workgroups per CU; nothing launched\n", per_cu); (void)hipGetLastError(); grid = -1; return; }
        grid = cus;
    }
    if (grid < 0) return;
    if (hipMemsetAsync((char*)d_ws + WS_CTL, 0, CTL_ZERO_BYTES, stream) != hipSuccess) return;
    Args a{};
    for (int i = 0; i < 15; ++i) a.in[i] = (const float*)d_in[i];
    a.out = (float*)d_out; a.ws = (unsigned char*)d_ws;
#if MK_PER_PHASE
    for (int p = 0; p < N_PHASES; ++p) { a.ph_lo = p; a.ph_hi = p + 1; hipLaunchKernelGGL(trunk_fwd, dim3(grid), dim3(NWAVES * 64), LDS_BYTES, stream, a); }
#else
    a.ph_lo = 0; a.ph_hi = N_PHASES;
    hipLaunchKernelGGL(trunk_fwd, dim3(grid), dim3(NWAVES * 64), LDS_BYTES, stream, a);
#endif
}
```

```cpp
#include <hip/hip_runtime.h>
#include <cstdio>
#include <cstdint>
#ifndef PROBE
#define PROBE 0
#endif
#ifndef PG8_KROT
#define PG8_KROT 0
#endif
namespace pg8 {
#define PG8_LAS __attribute__((address_space(3)))
typedef unsigned short bf16_t;
typedef short bf16x8 __attribute__((ext_vector_type(8)));
typedef float f32x4 __attribute__((ext_vector_type(4)));
typedef unsigned u32x4 __attribute__((ext_vector_type(4)));
constexpr int BM = 256, BK = 64, HALF = 128, HTB = HALF * BK * 2  , STAGE_BYTES = 8 * HTB, NXCD = 8, WGM = 8;

__host__ __device__ __forceinline__ int lds_byte(int r, int c) { const int st = (r >> 4) * 2 + (c >> 5), rr = r & 15, cc = c & 31, ob = rr * 64 + cc * 2; return st * 1024 + (ob ^ (((ob >> 9) & 1) << 5)); }
__host__ __device__ __forceinline__ void stage_rc(int b, int& R, int& C) { const int st = b / 1024, sb = b % 1024, swz = sb ^ (((sb >> 9) & 1) << 5); R = (st >> 1) * 16 + swz / 64; C = (st & 1) * 32 + (swz % 64) / 2; }
__host__ __device__ __forceinline__ int perm32(int rho) { const int n = rho >> 4, i = rho & 15; return 8 * (i >> 2) + 4 * n + (i & 3); }

struct Unit { int pm, pn, hf; };
struct Gemm { const bf16_t* A; const bf16_t* Bt; int M, N, K, lda; };

struct StaticOrder {
    int nM, nN, nwg, G, c;
    __host__ __device__ void init(int M, int N, int G_, int c_) { nM = M / BM; nN = N / BM; nwg = nM * nN; G = G_; c = c_; }
    __host__ __device__ bool next(int i, Unit& u) const {
        const long L = (long)i * G + c; if (L >= nwg) return false;
        int wgid = (int)L; { const int q = nwg / NXCD, r = nwg % NXCD, xcd = wgid % NXCD, off = wgid / NXCD; wgid = (xcd < r ? xcd * (q + 1) : r * (q + 1) + (xcd - r) * q) + off; }
        const int nig = WGM * nN, gid = wgid / nig, fm = gid * WGM, gsz = (nM - fm) < WGM ? (nM - fm) : WGM;
        u.pm = fm + ((wgid % nig) % gsz); u.pn = (wgid % nig) / gsz; u.hf = 0; return true;
    }
    static constexpr bool HAS_HALF = false;
    __host__ __device__ int brow(const Unit& u) const { return u.pn * BM; }
    __device__ __forceinline__ int koff(const Unit& u, int nt) const { int k = PG8_KROT ? 2 * (u.pm & 7) + 4 * (u.pn & 3) : 0; k -= (k >= nt) ? nt : 0; return k; }
    __device__ __forceinline__ void a_ready(const Unit&) const {}
    __device__ __forceinline__ void done(const Unit&) const {}
};

__device__ __forceinline__ unsigned cvt_pk_bf16(float lo, float hi) { unsigned r; asm volatile("v_cvt_pk_bf16_f32 %0, %1, %2" : "=v"(r) : "v"(lo), "v"(hi)); return r; }
typedef float f32x2 __attribute__((ext_vector_type(2)));
struct Sch { int lm, gi, rank, nloc; };
struct PanelOrder {
    StaticOrder so; Sch sc; int nN;
    static constexpr bool HAS_HALF = false;
    __device__ void init(int M, int N, int G_, int c_, const Sch& s_) { so.init(M, N, G_, c_); sc = s_; nN = N / BM; }
    __device__ bool next(int i, Unit& u) const {
        if (sc.lm) { const int idx = sc.rank + sc.nloc * i; if (idx >= 8 * nN) return false; u.pm = 8 * sc.gi + (idx & 7); u.pn = idx >> 3; u.hf = 0; return true; }
        return so.next(i, u);
    }
    __device__ int brow(const Unit& u) const { return u.pn * BM; }
    __device__ __forceinline__ int koff(const Unit& u, int nt) const { int k = PG8_KROT ? 2 * (u.pm & 7) + 4 * (u.pn & 3) : 0; k -= (k >= nt) ? nt : 0; return k; }
    __device__ __forceinline__ void a_ready(const Unit&) const {}
    __device__ __forceinline__ void done(const Unit&) const {}
};
struct FfnOrder {
    PanelOrder po; int nfull, G, c, NFULL;
    static constexpr bool HAS_HALF = true;
    __device__ void init(int M, int NFULL_, int G_, int c_, const Sch& s_) { NFULL = NFULL_; po.init(M, NFULL_ * BM, G_, c_, s_); G = G_; c = c_;
        nfull = s_.lm ? ((s_.rank < 8 * NFULL_) ? (8 * NFULL_ - s_.rank + s_.nloc - 1) / s_.nloc : 0) : ((c_ < po.so.nwg) ? (po.so.nwg - c_ + G_ - 1) / G_ : 0); }
    __device__ bool next(int i, Unit& u) const {
        if (i < nfull) return po.next(i, u);
        const int k = i - nfull;
        if (po.sc.lm) { const int hidx = po.sc.rank + po.sc.nloc * k; if (hidx >= 32) return false; u.pm = 8 * po.sc.gi + (hidx & 7); u.pn = hidx >> 3; u.hf = 1; return true; }
        const int nh = po.so.nM * 4; const int hu = k * G + c; if (hu >= nh) return false;
        if (G == 256 && po.so.nM == 64) { Unit f; po.so.next(0, f); u.pm = f.pm; u.pn = f.pn & 3; }
        else { u.pm = hu % po.so.nM; u.pn = hu / po.so.nM; }
        u.hf = 1; return true;
    }
    __device__ int brow(const Unit& u) const { return u.hf ? NFULL * BM + u.pn * HALF : u.pn * BM; }
    __device__ __forceinline__ int koff(const Unit& u, int nt) const { int k = PG8_KROT ? 2 * (u.pm & 7) + 4 * (u.pn & 3) : 0; k -= (k >= nt) ? nt : 0; return k; }
    __device__ __forceinline__ void a_ready(const Unit&) const {}
    __device__ __forceinline__ void done(const Unit&) const {}
};

#ifndef PG8_B_AUX
#define PG8_B_AUX 0
#endif
#ifndef PG8_SKIPW
#define PG8_SKIPW 0
#endif
#ifndef STORE_WT
#define STORE_WT 1
#endif
__device__ __forceinline__ void store16(void* p, u32x4 v) {
#if STORE_WT
    asm volatile("global_store_dwordx4 %0, %1, off sc1\n\ts_nop 1" :: "v"(p), "v"(v) : "memory");
#else
    *(u32x4*)p = v;
#endif
}
__device__ __forceinline__ void store16f(void* p, f32x4 v) {
#if STORE_WT
    asm volatile("global_store_dwordx4 %0, %1, off sc1\n\ts_nop 1" :: "v"(p), "v"(v) : "memory");
#else
    *(f32x4*)p = v;
#endif
}
typedef unsigned u32x2 __attribute__((ext_vector_type(2)));
__device__ __forceinline__ void store8(void* p, u32x2 v) {
#if STORE_WT
    asm volatile("global_store_dwordx2 %0, %1, off sc1\n\ts_nop 1" :: "v"(p), "v"(v) : "memory");
#else
    *(u32x2*)p = v;
#endif
}
constexpr int NSLOT_X = 16;
constexpr int NSLOT_V = 32;
struct RsTab { const PG8_LAS float* t; int pm; };
__device__ __forceinline__ void row_scales(const float* ss, const RsTab& T, int pm, int wr, int fr, int fq, float inv_n, float eps, float (&rs)[2][4]) {
    if (pm == T.pm) {
#pragma unroll
        for (int ai = 0; ai < 2; ++ai)
#pragma unroll
            for (int m = 0; m < 4; ++m) rs[ai][m] = T.t[wr * 64 + fr + ai * HALF + m * 16];
    } else {
        const int row0 = pm * BM + wr * 64 + fr;
#pragma unroll
        for (int ai = 0; ai < 2; ++ai)
#pragma unroll
            for (int m = 0; m < 4; ++m) {
                const f32x4 v = *(const f32x4*)(ss + (size_t)(row0 + ai * HALF + m * 16) * NSLOT_X + fq * 4);
                float s = (v[0] + v[1]) + (v[2] + v[3]);
                s += __shfl_xor(s, 16); s += __shfl_xor(s, 32);
                rs[ai][m] = __builtin_amdgcn_rsqf(s * inv_n + eps);
            }
    }
}
__device__ __forceinline__ void build_rs_table(const float* ss, int pm, PG8_LAS float* t, int tid, float inv_n, float eps) {
    asm volatile("" : "+v"(tid));
    const int row = tid >> 1, half = tid & 1;
    const f32x4 a = *(const f32x4*)(ss + (size_t)(pm * BM + row) * NSLOT_X + half * 8), b = *(const f32x4*)(ss + (size_t)(pm * BM + row) * NSLOT_X + half * 8 + 4);
    float s = ((a[0] + a[1]) + (a[2] + a[3])) + ((b[0] + b[1]) + (b[2] + b[3]));
    s += __shfl_xor(s, 1);
    if (half == 0) t[row] = __builtin_amdgcn_rsqf(s * inv_n + eps);
    asm volatile("s_waitcnt lgkmcnt(0)" ::: "memory"); __syncthreads();
}
__device__ __forceinline__ float gelu_tanh(float x) {
    const float t = x * x, u2 = x * (2.302208198f + 0.1029432398f * t);
    const float e = __builtin_amdgcn_exp2f(-u2);
    return x * __builtin_amdgcn_rcpf(1.0f + e);
}
__device__ __forceinline__ float silu_mul(float g, float u) {
    const float e = __builtin_amdgcn_exp2f(g * -1.4426950408889634f);
    return (g * u) * __builtin_amdgcn_rcpf(1.0f + e);
}
__device__ __forceinline__ f32x2 gelu_tanh2(f32x2 x) {
    const f32x2 t = x * x;
    const f32x2 p = __builtin_elementwise_fma(t, (f32x2){-0.1029432398f, -0.1029432398f}, (f32x2){-2.302208198f, -2.302208198f});
    const f32x2 u2n = x * p;
    f32x2 d; d[0] = __builtin_amdgcn_exp2f(u2n[0]); d[1] = __builtin_amdgcn_exp2f(u2n[1]);
    d = d + (f32x2){1.0f, 1.0f};
    f32x2 r; r[0] = __builtin_amdgcn_rcpf(d[0]); r[1] = __builtin_amdgcn_rcpf(d[1]);
    return x * r;
}
__device__ __forceinline__ f32x2 silu_mul2(f32x2 g, f32x2 u, float rneg, float rr) {
    const f32x2 a = g * rneg;
    f32x2 d; d[0] = __builtin_amdgcn_exp2f(a[0]); d[1] = __builtin_amdgcn_exp2f(a[1]);
    d = d + (f32x2){1.0f, 1.0f};
    f32x2 q; q[0] = __builtin_amdgcn_rcpf(d[0]); q[1] = __builtin_amdgcn_rcpf(d[1]);
    return ((g * u) * rr) * q;
}
struct EpiGeluStats {
    static constexpr bool PERM = true, AFTER_DRAIN = false, PROBE_TWICE = false;
    bf16_t* O; int ldc; const float* xss; float* vss; int vtile0; float eps; RsTab rt;
    __device__ __forceinline__ void operator()(const f32x4 (&acc)[2][2][4][2], const Unit& u, int wr, int wc, int fr, int fq) const {
        const int row0 = u.pm * BM + wr * 64 + fr, col0 = u.pn * BM + wc * 32 + 8 * fq;
        float rs[2][4]; row_scales(xss, rt, u.pm, wr, fr, fq, 1.0f / 1024.0f, eps, rs);
        const bool isv = u.pn >= vtile0;
#pragma unroll
        for (int ai = 0; ai < 2; ++ai)
#pragma unroll
            for (int m = 0; m < 4; ++m) { const int row = row0 + ai * HALF + m * 16; bf16_t* rowp = O + (size_t)row * ldc + col0; const float r = rs[ai][m]; float ssq = 0.f;
                f32x2 sq2 = (f32x2){0.f, 0.f};
#pragma unroll
                for (int bj = 0; bj < 2; ++bj) { const f32x4 a0 = acc[ai][bj][m][0], a1 = acc[ai][bj][m][1];
                    const f32x2 y0 = gelu_tanh2((f32x2){a0[0], a0[1]} * r), y1 = gelu_tanh2((f32x2){a0[2], a0[3]} * r), y2 = gelu_tanh2((f32x2){a1[0], a1[1]} * r), y3 = gelu_tanh2((f32x2){a1[2], a1[3]} * r);
                    sq2 = __builtin_elementwise_fma(y0, y0, sq2); sq2 = __builtin_elementwise_fma(y1, y1, sq2); sq2 = __builtin_elementwise_fma(y2, y2, sq2); sq2 = __builtin_elementwise_fma(y3, y3, sq2);
                    u32x4 w; w.x = cvt_pk_bf16(y0[0], y0[1]); w.y = cvt_pk_bf16(y1[0], y1[1]); w.z = cvt_pk_bf16(y2[0], y2[1]); w.w = cvt_pk_bf16(y3[0], y3[1]);
                    store16(rowp + bj * HALF, w); }
                if (isv) { ssq = sq2[0] + sq2[1]; ssq += __shfl_xor(ssq, 16); ssq += __shfl_xor(ssq, 32); if (fq == 0) vss[(size_t)row * NSLOT_V + (u.pn - vtile0) * 4 + wc] = ssq; } }
    }
};
struct EpiSwiglu {
    static constexpr bool PERM = true, AFTER_DRAIN = false, PROBE_TWICE = true;
    bf16_t* O; int ldc; const float* xss; float eps; RsTab rt;
    int half_col0;
    __device__ __forceinline__ void operator()(const f32x4 (&acc)[2][2][4][2], const Unit& u, int wr, int wc, int fr, int fq) const {
        const int row0 = u.pm * BM + wr * 64 + fr, col0 = u.pn * HALF + wc * 32 + 8 * fq;
        float rs[2][4]; row_scales(xss, rt, u.pm, wr, fr, fq, 1.0f / 1024.0f, eps, rs);
        if (u.hf) {
            const int hc = half_col0 + u.pn * 64 + wc * 16 + 4 * fq;
#pragma unroll
            for (int ai = 0; ai < 2; ++ai)
#pragma unroll
                for (int m = 0; m < 4; ++m) { const int row = row0 + ai * HALF + m * 16; const float r = rs[ai][m], rneg = r * -1.4426950408889634f, rr = r * r;
                    const f32x4 g0 = acc[ai][0][m][0], u0 = acc[ai][0][m][1];
                    const f32x2 o0 = silu_mul2((f32x2){g0[0], g0[1]}, (f32x2){u0[0], u0[1]}, rneg, rr), o1 = silu_mul2((f32x2){g0[2], g0[3]}, (f32x2){u0[2], u0[3]}, rneg, rr);
                    u32x2 w; w.x = cvt_pk_bf16(o0[0], o0[1]); w.y = cvt_pk_bf16(o1[0], o1[1]);
                    *(u32x2*)(O + (size_t)row * ldc + hc) = w; }
            return;
        }
#pragma unroll
        for (int ai = 0; ai < 2; ++ai)
#pragma unroll
            for (int m = 0; m < 4; ++m) { const int row = row0 + ai * HALF + m * 16; const float r = rs[ai][m] * (PROBE == 9 ? 0.5f : 1.0f);
                const float rneg = r * -1.4426950408889634f, rr = r * r;
                const f32x4 g0 = acc[ai][0][m][0], g1 = acc[ai][0][m][1], u0 = acc[ai][1][m][0], u1 = acc[ai][1][m][1];
                const f32x2 o0 = silu_mul2((f32x2){g0[0], g0[1]}, (f32x2){u0[0], u0[1]}, rneg, rr), o1 = silu_mul2((f32x2){g0[2], g0[3]}, (f32x2){u0[2], u0[3]}, rneg, rr);
                const f32x2 o2 = silu_mul2((f32x2){g1[0], g1[1]}, (f32x2){u1[0], u1[1]}, rneg, rr), o3 = silu_mul2((f32x2){g1[2], g1[3]}, (f32x2){u1[2], u1[3]}, rneg, rr);
                u32x4 w; w.x = cvt_pk_bf16(o0[0], o0[1]); w.y = cvt_pk_bf16(o1[0], o1[1]); w.z = cvt_pk_bf16(o2[0], o2[1]); w.w = cvt_pk_bf16(o3[0], o3[1]);
                if (PROBE == 11) *(u32x4*)(O + (size_t)row * ldc + col0) = w; else store16(O + (size_t)row * ldc + col0, w); }
    }
};
struct EpiQkv {
    static constexpr bool PERM = true, AFTER_DRAIN = false, PROBE_TWICE = false;
    bf16_t* O; int ldc; size_t split_stride; const float* xss; float eps; float scale0; RsTab rt;
    __device__ __forceinline__ void operator()(const f32x4 (&acc)[2][2][4][2], const Unit& u, int wr, int wc, int fr, int fq) const {
        const int t = u.pn >> 2; bf16_t* base = O + (size_t)t * split_stride; const float sc = (t == 0) ? scale0 : 1.0f;
        const int row0 = u.pm * BM + wr * 64 + fr, col0 = (u.pn & 3) * BM + wc * 32 + 8 * fq;
        float rs[2][4]; row_scales(xss, rt, u.pm, wr, fr, fq, 1.0f / 1024.0f, eps, rs);
#pragma unroll
        for (int ai = 0; ai < 2; ++ai)
#pragma unroll
            for (int m = 0; m < 4; ++m) { const int row = row0 + ai * HALF + m * 16; bf16_t* rowp = base + (size_t)row * ldc + col0; const float r = rs[ai][m] * sc;
#pragma unroll
                for (int bj = 0; bj < 2; ++bj) { const f32x4 v0 = acc[ai][bj][m][0] * r, v1 = acc[ai][bj][m][1] * r;
                    u32x4 w; w.x = cvt_pk_bf16(v0[0], v0[1]); w.y = cvt_pk_bf16(v0[2], v0[3]); w.z = cvt_pk_bf16(v1[0], v1[1]); w.w = cvt_pk_bf16(v1[2], v1[3]);
                    store16(rowp + bj * HALF, w); } }
    }
};
struct EpiResid {
    static constexpr bool PERM = true, AFTER_DRAIN = false, PROBE_TWICE = false;
    bf16_t* xb; float* xss; int ldc;
    __device__ __forceinline__ void operator()(const f32x4 (&acc)[2][2][4][2], const Unit& u, int wr, int wc, int fr, int fq) const {
        asm volatile("" : "+v"(fr), "+v"(fq));
        const int row0 = u.pm * BM + wr * 64 + fr, col0 = u.pn * BM + wc * 32 + 8 * fq;
        u32x4 pre[2][4][2];
#pragma unroll
        for (int ai = 0; ai < 2; ++ai)
#pragma unroll
            for (int m = 0; m < 4; ++m)
#pragma unroll
                for (int bj = 0; bj < 2; ++bj) pre[ai][m][bj] = __builtin_nontemporal_load((const u32x4*)(xb + (size_t)(row0 + ai * HALF + m * 16) * ldc + col0 + bj * HALF));
#pragma unroll
        for (int ai = 0; ai < 2; ++ai)
#pragma unroll
            for (int m = 0; m < 4; ++m) { const int row = row0 + ai * HALF + m * 16; bf16_t* rowp = xb + (size_t)row * ldc + col0; float ssq = 0.f;
#pragma unroll
                for (int bj = 0; bj < 2; ++bj) { const u32x4 b = pre[ai][m][bj]; const f32x4 a0 = acc[ai][bj][m][0], a1 = acc[ai][bj][m][1];
                    float o[8];
                    o[0] = __uint_as_float(b.x << 16) + a0[0]; o[1] = __uint_as_float(b.x & 0xffff0000u) + a0[1]; o[2] = __uint_as_float(b.y << 16) + a0[2]; o[3] = __uint_as_float(b.y & 0xffff0000u) + a0[3];
                    o[4] = __uint_as_float(b.z << 16) + a1[0]; o[5] = __uint_as_float(b.z & 0xffff0000u) + a1[1]; o[6] = __uint_as_float(b.w << 16) + a1[2]; o[7] = __uint_as_float(b.w & 0xffff0000u) + a1[3];
                    ssq += ((o[0] * o[0] + o[1] * o[1]) + (o[2] * o[2] + o[3] * o[3])) + ((o[4] * o[4] + o[5] * o[5]) + (o[6] * o[6] + o[7] * o[7]));
                    u32x4 w; w.x = cvt_pk_bf16(o[0], o[1]); w.y = cvt_pk_bf16(o[2], o[3]); w.z = cvt_pk_bf16(o[4], o[5]); w.w = cvt_pk_bf16(o[6], o[7]);
                    store16(rowp + bj * HALF, w); }
                ssq += __shfl_xor(ssq, 16); ssq += __shfl_xor(ssq, 32);
                if (fq == 0) xss[(size_t)row * NSLOT_X + u.pn * 4 + wc] = ssq; }
    }
};

template <class Epi, class Sched, bool ALIGN_EPI = false, bool SP2 = false>
__device__ __forceinline__ void gemm_phase(PG8_LAS unsigned char* lds, const Gemm g, const Sched& S, const Epi& E) {
    int tid_ = threadIdx.x; asm volatile("" : "+v"(tid_));
    const int tid = tid_, wid = __builtin_amdgcn_readfirstlane(tid >> 6), lane = tid & 63, wr = wid >> 2, wc = wid & 3, fr = lane & 15, fq = lane >> 4;
    const int K = g.K, nt = K / BK;
    unsigned voffA[2], voffB[2];
#pragma unroll
    for (int i = 0; i < 2; ++i) { int R, C; stage_rc(tid * 16 + i * 8192, R, C); const int Rb = Epi::PERM ? ((R & ~31) + perm32(R & 31)) : R;
        voffA[i] = (unsigned)(R * g.lda + C) * 2u; voffB[i] = (unsigned)(Rb * K + C) * 2u; }
    const size_t kstep = (size_t)(BK * 2);
    const size_t hstep = (size_t)HALF * K * 2;
    const size_t tstep = 2 * hstep; const size_t hstepA = (size_t)HALF * g.lda * 2, tstepA = 2 * hstepA;
    const unsigned ldsw = (unsigned)wid * 1024u;
    const int aoff = lds_byte(wr * 64 + fr, fq * 8), boff = lds_byte(wc * 32 + fr, fq * 8);
#define PG8_SA(b, h) (((b) * 2 + (h)) * HTB)
#define PG8_SB(b, h) ((4 + (b) * 2 + (h)) * HTB)
#define PG8_STAGE(bufoff, gbase, voff) do { _Pragma("unroll") for (int _i = 0; _i < 2; ++_i) \
        __builtin_amdgcn_global_load_lds((const unsigned*)((const char*)(gbase) + (voff)[_i]), (PG8_LAS unsigned*)(lds + (bufoff) + ldsw + _i * 8192), 16, 0, 0); } while (0)
#define PG8_STAGE_B(bufoff, gbase, voff) do { _Pragma("unroll") for (int _i = 0; _i < 2; ++_i) \
        __builtin_amdgcn_global_load_lds((const unsigned*)((const char*)(gbase) + (voff)[_i]), (PG8_LAS unsigned*)(lds + (bufoff) + ldsw + _i * 8192), 16, 0, PG8_B_AUX); } while (0)
#define PG8_LDA(dst, b, h) do { _Pragma("unroll") for (int m = 0; m < 4; ++m) _Pragma("unroll") for (int k = 0; k < 2; ++k) dst[m][k] = *(const PG8_LAS bf16x8*)(lds + PG8_SA(b, h) + aoff + m * 2048 + k * 1024); } while (0)
#define PG8_LDB(dst, b, h) do { _Pragma("unroll") for (int n = 0; n < 2; ++n) _Pragma("unroll") for (int k = 0; k < 2; ++k) dst[n][k] = *(const PG8_LAS bf16x8*)(lds + PG8_SB(b, h) + boff + n * 2048 + k * 1024); } while (0)
#define PG8_MMA(ai, bj, At, Bt) do { __builtin_amdgcn_s_setprio(1); _Pragma("unroll") for (int m = 0; m < 4; ++m) _Pragma("unroll") for (int n = 0; n < 2; ++n) _Pragma("unroll") for (int k = 0; k < 2; ++k) \
        acc[ai][bj][m][n] = __builtin_amdgcn_mfma_f32_16x16x32_bf16(Bt[n][k], At[m][k], acc[ai][bj][m][n], 0, 0, 0); __builtin_amdgcn_s_setprio(0); } while (0)
#define PG8_WAIT_V(n) asm volatile("s_waitcnt vmcnt(" #n ")" ::: "memory")
#if PG8_SKIPW
#define PG8_WAIT_V8_UNLESS(c) asm volatile("s_cmp_lg_u32 %0, 0\n\ts_cbranch_scc1 .Lskipw%=\n\ts_waitcnt vmcnt(8)\n.Lskipw%=:" :: "s"(c) : "memory", "scc")
#else
#define PG8_WAIT_V8_UNLESS(c) PG8_WAIT_V(8)
#endif
#define PG8_WAIT_L(n) asm volatile("s_waitcnt lgkmcnt(" #n ")" ::: "memory")
#define PG8_BAR __builtin_amdgcn_s_barrier()
#define PG8_SCHED __builtin_amdgcn_sched_barrier(0)
    Unit cur, nxt; int ui = 0;
    if (!S.next(0, cur)) return;
    f32x4 acc[2][2][4][2];
#pragma unroll
    for (int a = 0; a < 2; ++a)
#pragma unroll
        for (int b = 0; b < 2; ++b)
#pragma unroll
            for (int m = 0; m < 4; ++m)
#pragma unroll
                for (int n = 0; n < 2; ++n) acc[a][b][m][n] = (f32x4){0.f, 0.f, 0.f, 0.f};
    bf16x8 At[4][2], B0[2][2], B1[2][2];
    const char* bA = (const char*)g.A + (size_t)cur.pm * tstepA; const char* bB = (const char*)g.Bt + (size_t)S.brow(cur) * K * 2;
    int ko = S.koff(cur, nt);
    const char* cA = bA + (size_t)ko * kstep; const char* cB = bB + (size_t)ko * kstep;
    S.a_ready(cur);
    if constexpr (SP2) {
        PG8_STAGE_B(PG8_SB(0, 0), cB, voffB); PG8_STAGE_B(PG8_SB(0, 1), cB + hstep, voffB); PG8_STAGE(PG8_SA(0, 0), cA, voffA); PG8_STAGE(PG8_SA(0, 1), cA + hstepA, voffA);
        if (wr == 1) PG8_BAR;
        PG8_WAIT_V(2); PG8_BAR;
        PG8_STAGE_B(PG8_SB(1, 0), cB + kstep, voffB); PG8_STAGE(PG8_SA(1, 0), cA + kstep, voffA); PG8_STAGE_B(PG8_SB(1, 1), cB + hstep + kstep, voffB);
        PG8_WAIT_V(6); PG8_BAR;
    } else {
        PG8_STAGE_B(PG8_SB(0, 0), cB, voffB); PG8_STAGE(PG8_SA(0, 0), cA, voffA); PG8_STAGE_B(PG8_SB(0, 1), cB + hstep, voffB); PG8_STAGE(PG8_SA(0, 1), cA + hstepA, voffA);
        if (wr == 1) PG8_BAR;
        PG8_WAIT_V(4); PG8_BAR;
        PG8_STAGE_B(PG8_SB(1, 0), cB + kstep, voffB); PG8_STAGE(PG8_SA(1, 0), cA + kstep, voffA); PG8_STAGE_B(PG8_SB(1, 1), cB + hstep + kstep, voffB);
        PG8_WAIT_V(6); PG8_BAR;
    }
    for (;;) {
        const bool has_next = S.next(ui + 1, nxt);
        const char* nbA = has_next ? (const char*)g.A + (size_t)nxt.pm * tstepA : bA; const char* nbB = has_next ? (const char*)g.Bt + (size_t)S.brow(nxt) * K * 2 : bB;
        const int kon = has_next ? S.koff(nxt, nt) : ko;
        const char* nA = nbA + (size_t)kon * kstep; const char* nB = nbB + (size_t)kon * kstep;
        const bool full = !(Sched::HAS_HALF && cur.hf);
        const int ntl = (PROBE == 9 && Epi::PROBE_TWICE) ? 2 * nt : nt;
        for (int t = 0; t < ntl; t += 2) {
            const bool last = (t == ntl - 2);
#if PG8_SKIPW
            int skipv_ = (ui > 0 && t == 0) ? 1 : 0; asm volatile("" : "+v"(skipv_)); const int skipw = __builtin_amdgcn_readfirstlane(skipv_);
#endif
            int t1 = t + 1 + ko, t2 = t + 2 + ko; t1 -= (t1 >= nt) ? nt : 0; t1 -= (t1 >= nt) ? nt : 0; t1 -= (t1 >= nt) ? nt : 0; t2 -= (t2 >= nt) ? nt : 0; t2 -= (t2 >= nt) ? nt : 0; t2 -= (t2 >= nt) ? nt : 0;
            const char* a1 = bA + (size_t)t1 * kstep;
            const char* a2 = last ? nA : bA + (size_t)t2 * kstep; const char* b2 = last ? nB : bB + (size_t)t2 * kstep;
            const char* a3 = a2 + kstep; const char* b3 = b2 + kstep;
            if (last && has_next) S.a_ready(nxt);
            if constexpr (SP2) {
            PG8_LDB(B0, 0, 0); if (full) PG8_LDB(B1, 0, 1); PG8_SCHED; PG8_LDA(At, 0, 0); PG8_STAGE(PG8_SA(1, 1), a1 + hstepA, voffA);
            PG8_WAIT_V8_UNLESS(skipw); PG8_WAIT_L(0); PG8_BAR; PG8_MMA(0, 0, At, B0); if (full) PG8_MMA(0, 1, At, B1); PG8_BAR; PG8_SCHED;
            PG8_LDA(At, 0, 1); PG8_STAGE_B(PG8_SB(0, 0), b2, voffB); PG8_STAGE_B(PG8_SB(0, 1), b2 + hstep, voffB); PG8_STAGE(PG8_SA(0, 0), a2, voffA);
            PG8_WAIT_V8_UNLESS(skipw); PG8_WAIT_L(0); PG8_BAR; PG8_MMA(1, 0, At, B0); if (full) PG8_MMA(1, 1, At, B1); PG8_BAR; PG8_SCHED;
            PG8_LDB(B0, 1, 0); if (full) PG8_LDB(B1, 1, 1); PG8_SCHED; PG8_LDA(At, 1, 0); PG8_STAGE(PG8_SA(0, 1), a2 + hstepA, voffA);
            PG8_WAIT_V(8); PG8_WAIT_L(0); PG8_BAR; PG8_MMA(0, 0, At, B0); if (full) PG8_MMA(0, 1, At, B1); PG8_BAR; PG8_SCHED;
            PG8_LDA(At, 1, 1); PG8_STAGE_B(PG8_SB(1, 0), b3, voffB); PG8_STAGE_B(PG8_SB(1, 1), b3 + hstep, voffB); PG8_STAGE(PG8_SA(1, 0), a3, voffA);
            PG8_WAIT_V(8); PG8_WAIT_L(0); PG8_BAR; PG8_MMA(1, 0, At, B0); if (full) PG8_MMA(1, 1, At, B1); PG8_BAR; PG8_SCHED;
            } else {
            PG8_LDB(B0, 0, 0); PG8_SCHED; PG8_LDA(At, 0, 0); PG8_STAGE(PG8_SA(1, 1), a1 + hstepA, voffA);
            PG8_WAIT_L(8); PG8_BAR; PG8_WAIT_L(0); PG8_MMA(0, 0, At, B0); PG8_BAR; PG8_SCHED;
            PG8_LDB(B1, 0, 1); PG8_STAGE_B(PG8_SB(0, 0), b2, voffB);
            PG8_BAR; PG8_WAIT_L(0); if (full) PG8_MMA(0, 1, At, B1); PG8_BAR;
            PG8_LDA(At, 0, 1); PG8_STAGE(PG8_SA(0, 0), a2, voffA);
            PG8_BAR; PG8_WAIT_L(0); PG8_MMA(1, 0, At, B0); PG8_BAR; PG8_SCHED;
            PG8_STAGE_B(PG8_SB(0, 1), b2 + hstep, voffB);
            PG8_WAIT_V(6); PG8_BAR; if (full) PG8_MMA(1, 1, At, B1); PG8_BAR;
            PG8_LDB(B0, 1, 0); PG8_SCHED; PG8_LDA(At, 1, 0); PG8_STAGE(PG8_SA(0, 1), a2 + hstepA, voffA);
            PG8_WAIT_L(8); PG8_BAR; PG8_WAIT_L(0); PG8_MMA(0, 0, At, B0); PG8_BAR; PG8_SCHED;
            PG8_LDB(B1, 1, 1); PG8_STAGE_B(PG8_SB(1, 0), b3, voffB);
            PG8_BAR; PG8_WAIT_L(0); if (full) PG8_MMA(0, 1, At, B1); PG8_BAR;
            PG8_LDA(At, 1, 1); PG8_STAGE(PG8_SA(1, 0), a3, voffA);
            PG8_BAR; PG8_WAIT_L(0); PG8_MMA(1, 0, At, B0); PG8_BAR; PG8_SCHED;
            PG8_STAGE_B(PG8_SB(1, 1), b3 + hstep, voffB);
            PG8_WAIT_V(6); PG8_BAR; if (full) PG8_MMA(1, 1, At, B1); PG8_BAR;
            }
        }
        if constexpr (ALIGN_EPI) { if (wr == 0) PG8_BAR; }
        if constexpr (!Epi::AFTER_DRAIN) { if (PG8_SKIPW) PG8_WAIT_V(0); E(acc, cur, wr, wc, fr, fq); if (PROBE == 8 && Epi::PROBE_TWICE) { asm volatile("" ::: "memory"); E(acc, cur, wr, wc, fr, fq); } S.done(cur); }
        if (!has_next) break;
#pragma unroll
        for (int a = 0; a < 2; ++a)
#pragma unroll
            for (int b = 0; b < 2; ++b)
#pragma unroll
                for (int m = 0; m < 4; ++m)
#pragma unroll
                    for (int n = 0; n < 2; ++n) acc[a][b][m][n] = (f32x4){0.f, 0.f, 0.f, 0.f};
        cur = nxt; bA = nbA; bB = nbB; ko = kon; ++ui;
        if constexpr (ALIGN_EPI) { if (wr == 1) PG8_BAR; }
    }
    PG8_WAIT_V(0);
    if constexpr (!ALIGN_EPI) { if (wr == 0) PG8_BAR; }
    PG8_BAR;
    if constexpr (Epi::AFTER_DRAIN) { E.fused(acc, cur, wr, wc, fr, fq, lds, wid, lane); S.done(cur); }
#undef PG8_SA
#undef PG8_SB
#undef PG8_STAGE
#undef PG8_STAGE_B
#undef PG8_LDA
#undef PG8_LDB
#undef PG8_MMA
#undef PG8_WAIT_V
#undef PG8_WAIT_V8_UNLESS
#undef PG8_WAIT_L
#undef PG8_BAR
#undef PG8_SCHED
}
}

constexpr int NWAVES = 8;
constexpr int BATCH = 2, SEQ = 8192, D = 1024, DEPTH = 4, M = BATCH * SEQ;
constexpr int AP = 4096 + 64;
constexpr int GH = 2048, GH2 = 4096, SGU_G = 8, SGU_P = 128, SGU_C = 256;
constexpr int NH = 16, HD = 64, NREL = 192, CHUNK = 64;
constexpr int FF = 2816, FF2 = 5632, FF_NFULL = 20;
constexpr float EPS = 1e-6f;
constexpr float LOG2E = 1.4426950408889634f;
constexpr float QSCALE = 0.125f * LOG2E;

#ifndef MK_PER_PHASE
#define MK_PER_PHASE 0
#endif
constexpr int N_PHASES = 22;

constexpr size_t MiB = 1u << 20;
constexpr size_t WS_CTL = 0, CTL_ZERO_BYTES = 64 * 1024;
constexpr size_t WS_XSS = 1 * MiB;
constexpr size_t WS_VSS = 2 * MiB;
constexpr size_t WS_W = 4 * MiB;
constexpr size_t WS_XB = 110 * MiB;
constexpr size_t WS_ACT = 142 * MiB;
constexpr size_t WS_END = 273 * MiB;
constexpr size_t WO_IN = 0, WO_AOUT = 8388608, WO_QKV = 12582912, WO_BOUT = 18874368, WO_GU = 20971520, WO_DN = 44040192, WO_END = 55574528;
static_assert(WS_W + WO_END * 2 <= WS_XB && WS_XB + (size_t)M * D * 2 <= WS_ACT && WS_ACT + (size_t)M * AP * 2 <= WS_END, "d_ws map");
constexpr int CW_BAR = 1024;

constexpr int RING_OFF = 0, RING_BYTES = 131072;
constexpr int LDSCTL_OFF = RING_BYTES, MISC_OFF = LDSCTL_OFF + 320, RSTAB_OFF = LDSCTL_OFF + 1024;
constexpr int LDS_BYTES = 147456;
static_assert(MISC_OFF + 128 <= LDS_BYTES, "LDS map");

#define GAS __attribute__((address_space(1)))
#define LAS __attribute__((address_space(3)))
typedef unsigned short bf16;
typedef unsigned v4u __attribute__((ext_vector_type(4)));
typedef unsigned v2u __attribute__((ext_vector_type(2)));
typedef float f32x4 __attribute__((ext_vector_type(4)));
typedef float f32x16 __attribute__((ext_vector_type(16)));
typedef short bf16x8 __attribute__((ext_vector_type(8)));
typedef short s16x4 __attribute__((ext_vector_type(4)));
typedef GAS unsigned gu32;
#define RLX_AGENT __ATOMIC_RELAXED, __HIP_MEMORY_SCOPE_AGENT
#define LDS_WAIT() asm volatile("s_waitcnt lgkmcnt(0)" ::: "memory")
#define VM_WAIT() asm volatile("s_waitcnt vmcnt(0)" ::: "memory")
__device__ __forceinline__ unsigned pk2(float lo, float hi) { return pg8::cvt_pk_bf16(lo, hi); }
__device__ __forceinline__ float bf_lo(unsigned w) { return __uint_as_float(w << 16); }
__device__ __forceinline__ float bf_hi(unsigned w) { return __uint_as_float(w & 0xffff0000u); }
__device__ __forceinline__ float wave_sum(float v) {
#pragma unroll
    for (int o = 1; o < 64; o <<= 1) v += __shfl_xor(v, o);
    return v;
}
#define XB_TMO      128
#define XB_XCNT(j)  (256  + 64 * (j))
#define XB_XSUB(j)  (1280 + 64 * (j))
#define XB_XGEN(j)  (2304 + 64 * (j))
#define XB_TOP      3328
#define XB_TOPGEN   3392
#define XB_LSUB(j)  (3456 + 64 * (j))
#define XB_LGEN(j)  (4480 + 64 * (j))
#define XCD_BAR_WORDS 5504
#define XB_SPIN_CAP (1u << 18)
#ifndef XB_EARLY
#define XB_EARLY 1
#endif
#if XB_EARLY
#define XB_EARLY_INV() asm volatile("buffer_inv sc1" ::: "memory")
#define XB_LATE_ACQ()  asm volatile("" ::: "memory")
#else
#define XB_EARLY_INV() do { } while (0)
#define XB_LATE_ACQ()  __builtin_amdgcn_fence(__ATOMIC_ACQUIRE, "agent")
#endif

__device__ __forceinline__ unsigned xb_ld(unsigned* p)              { return __hip_atomic_load(p, __ATOMIC_RELAXED, __HIP_MEMORY_SCOPE_AGENT); }
__device__ __forceinline__ unsigned xb_add(unsigned* p, unsigned v) { return __hip_atomic_fetch_add(p, v, __ATOMIC_RELAXED, __HIP_MEMORY_SCOPE_AGENT); }
__device__ __forceinline__ unsigned xb_xcc_id() { return (unsigned)__builtin_amdgcn_s_getreg((3 << 11) | 20) & 0xFu; }
#define XB_SPIN(cond, bar) do { unsigned _sp = 0; while (cond) { __builtin_amdgcn_s_sleep(1); \
    if ((++_sp & 255u) == 0u) { if (xb_ld(&(bar)[XB_TMO])) break; if (_sp > XB_SPIN_CAP) { atomicAdd(&(bar)[XB_TMO], 1u); break; } } } } while (0)

struct XcdBarrier {
    unsigned* bar; unsigned x;
    volatile LAS unsigned* st;
};

__device__ __forceinline__ XcdBarrier xcd_barrier_post(unsigned* bar, volatile LAS unsigned* st) {
    XcdBarrier b; b.bar = bar; b.x = xb_xcc_id(); b.st = st;
    if (threadIdx.x == 0) st[3] = xb_add(&bar[XB_XCNT(b.x)], 1u);
    return b;
}
__device__ __forceinline__ void xcd_barrier_complete(unsigned* bar, unsigned x, unsigned& nloc, unsigned& nx, unsigned& xi) {
    const unsigned G = gridDim.x * gridDim.y * gridDim.z;
    unsigned sum, cnt, mine, below, sp = 0u;
    for (;;) {
        sum = 0u; cnt = 0u; mine = 0u; below = 0u;
#pragma unroll
        for (unsigned j = 0; j < 16; ++j) { const unsigned c = xb_ld(&bar[XB_XCNT(j)]); sum += c; cnt += (c > 0u) ? 1u : 0u; mine = (j == x) ? c : mine; below += (j < x && c > 0u) ? 1u : 0u; }
        if (sum == G) break;
        __builtin_amdgcn_s_sleep(1);
        if ((++sp & 255u) == 0u) { if (xb_ld(&bar[XB_TMO])) break; if (sp > XB_SPIN_CAP) { atomicAdd(&bar[XB_TMO], 1u); break; } }
    }
    nloc = mine > 0u ? mine : 1u; nx = cnt > 0u ? cnt : 1u; xi = below;
}

__device__ __forceinline__ void xcd_barrier(const XcdBarrier& b) {
    asm volatile("s_waitcnt vmcnt(0)" ::: "memory");
    __syncthreads();
    if (threadIdx.x == 0) {
        const unsigned bx_ = xb_xcc_id();
        unsigned* bar = b.bar; asm volatile("" : "+s"(bar));
        __builtin_amdgcn_s_waitcnt(0);
        XB_EARLY_INV();
        unsigned nloc = b.st[0], nx = b.st[1];
        if (nloc == 0u) { unsigned xi_; xcd_barrier_complete(bar, bx_, nloc, nx, xi_); b.st[0] = nloc; b.st[1] = nx; b.st[2] = xi_; }
        const unsigned old = xb_add(&bar[XB_XSUB(bx_)], 1u);
        const unsigned gen = old / nloc;
        if (old + 1u == (gen + 1u) * nloc) {
            __builtin_amdgcn_fence(__ATOMIC_RELEASE, "agent");
            asm volatile("s_waitcnt vmcnt(0)" ::: "memory");
            const unsigned og = xb_add(&bar[XB_TOP], 1u);
            const unsigned tg = og / nx;
            if (og + 1u == (tg + 1u) * nx) xb_add(&bar[XB_TOPGEN], 1u);
            else XB_SPIN(xb_ld(&bar[XB_TOPGEN]) == tg, bar);
            XB_LATE_ACQ();
            xb_add(&bar[XB_XGEN(bx_)], 1u);
            asm volatile("s_waitcnt vmcnt(0)" ::: "memory");
        } else {
            XB_SPIN(xb_ld(&bar[XB_XGEN(bx_)]) == gen, bar);
            XB_LATE_ACQ();
            asm volatile("s_waitcnt vmcnt(0)" ::: "memory");
        }
    }
    __syncthreads();
}

__device__ __forceinline__ void xcd_barrier_local(const XcdBarrier& b) {
    asm volatile("s_waitcnt vmcnt(0)" ::: "memory");
    __syncthreads();
    if (threadIdx.x == 0) {
        const unsigned bx_ = xb_xcc_id();
        unsigned* bar = b.bar; asm volatile("" : "+s"(bar));
        const unsigned nloc = b.st[0];
        XB_EARLY_INV();
        const unsigned old = xb_add(&bar[XB_LSUB(bx_)], 1u);
        const unsigned gen = old / nloc;
        if (old + 1u == (gen + 1u) * nloc) xb_add(&bar[XB_LGEN(bx_)], 1u);
        else XB_SPIN(xb_ld(&bar[XB_LGEN(bx_)]) == gen, bar);
        XB_LATE_ACQ();
        asm volatile("s_waitcnt vmcnt(0)" ::: "memory");
    }
    __syncthreads();
}

__device__ __forceinline__ void p0_transpose_item(const float* W, const float* gain, int K, int N, bf16* WT, int drow0, bool sp, int k0, int n0, LAS unsigned* scr, int lane) {
    const int kp = lane >> 4, n4 = lane & 15;
    f32x4 w[8][2];
    const float* src = W + (size_t)(k0 + 2 * kp) * N + n0 + 4 * n4;
#pragma unroll
    for (int i = 0; i < 8; ++i) { w[i][0] = __builtin_nontemporal_load((const f32x4*)(src + (size_t)(8 * i) * N)); w[i][1] = __builtin_nontemporal_load((const f32x4*)(src + (size_t)(8 * i + 1) * N)); }
    if (gain) {
#pragma unroll
        for (int i = 0; i < 8; ++i) { const float g0 = gain[k0 + 8 * i + 2 * kp], g1 = gain[k0 + 8 * i + 2 * kp + 1]; w[i][0] = w[i][0] * g0; w[i][1] = w[i][1] * g1; }
    }
#pragma unroll
    for (int i = 0; i < 8; ++i)
#pragma unroll
        for (int e = 0; e < 4; ++e) scr[(4 * n4 + e) * 33 + 4 * i + kp] = pk2(w[i][0][e], w[i][1][e]);
    LDS_WAIT(); asm volatile("" ::: "memory");
    const int c = lane & 7;
#pragma unroll
    for (int jn = 0; jn < 8; ++jn) { const int n = (lane >> 3) + 8 * jn; const LAS unsigned* s = scr + n * 33 + 4 * c;
        v4u o; o.x = s[0]; o.y = s[1]; o.z = s[2]; o.w = s[3];
        const int dr = sp ? ((n >> 4) * 32 + ((n & 15) >> 2) * 8 + (n & 3)) : n;
        pg8::store16(WT + (size_t)(drow0 + dr) * K + k0 + 8 * c, o); }
    LDS_WAIT(); asm volatile("" ::: "memory");
}
struct Ptrs {
    const float *x, *norm_mix_g, *norm_ffn_g, *final_g, *a_w_in, *a_v_gain, *a_w_s, *a_b_s, *a_w_out, *b_w_qkv, *b_rel_bias, *b_w_out, *ffn_w_gate, *ffn_w_up, *ffn_w_down;
    float* out; bf16* wt; bf16* xb; bf16* act; float* xss; float* vss;
};
__device__ __forceinline__ void p0_prologue(const Ptrs& P, LAS unsigned char* lds, int vcu, int G, int wave, int lane) {
    LAS unsigned* scr = (LAS unsigned*)(lds + RING_OFF + wave * 16384);
    const int gw = vcu * NWAVES + wave, NGW = G * NWAVES;
    constexpr int I_IN = 16 * 64, I_AOUT = 32 * 16, I_QKV = 16 * 48, I_BOUT = 16 * 16, I_GU = 16 * 44, I_DN = 44 * 16;
    constexpr int NITEMS = 2 * I_IN + 2 * I_AOUT + 2 * I_QKV + 2 * I_BOUT + 8 * I_GU + 4 * I_DN;
    for (int it = gw; it < NITEMS; it += NGW) {
        int r = it; const float* W; const float* gain = nullptr; bf16* dst; int K, N, mode = 0;
        if (r < 2 * I_IN) { const int j = r / I_IN; r -= j * I_IN; W = P.a_w_in + (size_t)j * D * GH2; gain = P.norm_mix_g + (2 * j) * D; K = D; N = GH2; dst = P.wt + WO_IN + (size_t)j * D * GH2; }
        else if ((r -= 2 * I_IN) < 2 * I_AOUT) { const int j = r / I_AOUT; r -= j * I_AOUT; W = P.a_w_out + (size_t)j * GH * D; K = GH; N = D; dst = P.wt + WO_AOUT + (size_t)j * GH * D; }
        else if ((r -= 2 * I_AOUT) < 2 * I_QKV) { const int j = r / I_QKV; r -= j * I_QKV; W = P.b_w_qkv + (size_t)j * D * 3 * D; gain = P.norm_mix_g + (2 * j + 1) * D; K = D; N = 3 * D; dst = P.wt + WO_QKV + (size_t)j * D * 3 * D; }
        else if ((r -= 2 * I_QKV) < 2 * I_BOUT) { const int j = r / I_BOUT; r -= j * I_BOUT; W = P.b_w_out + (size_t)j * D * D; K = D; N = D; dst = P.wt + WO_BOUT + (size_t)j * D * D; }
        else if ((r -= 2 * I_BOUT) < 4 * I_GU) { const int i = r / I_GU; r -= i * I_GU; W = P.ffn_w_gate + (size_t)i * D * FF; gain = P.norm_ffn_g + i * D; K = D; N = FF; dst = P.wt + WO_GU + (size_t)i * D * FF2; mode = 1; }
        else if ((r -= 4 * I_GU) < 4 * I_GU) { const int i = r / I_GU; r -= i * I_GU; W = P.ffn_w_up + (size_t)i * D * FF; gain = P.norm_ffn_g + i * D; K = D; N = FF; dst = P.wt + WO_GU + (size_t)i * D * FF2; mode = 2; }
        else { r -= 4 * I_GU; const int i = r / I_DN; r -= i * I_DN; W = P.ffn_w_down + (size_t)i * FF * D; K = FF; N = D; dst = P.wt + WO_DN + (size_t)i * FF * D; }
        const int nblk = N / 64, kb = r / nblk, nb = r % nblk, k0 = 64 * kb, n0 = 64 * nb;
        const bool sp = (mode != 0) && (n0 >= FF_NFULL * 128);
        const int drow0 = (mode == 0) ? n0 : sp ? (FF_NFULL * 256 + ((n0 - FF_NFULL * 128) >> 6) * 128 + (mode == 2 ? 4 : 0)) : ((n0 >> 7) * 256 + (n0 & 127) + (mode == 2 ? 128 : 0));
        p0_transpose_item(W, gain, K, N, dst, drow0, sp, k0, n0, scr, lane);
    }
    for (int m = gw; m < M; m += 2 * NGW) {
        const int m2 = (m + NGW < M) ? m + NGW : m;
        const GAS f32x4* xr = (const GAS f32x4*)(P.x + (size_t)m * D) + 2 * lane; const GAS f32x4* xr2 = (const GAS f32x4*)(P.x + (size_t)m2 * D) + 2 * lane; f32x4 v[4], v2[4]; float s = 0.f, s2 = 0.f;
#pragma unroll
        for (int j = 0; j < 2; ++j) { v[2 * j] = __builtin_nontemporal_load(xr + 128 * j); v[2 * j + 1] = __builtin_nontemporal_load(xr + 128 * j + 1); v2[2 * j] = __builtin_nontemporal_load(xr2 + 128 * j); v2[2 * j + 1] = __builtin_nontemporal_load(xr2 + 128 * j + 1); }
#pragma unroll
        for (int j = 0; j < 4; ++j) { s += (v[j].x * v[j].x + v[j].y * v[j].y) + (v[j].z * v[j].z + v[j].w * v[j].w); s2 += (v2[j].x * v2[j].x + v2[j].y * v2[j].y) + (v2[j].z * v2[j].z + v2[j].w * v2[j].w); }
        s = wave_sum(s); s2 = wave_sum(s2);
        bf16* o8 = P.xb + (size_t)m * D + 8 * lane; bf16* o82 = P.xb + (size_t)m2 * D + 8 * lane;
#pragma unroll
        for (int j = 0; j < 2; ++j) {
            v4u w; w.x = pk2(v[2 * j].x, v[2 * j].y); w.y = pk2(v[2 * j].z, v[2 * j].w); w.z = pk2(v[2 * j + 1].x, v[2 * j + 1].y); w.w = pk2(v[2 * j + 1].z, v[2 * j + 1].w); pg8::store16(o8 + 512 * j, w);
            v4u w2; w2.x = pk2(v2[2 * j].x, v2[2 * j].y); w2.y = pk2(v2[2 * j].z, v2[2 * j].w); w2.z = pk2(v2[2 * j + 1].x, v2[2 * j + 1].y); w2.w = pk2(v2[2 * j + 1].z, v2[2 * j + 1].w); pg8::store16(o82 + 512 * j, w2); }
        if (lane < pg8::NSLOT_X) { P.xss[(size_t)m * pg8::NSLOT_X + lane] = (lane == 0) ? s : 0.f; P.xss[(size_t)m2 * pg8::NSLOT_X + lane] = (lane == 0) ? s2 : 0.f; }
    }
}

constexpr int SP_A_PITCH = 272, SP_V_PITCH = 528;
constexpr int SP_A_OFF = 0, SP_V_OFF = 36864, SP_R_OFF = 106496;
typedef short v4i16_t __attribute__((ext_vector_type(4)));
__device__ __forceinline__ s16x4 tr_read(const LAS unsigned char* p) { return __builtin_bit_cast(s16x4, __builtin_amdgcn_ds_read_tr16_b64_v4i16((LAS v4i16_t*)p)); }
template <bool DRY> __device__ __forceinline__ void spatial_phase(const Ptrs& P, int j, LAS unsigned char* lds, int vcu, int G, int wave, const pg8::Sch sc) {
    int tid = threadIdx.x; asm volatile("" : "+v"(tid)); const int lane = tid & 63;
    bf16* uv = P.act;
    LAS unsigned char* Aimg = lds + SP_A_OFF; LAS unsigned char* Vimg = lds + SP_V_OFF; LAS float* rsL = (LAS float*)(lds + SP_R_OFF);
    const int fr = lane & 15, fq = lane >> 4;
    const int NU = sc.lm ? 128 : (M / SGU_P) * SGU_G, ufirst = sc.lm ? sc.rank : vcu, ustride = sc.lm ? sc.nloc : G, ubase = sc.lm ? 128 * sc.gi : 0;
    f32x4 sv[2]; v4u vt[8]; f32x4 wq[8]; v4u uq[8]; float bq[8]; f32x4 gq0, gq1;
#define SP_LOAD_A(U) do { const int g_ = (U) & 7, row0_ = ((U) >> 3) * SGU_P; \
        { const f32x4* p_ = (const f32x4*)(P.vss + (size_t)(row0_ + (tid >> 2)) * pg8::NSLOT_V) + (tid & 3) * 2; sv[0] = p_[0]; sv[1] = p_[1]; } \
        _Pragma("unroll") for (int i = 0; i < 8; ++i) { const int pc = tid + 512 * i, q = pc >> 5, ch = pc & 31; vt[i] = __builtin_nontemporal_load((const v4u*)(uv + (size_t)(row0_ + q) * AP + GH + g_ * SGU_C + ch * 8)); } \
        { const float* ws_ = P.a_w_s + ((size_t)j * SGU_G + g_) * SGU_P * SGU_P; \
          _Pragma("unroll") for (int i = 0; i < 4; ++i) { const int e = tid + 512 * i, p = e >> 4, q0 = (e & 15) * 8; wq[2 * i] = *(const f32x4*)(ws_ + p * SGU_P + q0); wq[2 * i + 1] = *(const f32x4*)(ws_ + p * SGU_P + q0 + 4); } } } while (0)
#define SP_LOAD_B(U) do { const int g_ = (U) & 7, row0_ = ((U) >> 3) * SGU_P; \
        { const int cc_ = g_ * SGU_C + 32 * wave + 8 * fq; gq0 = *(const f32x4*)(P.a_v_gain + (size_t)j * GH + cc_); gq1 = *(const f32x4*)(P.a_v_gain + (size_t)j * GH + cc_ + 4); \
          _Pragma("unroll") for (int pt = 0; pt < 8; ++pt) { const int p = 16 * pt + fr; uq[pt] = __builtin_nontemporal_load((const v4u*)(uv + (size_t)(row0_ + p) * AP + cc_)); bq[pt] = P.a_b_s[((size_t)j * SGU_G + g_) * SGU_P + p]; } } } while (0)
    int uk = ufirst;
    if (uk < NU) { SP_LOAD_A(uk + ubase); SP_LOAD_B(uk + ubase); }
    for (; uk < NU; uk += ustride) {
        const int unit = uk + ubase, nb = unit >> 3, g = unit & 7, row0 = nb * SGU_P;
        { float s = ((sv[0][0] + sv[0][1]) + (sv[0][2] + sv[0][3])) + ((sv[1][0] + sv[1][1]) + (sv[1][2] + sv[1][3])); s += __shfl_xor(s, 1); s += __shfl_xor(s, 2);
            if ((tid & 3) == 0) rsL[tid >> 2] = __builtin_amdgcn_rsqf(s * (1.0f / GH) + EPS); }
#pragma unroll
        for (int i = 0; i < 8; ++i) { const int pc = tid + 512 * i, q = pc >> 5, ch = pc & 31; *(LAS v4u*)(Vimg + q * SP_V_PITCH + ch * 16) = vt[i]; }
        __syncthreads();
#pragma unroll
        for (int i = 0; i < 4; ++i) { const int e = tid + 512 * i, p = e >> 4, q0 = (e & 15) * 8;
            const f32x4 w0 = wq[2 * i], w1 = wq[2 * i + 1];
            const f32x4 r0 = *(const LAS f32x4*)(rsL + q0), r1 = *(const LAS f32x4*)(rsL + q0 + 4);
            v4u o; o.x = pk2(w0[0] * r0[0], w0[1] * r0[1]); o.y = pk2(w0[2] * r0[2], w0[3] * r0[3]); o.z = pk2(w1[0] * r1[0], w1[1] * r1[1]); o.w = pk2(w1[2] * r1[2], w1[3] * r1[3]);
            *(LAS v4u*)(Aimg + p * SP_A_PITCH + q0 * 2) = o; }
        __syncthreads();
        if (uk + ustride < NU) SP_LOAD_A(unit + ustride);
        const f32x4 gn0 = gq0, gn1 = gq1;
        bf16x8 vf[2][4];
        { const LAS unsigned char* vb = Vimg + (8 * fq + ((lane & 15) >> 2)) * SP_V_PITCH + (32 * wave + 8 * (lane & 3)) * 2;
#pragma unroll
            for (int ks = 0; ks < 4; ++ks)
#pragma unroll
                for (int n = 0; n < 2; ++n) { const s16x4 lo = tr_read(vb + ks * 32 * SP_V_PITCH + n * 8), hi = tr_read(vb + ks * 32 * SP_V_PITCH + 4 * SP_V_PITCH + n * 8);
                    vf[n][ks] = (bf16x8){lo[0], lo[1], lo[2], lo[3], hi[0], hi[1], hi[2], hi[3]}; } }
        const int cc = g * SGU_C + 32 * wave + 8 * fq;
#pragma unroll
        for (int pt = 0; pt < 8; ++pt) {
            f32x4 a0 = {0.f, 0.f, 0.f, 0.f}, a1 = {0.f, 0.f, 0.f, 0.f};
            const LAS unsigned char* ab = Aimg + (16 * pt + fr) * SP_A_PITCH + (8 * fq) * 2;
#pragma unroll
            for (int ks = 0; ks < 4; ++ks) if (ks < (pt < 4 ? 2 : 4)) { const bf16x8 af = *(const LAS bf16x8*)(ab + ks * 64);
                a0 = __builtin_amdgcn_mfma_f32_16x16x32_bf16(vf[0][ks], af, a0, 0, 0, 0); a1 = __builtin_amdgcn_mfma_f32_16x16x32_bf16(vf[1][ks], af, a1, 0, 0, 0); }
            const int p = 16 * pt + fr; bf16* up = uv + (size_t)(row0 + p) * AP + cc;
            const float b = bq[pt]; const v4u u8 = uq[pt];
            v4u o;
            o.x = pk2(bf_lo(u8.x) * (gn0[0] * a0[0] + b), bf_hi(u8.x) * (gn0[1] * a0[1] + b)); o.y = pk2(bf_lo(u8.y) * (gn0[2] * a0[2] + b), bf_hi(u8.y) * (gn0[3] * a0[3] + b));
            o.z = pk2(bf_lo(u8.z) * (gn1[0] * a1[0] + b), bf_hi(u8.z) * (gn1[1] * a1[1] + b)); o.w = pk2(bf_lo(u8.w) * (gn1[2] * a1[2] + b), bf_hi(u8.w) * (gn1[3] * a1[3] + b));
            if (DRY) *(v4u*)((bf16*)P.out + (size_t)(row0 + p) * D + (g & 3) * SGU_C + 32 * wave + 8 * fq) = o; else pg8::store16(up, o);
        }
        asm volatile("" ::: "memory");
        if (uk + ustride < NU) SP_LOAD_B(unit + ustride);
        __syncthreads();
    }
#undef SP_LOAD_A
#undef SP_LOAD_B
}

constexpr int AT_NSL = 8, AT_K = 0, AT_V = AT_NSL * 8192, AT_BT = RSTAB_OFF + 1024, AT_WS = AT_BT + 1024, AT_OST = AT_K;
static_assert(AT_WS + 2048 <= LDS_BYTES && 2 * AT_NSL * 8192 <= RING_BYTES, "attention LDS map");
constexpr int AT_ZV = LDSCTL_OFF + 8192;
static_assert(AT_ZV + 8192 <= LDS_BYTES && AT_WS + 2048 <= AT_ZV, "attention zero region");
constexpr float ATT_THR = 8.0f;
__device__ __forceinline__ int crow(int r, int hi) { return (r & 3) + 8 * (r >> 2) + 4 * hi; }
#define MX3(a, b, c) __builtin_fmaxf(__builtin_fmaxf((a), (b)), (c))
__device__ __forceinline__ void glds16(const void* gsrc, unsigned lds_dst) { unsigned keep;
    asm volatile("s_mov_b32 %0, m0\n\ts_mov_b32 m0, %2\n\ts_nop 0\n\tglobal_load_lds_dwordx4 %1, off\n\ts_mov_b32 m0, %0" : "=&s"(keep) : "v"(gsrc), "s"(lds_dst) : "memory"); }
template <int DRY> __device__ __forceinline__ void attn_phase(const Ptrs& P, int j, LAS unsigned char* lds, int vcu, int G, int wave, const pg8::Sch sc) {
    int tid = threadIdx.x; asm volatile("" : "+v"(tid)); const int lane = tid & 63;
    bf16* Q = P.act; const bf16* Kt = P.act + D; const bf16* Vt = P.act + 2 * D;
    const int r32 = lane & 31, hi = lane >> 5, ci = wave >> 1, qh = wave & 1;
    LAS float* bt = (LAS float*)(lds + AT_BT); LAS float* wsf = (LAS float*)(lds + AT_WS) + wave * 64;
    const unsigned lds0 = (unsigned)(size_t)lds;
    const int NUA = sc.lm ? 128 : BATCH * NH * (SEQ / 256), afirst = sc.lm ? sc.rank : vcu, astride = sc.lm ? sc.nloc : G;
#define ATT_DEC(UK, B_, H_, CQ_) do { if (sc.lm) { const int p_ = 8 * sc.gi + ((UK) & 7); H_ = (UK) >> 3; B_ = p_ >> 5; CQ_ = p_ & 31; } else { const int bh_ = (UK) >> 5; CQ_ = (UK) & 31; B_ = bh_ >> 4; H_ = bh_ & 15; } } while (0)
#define ATT_SLOT(t, pr) ((((t) + 4 * (pr)) & 7) * 8192)
    int par = 0;
    bf16x8 qnx[4] = {}; float rbx0 = 0.f, rbx1 = 0.f;
    for (int uk = afirst; uk < NUA; uk += astride, par ^= 1) {
        int b, h, cq; ATT_DEC(uk, b, h, cq);
        const size_t rowbase = (size_t)b * SEQ;
        const size_t qrow = rowbase + (size_t)(4 * cq + ci) * CHUNK + 32 * qh;
        const int s_lo = (4 * cq >= 8) ? 0 : 8 - 4 * cq;
        const long trow0 = (long)rowbase + (long)(4 * cq - 8) * CHUNK;
        const bf16* ksrc = Kt + (trow0 + 8 * wave + (lane >> 3)) * AP + h * HD + ((lane & 7) ^ ((4 * (wave & 1) + (lane >> 4)) & 7)) * 8;
        const bf16* vsrc = Vt + (trow0 + 16 * (wave & 3) + (lane >> 2)) * AP + h * HD + (wave >> 2) * 32 + (lane & 3) * 8;
        const bool has_n = uk + astride < NUA; int bn = 0, hn = 0, cqn = 0; if (has_n) ATT_DEC(uk + astride, bn, hn, cqn);
        const int s_lo_n = has_n ? ((4 * cqn >= 8) ? 0 : 8 - 4 * cqn) : 99;
        const long trow0n = (long)bn * SEQ + (long)(4 * cqn - 8) * CHUNK;
        const bf16* ksrcn = Kt + (trow0n + 8 * wave + (lane >> 3)) * AP + hn * HD + ((lane & 7) ^ ((4 * (wave & 1) + (lane >> 4)) & 7)) * 8;
        const bf16* vsrcn = Vt + (trow0n + 16 * (wave & 3) + (lane >> 2)) * AP + hn * HD + (wave >> 2) * 32 + (lane & 3) * 8;
#define ATT_DMA_X(KS, VS, t, pr) do { const int sl_ = ATT_SLOT(t, pr); \
            glds16((KS) + (long)(t) * CHUNK * AP, (unsigned)__builtin_amdgcn_readfirstlane((int)(lds0 + AT_K + sl_ + wave * 1024))); \
            glds16((VS) + (long)(t) * CHUNK * AP, (unsigned)__builtin_amdgcn_readfirstlane((int)(lds0 + AT_V + sl_ + wave * 1024))); } while (0)
#define ATT_DMA(t) ATT_DMA_X(ksrc, vsrc, t, par)
#define ATT_DMA_ANY(T) do { if ((T) < 12) { if ((T) >= s_lo) ATT_DMA(T); } else { if ((T) - 12 >= s_lo_n) ATT_DMA_X(ksrcn, vsrcn, (T) - 12, par ^ 1); } } while (0)
#pragma unroll
        for (int t = 0; t < 5; ++t) if (uk == afirst && t >= s_lo) ATT_DMA(t);
        bf16x8 qr[4]; float rbv = rbx0, rbf = rbx1;
        if (uk == afirst) {
#pragma unroll
            for (int d0 = 0; d0 < 4; ++d0) qr[d0] = __builtin_nontemporal_load((const bf16x8*)(Q + (qrow + r32) * AP + h * HD + d0 * 16 + hi * 8));
            if (tid < NREL) { const float* rb = P.b_rel_bias + ((size_t)j * NH + h) * NREL; rbv = rb[tid]; rbf = rb[NREL - 1]; }
        } else {
#pragma unroll
            for (int d0 = 0; d0 < 4; ++d0) qr[d0] = qnx[d0];
        }
        if (tid < 256) bt[tid] = tid < NREL ? (rbv - rbf) * LOG2E : 0.f;
        asm volatile("" :: "v"(qr[0]), "v"(qr[1]), "v"(qr[2]), "v"(qr[3]));
        float mhat = 0.f, lrun = 0.f; f32x16 o0 = {}, o1 = {};
        v4u pwp[4] = {}; const LAS unsigned char* vprev = lds + AT_ZV;
        const int j_first = (s_lo > ci) ? s_lo - ci : 0;
#pragma unroll 1
        for (int jj = 0; jj < 9; ++jj) {
            const int s = ci + jj;
            if ((jj & 1) == 0) {
                asm volatile("s_waitcnt vmcnt(0)" ::: "memory");
                __syncthreads();
                ATT_DMA_ANY(jj + 5);
                ATT_DMA_ANY(jj + 6);
            }
            const int delta = 8 - jj;
            if (jj >= j_first && DRY != 2) {
                const LAS unsigned char* Ks = lds + AT_K + ATT_SLOT(s, par); const LAS unsigned char* Vs = lds + AT_V + ATT_SLOT(s, par);
                f32x16 p0, p1;
                { const float c0 = -mhat;
#pragma unroll
                    for (int r = 0; r < 16; ++r) { p0[r] = c0; p1[r] = c0; } }
                { const LAS unsigned char* kb = Ks + r32 * 128; const int kx = (r32 >> 1) & 7; bf16x8 kf[8];
#pragma unroll
                    for (int d0 = 0; d0 < 4; ++d0) { const int kp = ((2 * d0 + hi) ^ kx) * 16; kf[2 * d0] = *(const LAS bf16x8*)(kb + kp); kf[2 * d0 + 1] = *(const LAS bf16x8*)(kb + 4096 + kp); }
                    __builtin_amdgcn_sched_barrier(0);
#pragma unroll
                    for (int d0 = 0; d0 < 4; ++d0) { p0 = __builtin_amdgcn_mfma_f32_32x32x16_bf16(kf[2 * d0], qr[d0], p0, 0, 0, 0); p1 = __builtin_amdgcn_mfma_f32_32x32x16_bf16(kf[2 * d0 + 1], qr[d0], p1, 0, 0, 0); } }
                if (delta < 3) {
                    const LAS float* bp = bt + (64 * delta + 32 * qh + r32 - 4 * hi);
                    asm volatile("" : "+v"(bp));
                    typedef pg8::f32x2 f32x2; typedef f32x2 __attribute__((aligned(4))) f32x2u;
                    f32x2 b0[8], b1[8];
#pragma unroll
                    for (int r = 0; r < 16; r += 2) { const int kc = (r & 3) + 8 * (r >> 2);
                        b0[r >> 1] = *(const LAS f32x2u*)(bp + 62 - kc); b1[r >> 1] = *(const LAS f32x2u*)(bp + 30 - kc); }
#pragma unroll
                    for (int r = 0; r < 8; ++r) { asm volatile("" : "+v"(b0[r])); asm volatile("" : "+v"(b1[r])); }
#pragma unroll
                    for (int r = 0; r < 16; r += 2) { p0[r] += b0[r >> 1][1]; p0[r + 1] += b0[r >> 1][0]; p1[r] += b1[r >> 1][1]; p1[r + 1] += b1[r >> 1][0]; }
                }
                float rm;
                { float a = MX3(p0[0], p0[1], p1[0]), c = MX3(p0[2], p0[3], p1[1]); a = MX3(a, p1[2], p1[3]);
#pragma unroll
                    for (int r = 4; r < 16; r += 4) { a = MX3(a, p0[r], p0[r + 1]); c = MX3(c, p0[r + 2], p0[r + 3]); a = MX3(a, p1[r], p1[r + 1]); c = MX3(c, p1[r + 2], p1[r + 3]); }
                    rm = __builtin_fmaxf(a, c);
                    auto rr = __builtin_amdgcn_permlane32_swap(__float_as_uint(rm), __float_as_uint(rm), false, false); rm = __builtin_fmaxf(__uint_as_float(rr[0]), __uint_as_float(rr[1])); }
                float dl = 0.f; bool resc = false;
                if (jj == j_first) { dl = rm; mhat = rm; }
                else if (__any(rm > ATT_THR)) {
                    dl = __builtin_fmaxf(rm, 0.f); mhat += dl;
                    const float f = __builtin_amdgcn_exp2f(-dl); lrun *= f;
                    if (hi == 0) wsf[r32] = f;
                    resc = true;
                }
                { const LAS unsigned char* vb = vprev + ((lane >> 4) & 1) * 32 + (lane & 3) * 8 + (4 * hi + ((lane & 15) >> 2)) * 64;
#pragma unroll
                    for (int kh = 0; kh < 2; ++kh) {
                        s16x4 vl[4], vh[4];
#pragma unroll
                        for (int i = 0; i < 4; ++i) { const int ks = 2 * kh + (i >> 1), dh = i & 1; vl[i] = tr_read(vb + dh * 4096 + ks * 1024); vh[i] = tr_read(vb + dh * 4096 + ks * 1024 + 512); }
#pragma unroll
                        for (int i = 0; i < 4; ++i) { const int ks = 2 * kh + (i >> 1); const bf16x8 pa = __builtin_bit_cast(bf16x8, pwp[ks]); const bf16x8 vfr = (bf16x8){vl[i][0], vl[i][1], vl[i][2], vl[i][3], vh[i][0], vh[i][1], vh[i][2], vh[i][3]};
                            if (i & 1) o1 = __builtin_amdgcn_mfma_f32_32x32x16_bf16(pa, vfr, o1, 0, 0, 0); else o0 = __builtin_amdgcn_mfma_f32_32x32x16_bf16(pa, vfr, o0, 0, 0, 0); } } }
                { typedef pg8::f32x2 f32x2; const f32x2 ndl = (f32x2){-dl, -dl}; f32x2 ps2 = (f32x2){0.f, 0.f};
#pragma unroll
                    for (int r = 0; r < 16; r += 2) { f32x2 a = (f32x2){p0[r], p0[r + 1]} + ndl, b = (f32x2){p1[r], p1[r + 1]} + ndl;
                        a[0] = __builtin_amdgcn_exp2f(a[0]); a[1] = __builtin_amdgcn_exp2f(a[1]); b[0] = __builtin_amdgcn_exp2f(b[0]); b[1] = __builtin_amdgcn_exp2f(b[1]);
                        ps2 = ps2 + a; ps2 = ps2 + b; p0[r] = a[0]; p0[r + 1] = a[1]; p1[r] = b[0]; p1[r + 1] = b[1]; }
                    lrun += ps2[0] + ps2[1]; }
                pwp[0] = (v4u){pk2(p0[0], p0[1]), pk2(p0[2], p0[3]), pk2(p0[4], p0[5]), pk2(p0[6], p0[7])};
                pwp[1] = (v4u){pk2(p0[8], p0[9]), pk2(p0[10], p0[11]), pk2(p0[12], p0[13]), pk2(p0[14], p0[15])};
                pwp[2] = (v4u){pk2(p1[0], p1[1]), pk2(p1[2], p1[3]), pk2(p1[4], p1[5]), pk2(p1[6], p1[7])};
                pwp[3] = (v4u){pk2(p1[8], p1[9]), pk2(p1[10], p1[11]), pk2(p1[12], p1[13]), pk2(p1[14], p1[15])};
                vprev = Vs;
                if (resc) {
#pragma unroll
                    for (int r = 0; r < 16; ++r) { const float fr_ = wsf[crow(r, hi)]; o0[r] *= fr_; o1[r] *= fr_; }
                }
            }
        }
        if (DRY != 2) {
            const LAS unsigned char* vb = vprev + ((lane >> 4) & 1) * 32 + (lane & 3) * 8 + (4 * hi + ((lane & 15) >> 2)) * 64;
#pragma unroll
            for (int kh = 0; kh < 2; ++kh) {
                s16x4 vl[4], vh[4];
#pragma unroll
                for (int i = 0; i < 4; ++i) { const int ks = 2 * kh + (i >> 1), dh = i & 1; vl[i] = tr_read(vb + dh * 4096 + ks * 1024); vh[i] = tr_read(vb + dh * 4096 + ks * 1024 + 512); }
#pragma unroll
                for (int i = 0; i < 4; ++i) { const int ks = 2 * kh + (i >> 1); const bf16x8 pa = __builtin_bit_cast(bf16x8, pwp[ks]); const bf16x8 vfr = (bf16x8){vl[i][0], vl[i][1], vl[i][2], vl[i][3], vh[i][0], vh[i][1], vh[i][2], vh[i][3]};
                    if (i & 1) o1 = __builtin_amdgcn_mfma_f32_32x32x16_bf16(pa, vfr, o1, 0, 0, 0); else o0 = __builtin_amdgcn_mfma_f32_32x32x16_bf16(pa, vfr, o0, 0, 0, 0); } } }
        __syncthreads();
        ATT_DMA_ANY(15); ATT_DMA_ANY(16);
        if (has_n) {
            const size_t qrown = (size_t)bn * SEQ + (size_t)(4 * cqn + ci) * CHUNK + 32 * qh;
#pragma unroll
            for (int d0 = 0; d0 < 4; ++d0) qnx[d0] = __builtin_nontemporal_load((const bf16x8*)(Q + (qrown + r32) * AP + hn * HD + d0 * 16 + hi * 8));
            if (tid < NREL) { const float* rbn = P.b_rel_bias + ((size_t)j * NH + hn) * NREL; rbx0 = rbn[tid]; rbx1 = rbn[NREL - 1]; }
        }
#undef ATT_DMA_ANY
#undef ATT_DMA
#undef ATT_DMA_X
        { auto rr = __builtin_amdgcn_permlane32_swap(__float_as_uint(lrun), __float_as_uint(lrun), false, false); lrun = __uint_as_float(rr[0]) + __uint_as_float(rr[1]); }
        if (hi == 0) wsf[32 + r32] = lrun;
        { LAS bf16* stg = (LAS bf16*)(lds + (wave < 6 ? AT_K + ATT_SLOT(9 + (wave >> 1), par) : AT_V + ATT_SLOT(9, par)) + (wave & 1) * 4096);
#pragma unroll
            for (int r = 0; r < 16; ++r) { const int orow = crow(r, hi); const float rl = __builtin_amdgcn_rcpf(wsf[32 + orow]);
                stg[orow * 64 + r32] = (bf16)(pk2(o0[r] * rl, 0.f) & 0xffffu); stg[orow * 64 + 32 + r32] = (bf16)(pk2(o1[r] * rl, 0.f) & 0xffffu); }
            bf16* Ow = (DRY ? (bf16*)P.out + qrow * D : Q + qrow * AP) + h * HD; const int opitch = DRY ? D : AP;
#pragma unroll
            for (int i = 0; i < 4; ++i) { const int row = i * 8 + (lane >> 3), ch = lane & 7; const v4u v = *(const LAS v4u*)(stg + row * 64 + ch * 8); *(v4u*)(Ow + (size_t)row * opitch + ch * 8) = v; } }
        asm volatile("s_waitcnt lgkmcnt(0)\n\ts_barrier" ::: "memory");
    }
#undef ATT_DEC
#undef ATT_SLOT
}
#undef MX3

__device__ __forceinline__ void final_phase(const Ptrs& P, int vcu, int G, int wave, const pg8::Sch sc) {
    int tid_ = threadIdx.x; asm volatile("" : "+v"(tid_)); const int lane = tid_ & 63;
    const int gw = (sc.lm ? sc.rank : vcu) * NWAVES + wave, NGW = (sc.lm ? sc.nloc : G) * NWAVES, mbase = sc.lm ? 2048 * sc.gi : 0, mcount = sc.lm ? 2048 : M;
    f32x4 gn[4];
#pragma unroll
    for (int j = 0; j < 4; ++j) gn[j] = ((const f32x4*)P.final_g)[lane + 64 * j];
    for (int mk = gw; mk < mcount; mk += NGW) { const int m = mbase + mk;
        const f32x4 sv = *(const f32x4*)(P.xss + (size_t)m * pg8::NSLOT_X + (lane & 3) * 4);
        float s = (sv[0] + sv[1]) + (sv[2] + sv[3]); s += __shfl_xor(s, 1); s += __shfl_xor(s, 2);
        const float r = __builtin_amdgcn_rsqf(s * (1.0f / D) + EPS);
        const GAS v2u* xr = (const GAS v2u*)(P.xb + (size_t)m * D) + lane;
        GAS f32x4* orow = (GAS f32x4*)(P.out + (size_t)m * D) + lane;
#pragma unroll
        for (int j = 0; j < 4; ++j) { const v2u w = __builtin_nontemporal_load(xr + 64 * j); const f32x4 v = {bf_lo(w.x), bf_hi(w.x), bf_lo(w.y), bf_hi(w.y)}; orow[64 * j] = v * r * gn[j]; }
    }
}

#ifndef PANEL_OWNER
#define PANEL_OWNER 1
#endif
__device__ __forceinline__ pg8::Sch get_sch(volatile LAS unsigned* MISC, int G) {
    pg8::Sch s; const int nloc = __builtin_amdgcn_readfirstlane((int)MISC[8]), nx = __builtin_amdgcn_readfirstlane((int)MISC[9]);
    s.gi = __builtin_amdgcn_readfirstlane((int)MISC[10]); s.rank = __builtin_amdgcn_readfirstlane((int)MISC[11]); s.nloc = nloc > 0 ? nloc : 1;
    s.lm = (PANEL_OWNER && !MK_PER_PHASE && nx == 8 && nloc > 0 && M == 16384) ? 1 : 0; return s;
}
__device__ __forceinline__ int launder_s(int x) { asm volatile("" : "+s"(x)); return x; }
struct Args { const float* in[15]; float* out; unsigned char* ws; int ph_lo, ph_hi; };
static_assert(sizeof(Args) == 17 * 8 + 8, "Args has no padding");
__global__ void __launch_bounds__(NWAVES * 64, 2) trunk_fwd(Args args) {
    extern __shared__ __attribute__((aligned(16))) unsigned char lds_raw[];
    LAS unsigned char* lds = (LAS unsigned char*)lds_raw;
    volatile LAS unsigned* MISC = (volatile LAS unsigned*)(lds + MISC_OFF);
    const int tid = threadIdx.x, lane = tid & 63, wave = __builtin_amdgcn_readfirstlane(tid >> 6);
    const int G = gridDim.x; const int bx = blockIdx.x; const int vcu = (G % 8 == 0) ? (bx % 8) * (G / 8) + bx / 8 : bx;
    unsigned char* ws = args.ws;
    gu32* ctl = (gu32*)(ws + WS_CTL);
    Ptrs P;
    P.x = args.in[0]; P.norm_mix_g = args.in[1]; P.norm_ffn_g = args.in[2]; P.final_g = args.in[3]; P.a_w_in = args.in[4]; P.a_v_gain = args.in[5]; P.a_w_s = args.in[6]; P.a_b_s = args.in[7];
    P.a_w_out = args.in[8]; P.b_w_qkv = args.in[9]; P.b_rel_bias = args.in[10]; P.b_w_out = args.in[11]; P.ffn_w_gate = args.in[12]; P.ffn_w_up = args.in[13]; P.ffn_w_down = args.in[14];
    P.out = args.out; P.wt = (bf16*)(ws + WS_W); P.xb = (bf16*)(ws + WS_XB); P.act = (bf16*)(ws + WS_ACT); P.xss = (float*)(ws + WS_XSS); P.vss = (float*)(ws + WS_VSS);
    for (int u = tid; u < (LDS_BYTES - LDSCTL_OFF) / 4; u += NWAVES * 64) ((LAS unsigned*)(lds + LDSCTL_OFF))[u] = 0u;
    __syncthreads();
    XcdBarrier bar; bar.bar = (unsigned*)(ctl + CW_BAR); bar.x = 0; bar.st = nullptr;
    if (!MK_PER_PHASE) bar = xcd_barrier_post((unsigned*)(ctl + CW_BAR), MISC + 8);
    const int lo = args.ph_lo, hi = args.ph_hi;
#define RS_TABLE(S) pg8::RsTab rt{(const LAS float*)(lds + RSTAB_OFF), -1}; { pg8::Unit u0_; if (S.next(0, u0_)) { rt.pm = u0_.pm; pg8::build_rs_table(P.xss, u0_.pm, (LAS float*)(lds + RSTAB_OFF), tid, 1.0f / D, EPS); } }
#ifndef DBG_MASK
#define DBG_MASK 0xff
#endif
#if MK_PER_PHASE
#define IN(k) (lo <= (k) && (k) < hi)
#else
#define IN(k) true
#endif
#define SEAM(k, local_ok) do { if (IN(k) && IN((k) + 1)) { if ((local_ok) && get_sch(MISC, G).lm) xcd_barrier_local(bar); else xcd_barrier(bar); if (PROBE == 1) xcd_barrier(bar); } } while (0)

    if ((DBG_MASK & 1) && IN(0)) { p0_prologue(P, lds, vcu, G, wave, lane); if (PROBE == 2) { __syncthreads(); p0_prologue(P, lds, vcu, G, wave, lane); } }
    SEAM(0, false);
    if (PROBE == 12 && get_sch(MISC, G).lm) { const unsigned long long t0_ = __builtin_amdgcn_s_memrealtime(); while (__builtin_amdgcn_s_memrealtime() - t0_ < 20000ull) __builtin_amdgcn_s_sleep(8); }
#pragma unroll 1
    for (int layer = 0; layer < DEPTH; ++layer) {
        const int j = layer >> 1, ph = 1 + 5 * layer;
        const bf16* wgu = P.wt + WO_GU + (size_t)layer * D * FF2; const bf16* wdn = P.wt + WO_DN + (size_t)layer * FF * D;
        if ((layer & 1) == 0) {
            if ((DBG_MASK & 2) && IN(ph)) { pg8::Gemm g{P.xb, P.wt + WO_IN + (size_t)j * D * GH2, M, GH2, D, D}; const pg8::Sch sch = get_sch(MISC, G); pg8::PanelOrder S; S.init(M, GH2, G, launder_s(bx), sch);
                RS_TABLE(S);
                pg8::EpiGeluStats E{P.act, AP, P.xss, P.vss, GH / 256, EPS, rt};
                pg8::gemm_phase<pg8::EpiGeluStats, pg8::PanelOrder, true, true>(lds + RING_OFF, g, S, E);
                if (PROBE == 5) { __syncthreads(); pg8::gemm_phase<pg8::EpiGeluStats, pg8::PanelOrder, true, true>(lds + RING_OFF, g, S, E); } }
            SEAM(ph, true);
            if ((DBG_MASK & 4) && IN(ph + 1)) { if (PROBE == 4) spatial_phase<true>(P, j, lds, vcu, G, wave, get_sch(MISC, G)); spatial_phase<false>(P, j, lds, vcu, G, wave, get_sch(MISC, G)); }
            SEAM(ph + 1, true);
            if ((DBG_MASK & 8) && IN(ph + 2)) { pg8::Gemm g{P.act, P.wt + WO_AOUT + (size_t)j * GH * D, M, D, GH, AP}; const pg8::Sch sch = get_sch(MISC, G); pg8::PanelOrder S; S.init(M, D, G, launder_s(bx), sch);
                pg8::EpiResid E{P.xb, P.xss, D};
                pg8::gemm_phase<pg8::EpiResid, pg8::PanelOrder, false, true>(lds + RING_OFF, g, S, E); }
            SEAM(ph + 2, true);
        } else {
            if ((DBG_MASK & 16) && IN(ph)) { pg8::Gemm g{P.xb, P.wt + WO_QKV + (size_t)j * D * 3 * D, M, 3 * D, D, D}; const pg8::Sch sch = get_sch(MISC, G); pg8::PanelOrder S; S.init(M, 3 * D, G, launder_s(bx), sch);
                RS_TABLE(S);
                pg8::EpiQkv E{P.act, AP, (size_t)D, P.xss, EPS, QSCALE, rt};
                pg8::gemm_phase<pg8::EpiQkv, pg8::PanelOrder, true, true>(lds + RING_OFF, g, S, E);
                if (PROBE == 7) { __syncthreads(); pg8::gemm_phase<pg8::EpiQkv, pg8::PanelOrder, true, true>(lds + RING_OFF, g, S, E); } }
            SEAM(ph, false);
            if ((DBG_MASK & 32) && IN(ph + 1)) { if (PROBE == 3) attn_phase<1>(P, j, lds, vcu, G, wave, get_sch(MISC, G)); if (PROBE == 10) attn_phase<2>(P, j, lds, vcu, G, wave, get_sch(MISC, G)); attn_phase<0>(P, j, lds, vcu, G, wave, get_sch(MISC, G)); }
            SEAM(ph + 1, true);
            if ((DBG_MASK & 8) && IN(ph + 2)) { pg8::Gemm g{P.act, P.wt + WO_BOUT + (size_t)j * D * D, M, D, D, AP}; const pg8::Sch sch = get_sch(MISC, G); pg8::PanelOrder S; S.init(M, D, G, launder_s(bx), sch);
                pg8::EpiResid E{P.xb, P.xss, D};
                pg8::gemm_phase<pg8::EpiResid, pg8::PanelOrder, false, true>(lds + RING_OFF, g, S, E); }
            SEAM(ph + 2, false);
        }
        if ((DBG_MASK & 64) && IN(ph + 3)) { pg8::Gemm g{P.xb, wgu, M, FF2, D, D}; const pg8::Sch sch = get_sch(MISC, G); pg8::FfnOrder S; S.init(M, FF_NFULL, G, launder_s(bx), sch);
            RS_TABLE(S);
            pg8::EpiSwiglu E{P.act, AP, P.xss, EPS, rt, FF_NFULL * 128};
            pg8::gemm_phase<pg8::EpiSwiglu, pg8::FfnOrder, true, true>(lds + RING_OFF, g, S, E);
            if (PROBE == 6 || PROBE == 11) { __syncthreads(); pg8::gemm_phase<pg8::EpiSwiglu, pg8::FfnOrder, true, true>(lds + RING_OFF, g, S, E); } }
        SEAM(ph + 3, true);
        if ((DBG_MASK & 8) && IN(ph + 4)) { pg8::Gemm g{P.act, wdn, M, D, FF, AP}; const pg8::Sch sch = get_sch(MISC, G); pg8::PanelOrder S; S.init(M, D, G, launder_s(bx), sch);
            pg8::EpiResid E{P.xb, P.xss, D};
            pg8::gemm_phase<pg8::EpiResid, pg8::PanelOrder, false, true>(lds + RING_OFF, g, S, E); }
        SEAM(ph + 4, true);
    }
    if ((DBG_MASK & 128) && IN(N_PHASES - 1)) final_phase(P, vcu, G, wave, get_sch(MISC, G));
#undef IN
#undef SEAM
}

extern "C" void kernel_launch(void* const* d_in, const int* in_sizes, int n_in, void* d_out, int out_size, void* d_ws, size_t ws_size, hipStream_t stream) {
    static int grid = 0;
    if (grid == 0) {
        if (n_in != 15 || in_sizes[0] != M * D || out_size != M * D || ws_size < WS_END) { fprintf(stderr, "kernel_launch: unexpected shapes (n_in %d, in0 %d, out %d, ws %zu < %zu); nothing launched\n", n_in, n_in > 0 ? in_sizes[0] : -1, out_size, ws_size, (size_t)WS_END); grid = -1; return; }
        int dev = 0, cus = 0, per_cu = 0;
        if (hipGetDevice(&dev) != hipSuccess || hipDeviceGetAttribute(&cus, hipDeviceAttributeMultiprocessorCount, dev) != hipSuccess) { grid = -1; return; }
        if (hipFuncSetAttribute((const void*)trunk_fwd, hipFuncAttributeMaxDynamicSharedMemorySize, LDS_BYTES) != hipSuccess) { fprintf(stderr, "kernel_launch: hipFuncSetAttribute failed\n"); grid = -1; return; }
        if (hipOccupancyMaxActiveBlocksPerMultiprocessor(&per_cu, (const void*)trunk_fwd, NWAVES * 64, LDS_BYTES) != hipSuccess || per_cu < 1) { fprintf(stderr, "kernel_launch: occupancy query reports %d workgroups per CU; nothing launched\n", per_cu); (void)hipGetLastError(); grid = -1; return; }
        grid = cus;
    }
    if (grid < 0) return;
    if (hipMemsetAsync((char*)d_ws + WS_CTL, 0, CTL_ZERO_BYTES, stream) != hipSuccess) return;
    Args a{};
    for (int i = 0; i < 15; ++i) a.in[i] = (const float*)d_in[i];
    a.out = (float*)d_out; a.ws = (unsigned char*)d_ws;
#if MK_PER_PHASE
    for (int p = 0; p < N_PHASES; ++p) { a.ph_lo = p; a.ph_hi = p + 1; hipLaunchKernelGGL(trunk_fwd, dim3(grid), dim3(NWAVES * 64), LDS_BYTES, stream, a); }
#else
    a.ph_lo = 0; a.ph_hi = N_PHASES;
    hipLaunchKernelGGL(trunk_fwd, dim3(grid), dim3(NWAVES * 64), LDS_BYTES, stream, a);
#endif
}
```

```cpp
#include <hip/hip_runtime.h>
#include <cstdio>
#include <cstdint>
#ifndef PROBE
#define PROBE 0
#endif
#ifndef PG8_KROT
#define PG8_KROT 0
#endif
namespace pg8 {
#define PG8_LAS __attribute__((address_space(3)))
typedef unsigned short bf16_t;
typedef short bf16x8 __attribute__((ext_vector_type(8)));
typedef float f32x4 __attribute__((ext_vector_type(4)));
typedef unsigned u32x4 __attribute__((ext_vector_type(4)));
constexpr int BM = 256, BK = 64, HALF = 128, HTB = HALF * BK * 2  , STAGE_BYTES = 8 * HTB, NXCD = 8, WGM = 8;

__host__ __device__ __forceinline__ int lds_byte(int r, int c) { const int st = (r >> 4) * 2 + (c >> 5), rr = r & 15, cc = c & 31, ob = rr * 64 + cc * 2; return st * 1024 + (ob ^ (((ob >> 9) & 1) << 5)); }
__host__ __device__ __forceinline__ void stage_rc(int b, int& R, int& C) { const int st = b / 1024, sb = b % 1024, swz = sb ^ (((sb >> 9) & 1) << 5); R = (st >> 1) * 16 + swz / 64; C = (st & 1) * 32 + (swz % 64) / 2; }
__host__ __device__ __forceinline__ int perm32(int rho) { const int n = rho >> 4, i = rho & 15; return 8 * (i >> 2) + 4 * n + (i & 3); }

struct Unit { int pm, pn, hf; };
struct Gemm { const bf16_t* A; const bf16_t* Bt; int M, N, K, lda; };

struct StaticOrder {
    int nM, nN, nwg, G, c;
    __host__ __device__ void init(int M, int N, int G_, int c_) { nM = M / BM; nN = N / BM; nwg = nM * nN; G = G_; c = c_; }
    __host__ __device__ bool next(int i, Unit& u) const {
        const long L = (long)i * G + c; if (L >= nwg) return false;
        int wgid = (int)L; { const int q = nwg / NXCD, r = nwg % NXCD, xcd = wgid % NXCD, off = wgid / NXCD; wgid = (xcd < r ? xcd * (q + 1) : r * (q + 1) + (xcd - r) * q) + off; }
        const int nig = WGM * nN, gid = wgid / nig, fm = gid * WGM, gsz = (nM - fm) < WGM ? (nM - fm) : WGM;
        u.pm = fm + ((wgid % nig) % gsz); u.pn = (wgid % nig) / gsz; u.hf = 0; return true;
    }
    static constexpr bool HAS_HALF = false;
    __host__ __device__ int brow(const Unit& u) const { return u.pn * BM; }
    __device__ __forceinline__ int koff(const Unit& u, int nt) const { int k = PG8_KROT ? 2 * (u.pm & 7) + 4 * (u.pn & 3) : 0; k -= (k >= nt) ? nt : 0; return k; }
    __device__ __forceinline__ void a_ready(const Unit&) const {}
    __device__ __forceinline__ void done(const Unit&) const {}
};

__device__ __forceinline__ unsigned cvt_pk_bf16(float lo, float hi) { unsigned r; asm volatile("v_cvt_pk_bf16_f32 %0, %1, %2" : "=v"(r) : "v"(lo), "v"(hi)); return r; }
typedef float f32x2 __attribute__((ext_vector_type(2)));
struct Sch { int lm, gi, rank, nloc; };
struct PanelOrder {
    StaticOrder so; Sch sc; int nN;
    static constexpr bool HAS_HALF = false;
    __device__ void init(int M, int N, int G_, int c_, const Sch& s_) { so.init(M, N, G_, c_); sc = s_; nN = N / BM; }
    __device__ bool next(int i, Unit& u) const {
        if (sc.lm) { const int idx = sc.rank + sc.nloc * i; if (idx >= 8 * nN) return false; u.pm = 8 * sc.gi + (idx & 7); u.pn = idx >> 3; u.hf = 0; return true; }
        return so.next(i, u);
    }
    __device__ int brow(const Unit& u) const { return u.pn * BM; }
    __device__ __forceinline__ int koff(const Unit& u, int nt) const { int k = PG8_KROT ? 2 * (u.pm & 7) + 4 * (u.pn & 3) : 0; k -= (k >= nt) ? nt : 0; return k; }
    __device__ __forceinline__ void a_ready(const Unit&) const {}
    __device__ __forceinline__ void done(const Unit&) const {}
};
struct FfnOrder {
    PanelOrder po; int nfull, G, c, NFULL;
    static constexpr bool HAS_HALF = true;
    __device__ void init(int M, int NFULL_, int G_, int c_, const Sch& s_) { NFULL = NFULL_; po.init(M, NFULL_ * BM, G_, c_, s_); G = G_; c = c_;
        nfull = s_.lm ? ((s_.rank < 8 * NFULL_) ? (8 * NFULL_ - s_.rank + s_.nloc - 1) / s_.nloc : 0) : ((c_ < po.so.nwg) ? (po.so.nwg - c_ + G_ - 1) / G_ : 0); }
    __device__ bool next(int i, Unit& u) const {
        if (i < nfull) return po.next(i, u);
        const int k = i - nfull;
        if (po.sc.lm) { const int hidx = po.sc.rank + po.sc.nloc * k; if (hidx >= 32) return false; u.pm = 8 * po.sc.gi + (hidx & 7); u.pn = hidx >> 3; u.hf = 1; return true; }
        const int nh = po.so.nM * 4; const int hu = k * G + c; if (hu >= nh) return false;
        if (G == 256 && po.so.nM == 64) { Unit f; po.so.next(0, f); u.pm = f.pm; u.pn = f.pn & 3; }
        else { u.pm = hu % po.so.nM; u.pn = hu / po.so.nM; }
        u.hf = 1; return true;
    }
    __device__ int brow(const Unit& u) const { return u.hf ? NFULL * BM + u.pn * HALF : u.pn * BM; }
    __device__ __forceinline__ int koff(const Unit& u, int nt) const { int k = PG8_KROT ? 2 * (u.pm & 7) + 4 * (u.pn & 3) : 0; k -= (k >= nt) ? nt : 0; return k; }
    __device__ __forceinline__ void a_ready(const Unit&) const {}
    __device__ __forceinline__ void done(const Unit&) const {}
};

#ifndef PG8_B_AUX
#define PG8_B_AUX 0
#endif
#ifndef PG8_SKIPW
#define PG8_SKIPW 0
#endif
#ifndef STORE_WT
#define STORE_WT 1
#endif
__device__ __forceinline__ void store16(void* p, u32x4 v) {
#if STORE_WT
    asm volatile("global_store_dwordx4 %0, %1, off sc1\n\ts_nop 1" :: "v"(p), "v"(v) : "memory");
#else
    *(u32x4*)p = v;
#endif
}
__device__ __forceinline__ void store16f(void* p, f32x4 v) {
#if STORE_WT
    asm volatile("global_store_dwordx4 %0, %1, off sc1\n\ts_nop 1" :: "v"(p), "v"(v) : "memory");
#else
    *(f32x4*)p = v;
#endif
}
typedef unsigned u32x2 __attribute__((ext_vector_type(2)));
__device__ __forceinline__ void store8(void* p, u32x2 v) {
#if STORE_WT
    asm volatile("global_store_dwordx2 %0, %1, off sc1\n\ts_nop 1" :: "v"(p), "v"(v) : "memory");
#else
    *(u32x2*)p = v;
#endif
}
constexpr int NSLOT_X = 16;
constexpr int NSLOT_V = 32;
struct RsTab { const PG8_LAS float* t; int pm; };
__device__ __forceinline__ void row_scales(const float* ss, const RsTab& T, int pm, int wr, int fr, int fq, float inv_n, float eps, float (&rs)[2][4]) {
    if (pm == T.pm) {
#pragma unroll
        for (int ai = 0; ai < 2; ++ai)
#pragma unroll
            for (int m = 0; m < 4; ++m) rs[ai][m] = T.t[wr * 64 + fr + ai * HALF + m * 16];
    } else {
        const int row0 = pm * BM + wr * 64 + fr;
#pragma unroll
        for (int ai = 0; ai < 2; ++ai)
#pragma unroll
            for (int m = 0; m < 4; ++m) {
                const f32x4 v = *(const f32x4*)(ss + (size_t)(row0 + ai * HALF + m * 16) * NSLOT_X + fq * 4);
                float s = (v[0] + v[1]) + (v[2] + v[3]);
                s += __shfl_xor(s, 16); s += __shfl_xor(s, 32);
                rs[ai][m] = __builtin_amdgcn_rsqf(s * inv_n + eps);
            }
    }
}
__device__ __forceinline__ void build_rs_table(const float* ss, int pm, PG8_LAS float* t, int tid, float inv_n, float eps) {
    asm volatile("" : "+v"(tid));
    const int row = tid >> 1, half = tid & 1;
    const f32x4 a = *(const f32x4*)(ss + (size_t)(pm * BM + row) * NSLOT_X + half * 8), b = *(const f32x4*)(ss + (size_t)(pm * BM + row) * NSLOT_X + half * 8 + 4);
    float s = ((a[0] + a[1]) + (a[2] + a[3])) + ((b[0] + b[1]) + (b[2] + b[3]));
    s += __shfl_xor(s, 1);
    if (half == 0) t[row] = __builtin_amdgcn_rsqf(s * inv_n + eps);
    asm volatile("s_waitcnt lgkmcnt(0)" ::: "memory"); __syncthreads();
}
__device__ __forceinline__ float gelu_tanh(float x) {
    const float t = x * x, u2 = x * (2.302208198f + 0.1029432398f * t);
    const float e = __builtin_amdgcn_exp2f(-u2);
    return x * __builtin_amdgcn_rcpf(1.0f + e);
}
__device__ __forceinline__ float silu_mul(float g, float u) {
    const float e = __builtin_amdgcn_exp2f(g * -1.4426950408889634f);
    return (g * u) * __builtin_amdgcn_rcpf(1.0f + e);
}
__device__ __forceinline__ f32x2 gelu_tanh2(f32x2 x) {
    const f32x2 t = x * x;
    const f32x2 p = __builtin_elementwise_fma(t, (f32x2){-0.1029432398f, -0.1029432398f}, (f32x2){-2.302208198f, -2.302208198f});
    const f32x2 u2n = x * p;
    f32x2 d; d[0] = __builtin_amdgcn_exp2f(u2n[0]); d[1] = __builtin_amdgcn_exp2f(u2n[1]);
    d = d + (f32x2){1.0f, 1.0f};
    f32x2 r; r[0] = __builtin_amdgcn_rcpf(d[0]); r[1] = __builtin_amdgcn_rcpf(d[1]);
    return x * r;
}
__device__ __forceinline__ f32x2 silu_mul2(f32x2 g, f32x2 u, float rneg, float rr) {
    const f32x2 a = g * rneg;
    f32x2 d; d[0] = __builtin_amdgcn_exp2f(a[0]); d[1] = __builtin_amdgcn_exp2f(a[1]);
    d = d + (f32x2){1.0f, 1.0f};
    f32x2 q; q[0] = __builtin_amdgcn_rcpf(d[0]); q[1] = __builtin_amdgcn_rcpf(d[1]);
    return ((g * u) * rr) * q;
}
struct EpiGeluStats {
    static constexpr bool PERM = true, AFTER_DRAIN = false, PROBE_TWICE = false;
    bf16_t* O; int ldc; const float* xss; float* vss; int vtile0; float eps; RsTab rt;
    __device__ __forceinline__ void operator()(const f32x4 (&acc)[2][2][4][2], const Unit& u, int wr, int wc, int fr, int fq) const {
        const int row0 = u.pm * BM + wr * 64 + fr, col0 = u.pn * BM + wc * 32 + 8 * fq;
        float rs[2][4]; row_scales(xss, rt, u.pm, wr, fr, fq, 1.0f / 1024.0f, eps, rs);
        const bool isv = u.pn >= vtile0;
#pragma unroll
        for (int ai = 0; ai < 2; ++ai)
#pragma unroll
            for (int m = 0; m < 4; ++m) { const int row = row0 + ai * HALF + m * 16; bf16_t* rowp = O + (size_t)row * ldc + col0; const float r = rs[ai][m]; float ssq = 0.f;
                f32x2 sq2 = (f32x2){0.f, 0.f};
#pragma unroll
                for (int bj = 0; bj < 2; ++bj) { const f32x4 a0 = acc[ai][bj][m][0], a1 = acc[ai][bj][m][1];
                    const f32x2 y0 = gelu_tanh2((f32x2){a0[0], a0[1]} * r), y1 = gelu_tanh2((f32x2){a0[2], a0[3]} * r), y2 = gelu_tanh2((f32x2){a1[0], a1[1]} * r), y3 = gelu_tanh2((f32x2){a1[2], a1[3]} * r);
                    sq2 = __builtin_elementwise_fma(y0, y0, sq2); sq2 = __builtin_elementwise_fma(y1, y1, sq2); sq2 = __builtin_elementwise_fma(y2, y2, sq2); sq2 = __builtin_elementwise_fma(y3, y3, sq2);
                    u32x4 w; w.x = cvt_pk_bf16(y0[0], y0[1]); w.y = cvt_pk_bf16(y1[0], y1[1]); w.z = cvt_pk_bf16(y2[0], y2[1]); w.w = cvt_pk_bf16(y3[0], y3[1]);
                    store16(rowp + bj * HALF, w); }
                if (isv) { ssq = sq2[0] + sq2[1]; ssq += __shfl_xor(ssq, 16); ssq += __shfl_xor(ssq, 32); if (fq == 0) vss[(size_t)row * NSLOT_V + (u.pn - vtile0) * 4 + wc] = ssq; } }
    }
};
struct EpiSwiglu {
    static constexpr bool PERM = true, AFTER_DRAIN = false, PROBE_TWICE = true;
    bf16_t* O; int ldc; const float* xss; float eps; RsTab rt;
    int half_col0;
    __device__ __forceinline__ void operator()(const f32x4 (&acc)[2][2][4][2], const Unit& u, int wr, int wc, int fr, int fq) const {
        const int row0 = u.pm * BM + wr * 64 + fr, col0 = u.pn * HALF + wc * 32 + 8 * fq;
        float rs[2][4]; row_scales(xss, rt, u.pm, wr, fr, fq, 1.0f / 1024.0f, eps, rs);
        if (u.hf) {
            const int hc = half_col0 + u.pn * 64 + wc * 16 + 4 * fq;
#pragma unroll
            for (int ai = 0; ai < 2; ++ai)
#pragma unroll
                for (int m = 0; m < 4; ++m) { const int row = row0 + ai * HALF + m * 16; const float r = rs[ai][m], rneg = r * -1.4426950408889634f, rr = r * r;
                    const f32x4 g0 = acc[ai][0][m][0], u0 = acc[ai][0][m][1];
                    const f32x2 o0 = silu_mul2((f32x2){g0[0], g0[1]}, (f32x2){u0[0], u0[1]}, rneg, rr), o1 = silu_mul2((f32x2){g0[2], g0[3]}, (f32x2){u0[2], u0[3]}, rneg, rr);
                    u32x2 w; w.x = cvt_pk_bf16(o0[0], o0[1]); w.y = cvt_pk_bf16(o1[0], o1[1]);
                    *(u32x2*)(O + (size_t)row * ldc + hc) = w; }
            return;
        }
#pragma unroll
        for (int ai = 0; ai < 2; ++ai)
#pragma unroll
            for (int m = 0; m < 4; ++m) { const int row = row0 + ai * HALF + m * 16; const float r = rs[ai][m] * (PROBE == 9 ? 0.5f : 1.0f);
                const float rneg = r * -1.4426950408889634f, rr = r * r;
                const f32x4 g0 = acc[ai][0][m][0], g1 = acc[ai][0][m][1], u0 = acc[ai][1][m][0], u1 = acc[ai][1][m][1];
                const f32x2 o0 = silu_mul2((f32x2){g0[0], g0[1]}, (f32x2){u0[0], u0[1]}, rneg, rr), o1 = silu_mul2((f32x2){g0[2], g0[3]}, (f32x2){u0[2], u0[3]}, rneg, rr);
                const f32x2 o2 = silu_mul2((f32x2){g1[0], g1[1]}, (f32x2){u1[0], u1[1]}, rneg, rr), o3 = silu_mul2((f32x2){g1[2], g1[3]}, (f32x2){u1[2], u1[3]}, rneg, rr);
                u32x4 w; w.x = cvt_pk_bf16(o0[0], o0[1]); w.y = cvt_pk_bf16(o1[0], o1[1]); w.z = cvt_pk_bf16(o2[0], o2[1]); w.w = cvt_pk_bf16(o3[0], o3[1]);
                if (PROBE == 11) *(u32x4*)(O + (size_t)row * ldc + col0) = w; else store16(O + (size_t)row * ldc + col0, w); }
    }
};
struct EpiQkv {
    static constexpr bool PERM = true, AFTER_DRAIN = false, PROBE_TWICE = false;
    bf16_t* O; int ldc; size_t split_stride; const float* xss; float eps; float scale0; RsTab rt;
    __device__ __forceinline__ void operator()(const f32x4 (&acc)[2][2][4][2], const Unit& u, int wr, int wc, int fr, int fq) const {
        const int t = u.pn >> 2; bf16_t* base = O + (size_t)t * split_stride; const float sc = (t == 0) ? scale0 : 1.0f;
        const int row0 = u.pm * BM + wr * 64 + fr, col0 = (u.pn & 3) * BM + wc * 32 + 8 * fq;
        float rs[2][4]; row_scales(xss, rt, u.pm, wr, fr, fq, 1.0f / 1024.0f, eps, rs);
#pragma unroll
        for (int ai = 0; ai < 2; ++ai)
#pragma unroll
            for (int m = 0; m < 4; ++m) { const int row = row0 + ai * HALF + m * 16; bf16_t* rowp = base + (size_t)row * ldc + col0; const float r = rs[ai][m] * sc;
#pragma unroll
                for (int bj = 0; bj < 2; ++bj) { const f32x4 v0 = acc[ai][bj][m][0] * r, v1 = acc[ai][bj][m][1] * r;
                    u32x4 w; w.x = cvt_pk_bf16(v0[0], v0[1]); w.y = cvt_pk_bf16(v0[2], v0[3]); w.z = cvt_pk_bf16(v1[0], v1[1]); w.w = cvt_pk_bf16(v1[2], v1[3]);
                    store16(rowp + bj * HALF, w); } }
    }
};
struct EpiResid {
    static constexpr bool PERM = true, AFTER_DRAIN = false, PROBE_TWICE = false;
    bf16_t* xb; float* xss; int ldc;
    __device__ __forceinline__ void operator()(const f32x4 (&acc)[2][2][4][2], const Unit& u, int wr, int wc, int fr, int fq) const {
        asm volatile("" : "+v"(fr), "+v"(fq));
        const int row0 = u.pm * BM + wr * 64 + fr, col0 = u.pn * BM + wc * 32 + 8 * fq;
        u32x4 pre[2][4][2];
#pragma unroll
        for (int ai = 0; ai < 2; ++ai)
#pragma unroll
            for (int m = 0; m < 4; ++m)
#pragma unroll
                for (int bj = 0; bj < 2; ++bj) pre[ai][m][bj] = __builtin_nontemporal_load((const u32x4*)(xb + (size_t)(row0 + ai * HALF + m * 16) * ldc + col0 + bj * HALF));
#pragma unroll
        for (int ai = 0; ai < 2; ++ai)
#pragma unroll
            for (int m = 0; m < 4; ++m) { const int row = row0 + ai * HALF + m * 16; bf16_t* rowp = xb + (size_t)row * ldc + col0; float ssq = 0.f;
#pragma unroll
                for (int bj = 0; bj < 2; ++bj) { const u32x4 b = pre[ai][m][bj]; const f32x4 a0 = acc[ai][bj][m][0], a1 = acc[ai][bj][m][1];
                    float o[8];
                    o[0] = __uint_as_float(b.x << 16) + a0[0]; o[1] = __uint_as_float(b.x & 0xffff0000u) + a0[1]; o[2] = __uint_as_float(b.y << 16) + a0[2]; o[3] = __uint_as_float(b.y & 0xffff0000u) + a0[3];
                    o[4] = __uint_as_float(b.z << 16) + a1[0]; o[5] = __uint_as_float(b.z & 0xffff0000u) + a1[1]; o[6] = __uint_as_float(b.w << 16) + a1[2]; o[7] = __uint_as_float(b.w & 0xffff0000u) + a1[3];
                    ssq += ((o[0] * o[0] + o[1] * o[1]) + (o[2] * o[2] + o[3] * o[3])) + ((o[4] * o[4] + o[5] * o[5]) + (o[6] * o[6] + o[7] * o[7]));
                    u32x4 w; w.x = cvt_pk_bf16(o[0], o[1]); w.y = cvt_pk_bf16(o[2], o[3]); w.z = cvt_pk_bf16(o[4], o[5]); w.w = cvt_pk_bf16(o[6], o[7]);
                    store16(rowp + bj * HALF, w); }
                ssq += __shfl_xor(ssq, 16); ssq += __shfl_xor(ssq, 32);
                if (fq == 0) xss[(size_t)row * NSLOT_X + u.pn * 4 + wc] = ssq; }
    }
};

template <class Epi, class Sched, bool ALIGN_EPI = false, bool SP2 = false>
__device__ __forceinline__ void gemm_phase(PG8_LAS unsigned char* lds, const Gemm g, const Sched& S, const Epi& E) {
    int tid_ = threadIdx.x; asm volatile("" : "+v"(tid_));
    const int tid = tid_, wid = __builtin_amdgcn_readfirstlane(tid >> 6), lane = tid & 63, wr = wid >> 2, wc = wid & 3, fr = lane & 15, fq = lane >> 4;
    const int K = g.K, nt = K / BK;
    unsigned voffA[2], voffB[2];
#pragma unroll
    for (int i = 0; i < 2; ++i) { int R, C; stage_rc(tid * 16 + i * 8192, R, C); const int Rb = Epi::PERM ? ((R & ~31) + perm32(R & 31)) : R;
        voffA[i] = (unsigned)(R * g.lda + C) * 2u; voffB[i] = (unsigned)(Rb * K + C) * 2u; }
    const size_t kstep = (size_t)(BK * 2);
    const size_t hstep = (size_t)HALF * K * 2;
    const size_t tstep = 2 * hstep; const size_t hstepA = (size_t)HALF * g.lda * 2, tstepA = 2 * hstepA;
    const unsigned ldsw = (unsigned)wid * 1024u;
    const int aoff = lds_byte(wr * 64 + fr, fq * 8), boff = lds_byte(wc * 32 + fr, fq * 8);
#define PG8_SA(b, h) (((b) * 2 + (h)) * HTB)
#define PG8_SB(b, h) ((4 + (b) * 2 + (h)) * HTB)
#define PG8_STAGE(bufoff, gbase, voff) do { _Pragma("unroll") for (int _i = 0; _i < 2; ++_i) \
        __builtin_amdgcn_global_load_lds((const unsigned*)((const char*)(gbase) + (voff)[_i]), (PG8_LAS unsigned*)(lds + (bufoff) + ldsw + _i * 8192), 16, 0, 0); } while (0)
#define PG8_STAGE_B(bufoff, gbase, voff) do { _Pragma("unroll") for (int _i = 0; _i < 2; ++_i) \
        __builtin_amdgcn_global_load_lds((const unsigned*)((const char*)(gbase) + (voff)[_i]), (PG8_LAS unsigned*)(lds + (bufoff) + ldsw + _i * 8192), 16, 0, PG8_B_AUX); } while (0)
#define PG8_LDA(dst, b, h) do { _Pragma("unroll") for (int m = 0; m < 4; ++m) _Pragma("unroll") for (int k = 0; k < 2; ++k) dst[m][k] = *(const PG8_LAS bf16x8*)(lds + PG8_SA(b, h) + aoff + m * 2048 + k * 1024); } while (0)
#define PG8_LDB(dst, b, h) do { _Pragma("unroll") for (int n = 0; n < 2; ++n) _Pragma("unroll") for (int k = 0; k < 2; ++k) dst[n][k] = *(const PG8_LAS bf16x8*)(lds + PG8_SB(b, h) + boff + n * 2048 + k * 1024); } while (0)
#define PG8_MMA(ai, bj, At, Bt) do { __builtin_amdgcn_s_setprio(1); _Pragma("unroll") for (int m = 0; m < 4; ++m) _Pragma("unroll") for (int n = 0; n < 2; ++n) _Pragma("unroll") for (int k = 0; k < 2; ++k) \
        acc[ai][bj][m][n] = __builtin_amdgcn_mfma_f32_16x16x32_bf16(Bt[n][k], At[m][k], acc[ai][bj][m][n], 0, 0, 0); __builtin_amdgcn_s_setprio(0); } while (0)
#define PG8_WAIT_V(n) asm volatile("s_waitcnt vmcnt(" #n ")" ::: "memory")
#if PG8_SKIPW
#define PG8_WAIT_V8_UNLESS(c) asm volatile("s_cmp_lg_u32 %0, 0\n\ts_cbranch_scc1 .Lskipw%=\n\ts_waitcnt vmcnt(8)\n.Lskipw%=:" :: "s"(c) : "memory", "scc")
#else
#define PG8_WAIT_V8_UNLESS(c) PG8_WAIT_V(8)
#endif
#define PG8_WAIT_L(n) asm volatile("s_waitcnt lgkmcnt(" #n ")" ::: "memory")
#define PG8_BAR __builtin_amdgcn_s_barrier()
#define PG8_SCHED __builtin_amdgcn_sched_barrier(0)
    Unit cur, nxt; int ui = 0;
    if (!S.next(0, cur)) return;
    f32x4 acc[2][2][4][2];
#pragma unroll
    for (int a = 0; a < 2; ++a)
#pragma unroll
        for (int b = 0; b < 2; ++b)
#pragma unroll
            for (int m = 0; m < 4; ++m)
#pragma unroll
                for (int n = 0; n < 2; ++n) acc[a][b][m][n] = (f32x4){0.f, 0.f, 0.f, 0.f};
    bf16x8 At[4][2], B0[2][2], B1[2][2];
    const char* bA = (const char*)g.A + (size_t)cur.pm * tstepA; const char* bB = (const char*)g.Bt + (size_t)S.brow(cur) * K * 2;
    int ko = S.koff(cur, nt);
    const char* cA = bA + (size_t)ko * kstep; const char* cB = bB + (size_t)ko * kstep;
    S.a_ready(cur);
    if constexpr (SP2) {
        PG8_STAGE_B(PG8_SB(0, 0), cB, voffB); PG8_STAGE_B(PG8_SB(0, 1), cB + hstep, voffB); PG8_STAGE(PG8_SA(0, 0), cA, voffA); PG8_STAGE(PG8_SA(0, 1), cA + hstepA, voffA);
        if (wr == 1) PG8_BAR;
        PG8_WAIT_V(2); PG8_BAR;
        PG8_STAGE_B(PG8_SB(1, 0), cB + kstep, voffB); PG8_STAGE(PG8_SA(1, 0), cA + kstep, voffA); PG8_STAGE_B(PG8_SB(1, 1), cB + hstep + kstep, voffB);
        PG8_WAIT_V(6); PG8_BAR;
    } else {
        PG8_STAGE_B(PG8_SB(0, 0), cB, voffB); PG8_STAGE(PG8_SA(0, 0), cA, voffA); PG8_STAGE_B(PG8_SB(0, 1), cB + hstep, voffB); PG8_STAGE(PG8_SA(0, 1), cA + hstepA, voffA);
        if (wr == 1) PG8_BAR;
        PG8_WAIT_V(4); PG8_BAR;
        PG8_STAGE_B(PG8_SB(1, 0), cB + kstep, voffB); PG8_STAGE(PG8_SA(1, 0), cA + kstep, voffA); PG8_STAGE_B(PG8_SB(1, 1), cB + hstep + kstep, voffB);
        PG8_WAIT_V(6); PG8_BAR;
    }
    for (;;) {
        const bool has_next = S.next(ui + 1, nxt);
        const char* nbA = has_next ? (const char*)g.A + (size_t)nxt.pm * tstepA : bA; const char* nbB = has_next ? (const char*)g.Bt + (size_t)S.brow(nxt) * K * 2 : bB;
        const int kon = has_next ? S.koff(nxt, nt) : ko;
        const char* nA = nbA + (size_t)kon * kstep; const char* nB = nbB + (size_t)kon * kstep;
        const bool full = !(Sched::HAS_HALF && cur.hf);
        const int ntl = (PROBE == 9 && Epi::PROBE_TWICE) ? 2 * nt : nt;
        for (int t = 0; t < ntl; t += 2) {
            const bool last = (t == ntl - 2);
#if PG8_SKIPW
            int skipv_ = (ui > 0 && t == 0) ? 1 : 0; asm volatile("" : "+v"(skipv_)); const int skipw = __builtin_amdgcn_readfirstlane(skipv_);
#endif
            int t1 = t + 1 + ko, t2 = t + 2 + ko; t1 -= (t1 >= nt) ? nt : 0; t1 -= (t1 >= nt) ? nt : 0; t1 -= (t1 >= nt) ? nt : 0; t2 -= (t2 >= nt) ? nt : 0; t2 -= (t2 >= nt) ? nt : 0; t2 -= (t2 >= nt) ? nt : 0;
            const char* a1 = bA + (size_t)t1 * kstep;
            const char* a2 = last ? nA : bA + (size_t)t2 * kstep; const char* b2 = last ? nB : bB + (size_t)t2 * kstep;
            const char* a3 = a2 + kstep; const char* b3 = b2 + kstep;
            if (last && has_next) S.a_ready(nxt);
            if constexpr (SP2) {
            PG8_LDB(B0, 0, 0); if (full) PG8_LDB(B1, 0, 1); PG8_SCHED; PG8_LDA(At, 0, 0); PG8_STAGE(PG8_SA(1, 1), a1 + hstepA, voffA);
            PG8_WAIT_V8_UNLESS(skipw); PG8_WAIT_L(0); PG8_BAR; PG8_MMA(0, 0, At, B0); if (full) PG8_MMA(0, 1, At, B1); PG8_BAR; PG8_SCHED;
            PG8_LDA(At, 0, 1); PG8_STAGE_B(PG8_SB(0, 0), b2, voffB); PG8_STAGE_B(PG8_SB(0, 1), b2 + hstep, voffB); PG8_STAGE(PG8_SA(0, 0), a2, voffA);
            PG8_WAIT_V8_UNLESS(skipw); PG8_WAIT_L(0); PG8_BAR; PG8_MMA(1, 0, At, B0); if (full) PG8_MMA(1, 1, At, B1); PG8_BAR; PG8_SCHED;
            PG8_LDB(B0, 1, 0); if (full) PG8_LDB(B1, 1, 1); PG8_SCHED; PG8_LDA(At, 1, 0); PG8_STAGE(PG8_SA(0, 1), a2 + hstepA, voffA);
            PG8_WAIT_V(8); PG8_WAIT_L(0); PG8_BAR; PG8_MMA(0, 0, At, B0); if (full) PG8_MMA(0, 1, At, B1); PG8_BAR; PG8_SCHED;
            PG8_LDA(At, 1, 1); PG8_STAGE_B(PG8_SB(1, 0), b3, voffB); PG8_STAGE_B(PG8_SB(1, 1), b3 + hstep, voffB); PG8_STAGE(PG8_SA(1, 0), a3, voffA);
            PG8_WAIT_V(8); PG8_WAIT_L(0); PG8_BAR; PG8_MMA(1, 0, At, B0); if (full) PG8_MMA(1, 1, At, B1); PG8_BAR; PG8_SCHED;
            } else {
            PG8_LDB(B0, 0, 0); PG8_SCHED; PG8_LDA(At, 0, 0); PG8_STAGE(PG8_SA(1, 1), a1 + hstepA, voffA);
            PG8_WAIT_L(8); PG8_BAR; PG8_WAIT_L(0); PG8_MMA(0, 0, At, B0); PG8_BAR; PG8_SCHED;
            PG8_LDB(B1, 0, 1); PG8_STAGE_B(PG8_SB(0, 0), b2, voffB);
            PG8_BAR; PG8_WAIT_L(0); if (full) PG8_MMA(0, 1, At, B1); PG8_BAR;
            PG8_LDA(At, 0, 1); PG8_STAGE(PG8_SA(0, 0), a2, voffA);
            PG8_BAR; PG8_WAIT_L(0); PG8_MMA(1, 0, At, B0); PG8_BAR; PG8_SCHED;
            PG8_STAGE_B(PG8_SB(0, 1), b2 + hstep, voffB);
            PG8_WAIT_V(6); PG8_BAR; if (full) PG8_MMA(1, 1, At, B1); PG8_BAR;
            PG8_LDB(B0, 1, 0); PG8_SCHED; PG8_LDA(At, 1, 0); PG8_STAGE(PG8_SA(0, 1), a2 + hstepA, voffA);
            PG8_WAIT_L(8); PG8_BAR; PG8_WAIT_L(0); PG8_MMA(0, 0, At, B0); PG8_BAR; PG8_SCHED;
            PG8_LDB(B1, 1, 1); PG8_STAGE_B(PG8_SB(1, 0), b3, voffB);
            PG8_BAR; PG8_WAIT_L(0); if (full) PG8_MMA(0, 1, At, B1); PG8_BAR;
            PG8_LDA(At, 1, 1); PG8_STAGE(PG8_SA(1, 0), a3, voffA);
            PG8_BAR; PG8_WAIT_L(0); PG8_MMA(1, 0, At, B0); PG8_BAR; PG8_SCHED;
            PG8_STAGE_B(PG8_SB(1, 1), b3 + hstep, voffB);
            PG8_WAIT_V(6); PG8_BAR; if (full) PG8_MMA(1, 1, At, B1); PG8_BAR;
            }
        }
        if constexpr (ALIGN_EPI) { if (wr == 0) PG8_BAR; }
        if constexpr (!Epi::AFTER_DRAIN) { if (PG8_SKIPW) PG8_WAIT_V(0); E(acc, cur, wr, wc, fr, fq); if (PROBE == 8 && Epi::PROBE_TWICE) { asm volatile("" ::: "memory"); E(acc, cur, wr, wc, fr, fq); } S.done(cur); }
        if (!has_next) break;
#pragma unroll
        for (int a = 0; a < 2; ++a)
#pragma unroll
            for (int b = 0; b < 2; ++b)
#pragma unroll
                for (int m = 0; m < 4; ++m)
#pragma unroll
                    for (int n = 0; n < 2; ++n) acc[a][b][m][n] = (f32x4){0.f, 0.f, 0.f, 0.f};
        cur = nxt; bA = nbA; bB = nbB; ko = kon; ++ui;
        if constexpr (ALIGN_EPI) { if (wr == 1) PG8_BAR; }
    }
    PG8_WAIT_V(0);
    if constexpr (!ALIGN_EPI) { if (wr == 0) PG8_BAR; }
    PG8_BAR;
    if constexpr (Epi::AFTER_DRAIN) { E.fused(acc, cur, wr, wc, fr, fq, lds, wid, lane); S.done(cur); }
#undef PG8_SA
#undef PG8_SB
#undef PG8_STAGE
#undef PG8_STAGE_B
#undef PG8_LDA
#undef PG8_LDB
#undef PG8_MMA
#undef PG8_WAIT_V
#undef PG8_WAIT_V8_UNLESS
#undef PG8_WAIT_L
#undef PG8_BAR
#undef PG8_SCHED
}
}

constexpr int NWAVES = 8;
constexpr int BATCH = 2, SEQ = 8192, D = 1024, DEPTH = 4, M = BATCH * SEQ;
constexpr int AP = 4096 + 64;
constexpr int GH = 2048, GH2 = 4096, SGU_G = 8, SGU_P = 128, SGU_C = 256;
constexpr int NH = 16, HD = 64, NREL = 192, CHUNK = 64;
constexpr int FF = 2816, FF2 = 5632, FF_NFULL = 20;
constexpr float EPS = 1e-6f;
constexpr float LOG2E = 1.4426950408889634f;
constexpr float QSCALE = 0.125f * LOG2E;

#ifndef MK_PER_PHASE
#define MK_PER_PHASE 0
#endif
constexpr int N_PHASES = 22;

constexpr size_t MiB = 1u << 20;
constexpr size_t WS_CTL = 0, CTL_ZERO_BYTES = 64 * 1024;
constexpr size_t WS_XSS = 1 * MiB;
constexpr size_t WS_VSS = 2 * MiB;
constexpr size_t WS_W = 4 * MiB;
constexpr size_t WS_XB = 110 * MiB;
constexpr size_t WS_ACT = 142 * MiB;
constexpr size_t WS_END = 273 * MiB;
constexpr size_t WO_IN = 0, WO_AOUT = 8388608, WO_QKV = 12582912, WO_BOUT = 18874368, WO_GU = 20971520, WO_DN = 44040192, WO_END = 55574528;
static_assert(WS_W + WO_END * 2 <= WS_XB && WS_XB + (size_t)M * D * 2 <= WS_ACT && WS_ACT + (size_t)M * AP * 2 <= WS_END, "d_ws map");
constexpr int CW_BAR = 1024;

constexpr int RING_OFF = 0, RING_BYTES = 131072;
constexpr int LDSCTL_OFF = RING_BYTES, MISC_OFF = LDSCTL_OFF + 320, RSTAB_OFF = LDSCTL_OFF + 1024;
constexpr int LDS_BYTES = 147456;
static_assert(MISC_OFF + 128 <= LDS_BYTES, "LDS map");

#define GAS __attribute__((address_space(1)))
#define LAS __attribute__((address_space(3)))
typedef unsigned short bf16;
typedef unsigned v4u __attribute__((ext_vector_type(4)));
typedef unsigned v2u __attribute__((ext_vector_type(2)));
typedef float f32x4 __attribute__((ext_vector_type(4)));
typedef float f32x16 __attribute__((ext_vector_type(16)));
typedef short bf16x8 __attribute__((ext_vector_type(8)));
typedef short s16x4 __attribute__((ext_vector_type(4)));
typedef GAS unsigned gu32;
#define RLX_AGENT __ATOMIC_RELAXED, __HIP_MEMORY_SCOPE_AGENT
#define LDS_WAIT() asm volatile("s_waitcnt lgkmcnt(0)" ::: "memory")
#define VM_WAIT() asm volatile("s_waitcnt vmcnt(0)" ::: "memory")
__device__ __forceinline__ unsigned pk2(float lo, float hi) { return pg8::cvt_pk_bf16(lo, hi); }
__device__ __forceinline__ float bf_lo(unsigned w) { return __uint_as_float(w << 16); }
__device__ __forceinline__ float bf_hi(unsigned w) { return __uint_as_float(w & 0xffff0000u); }
__device__ __forceinline__ float wave_sum(float v) {
#pragma unroll
    for (int o = 1; o < 64; o <<= 1) v += __shfl_xor(v, o);
    return v;
}
#define XB_TMO      128
#define XB_XCNT(j)  (256  + 64 * (j))
#define XB_XSUB(j)  (1280 + 64 * (j))
#define XB_XGEN(j)  (2304 + 64 * (j))
#define XB_TOP      3328
#define XB_TOPGEN   3392
#define XB_LSUB(j)  (3456 + 64 * (j))
#define XB_LGEN(j)  (4480 + 64 * (j))
#define XCD_BAR_WORDS 5504
#define XB_SPIN_CAP (1u << 18)
#ifndef XB_EARLY
#define XB_EARLY 1
#endif
#if XB_EARLY
#define XB_EARLY_INV() asm volatile("buffer_inv sc1" ::: "memory")
#define XB_LATE_ACQ()  asm volatile("" ::: "memory")
#else
#define XB_EARLY_INV() do { } while (0)
#define XB_LATE_ACQ()  __builtin_amdgcn_fence(__ATOMIC_ACQUIRE, "agent")
#endif

__device__ __forceinline__ unsigned xb_ld(unsigned* p)              { return __hip_atomic_load(p, __ATOMIC_RELAXED, __HIP_MEMORY_SCOPE_AGENT); }
__device__ __forceinline__ unsigned xb_add(unsigned* p, unsigned v) { return __hip_atomic_fetch_add(p, v, __ATOMIC_RELAXED, __HIP_MEMORY_SCOPE_AGENT); }
__device__ __forceinline__ unsigned xb_xcc_id() { return (unsigned)__builtin_amdgcn_s_getreg((3 << 11) | 20) & 0xFu; }
#define XB_SPIN(cond, bar) do { unsigned _sp = 0; while (cond) { __builtin_amdgcn_s_sleep(1); \
    if ((++_sp & 255u) == 0u) { if (xb_ld(&(bar)[XB_TMO])) break; if (_sp > XB_SPIN_CAP) { atomicAdd(&(bar)[XB_TMO], 1u); break; } } } } while (0)

struct XcdBarrier {
    unsigned* bar; unsigned x;
    volatile LAS unsigned* st;
};

__device__ __forceinline__ XcdBarrier xcd_barrier_post(unsigned* bar, volatile LAS unsigned* st) {
    XcdBarrier b; b.bar = bar; b.x = xb_xcc_id(); b.st = st;
    if (threadIdx.x == 0) st[3] = xb_add(&bar[XB_XCNT(b.x)], 1u);
    return b;
}
__device__ __forceinline__ void xcd_barrier_complete(unsigned* bar, unsigned x, unsigned& nloc, unsigned& nx, unsigned& xi) {
    const unsigned G = gridDim.x * gridDim.y * gridDim.z;
    unsigned sum, cnt, mine, below, sp = 0u;
    for (;;) {
        sum = 0u; cnt = 0u; mine = 0u; below = 0u;
#pragma unroll
        for (unsigned j = 0; j < 16; ++j) { const unsigned c = xb_ld(&bar[XB_XCNT(j)]); sum += c; cnt += (c > 0u) ? 1u : 0u; mine = (j == x) ? c : mine; below += (j < x && c > 0u) ? 1u : 0u; }
        if (sum == G) break;
        __builtin_amdgcn_s_sleep(1);
        if ((++sp & 255u) == 0u) { if (xb_ld(&bar[XB_TMO])) break; if (sp > XB_SPIN_CAP) { atomicAdd(&bar[XB_TMO], 1u); break; } }
    }
    nloc = mine > 0u ? mine : 1u; nx = cnt > 0u ? cnt : 1u; xi = below;
}

__device__ __forceinline__ void xcd_barrier(const XcdBarrier& b) {
    asm volatile("s_waitcnt vmcnt(0)" ::: "memory");
    __syncthreads();
    if (threadIdx.x == 0) {
        const unsigned bx_ = xb_xcc_id();
        unsigned* bar = b.bar; asm volatile("" : "+s"(bar));
        __builtin_amdgcn_s_waitcnt(0);
        XB_EARLY_INV();
        unsigned nloc = b.st[0], nx = b.st[1];
        if (nloc == 0u) { unsigned xi_; xcd_barrier_complete(bar, bx_, nloc, nx, xi_); b.st[0] = nloc; b.st[1] = nx; b.st[2] = xi_; }
        const unsigned old = xb_add(&bar[XB_XSUB(bx_)], 1u);
        const unsigned gen = old / nloc;
        if (old + 1u == (gen + 1u) * nloc) {
            __builtin_amdgcn_fence(__ATOMIC_RELEASE, "agent");
            asm volatile("s_waitcnt vmcnt(0)" ::: "memory");
            const unsigned og = xb_add(&bar[XB_TOP], 1u);
            const unsigned tg = og / nx;
            if (og + 1u == (tg + 1u) * nx) xb_add(&bar[XB_TOPGEN], 1u);
            else XB_SPIN(xb_ld(&bar[XB_TOPGEN]) == tg, bar);
            XB_LATE_ACQ();
            xb_add(&bar[XB_XGEN(bx_)], 1u);
            asm volatile("s_waitcnt vmcnt(0)" ::: "memory");
        } else {
            XB_SPIN(xb_ld(&bar[XB_XGEN(bx_)]) == gen, bar);
            XB_LATE_ACQ();
            asm volatile("s_waitcnt vmcnt(0)" ::: "memory");
        }
    }
    __syncthreads();
}

__device__ __forceinline__ void xcd_barrier_local(const XcdBarrier& b) {
    asm volatile("s_waitcnt vmcnt(0)" ::: "memory");
    __syncthreads();
    if (threadIdx.x == 0) {
        const unsigned bx_ = xb_xcc_id();
        unsigned* bar = b.bar; asm volatile("" : "+s"(bar));
        const unsigned nloc = b.st[0];
        XB_EARLY_INV();
        const unsigned old = xb_add(&bar[XB_LSUB(bx_)], 1u);
        const unsigned gen = old / nloc;
        if (old + 1u == (gen + 1u) * nloc) xb_add(&bar[XB_LGEN(bx_)], 1u);
        else XB_SPIN(xb_ld(&bar[XB_LGEN(bx_)]) == gen, bar);
        XB_LATE_ACQ();
        asm volatile("s_waitcnt vmcnt(0)" ::: "memory");
    }
    __syncthreads();
}

__device__ __forceinline__ void p0_transpose_item(const float* W, const float* gain, int K, int N, bf16* WT, int drow0, bool sp, int k0, int n0, LAS unsigned* scr, int lane) {
    const int kp = lane >> 4, n4 = lane & 15;
    f32x4 w[8][2];
    const float* src = W + (size_t)(k0 + 2 * kp) * N + n0 + 4 * n4;
#pragma unroll
    for (int i = 0; i < 8; ++i) { w[i][0] = __builtin_nontemporal_load((const f32x4*)(src + (size_t)(8 * i) * N)); w[i][1] = __builtin_nontemporal_load((const f32x4*)(src + (size_t)(8 * i + 1) * N)); }
    if (gain) {
#pragma unroll
        for (int i = 0; i < 8; ++i) { const float g0 = gain[k0 + 8 * i + 2 * kp], g1 = gain[k0 + 8 * i + 2 * kp + 1]; w[i][0] = w[i][0] * g0; w[i][1] = w[i][1] * g1; }
    }
#pragma unroll
    for (int i = 0; i < 8; ++i)
#pragma unroll
        for (int e = 0; e < 4; ++e) scr[(4 * n4 + e) * 33 + 4 * i + kp] = pk2(w[i][0][e], w[i][1][e]);
    LDS_WAIT(); asm volatile("" ::: "memory");
    const int c = lane & 7;
#pragma unroll
    for (int jn = 0; jn < 8; ++jn) { const int n = (lane >> 3) + 8 * jn; const LAS unsigned* s = scr + n * 33 + 4 * c;
        v4u o; o.x = s[0]; o.y = s[1]; o.z = s[2]; o.w = s[3];
        const int dr = sp ? ((n >> 4) * 32 + ((n & 15) >> 2) * 8 + (n & 3)) : n;
        pg8::store16(WT + (size_t)(drow0 + dr) * K + k0 + 8 * c, o); }
    LDS_WAIT(); asm volatile("" ::: "memory");
}
struct Ptrs {
    const float *x, *norm_mix_g, *norm_ffn_g, *final_g, *a_w_in, *a_v_gain, *a_w_s, *a_b_s, *a_w_out, *b_w_qkv, *b_rel_bias, *b_w_out, *ffn_w_gate, *ffn_w_up, *ffn_w_down;
    float* out; bf16* wt; bf16* xb; bf16* act; float* xss; float* vss;
};
__device__ __forceinline__ void p0_prologue(const Ptrs& P, LAS unsigned char* lds, int vcu, int G, int wave, int lane) {
    LAS unsigned* scr = (LAS unsigned*)(lds + RING_OFF + wave * 16384);
    const int gw = vcu * NWAVES + wave, NGW = G * NWAVES;
    constexpr int I_IN = 16 * 64, I_AOUT = 32 * 16, I_QKV = 16 * 48, I_BOUT = 16 * 16, I_GU = 16 * 44, I_DN = 44 * 16;
    constexpr int NITEMS = 2 * I_IN + 2 * I_AOUT + 2 * I_QKV + 2 * I_BOUT + 8 * I_GU + 4 * I_DN;
    for (int it = gw; it < NITEMS; it += NGW) {
        int r = it; const float* W; const float* gain = nullptr; bf16* dst; int K, N, mode = 0;
        if (r < 2 * I_IN) { const int j = r / I_IN; r -= j * I_IN; W = P.a_w_in + (size_t)j * D * GH2; gain = P.norm_mix_g + (2 * j) * D; K = D; N = GH2; dst = P.wt + WO_IN + (size_t)j * D * GH2; }
        else if ((r -= 2 * I_IN) < 2 * I_AOUT) { const int j = r / I_AOUT; r -= j * I_AOUT; W = P.a_w_out + (size_t)j * GH * D; K = GH; N = D; dst = P.wt + WO_AOUT + (size_t)j * GH * D; }
        else if ((r -= 2 * I_AOUT) < 2 * I_QKV) { const int j = r / I_QKV; r -= j * I_QKV; W = P.b_w_qkv + (size_t)j * D * 3 * D; gain = P.norm_mix_g + (2 * j + 1) * D; K = D; N = 3 * D; dst = P.wt + WO_QKV + (size_t)j * D * 3 * D; }
        else if ((r -= 2 * I_QKV) < 2 * I_BOUT) { const int j = r / I_BOUT; r -= j * I_BOUT; W = P.b_w_out + (size_t)j * D * D; K = D; N = D; dst = P.wt + WO_BOUT + (size_t)j * D * D; }
        else if ((r -= 2 * I_BOUT) < 4 * I_GU) { const int i = r / I_GU; r -= i * I_GU; W = P.ffn_w_gate + (size_t)i * D * FF; gain = P.norm_ffn_g + i * D; K = D; N = FF; dst = P.wt + WO_GU + (size_t)i * D * FF2; mode = 1; }
        else if ((r -= 4 * I_GU) < 4 * I_GU) { const int i = r / I_GU; r -= i * I_GU; W = P.ffn_w_up + (size_t)i * D * FF; gain = P.norm_ffn_g + i * D; K = D; N = FF; dst = P.wt + WO_GU + (size_t)i * D * FF2; mode = 2; }
        else { r -= 4 * I_GU; const int i = r / I_DN; r -= i * I_DN; W = P.ffn_w_down + (size_t)i * FF * D; K = FF; N = D; dst = P.wt + WO_DN + (size_t)i * FF * D; }
        const int nblk = N / 64, kb = r / nblk, nb = r % nblk, k0 = 64 * kb, n0 = 64 * nb;
        const bool sp = (mode != 0) && (n0 >= FF_NFULL * 128);
        const int drow0 = (mode == 0) ? n0 : sp ? (FF_NFULL * 256 + ((n0 - FF_NFULL * 128) >> 6) * 128 + (mode == 2 ? 4 : 0)) : ((n0 >> 7) * 256 + (n0 & 127) + (mode == 2 ? 128 : 0));
        p0_transpose_item(W, gain, K, N, dst, drow0, sp, k0, n0, scr, lane);
    }
    for (int m = gw; m < M; m += 2 * NGW) {
        const int m2 = (m + NGW < M) ? m + NGW : m;
        const GAS f32x4* xr = (const GAS f32x4*)(P.x + (size_t)m * D) + 2 * lane; const GAS f32x4* xr2 = (const GAS f32x4*)(P.x + (size_t)m2 * D) + 2 * lane; f32x4 v[4], v2[4]; float s = 0.f, s2 = 0.f;
#pragma unroll
        for (int j = 0; j < 2; ++j) { v[2 * j] = __builtin_nontemporal_load(xr + 128 * j); v[2 * j + 1] = __builtin_nontemporal_load(xr + 128 * j + 1); v2[2 * j] = __builtin_nontemporal_load(xr2 + 128 * j); v2[2 * j + 1] = __builtin_nontemporal_load(xr2 + 128 * j + 1); }
#pragma unroll
        for (int j = 0; j < 4; ++j) { s += (v[j].x * v[j].x + v[j].y * v[j].y) + (v[j].z * v[j].z + v[j].w * v[j].w); s2 += (v2[j].x * v2[j].x + v2[j].y * v2[j].y) + (v2[j].z * v2[j].z + v2[j].w * v2[j].w); }
        s = wave_sum(s); s2 = wave_sum(s2);
        bf16* o8 = P.xb + (size_t)m * D + 8 * lane; bf16* o82 = P.xb + (size_t)m2 * D + 8 * lane;
#pragma unroll
        for (int j = 0; j < 2; ++j) {
            v4u w; w.x = pk2(v[2 * j].x, v[2 * j].y); w.y = pk2(v[2 * j].z, v[2 * j].w); w.z = pk2(v[2 * j + 1].x, v[2 * j + 1].y); w.w = pk2(v[2 * j + 1].z, v[2 * j + 1].w); pg8::store16(o8 + 512 * j, w);
            v4u w2; w2.x = pk2(v2[2 * j].x, v2[2 * j].y); w2.y = pk2(v2[2 * j].z, v2[2 * j].w); w2.z = pk2(v2[2 * j + 1].x, v2[2 * j + 1].y); w2.w = pk2(v2[2 * j + 1].z, v2[2 * j + 1].w); pg8::store16(o82 + 512 * j, w2); }
        if (lane < pg8::NSLOT_X) { P.xss[(size_t)m * pg8::NSLOT_X + lane] = (lane == 0) ? s : 0.f; P.xss[(size_t)m2 * pg8::NSLOT_X + lane] = (lane == 0) ? s2 : 0.f; }
    }
}

constexpr int SP_A_PITCH = 272, SP_V_PITCH = 528;
constexpr int SP_A_OFF = 0, SP_V_OFF = 36864, SP_R_OFF = 106496;
typedef short v4i16_t __attribute__((ext_vector_type(4)));
__device__ __forceinline__ s16x4 tr_read(const LAS unsigned char* p) { return __builtin_bit_cast(s16x4, __builtin_amdgcn_ds_read_tr16_b64_v4i16((LAS v4i16_t*)p)); }
template <bool DRY> __device__ __forceinline__ void spatial_phase(const Ptrs& P, int j, LAS unsigned char* lds, int vcu, int G, int wave, const pg8::Sch sc) {
    int tid = threadIdx.x; asm volatile("" : "+v"(tid)); const int lane = tid & 63;
    bf16* uv = P.act;
    LAS unsigned char* Aimg = lds + SP_A_OFF; LAS unsigned char* Vimg = lds + SP_V_OFF; LAS float* rsL = (LAS float*)(lds + SP_R_OFF);
    const int fr = lane & 15, fq = lane >> 4;
    const int NU = sc.lm ? 128 : (M / SGU_P) * SGU_G, ufirst = sc.lm ? sc.rank : vcu, ustride = sc.lm ? sc.nloc : G, ubase = sc.lm ? 128 * sc.gi : 0;
    f32x4 sv[2]; v4u vt[8]; f32x4 wq[8]; v4u uq[8]; float bq[8]; f32x4 gq0, gq1;
#define SP_LOAD_A(U) do { const int g_ = (U) & 7, row0_ = ((U) >> 3) * SGU_P; \
        { const f32x4* p_ = (const f32x4*)(P.vss + (size_t)(row0_ + (tid >> 2)) * pg8::NSLOT_V) + (tid & 3) * 2; sv[0] = p_[0]; sv[1] = p_[1]; } \
        _Pragma("unroll") for (int i = 0; i < 8; ++i) { const int pc = tid + 512 * i, q = pc >> 5, ch = pc & 31; vt[i] = __builtin_nontemporal_load((const v4u*)(uv + (size_t)(row0_ + q) * AP + GH + g_ * SGU_C + ch * 8)); } \
        { const float* ws_ = P.a_w_s + ((size_t)j * SGU_G + g_) * SGU_P * SGU_P; \
          _Pragma("unroll") for (int i = 0; i < 4; ++i) { const int e = tid + 512 * i, p = e >> 4, q0 = (e & 15) * 8; wq[2 * i] = *(const f32x4*)(ws_ + p * SGU_P + q0); wq[2 * i + 1] = *(const f32x4*)(ws_ + p * SGU_P + q0 + 4); } } } while (0)
#define SP_LOAD_B(U) do { const int g_ = (U) & 7, row0_ = ((U) >> 3) * SGU_P; \
        { const int cc_ = g_ * SGU_C + 32 * wave + 8 * fq; gq0 = *(const f32x4*)(P.a_v_gain + (size_t)j * GH + cc_); gq1 = *(const f32x4*)(P.a_v_gain + (size_t)j * GH + cc_ + 4); \
          _Pragma("unroll") for (int pt = 0; pt < 8; ++pt) { const int p = 16 * pt + fr; uq[pt] = __builtin_nontemporal_load((const v4u*)(uv + (size_t)(row0_ + p) * AP + cc_)); bq[pt] = P.a_b_s[((size_t)j * SGU_G + g_) * SGU_P + p]; } } } while (0)
    int uk = ufirst;
    if (uk < NU) { SP_LOAD_A(uk + ubase); SP_LOAD_B(uk + ubase); }
    for (; uk < NU; uk += ustride) {
        const int unit = uk + ubase, nb = unit >> 3, g = unit & 7, row0 = nb * SGU_P;
        { float s = ((sv[0][0] + sv[0][1]) + (sv[0][2] + sv[0][3])) + ((sv[1][0] + sv[1][1]) + (sv[1][2] + sv[1][3])); s += __shfl_xor(s, 1); s += __shfl_xor(s, 2);
            if ((tid & 3) == 0) rsL[tid >> 2] = __builtin_amdgcn_rsqf(s * (1.0f / GH) + EPS); }
#pragma unroll
        for (int i = 0; i < 8; ++i) { const int pc = tid + 512 * i, q = pc >> 5, ch = pc & 31; *(LAS v4u*)(Vimg + q * SP_V_PITCH + ch * 16) = vt[i]; }
        __syncthreads();
#pragma unroll
        for (int i = 0; i < 4; ++i) { const int e = tid + 512 * i, p = e >> 4, q0 = (e & 15) * 8;
            const f32x4 w0 = wq[2 * i], w1 = wq[2 * i + 1];
            const f32x4 r0 = *(const LAS f32x4*)(rsL + q0), r1 = *(const LAS f32x4*)(rsL + q0 + 4);
            v4u o; o.x = pk2(w0[0] * r0[0], w0[1] * r0[1]); o.y = pk2(w0[2] * r0[2], w0[3] * r0[3]); o.z = pk2(w1[0] * r1[0], w1[1] * r1[1]); o.w = pk2(w1[2] * r1[2], w1[3] * r1[3]);
            *(LAS v4u*)(Aimg + p * SP_A_PITCH + q0 * 2) = o; }
        __syncthreads();
        if (uk + ustride < NU) SP_LOAD_A(unit + ustride);
        const f32x4 gn0 = gq0, gn1 = gq1;
        bf16x8 vf[2][4];
        { const LAS unsigned char* vb = Vimg + (8 * fq + ((lane & 15) >> 2)) * SP_V_PITCH + (32 * wave + 8 * (lane & 3)) * 2;
#pragma unroll
            for (int ks = 0; ks < 4; ++ks)
#pragma unroll
                for (int n = 0; n < 2; ++n) { const s16x4 lo = tr_read(vb + ks * 32 * SP_V_PITCH + n * 8), hi = tr_read(vb + ks * 32 * SP_V_PITCH + 4 * SP_V_PITCH + n * 8);
                    vf[n][ks] = (bf16x8){lo[0], lo[1], lo[2], lo[3], hi[0], hi[1], hi[2], hi[3]}; } }
        const int cc = g * SGU_C + 32 * wave + 8 * fq;
#pragma unroll
        for (int pt = 0; pt < 8; ++pt) {
            f32x4 a0 = {0.f, 0.f, 0.f, 0.f}, a1 = {0.f, 0.f, 0.f, 0.f};
            const LAS unsigned char* ab = Aimg + (16 * pt + fr) * SP_A_PITCH + (8 * fq) * 2;
#pragma unroll
            for (int ks = 0; ks < 4; ++ks) if (ks < (pt < 4 ? 2 : 4)) { const bf16x8 af = *(const LAS bf16x8*)(ab + ks * 64);
                a0 = __builtin_amdgcn_mfma_f32_16x16x32_bf16(vf[0][ks], af, a0, 0, 0, 0); a1 = __builtin_amdgcn_mfma_f32_16x16x32_bf16(vf[1][ks], af, a1, 0, 0, 0); }
            const int p = 16 * pt + fr; bf16* up = uv + (size_t)(row0 + p) * AP + cc;
            const float b = bq[pt]; const v4u u8 = uq[pt];
            v4u o;
            o.x = pk2(bf_lo(u8.x) * (gn0[0] * a0[0] + b), bf_hi(u8.x) * (gn0[1] * a0[1] + b)); o.y = pk2(bf_lo(u8.y) * (gn0[2] * a0[2] + b), bf_hi(u8.y) * (gn0[3] * a0[3] + b));
            o.z = pk2(bf_lo(u8.z) * (gn1[0] * a1[0] + b), bf_hi(u8.z) * (gn1[1] * a1[1] + b)); o.w = pk2(bf_lo(u8.w) * (gn1[2] * a1[2] + b), bf_hi(u8.w) * (gn1[3] * a1[3] + b));
            if (DRY) *(v4u*)((bf16*)P.out + (size_t)(row0 + p) * D + (g & 3) * SGU_C + 32 * wave + 8 * fq) = o; else pg8::store16(up, o);
        }
        asm volatile("" ::: "memory");
        if (uk + ustride < NU) SP_LOAD_B(unit + ustride);
        __syncthreads();
    }
#undef SP_LOAD_A
#undef SP_LOAD_B
}

constexpr int AT_NSL = 8, AT_K = 0, AT_V = AT_NSL * 8192, AT_BT = RSTAB_OFF + 1024, AT_WS = AT_BT + 1024, AT_OST = AT_K;
static_assert(AT_WS + 2048 <= LDS_BYTES && 2 * AT_NSL * 8192 <= RING_BYTES, "attention LDS map");
constexpr float ATT_THR = 8.0f;
__device__ __forceinline__ int crow(int r, int hi) { return (r & 3) + 8 * (r >> 2) + 4 * hi; }
#define MX3(a, b, c) __builtin_fmaxf(__builtin_fmaxf((a), (b)), (c))
__device__ __forceinline__ void glds16(const void* gsrc, unsigned lds_dst) { unsigned keep;
    asm volatile("s_mov_b32 %0, m0\n\ts_mov_b32 m0, %2\n\ts_nop 0\n\tglobal_load_lds_dwordx4 %1, off\n\ts_mov_b32 m0, %0" : "=&s"(keep) : "v"(gsrc), "s"(lds_dst) : "memory"); }
template <int DRY> __device__ __forceinline__ void attn_phase(const Ptrs& P, int j, LAS unsigned char* lds, int vcu, int G, int wave, const pg8::Sch sc) {
    int tid = threadIdx.x; asm volatile("" : "+v"(tid)); const int lane = tid & 63;
    bf16* Q = P.act; const bf16* Kt = P.act + D; const bf16* Vt = P.act + 2 * D;
    const int r32 = lane & 31, hi = lane >> 5, ci = wave >> 1, qh = wave & 1;
    LAS float* bt = (LAS float*)(lds + AT_BT); LAS float* wsf = (LAS float*)(lds + AT_WS) + wave * 64;
    const unsigned lds0 = (unsigned)(size_t)lds;
    const int NUA = sc.lm ? 128 : BATCH * NH * (SEQ / 256), afirst = sc.lm ? sc.rank : vcu, astride = sc.lm ? sc.nloc : G;
#define ATT_DEC(UK, B_, H_, CQ_) do { if (sc.lm) { const int p_ = 8 * sc.gi + ((UK) & 7); H_ = (UK) >> 3; B_ = p_ >> 5; CQ_ = p_ & 31; } else { const int bh_ = (UK) >> 5; CQ_ = (UK) & 31; B_ = bh_ >> 4; H_ = bh_ & 15; } } while (0)
#define ATT_SLOT(t, pr) ((((t) + 4 * (pr)) & 7) * 8192)
    int par = 0;
    bf16x8 qnx[4] = {}; float rbx0 = 0.f, rbx1 = 0.f;
    for (int uk = afirst; uk < NUA; uk += astride, par ^= 1) {
        int b, h, cq; ATT_DEC(uk, b, h, cq);
        const size_t rowbase = (size_t)b * SEQ;
        const size_t qrow = rowbase + (size_t)(4 * cq + ci) * CHUNK + 32 * qh;
        const int s_lo = (4 * cq >= 8) ? 0 : 8 - 4 * cq;
        const long trow0 = (long)rowbase + (long)(4 * cq - 8) * CHUNK;
        const bf16* ksrc = Kt + (trow0 + 8 * wave + (lane >> 3)) * AP + h * HD + ((lane & 7) ^ ((4 * (wave & 1) + (lane >> 4)) & 7)) * 8;
        const bf16* vsrc = Vt + (trow0 + 16 * (wave & 3) + (lane >> 2)) * AP + h * HD + (wave >> 2) * 32 + (lane & 3) * 8;
        const bool has_n = uk + astride < NUA; int bn = 0, hn = 0, cqn = 0; if (has_n) ATT_DEC(uk + astride, bn, hn, cqn);
        const int s_lo_n = has_n ? ((4 * cqn >= 8) ? 0 : 8 - 4 * cqn) : 99;
        const long trow0n = (long)bn * SEQ + (long)(4 * cqn - 8) * CHUNK;
        const bf16* ksrcn = Kt + (trow0n + 8 * wave + (lane >> 3)) * AP + hn * HD + ((lane & 7) ^ ((4 * (wave & 1) + (lane >> 4)) & 7)) * 8;
        const bf16* vsrcn = Vt + (trow0n + 16 * (wave & 3) + (lane >> 2)) * AP + hn * HD + (wave >> 2) * 32 + (lane & 3) * 8;
#define ATT_DMA_X(KS, VS, t, pr) do { const int sl_ = ATT_SLOT(t, pr); \
            glds16((KS) + (long)(t) * CHUNK * AP, (unsigned)__builtin_amdgcn_readfirstlane((int)(lds0 + AT_K + sl_ + wave * 1024))); \
            glds16((VS) + (long)(t) * CHUNK * AP, (unsigned)__builtin_amdgcn_readfirstlane((int)(lds0 + AT_V + sl_ + wave * 1024))); } while (0)
#define ATT_DMA(t) ATT_DMA_X(ksrc, vsrc, t, par)
#define ATT_DMA_ANY(T) do { if ((T) < 12) { if ((T) >= s_lo) ATT_DMA(T); } else { if ((T) - 12 >= s_lo_n) ATT_DMA_X(ksrcn, vsrcn, (T) - 12, par ^ 1); } } while (0)
#pragma unroll
        for (int t = 0; t < 5; ++t) if (uk == afirst && t >= s_lo) ATT_DMA(t);
        bf16x8 qr[4]; float rbv = rbx0, rbf = rbx1;
        if (uk == afirst) {
#pragma unroll
            for (int d0 = 0; d0 < 4; ++d0) qr[d0] = __builtin_nontemporal_load((const bf16x8*)(Q + (qrow + r32) * AP + h * HD + d0 * 16 + hi * 8));
            if (tid < NREL) { const float* rb = P.b_rel_bias + ((size_t)j * NH + h) * NREL; rbv = rb[tid]; rbf = rb[NREL - 1]; }
        } else {
#pragma unroll
            for (int d0 = 0; d0 < 4; ++d0) qr[d0] = qnx[d0];
        }
        if (tid < 256) bt[tid] = tid < NREL ? (rbv - rbf) * LOG2E : 0.f;
        asm volatile("" :: "v"(qr[0]), "v"(qr[1]), "v"(qr[2]), "v"(qr[3]));
        float mhat = 0.f, lrun = 0.f; f32x16 o0 = {}, o1 = {};
        const int j_first = (s_lo > ci) ? s_lo - ci : 0;
#pragma unroll 1
        for (int jj = 0; jj < 9; ++jj) {
            const int s = ci + jj;
            if ((jj & 1) == 0) {
                asm volatile("s_waitcnt vmcnt(0)" ::: "memory");
                __syncthreads();
                ATT_DMA_ANY(jj + 5);
                ATT_DMA_ANY(jj + 6);
            }
            const int delta = 8 - jj;
            if (jj >= j_first && DRY != 2) {
                const LAS unsigned char* Ks = lds + AT_K + ATT_SLOT(s, par); const LAS unsigned char* Vs = lds + AT_V + ATT_SLOT(s, par);
                f32x16 p0, p1;
                { const float c0 = -mhat;
#pragma unroll
                    for (int r = 0; r < 16; ++r) { p0[r] = c0; p1[r] = c0; } }
                { const LAS unsigned char* kb = Ks + r32 * 128; const int kx = (r32 >> 1) & 7; bf16x8 kf[8];
#pragma unroll
                    for (int d0 = 0; d0 < 4; ++d0) { const int kp = ((2 * d0 + hi) ^ kx) * 16; kf[2 * d0] = *(const LAS bf16x8*)(kb + kp); kf[2 * d0 + 1] = *(const LAS bf16x8*)(kb + 4096 + kp); }
                    __builtin_amdgcn_sched_barrier(0);
#pragma unroll
                    for (int d0 = 0; d0 < 4; ++d0) { p0 = __builtin_amdgcn_mfma_f32_32x32x16_bf16(kf[2 * d0], qr[d0], p0, 0, 0, 0); p1 = __builtin_amdgcn_mfma_f32_32x32x16_bf16(kf[2 * d0 + 1], qr[d0], p1, 0, 0, 0); } }
                if (delta < 3) {
                    const LAS float* bp = bt + (64 * delta + 32 * qh + r32 - 4 * hi);
                    asm volatile("" : "+v"(bp));
                    typedef pg8::f32x2 f32x2; typedef f32x2 __attribute__((aligned(4))) f32x2u;
                    f32x2 b0[8], b1[8];
#pragma unroll
                    for (int r = 0; r < 16; r += 2) { const int kc = (r & 3) + 8 * (r >> 2);
                        b0[r >> 1] = *(const LAS f32x2u*)(bp + 62 - kc); b1[r >> 1] = *(const LAS f32x2u*)(bp + 30 - kc); }
#pragma unroll
                    for (int r = 0; r < 8; ++r) { asm volatile("" : "+v"(b0[r])); asm volatile("" : "+v"(b1[r])); }
#pragma unroll
                    for (int r = 0; r < 16; r += 2) { p0[r] += b0[r >> 1][1]; p0[r + 1] += b0[r >> 1][0]; p1[r] += b1[r >> 1][1]; p1[r + 1] += b1[r >> 1][0]; }
                }
                float rm;
                { float a = MX3(p0[0], p0[1], p1[0]), c = MX3(p0[2], p0[3], p1[1]); a = MX3(a, p1[2], p1[3]);
#pragma unroll
                    for (int r = 4; r < 16; r += 4) { a = MX3(a, p0[r], p0[r + 1]); c = MX3(c, p0[r + 2], p0[r + 3]); a = MX3(a, p1[r], p1[r + 1]); c = MX3(c, p1[r + 2], p1[r + 3]); }
                    rm = __builtin_fmaxf(a, c);
                    auto rr = __builtin_amdgcn_permlane32_swap(__float_as_uint(rm), __float_as_uint(rm), false, false); rm = __builtin_fmaxf(__uint_as_float(rr[0]), __uint_as_float(rr[1])); }
                float dl = 0.f; bool resc = false;
                if (jj == j_first) { dl = rm; mhat = rm; }
                else if (__any(rm > ATT_THR)) {
                    dl = __builtin_fmaxf(rm, 0.f); mhat += dl;
                    const float f = __builtin_amdgcn_exp2f(-dl); lrun *= f;
                    if (hi == 0) wsf[r32] = f;
                    resc = true;
                }
                if (resc) {
#pragma unroll
                    for (int r = 0; r < 16; ++r) { const float fr_ = wsf[crow(r, hi)]; o0[r] *= fr_; o1[r] *= fr_; }
                }
                { typedef pg8::f32x2 f32x2; const f32x2 ndl = (f32x2){-dl, -dl}; f32x2 ps2 = (f32x2){0.f, 0.f};
#pragma unroll
                    for (int r = 0; r < 16; r += 2) { f32x2 a = (f32x2){p0[r], p0[r + 1]} + ndl, b = (f32x2){p1[r], p1[r + 1]} + ndl;
                        a[0] = __builtin_amdgcn_exp2f(a[0]); a[1] = __builtin_amdgcn_exp2f(a[1]); b[0] = __builtin_amdgcn_exp2f(b[0]); b[1] = __builtin_amdgcn_exp2f(b[1]);
                        ps2 = ps2 + a; ps2 = ps2 + b; p0[r] = a[0]; p0[r + 1] = a[1]; p1[r] = b[0]; p1[r + 1] = b[1]; }
                    lrun += ps2[0] + ps2[1]; }
                v4u pw[4];
                pw[0] = (v4u){pk2(p0[0], p0[1]), pk2(p0[2], p0[3]), pk2(p0[4], p0[5]), pk2(p0[6], p0[7])};
                pw[1] = (v4u){pk2(p0[8], p0[9]), pk2(p0[10], p0[11]), pk2(p0[12], p0[13]), pk2(p0[14], p0[15])};
                pw[2] = (v4u){pk2(p1[0], p1[1]), pk2(p1[2], p1[3]), pk2(p1[4], p1[5]), pk2(p1[6], p1[7])};
                pw[3] = (v4u){pk2(p1[8], p1[9]), pk2(p1[10], p1[11]), pk2(p1[12], p1[13]), pk2(p1[14], p1[15])};
                const LAS unsigned char* vb = Vs + ((lane >> 4) & 1) * 32 + (lane & 3) * 8 + (4 * hi + ((lane & 15) >> 2)) * 64;
#pragma unroll
                for (int kh = 0; kh < 2; ++kh) {
                    s16x4 vl[4], vh[4];
#pragma unroll
                    for (int i = 0; i < 4; ++i) { const int ks = 2 * kh + (i >> 1), dh = i & 1; vl[i] = tr_read(vb + dh * 4096 + ks * 1024); vh[i] = tr_read(vb + dh * 4096 + ks * 1024 + 512); }
                    __builtin_amdgcn_sched_barrier(0);
#pragma unroll
                    for (int i = 0; i < 4; ++i) { const int ks = 2 * kh + (i >> 1); const bf16x8 pa = __builtin_bit_cast(bf16x8, pw[ks]); const bf16x8 vfr = (bf16x8){vl[i][0], vl[i][1], vl[i][2], vl[i][3], vh[i][0], vh[i][1], vh[i][2], vh[i][3]};
                        if (i & 1) o1 = __builtin_amdgcn_mfma_f32_32x32x16_bf16(pa, vfr, o1, 0, 0, 0); else o0 = __builtin_amdgcn_mfma_f32_32x32x16_bf16(pa, vfr, o0, 0, 0, 0); } }
            }
        }
        __syncthreads();
        ATT_DMA_ANY(15); ATT_DMA_ANY(16);
        if (has_n) {
            const size_t qrown = (size_t)bn * SEQ + (size_t)(4 * cqn + ci) * CHUNK + 32 * qh;
#pragma unroll
            for (int d0 = 0; d0 < 4; ++d0) qnx[d0] = __builtin_nontemporal_load((const bf16x8*)(Q + (qrown + r32) * AP + hn * HD + d0 * 16 + hi * 8));
            if (tid < NREL) { const float* rbn = P.b_rel_bias + ((size_t)j * NH + hn) * NREL; rbx0 = rbn[tid]; rbx1 = rbn[NREL - 1]; }
        }
#undef ATT_DMA_ANY
#undef ATT_DMA
#undef ATT_DMA_X
        { auto rr = __builtin_amdgcn_permlane32_swap(__float_as_uint(lrun), __float_as_uint(lrun), false, false); lrun = __uint_as_float(rr[0]) + __uint_as_float(rr[1]); }
        if (hi == 0) wsf[32 + r32] = lrun;
        { LAS bf16* stg = (LAS bf16*)(lds + (wave < 6 ? AT_K + ATT_SLOT(9 + (wave >> 1), par) : AT_V + ATT_SLOT(9, par)) + (wave & 1) * 4096);
#pragma unroll
            for (int r = 0; r < 16; ++r) { const int orow = crow(r, hi); const float rl = __builtin_amdgcn_rcpf(wsf[32 + orow]);
                stg[orow * 64 + r32] = (bf16)(pk2(o0[r] * rl, 0.f) & 0xffffu); stg[orow * 64 + 32 + r32] = (bf16)(pk2(o1[r] * rl, 0.f) & 0xffffu); }
            bf16* Ow = (DRY ? (bf16*)P.out + qrow * D : Q + qrow * AP) + h * HD; const int opitch = DRY ? D : AP;
#pragma unroll
            for (int i = 0; i < 4; ++i) { const int row = i * 8 + (lane >> 3), ch = lane & 7; const v4u v = *(const LAS v4u*)(stg + row * 64 + ch * 8); *(v4u*)(Ow + (size_t)row * opitch + ch * 8) = v; } }
        asm volatile("s_waitcnt lgkmcnt(0)\n\ts_barrier" ::: "memory");
    }
#undef ATT_DEC
#undef ATT_SLOT
}
#undef MX3

__device__ __forceinline__ void final_phase(const Ptrs& P, int vcu, int G, int wave, const pg8::Sch sc) {
    int tid_ = threadIdx.x; asm volatile("" : "+v"(tid_)); const int lane = tid_ & 63;
    const int gw = (sc.lm ? sc.rank : vcu) * NWAVES + wave, NGW = (sc.lm ? sc.nloc : G) * NWAVES, mbase = sc.lm ? 2048 * sc.gi : 0, mcount = sc.lm ? 2048 : M;
    f32x4 gn[4];
#pragma unroll
    for (int j = 0; j < 4; ++j) gn[j] = ((const f32x4*)P.final_g)[lane + 64 * j];
    for (int mk = gw; mk < mcount; mk += 4 * NGW) {
        v2u w[4][4]; f32x4 sv[4]; int mm[4];
#pragma unroll
        for (int q = 0; q < 4; ++q) { const int mq = mk + q * NGW; mm[q] = mbase + (mq < mcount ? mq : mk);
            sv[q] = *(const f32x4*)(P.xss + (size_t)mm[q] * pg8::NSLOT_X + (lane & 3) * 4);
            const GAS v2u* xr = (const GAS v2u*)(P.xb + (size_t)mm[q] * D) + lane;
#pragma unroll
            for (int j = 0; j < 4; ++j) w[q][j] = __builtin_nontemporal_load(xr + 64 * j); }
#pragma unroll
        for (int q = 0; q < 4; ++q) { if (mk + q * NGW >= mcount) break;
            float s = (sv[q][0] + sv[q][1]) + (sv[q][2] + sv[q][3]); s += __shfl_xor(s, 1); s += __shfl_xor(s, 2);
            const float r = __builtin_amdgcn_rsqf(s * (1.0f / D) + EPS);
            GAS f32x4* orow = (GAS f32x4*)(P.out + (size_t)mm[q] * D) + lane;
#pragma unroll
            for (int j = 0; j < 4; ++j) { const f32x4 v = {bf_lo(w[q][j].x), bf_hi(w[q][j].x), bf_lo(w[q][j].y), bf_hi(w[q][j].y)}; orow[64 * j] = v * r * gn[j]; } }
    }
}

#ifndef PANEL_OWNER
#define PANEL_OWNER 1
#endif
__device__ __forceinline__ pg8::Sch get_sch(volatile LAS unsigned* MISC, int G) {
    pg8::Sch s; const int nloc = __builtin_amdgcn_readfirstlane((int)MISC[8]), nx = __builtin_amdgcn_readfirstlane((int)MISC[9]);
    s.gi = __builtin_amdgcn_readfirstlane((int)MISC[10]); s.rank = __builtin_amdgcn_readfirstlane((int)MISC[11]); s.nloc = nloc > 0 ? nloc : 1;
    s.lm = (PANEL_OWNER && !MK_PER_PHASE && nx == 8 && nloc > 0 && M == 16384) ? 1 : 0; return s;
}
__device__ __forceinline__ int launder_s(int x) { asm volatile("" : "+s"(x)); return x; }
struct Args { const float* in[15]; float* out; unsigned char* ws; int ph_lo, ph_hi; };
static_assert(sizeof(Args) == 17 * 8 + 8, "Args has no padding");
__global__ void __launch_bounds__(NWAVES * 64, 2) trunk_fwd(Args args) {
    extern __shared__ __attribute__((aligned(16))) unsigned char lds_raw[];
    LAS unsigned char* lds = (LAS unsigned char*)lds_raw;
    volatile LAS unsigned* MISC = (volatile LAS unsigned*)(lds + MISC_OFF);
    const int tid = threadIdx.x, lane = tid & 63, wave = __builtin_amdgcn_readfirstlane(tid >> 6);
    const int G = gridDim.x; const int bx = blockIdx.x; const int vcu = (G % 8 == 0) ? (bx % 8) * (G / 8) + bx / 8 : bx;
    unsigned char* ws = args.ws;
    gu32* ctl = (gu32*)(ws + WS_CTL);
    Ptrs P;
    P.x = args.in[0]; P.norm_mix_g = args.in[1]; P.norm_ffn_g = args.in[2]; P.final_g = args.in[3]; P.a_w_in = args.in[4]; P.a_v_gain = args.in[5]; P.a_w_s = args.in[6]; P.a_b_s = args.in[7];
    P.a_w_out = args.in[8]; P.b_w_qkv = args.in[9]; P.b_rel_bias = args.in[10]; P.b_w_out = args.in[11]; P.ffn_w_gate = args.in[12]; P.ffn_w_up = args.in[13]; P.ffn_w_down = args.in[14];
    P.out = args.out; P.wt = (bf16*)(ws + WS_W); P.xb = (bf16*)(ws + WS_XB); P.act = (bf16*)(ws + WS_ACT); P.xss = (float*)(ws + WS_XSS); P.vss = (float*)(ws + WS_VSS);
    for (int u = tid; u < (LDS_BYTES - LDSCTL_OFF) / 4; u += NWAVES * 64) ((LAS unsigned*)(lds + LDSCTL_OFF))[u] = 0u;
    __syncthreads();
    XcdBarrier bar; bar.bar = (unsigned*)(ctl + CW_BAR); bar.x = 0; bar.st = nullptr;
    if (!MK_PER_PHASE) bar = xcd_barrier_post((unsigned*)(ctl + CW_BAR), MISC + 8);
    const int lo = args.ph_lo, hi = args.ph_hi;
#define RS_TABLE(S) pg8::RsTab rt{(const LAS float*)(lds + RSTAB_OFF), -1}; { pg8::Unit u0_; if (S.next(0, u0_)) { rt.pm = u0_.pm; pg8::build_rs_table(P.xss, u0_.pm, (LAS float*)(lds + RSTAB_OFF), tid, 1.0f / D, EPS); } }
#ifndef DBG_MASK
#define DBG_MASK 0xff
#endif
#if MK_PER_PHASE
#define IN(k) (lo <= (k) && (k) < hi)
#else
#define IN(k) true
#endif
#define SEAM(k, local_ok) do { if (IN(k) && IN((k) + 1)) { if ((local_ok) && get_sch(MISC, G).lm) xcd_barrier_local(bar); else xcd_barrier(bar); if (PROBE == 1) xcd_barrier(bar); } } while (0)

    if ((DBG_MASK & 1) && IN(0)) { p0_prologue(P, lds, vcu, G, wave, lane); if (PROBE == 2) { __syncthreads(); p0_prologue(P, lds, vcu, G, wave, lane); } }
    SEAM(0, false);
    if (PROBE == 12 && get_sch(MISC, G).lm) { const unsigned long long t0_ = __builtin_amdgcn_s_memrealtime(); while (__builtin_amdgcn_s_memrealtime() - t0_ < 20000ull) __builtin_amdgcn_s_sleep(8); }
#pragma unroll 1
    for (int layer = 0; layer < DEPTH; ++layer) {
        const int j = layer >> 1, ph = 1 + 5 * layer;
        const bf16* wgu = P.wt + WO_GU + (size_t)layer * D * FF2; const bf16* wdn = P.wt + WO_DN + (size_t)layer * FF * D;
        if ((layer & 1) == 0) {
            if ((DBG_MASK & 2) && IN(ph)) { pg8::Gemm g{P.xb, P.wt + WO_IN + (size_t)j * D * GH2, M, GH2, D, D}; const pg8::Sch sch = get_sch(MISC, G); pg8::PanelOrder S; S.init(M, GH2, G, launder_s(bx), sch);
                RS_TABLE(S);
                pg8::EpiGeluStats E{P.act, AP, P.xss, P.vss, GH / 256, EPS, rt};
                pg8::gemm_phase<pg8::EpiGeluStats, pg8::PanelOrder, true, true>(lds + RING_OFF, g, S, E);
                if (PROBE == 5) { __syncthreads(); pg8::gemm_phase<pg8::EpiGeluStats, pg8::PanelOrder, true, true>(lds + RING_OFF, g, S, E); } }
            SEAM(ph, true);
            if ((DBG_MASK & 4) && IN(ph + 1)) { if (PROBE == 4) spatial_phase<true>(P, j, lds, vcu, G, wave, get_sch(MISC, G)); spatial_phase<false>(P, j, lds, vcu, G, wave, get_sch(MISC, G)); }
            SEAM(ph + 1, true);
            if ((DBG_MASK & 8) && IN(ph + 2)) { pg8::Gemm g{P.act, P.wt + WO_AOUT + (size_t)j * GH * D, M, D, GH, AP}; const pg8::Sch sch = get_sch(MISC, G); pg8::PanelOrder S; S.init(M, D, G, launder_s(bx), sch);
                pg8::EpiResid E{P.xb, P.xss, D};
                pg8::gemm_phase<pg8::EpiResid, pg8::PanelOrder, false, true>(lds + RING_OFF, g, S, E); }
            SEAM(ph + 2, true);
        } else {
            if ((DBG_MASK & 16) && IN(ph)) { pg8::Gemm g{P.xb, P.wt + WO_QKV + (size_t)j * D * 3 * D, M, 3 * D, D, D}; const pg8::Sch sch = get_sch(MISC, G); pg8::PanelOrder S; S.init(M, 3 * D, G, launder_s(bx), sch);
                RS_TABLE(S);
                pg8::EpiQkv E{P.act, AP, (size_t)D, P.xss, EPS, QSCALE, rt};
                pg8::gemm_phase<pg8::EpiQkv, pg8::PanelOrder, true, true>(lds + RING_OFF, g, S, E);
                if (PROBE == 7) { __syncthreads(); pg8::gemm_phase<pg8::EpiQkv, pg8::PanelOrder, true, true>(lds + RING_OFF, g, S, E); } }
            SEAM(ph, false);
            if ((DBG_MASK & 32) && IN(ph + 1)) { if (PROBE == 3) attn_phase<1>(P, j, lds, vcu, G, wave, get_sch(MISC, G)); if (PROBE == 10) attn_phase<2>(P, j, lds, vcu, G, wave, get_sch(MISC, G)); attn_phase<0>(P, j, lds, vcu, G, wave, get_sch(MISC, G)); }
            SEAM(ph + 1, true);
            if ((DBG_MASK & 8) && IN(ph + 2)) { pg8::Gemm g{P.act, P.wt + WO_BOUT + (size_t)j * D * D, M, D, D, AP}; const pg8::Sch sch = get_sch(MISC, G); pg8::PanelOrder S; S.init(M, D, G, launder_s(bx), sch);
                pg8::EpiResid E{P.xb, P.xss, D};
                pg8::gemm_phase<pg8::EpiResid, pg8::PanelOrder, false, true>(lds + RING_OFF, g, S, E); }
            SEAM(ph + 2, false);
        }
        if ((DBG_MASK & 64) && IN(ph + 3)) { pg8::Gemm g{P.xb, wgu, M, FF2, D, D}; const pg8::Sch sch = get_sch(MISC, G); pg8::FfnOrder S; S.init(M, FF_NFULL, G, launder_s(bx), sch);
            RS_TABLE(S);
            pg8::EpiSwiglu E{P.act, AP, P.xss, EPS, rt, FF_NFULL * 128};
            pg8::gemm_phase<pg8::EpiSwiglu, pg8::FfnOrder, true, true>(lds + RING_OFF, g, S, E);
            if (PROBE == 6 || PROBE == 11) { __syncthreads(); pg8::gemm_phase<pg8::EpiSwiglu, pg8::FfnOrder, true, true>(lds + RING_OFF, g, S, E); } }
        SEAM(ph + 3, true);
        if ((DBG_MASK & 8) && IN(ph + 4)) { pg8::Gemm g{P.act, wdn, M, D, FF, AP}; const pg8::Sch sch = get_sch(MISC, G); pg8::PanelOrder S; S.init(M, D, G, launder_s(bx), sch);
            pg8::EpiResid E{P.xb, P.xss, D};
            pg8::gemm_phase<pg8::EpiResid, pg8::PanelOrder, false, true>(lds + RING_OFF, g, S, E); }
        SEAM(ph + 4, true);
    }
    if ((DBG_MASK & 128) && IN(N_PHASES - 1)) final_phase(P, vcu, G, wave, get_sch(MISC, G));
#undef IN
#undef SEAM
}

extern "C" void kernel_launch(void* const* d_in, const int* in_sizes, int n_in, void* d_out, int out_size, void* d_ws, size_t ws_size, hipStream_t stream) {
    static int grid = 0;
    if (grid == 0) {
        if (n_in != 15 || in_sizes[0] != M * D || out_size != M * D || ws_size < WS_END) { fprintf(stderr, "kernel_launch: unexpected shapes (n_in %d, in0 %d, out %d, ws %zu < %zu); nothing launched\n", n_in, n_in > 0 ? in_sizes[0] : -1, out_size, ws_size, (size_t)WS_END); grid = -1; return; }
        int dev = 0, cus = 0, per_cu = 0;
        if (hipGetDevice(&dev) != hipSuccess || hipDeviceGetAttribute(&cus, hipDeviceAttributeMultiprocessorCount, dev) != hipSuccess) { grid = -1; return; }
        if (hipFuncSetAttribute((const void*)trunk_fwd, hipFuncAttributeMaxDynamicSharedMemorySize, LDS_BYTES) != hipSuccess) { fprintf(stderr, "kernel_launch: hipFuncSetAttribute failed\n"); grid = -1; return; }
        if (hipOccupancyMaxActiveBlocksPerMultiprocessor(&per_cu, (const void*)trunk_fwd, NWAVES * 64, LDS_BYTES) != hipSuccess || per_cu < 1) { fprintf(stderr, "kernel_launch: occupancy query reports %d workgroups per CU; nothing launched\n", per_cu); (void)hipGetLastError(); grid = -1; return; }
        grid = cus;
    }
    if (grid < 0) return;
    if (hipMemsetAsync((char*)d_ws + WS_CTL, 0, CTL_ZERO_BYTES, stream) != hipSuccess) return;
    Args a{};
    for (int i = 0; i < 15; ++i) a.in[i] = (const float*)d_in[i];
    a.out = (float*)d_out; a.ws = (unsigned char*)d_ws;
#if MK_PER_PHASE
    for (int p = 0; p < N_PHASES; ++p) { a.ph_lo = p; a.ph_hi = p + 1; hipLaunchKernelGGL(trunk_fwd, dim3(grid), dim3(NWAVES * 64), LDS_BYTES, stream, a); }
#else
    a.ph_lo = 0; a.ph_hi = N_PHASES;
    hipLaunchKernelGGL(trunk_fwd, dim3(grid), dim3(NWAVES * 64), LDS_BYTES, stream, a);
#endif
}
```

```cpp
#include <hip/hip_runtime.h>
#include <cstdio>
#include <cstdint>
#ifndef PROBE
#define PROBE 0
#endif
#ifndef PG8_KROT
#define PG8_KROT 0
#endif
namespace pg8 {
#define PG8_LAS __attribute__((address_space(3)))
typedef unsigned short bf16_t;
typedef short bf16x8 __attribute__((ext_vector_type(8)));
typedef float f32x4 __attribute__((ext_vector_type(4)));
typedef unsigned u32x4 __attribute__((ext_vector_type(4)));
constexpr int BM = 256, BK = 64, HALF = 128, HTB = HALF * BK * 2  , STAGE_BYTES = 8 * HTB, NXCD = 8, WGM = 8;

__host__ __device__ __forceinline__ int lds_byte(int r, int c) { const int st = (r >> 4) * 2 + (c >> 5), rr = r & 15, cc = c & 31, ob = rr * 64 + cc * 2; return st * 1024 + (ob ^ (((ob >> 9) & 1) << 5)); }
__host__ __device__ __forceinline__ void stage_rc(int b, int& R, int& C) { const int st = b / 1024, sb = b % 1024, swz = sb ^ (((sb >> 9) & 1) << 5); R = (st >> 1) * 16 + swz / 64; C = (st & 1) * 32 + (swz % 64) / 2; }
__host__ __device__ __forceinline__ int perm32(int rho) { const int n = rho >> 4, i = rho & 15; return 8 * (i >> 2) + 4 * n + (i & 3); }

struct Unit { int pm, pn, hf; };
struct Gemm { const bf16_t* A; const bf16_t* Bt; int M, N, K, lda; };

struct StaticOrder {
    int nM, nN, nwg, G, c;
    __host__ __device__ void init(int M, int N, int G_, int c_) { nM = M / BM; nN = N / BM; nwg = nM * nN; G = G_; c = c_; }
    __host__ __device__ bool next(int i, Unit& u) const {
        const long L = (long)i * G + c; if (L >= nwg) return false;
        int wgid = (int)L; { const int q = nwg / NXCD, r = nwg % NXCD, xcd = wgid % NXCD, off = wgid / NXCD; wgid = (xcd < r ? xcd * (q + 1) : r * (q + 1) + (xcd - r) * q) + off; }
        const int nig = WGM * nN, gid = wgid / nig, fm = gid * WGM, gsz = (nM - fm) < WGM ? (nM - fm) : WGM;
        u.pm = fm + ((wgid % nig) % gsz); u.pn = (wgid % nig) / gsz; u.hf = 0; return true;
    }
    static constexpr bool HAS_HALF = false;
    __host__ __device__ int brow(const Unit& u) const { return u.pn * BM; }
    __device__ __forceinline__ int koff(const Unit& u, int nt) const { int k = PG8_KROT ? 2 * (u.pm & 7) + 4 * (u.pn & 3) : 0; k -= (k >= nt) ? nt : 0; return k; }
    __device__ __forceinline__ void a_ready(const Unit&) const {}
    __device__ __forceinline__ void done(const Unit&) const {}
};

__device__ __forceinline__ unsigned cvt_pk_bf16(float lo, float hi) { unsigned r; asm volatile("v_cvt_pk_bf16_f32 %0, %1, %2" : "=v"(r) : "v"(lo), "v"(hi)); return r; }
typedef float f32x2 __attribute__((ext_vector_type(2)));
struct Sch { int lm, gi, rank, nloc; };
struct PanelOrder {
    StaticOrder so; Sch sc; int nN;
    static constexpr bool HAS_HALF = false;
    __device__ void init(int M, int N, int G_, int c_, const Sch& s_) { so.init(M, N, G_, c_); sc = s_; nN = N / BM; }
    __device__ bool next(int i, Unit& u) const {
        if (sc.lm) { const int idx = sc.rank + sc.nloc * i; if (idx >= 8 * nN) return false; u.pm = 8 * sc.gi + (idx & 7); u.pn = idx >> 3; u.hf = 0; return true; }
        return so.next(i, u);
    }
    __device__ int brow(const Unit& u) const { return u.pn * BM; }
    __device__ __forceinline__ int koff(const Unit& u, int nt) const { int k = PG8_KROT ? 2 * (u.pm & 7) + 4 * (u.pn & 3) : 0; k -= (k >= nt) ? nt : 0; return k; }
    __device__ __forceinline__ void a_ready(const Unit&) const {}
    __device__ __forceinline__ void done(const Unit&) const {}
};
struct FfnOrder {
    PanelOrder po; int nfull, G, c, NFULL;
    static constexpr bool HAS_HALF = true;
    __device__ void init(int M, int NFULL_, int G_, int c_, const Sch& s_) { NFULL = NFULL_; po.init(M, NFULL_ * BM, G_, c_, s_); G = G_; c = c_;
        nfull = s_.lm ? ((s_.rank < 8 * NFULL_) ? (8 * NFULL_ - s_.rank + s_.nloc - 1) / s_.nloc : 0) : ((c_ < po.so.nwg) ? (po.so.nwg - c_ + G_ - 1) / G_ : 0); }
    __device__ bool next(int i, Unit& u) const {
        if (i < nfull) return po.next(i, u);
        const int k = i - nfull;
        if (po.sc.lm) { const int hidx = po.sc.rank + po.sc.nloc * k; if (hidx >= 32) return false; u.pm = 8 * po.sc.gi + (hidx & 7); u.pn = hidx >> 3; u.hf = 1; return true; }
        const int nh = po.so.nM * 4; const int hu = k * G + c; if (hu >= nh) return false;
        if (G == 256 && po.so.nM == 64) { Unit f; po.so.next(0, f); u.pm = f.pm; u.pn = f.pn & 3; }
        else { u.pm = hu % po.so.nM; u.pn = hu / po.so.nM; }
        u.hf = 1; return true;
    }
    __device__ int brow(const Unit& u) const { return u.hf ? NFULL * BM + u.pn * HALF : u.pn * BM; }
    __device__ __forceinline__ int koff(const Unit& u, int nt) const { int k = PG8_KROT ? 2 * (u.pm & 7) + 4 * (u.pn & 3) : 0; k -= (k >= nt) ? nt : 0; return k; }
    __device__ __forceinline__ void a_ready(const Unit&) const {}
    __device__ __forceinline__ void done(const Unit&) const {}
};

#ifndef PG8_B_AUX
#define PG8_B_AUX 0
#endif
#ifndef PG8_SKIPW
#define PG8_SKIPW 0
#endif
#ifndef STORE_WT
#define STORE_WT 1
#endif
__device__ __forceinline__ void store16(void* p, u32x4 v) {
#if STORE_WT
    asm volatile("global_store_dwordx4 %0, %1, off sc1\n\ts_nop 1" :: "v"(p), "v"(v) : "memory");
#else
    *(u32x4*)p = v;
#endif
}
__device__ __forceinline__ void store16f(void* p, f32x4 v) {
#if STORE_WT
    asm volatile("global_store_dwordx4 %0, %1, off sc1\n\ts_nop 1" :: "v"(p), "v"(v) : "memory");
#else
    *(f32x4*)p = v;
#endif
}
typedef unsigned u32x2 __attribute__((ext_vector_type(2)));
__device__ __forceinline__ void store8(void* p, u32x2 v) {
#if STORE_WT
    asm volatile("global_store_dwordx2 %0, %1, off sc1\n\ts_nop 1" :: "v"(p), "v"(v) : "memory");
#else
    *(u32x2*)p = v;
#endif
}
constexpr int NSLOT_X = 16;
constexpr int NSLOT_V = 32;
struct RsTab { const PG8_LAS float* t; int pm; };
__device__ __forceinline__ void row_scales(const float* ss, const RsTab& T, int pm, int wr, int fr, int fq, float inv_n, float eps, float (&rs)[2][4]) {
    if (pm == T.pm) {
#pragma unroll
        for (int ai = 0; ai < 2; ++ai)
#pragma unroll
            for (int m = 0; m < 4; ++m) rs[ai][m] = T.t[wr * 64 + fr + ai * HALF + m * 16];
    } else {
        const int row0 = pm * BM + wr * 64 + fr;
#pragma unroll
        for (int ai = 0; ai < 2; ++ai)
#pragma unroll
            for (int m = 0; m < 4; ++m) {
                const f32x4 v = *(const f32x4*)(ss + (size_t)(row0 + ai * HALF + m * 16) * NSLOT_X + fq * 4);
                float s = (v[0] + v[1]) + (v[2] + v[3]);
                s += __shfl_xor(s, 16); s += __shfl_xor(s, 32);
                rs[ai][m] = __builtin_amdgcn_rsqf(s * inv_n + eps);
            }
    }
}
__device__ __forceinline__ void build_rs_table(const float* ss, int pm, PG8_LAS float* t, int tid, float inv_n, float eps) {
    asm volatile("" : "+v"(tid));
    const int row = tid >> 1, half = tid & 1;
    const f32x4 a = *(const f32x4*)(ss + (size_t)(pm * BM + row) * NSLOT_X + half * 8), b = *(const f32x4*)(ss + (size_t)(pm * BM + row) * NSLOT_X + half * 8 + 4);
    float s = ((a[0] + a[1]) + (a[2] + a[3])) + ((b[0] + b[1]) + (b[2] + b[3]));
    s += __shfl_xor(s, 1);
    if (half == 0) t[row] = __builtin_amdgcn_rsqf(s * inv_n + eps);
    asm volatile("s_waitcnt lgkmcnt(0)" ::: "memory"); __syncthreads();
}
__device__ __forceinline__ float gelu_tanh(float x) {
    const float t = x * x, u2 = x * (2.302208198f + 0.1029432398f * t);
    const float e = __builtin_amdgcn_exp2f(-u2);
    return x * __builtin_amdgcn_rcpf(1.0f + e);
}
__device__ __forceinline__ float silu_mul(float g, float u) {
    const float e = __builtin_amdgcn_exp2f(g * -1.4426950408889634f);
    return (g * u) * __builtin_amdgcn_rcpf(1.0f + e);
}
__device__ __forceinline__ f32x2 gelu_tanh2(f32x2 x) {
    const f32x2 t = x * x;
    const f32x2 p = __builtin_elementwise_fma(t, (f32x2){-0.1029432398f, -0.1029432398f}, (f32x2){-2.302208198f, -2.302208198f});
    const f32x2 u2n = x * p;
    f32x2 d; d[0] = __builtin_amdgcn_exp2f(u2n[0]); d[1] = __builtin_amdgcn_exp2f(u2n[1]);
    d = d + (f32x2){1.0f, 1.0f};
    f32x2 r; r[0] = __builtin_amdgcn_rcpf(d[0]); r[1] = __builtin_amdgcn_rcpf(d[1]);
    return x * r;
}
__device__ __forceinline__ f32x2 silu_mul2(f32x2 g, f32x2 u, float rneg, float rr) {
    const f32x2 a = g * rneg;
    f32x2 d; d[0] = __builtin_amdgcn_exp2f(a[0]); d[1] = __builtin_amdgcn_exp2f(a[1]);
    d = d + (f32x2){1.0f, 1.0f};
    f32x2 q; q[0] = __builtin_amdgcn_rcpf(d[0]); q[1] = __builtin_amdgcn_rcpf(d[1]);
    return ((g * u) * rr) * q;
}
struct EpiGeluStats {
    static constexpr bool PERM = true, AFTER_DRAIN = false, PROBE_TWICE = false;
    bf16_t* O; int ldc; const float* xss; float* vss; int vtile0; float eps; RsTab rt;
    __device__ __forceinline__ void operator()(const f32x4 (&acc)[2][2][4][2], const Unit& u, int wr, int wc, int fr, int fq) const {
        const int row0 = u.pm * BM + wr * 64 + fr, col0 = u.pn * BM + wc * 32 + 8 * fq;
        float rs[2][4]; row_scales(xss, rt, u.pm, wr, fr, fq, 1.0f / 1024.0f, eps, rs);
        const bool isv = u.pn >= vtile0;
#pragma unroll
        for (int ai = 0; ai < 2; ++ai)
#pragma unroll
            for (int m = 0; m < 4; ++m) { const int row = row0 + ai * HALF + m * 16; bf16_t* rowp = O + (size_t)row * ldc + col0; const float r = rs[ai][m]; float ssq = 0.f;
                f32x2 sq2 = (f32x2){0.f, 0.f};
#pragma unroll
                for (int bj = 0; bj < 2; ++bj) { const f32x4 a0 = acc[ai][bj][m][0], a1 = acc[ai][bj][m][1];
                    const f32x2 y0 = gelu_tanh2((f32x2){a0[0], a0[1]} * r), y1 = gelu_tanh2((f32x2){a0[2], a0[3]} * r), y2 = gelu_tanh2((f32x2){a1[0], a1[1]} * r), y3 = gelu_tanh2((f32x2){a1[2], a1[3]} * r);
                    sq2 = __builtin_elementwise_fma(y0, y0, sq2); sq2 = __builtin_elementwise_fma(y1, y1, sq2); sq2 = __builtin_elementwise_fma(y2, y2, sq2); sq2 = __builtin_elementwise_fma(y3, y3, sq2);
                    u32x4 w; w.x = cvt_pk_bf16(y0[0], y0[1]); w.y = cvt_pk_bf16(y1[0], y1[1]); w.z = cvt_pk_bf16(y2[0], y2[1]); w.w = cvt_pk_bf16(y3[0], y3[1]);
                    store16(rowp + bj * HALF, w); }
                if (isv) { ssq = sq2[0] + sq2[1]; ssq += __shfl_xor(ssq, 16); ssq += __shfl_xor(ssq, 32); if (fq == 0) vss[(size_t)row * NSLOT_V + (u.pn - vtile0) * 4 + wc] = ssq; } }
    }
};
struct EpiSwiglu {
    static constexpr bool PERM = true, AFTER_DRAIN = false, PROBE_TWICE = true;
    bf16_t* O; int ldc; const float* xss; float eps; RsTab rt;
    int half_col0;
    __device__ __forceinline__ void operator()(const f32x4 (&acc)[2][2][4][2], const Unit& u, int wr, int wc, int fr, int fq) const {
        const int row0 = u.pm * BM + wr * 64 + fr, col0 = u.pn * HALF + wc * 32 + 8 * fq;
        float rs[2][4]; row_scales(xss, rt, u.pm, wr, fr, fq, 1.0f / 1024.0f, eps, rs);
        if (u.hf) {
            const int hc = half_col0 + u.pn * 64 + wc * 16 + 4 * fq;
#pragma unroll
            for (int ai = 0; ai < 2; ++ai)
#pragma unroll
                for (int m = 0; m < 4; ++m) { const int row = row0 + ai * HALF + m * 16; const float r = rs[ai][m], rneg = r * -1.4426950408889634f, rr = r * r;
                    const f32x4 g0 = acc[ai][0][m][0], u0 = acc[ai][0][m][1];
                    const f32x2 o0 = silu_mul2((f32x2){g0[0], g0[1]}, (f32x2){u0[0], u0[1]}, rneg, rr), o1 = silu_mul2((f32x2){g0[2], g0[3]}, (f32x2){u0[2], u0[3]}, rneg, rr);
                    u32x2 w; w.x = cvt_pk_bf16(o0[0], o0[1]); w.y = cvt_pk_bf16(o1[0], o1[1]);
                    *(u32x2*)(O + (size_t)row * ldc + hc) = w; }
            return;
        }
#pragma unroll
        for (int ai = 0; ai < 2; ++ai)
#pragma unroll
            for (int m = 0; m < 4; ++m) { const int row = row0 + ai * HALF + m * 16; const float r = rs[ai][m] * (PROBE == 9 ? 0.5f : 1.0f);
                const float rneg = r * -1.4426950408889634f, rr = r * r;
                const f32x4 g0 = acc[ai][0][m][0], g1 = acc[ai][0][m][1], u0 = acc[ai][1][m][0], u1 = acc[ai][1][m][1];
                const f32x2 o0 = silu_mul2((f32x2){g0[0], g0[1]}, (f32x2){u0[0], u0[1]}, rneg, rr), o1 = silu_mul2((f32x2){g0[2], g0[3]}, (f32x2){u0[2], u0[3]}, rneg, rr);
                const f32x2 o2 = silu_mul2((f32x2){g1[0], g1[1]}, (f32x2){u1[0], u1[1]}, rneg, rr), o3 = silu_mul2((f32x2){g1[2], g1[3]}, (f32x2){u1[2], u1[3]}, rneg, rr);
                u32x4 w; w.x = cvt_pk_bf16(o0[0], o0[1]); w.y = cvt_pk_bf16(o1[0], o1[1]); w.z = cvt_pk_bf16(o2[0], o2[1]); w.w = cvt_pk_bf16(o3[0], o3[1]);
                if (PROBE == 11) *(u32x4*)(O + (size_t)row * ldc + col0) = w; else store16(O + (size_t)row * ldc + col0, w); }
    }
};
struct EpiQkv {
    static constexpr bool PERM = true, AFTER_DRAIN = false, PROBE_TWICE = false;
    bf16_t* O; int ldc; size_t split_stride; const float* xss; float eps; float scale0; RsTab rt;
    __device__ __forceinline__ void operator()(const f32x4 (&acc)[2][2][4][2], const Unit& u, int wr, int wc, int fr, int fq) const {
        const int t = u.pn >> 2; bf16_t* base = O + (size_t)t * split_stride; const float sc = (t == 0) ? scale0 : 1.0f;
        const int row0 = u.pm * BM + wr * 64 + fr, col0 = (u.pn & 3) * BM + wc * 32 + 8 * fq;
        float rs[2][4]; row_scales(xss, rt, u.pm, wr, fr, fq, 1.0f / 1024.0f, eps, rs);
#pragma unroll
        for (int ai = 0; ai < 2; ++ai)
#pragma unroll
            for (int m = 0; m < 4; ++m) { const int row = row0 + ai * HALF + m * 16; bf16_t* rowp = base + (size_t)row * ldc + col0; const float r = rs[ai][m] * sc;
#pragma unroll
                for (int bj = 0; bj < 2; ++bj) { const f32x4 v0 = acc[ai][bj][m][0] * r, v1 = acc[ai][bj][m][1] * r;
                    u32x4 w; w.x = cvt_pk_bf16(v0[0], v0[1]); w.y = cvt_pk_bf16(v0[2], v0[3]); w.z = cvt_pk_bf16(v1[0], v1[1]); w.w = cvt_pk_bf16(v1[2], v1[3]);
                    store16(rowp + bj * HALF, w); } }
    }
};
struct EpiResid {
    static constexpr bool PERM = true, AFTER_DRAIN = false, PROBE_TWICE = false;
    bf16_t* xb; float* xss; int ldc;
    __device__ __forceinline__ void operator()(const f32x4 (&acc)[2][2][4][2], const Unit& u, int wr, int wc, int fr, int fq) const {
        asm volatile("" : "+v"(fr), "+v"(fq));
        const int row0 = u.pm * BM + wr * 64 + fr, col0 = u.pn * BM + wc * 32 + 8 * fq;
        u32x4 pre[2][4][2];
#pragma unroll
        for (int ai = 0; ai < 2; ++ai)
#pragma unroll
            for (int m = 0; m < 4; ++m)
#pragma unroll
                for (int bj = 0; bj < 2; ++bj) pre[ai][m][bj] = __builtin_nontemporal_load((const u32x4*)(xb + (size_t)(row0 + ai * HALF + m * 16) * ldc + col0 + bj * HALF));
#pragma unroll
        for (int ai = 0; ai < 2; ++ai)
#pragma unroll
            for (int m = 0; m < 4; ++m) { const int row = row0 + ai * HALF + m * 16; bf16_t* rowp = xb + (size_t)row * ldc + col0; float ssq = 0.f;
#pragma unroll
                for (int bj = 0; bj < 2; ++bj) { const u32x4 b = pre[ai][m][bj]; const f32x4 a0 = acc[ai][bj][m][0], a1 = acc[ai][bj][m][1];
                    float o[8];
                    o[0] = __uint_as_float(b.x << 16) + a0[0]; o[1] = __uint_as_float(b.x & 0xffff0000u) + a0[1]; o[2] = __uint_as_float(b.y << 16) + a0[2]; o[3] = __uint_as_float(b.y & 0xffff0000u) + a0[3];
                    o[4] = __uint_as_float(b.z << 16) + a1[0]; o[5] = __uint_as_float(b.z & 0xffff0000u) + a1[1]; o[6] = __uint_as_float(b.w << 16) + a1[2]; o[7] = __uint_as_float(b.w & 0xffff0000u) + a1[3];
                    ssq += ((o[0] * o[0] + o[1] * o[1]) + (o[2] * o[2] + o[3] * o[3])) + ((o[4] * o[4] + o[5] * o[5]) + (o[6] * o[6] + o[7] * o[7]));
                    u32x4 w; w.x = cvt_pk_bf16(o[0], o[1]); w.y = cvt_pk_bf16(o[2], o[3]); w.z = cvt_pk_bf16(o[4], o[5]); w.w = cvt_pk_bf16(o[6], o[7]);
                    store16(rowp + bj * HALF, w); }
                ssq += __shfl_xor(ssq, 16); ssq += __shfl_xor(ssq, 32);
                if (fq == 0) xss[(size_t)row * NSLOT_X + u.pn * 4 + wc] = ssq; }
    }
};

template <class Epi, class Sched, bool ALIGN_EPI = false, bool SP2 = false>
__device__ __forceinline__ void gemm_phase(PG8_LAS unsigned char* lds, const Gemm g, const Sched& S, const Epi& E) {
    int tid_ = threadIdx.x; asm volatile("" : "+v"(tid_));
    const int tid = tid_, wid = __builtin_amdgcn_readfirstlane(tid >> 6), lane = tid & 63, wr = wid >> 2, wc = wid & 3, fr = lane & 15, fq = lane >> 4;
    const int K = g.K, nt = K / BK;
    unsigned voffA[2], voffB[2];
#pragma unroll
    for (int i = 0; i < 2; ++i) { int R, C; stage_rc(tid * 16 + i * 8192, R, C); const int Rb = Epi::PERM ? ((R & ~31) + perm32(R & 31)) : R;
        voffA[i] = (unsigned)(R * g.lda + C) * 2u; voffB[i] = (unsigned)(Rb * K + C) * 2u; }
    const size_t kstep = (size_t)(BK * 2);
    const size_t hstep = (size_t)HALF * K * 2;
    const size_t tstep = 2 * hstep; const size_t hstepA = (size_t)HALF * g.lda * 2, tstepA = 2 * hstepA;
    const unsigned ldsw = (unsigned)wid * 1024u;
    const int aoff = lds_byte(wr * 64 + fr, fq * 8), boff = lds_byte(wc * 32 + fr, fq * 8);
#define PG8_SA(b, h) (((b) * 2 + (h)) * HTB)
#define PG8_SB(b, h) ((4 + (b) * 2 + (h)) * HTB)
#define PG8_STAGE(bufoff, gbase, voff) do { _Pragma("unroll") for (int _i = 0; _i < 2; ++_i) \
        __builtin_amdgcn_global_load_lds((const unsigned*)((const char*)(gbase) + (voff)[_i]), (PG8_LAS unsigned*)(lds + (bufoff) + ldsw + _i * 8192), 16, 0, 0); } while (0)
#define PG8_STAGE_B(bufoff, gbase, voff) do { _Pragma("unroll") for (int _i = 0; _i < 2; ++_i) \
        __builtin_amdgcn_global_load_lds((const unsigned*)((const char*)(gbase) + (voff)[_i]), (PG8_LAS unsigned*)(lds + (bufoff) + ldsw + _i * 8192), 16, 0, PG8_B_AUX); } while (0)
#define PG8_LDA(dst, b, h) do { _Pragma("unroll") for (int m = 0; m < 4; ++m) _Pragma("unroll") for (int k = 0; k < 2; ++k) dst[m][k] = *(const PG8_LAS bf16x8*)(lds + PG8_SA(b, h) + aoff + m * 2048 + k * 1024); } while (0)
#define PG8_LDB(dst, b, h) do { _Pragma("unroll") for (int n = 0; n < 2; ++n) _Pragma("unroll") for (int k = 0; k < 2; ++k) dst[n][k] = *(const PG8_LAS bf16x8*)(lds + PG8_SB(b, h) + boff + n * 2048 + k * 1024); } while (0)
#define PG8_MMA(ai, bj, At, Bt) do { __builtin_amdgcn_s_setprio(1); _Pragma("unroll") for (int m = 0; m < 4; ++m) _Pragma("unroll") for (int n = 0; n < 2; ++n) _Pragma("unroll") for (int k = 0; k < 2; ++k) \
        acc[ai][bj][m][n] = __builtin_amdgcn_mfma_f32_16x16x32_bf16(Bt[n][k], At[m][k], acc[ai][bj][m][n], 0, 0, 0); __builtin_amdgcn_s_setprio(0); } while (0)
#define PG8_WAIT_V(n) asm volatile("s_waitcnt vmcnt(" #n ")" ::: "memory")
#if PG8_SKIPW
#define PG8_WAIT_V8_UNLESS(c) asm volatile("s_cmp_lg_u32 %0, 0\n\ts_cbranch_scc1 .Lskipw%=\n\ts_waitcnt vmcnt(8)\n.Lskipw%=:" :: "s"(c) : "memory", "scc")
#else
#define PG8_WAIT_V8_UNLESS(c) PG8_WAIT_V(8)
#endif
#define PG8_WAIT_L(n) asm volatile("s_waitcnt lgkmcnt(" #n ")" ::: "memory")
#define PG8_BAR __builtin_amdgcn_s_barrier()
#define PG8_SCHED __builtin_amdgcn_sched_barrier(0)
    Unit cur, nxt; int ui = 0;
    if (!S.next(0, cur)) return;
    f32x4 acc[2][2][4][2];
#pragma unroll
    for (int a = 0; a < 2; ++a)
#pragma unroll
        for (int b = 0; b < 2; ++b)
#pragma unroll
            for (int m = 0; m < 4; ++m)
#pragma unroll
                for (int n = 0; n < 2; ++n) acc[a][b][m][n] = (f32x4){0.f, 0.f, 0.f, 0.f};
    bf16x8 At[4][2], B0[2][2], B1[2][2];
    const char* bA = (const char*)g.A + (size_t)cur.pm * tstepA; const char* bB = (const char*)g.Bt + (size_t)S.brow(cur) * K * 2;
    int ko = S.koff(cur, nt);
    const char* cA = bA + (size_t)ko * kstep; const char* cB = bB + (size_t)ko * kstep;
    S.a_ready(cur);
    if constexpr (SP2) {
        PG8_STAGE_B(PG8_SB(0, 0), cB, voffB); PG8_STAGE_B(PG8_SB(0, 1), cB + hstep, voffB); PG8_STAGE(PG8_SA(0, 0), cA, voffA); PG8_STAGE(PG8_SA(0, 1), cA + hstepA, voffA);
        if (wr == 1) PG8_BAR;
        PG8_WAIT_V(2); PG8_BAR;
        PG8_STAGE_B(PG8_SB(1, 0), cB + kstep, voffB); PG8_STAGE(PG8_SA(1, 0), cA + kstep, voffA); PG8_STAGE_B(PG8_SB(1, 1), cB + hstep + kstep, voffB);
        PG8_WAIT_V(6); PG8_BAR;
    } else {
        PG8_STAGE_B(PG8_SB(0, 0), cB, voffB); PG8_STAGE(PG8_SA(0, 0), cA, voffA); PG8_STAGE_B(PG8_SB(0, 1), cB + hstep, voffB); PG8_STAGE(PG8_SA(0, 1), cA + hstepA, voffA);
        if (wr == 1) PG8_BAR;
        PG8_WAIT_V(4); PG8_BAR;
        PG8_STAGE_B(PG8_SB(1, 0), cB + kstep, voffB); PG8_STAGE(PG8_SA(1, 0), cA + kstep, voffA); PG8_STAGE_B(PG8_SB(1, 1), cB + hstep + kstep, voffB);
        PG8_WAIT_V(6); PG8_BAR;
    }
    for (;;) {
        const bool has_next = S.next(ui + 1, nxt);
        const char* nbA = has_next ? (const char*)g.A + (size_t)nxt.pm * tstepA : bA; const char* nbB = has_next ? (const char*)g.Bt + (size_t)S.brow(nxt) * K * 2 : bB;
        const int kon = has_next ? S.koff(nxt, nt) : ko;
        const char* nA = nbA + (size_t)kon * kstep; const char* nB = nbB + (size_t)kon * kstep;
        const bool full = !(Sched::HAS_HALF && cur.hf);
        const int ntl = (PROBE == 9 && Epi::PROBE_TWICE) ? 2 * nt : nt;
        for (int t = 0; t < ntl; t += 2) {
            const bool last = (t == ntl - 2);
#if PG8_SKIPW
            int skipv_ = (ui > 0 && t == 0) ? 1 : 0; asm volatile("" : "+v"(skipv_)); const int skipw = __builtin_amdgcn_readfirstlane(skipv_);
#endif
            int t1 = t + 1 + ko, t2 = t + 2 + ko; t1 -= (t1 >= nt) ? nt : 0; t1 -= (t1 >= nt) ? nt : 0; t1 -= (t1 >= nt) ? nt : 0; t2 -= (t2 >= nt) ? nt : 0; t2 -= (t2 >= nt) ? nt : 0; t2 -= (t2 >= nt) ? nt : 0;
            const char* a1 = bA + (size_t)t1 * kstep;
            const char* a2 = last ? nA : bA + (size_t)t2 * kstep; const char* b2 = last ? nB : bB + (size_t)t2 * kstep;
            const char* a3 = a2 + kstep; const char* b3 = b2 + kstep;
            if (last && has_next) S.a_ready(nxt);
            if constexpr (SP2) {
            PG8_LDB(B0, 0, 0); if (full) PG8_LDB(B1, 0, 1); PG8_SCHED; PG8_LDA(At, 0, 0); PG8_STAGE(PG8_SA(1, 1), a1 + hstepA, voffA);
            PG8_WAIT_V8_UNLESS(skipw); PG8_WAIT_L(0); PG8_BAR; PG8_MMA(0, 0, At, B0); if (full) PG8_MMA(0, 1, At, B1); PG8_BAR; PG8_SCHED;
            PG8_LDA(At, 0, 1); PG8_STAGE_B(PG8_SB(0, 0), b2, voffB); PG8_STAGE_B(PG8_SB(0, 1), b2 + hstep, voffB); PG8_STAGE(PG8_SA(0, 0), a2, voffA);
            PG8_WAIT_V8_UNLESS(skipw); PG8_WAIT_L(0); PG8_BAR; PG8_MMA(1, 0, At, B0); if (full) PG8_MMA(1, 1, At, B1); PG8_BAR; PG8_SCHED;
            PG8_LDB(B0, 1, 0); if (full) PG8_LDB(B1, 1, 1); PG8_SCHED; PG8_LDA(At, 1, 0); PG8_STAGE(PG8_SA(0, 1), a2 + hstepA, voffA);
            PG8_WAIT_V(8); PG8_WAIT_L(0); PG8_BAR; PG8_MMA(0, 0, At, B0); if (full) PG8_MMA(0, 1, At, B1); PG8_BAR; PG8_SCHED;
            PG8_LDA(At, 1, 1); PG8_STAGE_B(PG8_SB(1, 0), b3, voffB); PG8_STAGE_B(PG8_SB(1, 1), b3 + hstep, voffB); PG8_STAGE(PG8_SA(1, 0), a3, voffA);
            PG8_WAIT_V(8); PG8_WAIT_L(0); PG8_BAR; PG8_MMA(1, 0, At, B0); if (full) PG8_MMA(1, 1, At, B1); PG8_BAR; PG8_SCHED;
            } else {
            PG8_LDB(B0, 0, 0); PG8_SCHED; PG8_LDA(At, 0, 0); PG8_STAGE(PG8_SA(1, 1), a1 + hstepA, voffA);
            PG8_WAIT_L(8); PG8_BAR; PG8_WAIT_L(0); PG8_MMA(0, 0, At, B0); PG8_BAR; PG8_SCHED;
            PG8_LDB(B1, 0, 1); PG8_STAGE_B(PG8_SB(0, 0), b2, voffB);
            PG8_BAR; PG8_WAIT_L(0); if (full) PG8_MMA(0, 1, At, B1); PG8_BAR;
            PG8_LDA(At, 0, 1); PG8_STAGE(PG8_SA(0, 0), a2, voffA);
            PG8_BAR; PG8_WAIT_L(0); PG8_MMA(1, 0, At, B0); PG8_BAR; PG8_SCHED;
            PG8_STAGE_B(PG8_SB(0, 1), b2 + hstep, voffB);
            PG8_WAIT_V(6); PG8_BAR; if (full) PG8_MMA(1, 1, At, B1); PG8_BAR;
            PG8_LDB(B0, 1, 0); PG8_SCHED; PG8_LDA(At, 1, 0); PG8_STAGE(PG8_SA(0, 1), a2 + hstepA, voffA);
            PG8_WAIT_L(8); PG8_BAR; PG8_WAIT_L(0); PG8_MMA(0, 0, At, B0); PG8_BAR; PG8_SCHED;
            PG8_LDB(B1, 1, 1); PG8_STAGE_B(PG8_SB(1, 0), b3, voffB);
            PG8_BAR; PG8_WAIT_L(0); if (full) PG8_MMA(0, 1, At, B1); PG8_BAR;
            PG8_LDA(At, 1, 1); PG8_STAGE(PG8_SA(1, 0), a3, voffA);
            PG8_BAR; PG8_WAIT_L(0); PG8_MMA(1, 0, At, B0); PG8_BAR; PG8_SCHED;
            PG8_STAGE_B(PG8_SB(1, 1), b3 + hstep, voffB);
            PG8_WAIT_V(6); PG8_BAR; if (full) PG8_MMA(1, 1, At, B1); PG8_BAR;
            }
        }
        if constexpr (ALIGN_EPI) { if (wr == 0) PG8_BAR; }
        if constexpr (!Epi::AFTER_DRAIN) { if (PG8_SKIPW) PG8_WAIT_V(0); E(acc, cur, wr, wc, fr, fq); if (PROBE == 8 && Epi::PROBE_TWICE) { asm volatile("" ::: "memory"); E(acc, cur, wr, wc, fr, fq); } S.done(cur); }
        if (!has_next) break;
#pragma unroll
        for (int a = 0; a < 2; ++a)
#pragma unroll
            for (int b = 0; b < 2; ++b)
#pragma unroll
                for (int m = 0; m < 4; ++m)
#pragma unroll
                    for (int n = 0; n < 2; ++n) acc[a][b][m][n] = (f32x4){0.f, 0.f, 0.f, 0.f};
        cur = nxt; bA = nbA; bB = nbB; ko = kon; ++ui;
        if constexpr (ALIGN_EPI) { if (wr == 1) PG8_BAR; }
    }
    PG8_WAIT_V(0);
    if constexpr (!ALIGN_EPI) { if (wr == 0) PG8_BAR; }
    PG8_BAR;
    if constexpr (Epi::AFTER_DRAIN) { E.fused(acc, cur, wr, wc, fr, fq, lds, wid, lane); S.done(cur); }
#undef PG8_SA
#undef PG8_SB
#undef PG8_STAGE
#undef PG8_STAGE_B
#undef PG8_LDA
#undef PG8_LDB
#undef PG8_MMA
#undef PG8_WAIT_V
#undef PG8_WAIT_V8_UNLESS
#undef PG8_WAIT_L
#undef PG8_BAR
#undef PG8_SCHED
}
}

constexpr int NWAVES = 8;
constexpr int BATCH = 2, SEQ = 8192, D = 1024, DEPTH = 4, M = BATCH * SEQ;
constexpr int AP = 4096 + 64;
constexpr int GH = 2048, GH2 = 4096, SGU_G = 8, SGU_P = 128, SGU_C = 256;
constexpr int NH = 16, HD = 64, NREL = 192, CHUNK = 64;
constexpr int FF = 2816, FF2 = 5632, FF_NFULL = 20;
constexpr float EPS = 1e-6f;
constexpr float LOG2E = 1.4426950408889634f;
constexpr float QSCALE = 0.125f * LOG2E;

#ifndef MK_PER_PHASE
#define MK_PER_PHASE 0
#endif
constexpr int N_PHASES = 22;

constexpr size_t MiB = 1u << 20;
constexpr size_t WS_CTL = 0, CTL_ZERO_BYTES = 64 * 1024;
constexpr size_t WS_XSS = 1 * MiB;
constexpr size_t WS_VSS = 2 * MiB;
constexpr size_t WS_W = 4 * MiB;
constexpr size_t WS_XB = 110 * MiB;
constexpr size_t WS_ACT = 142 * MiB;
constexpr size_t WS_END = 273 * MiB;
constexpr size_t WO_IN = 0, WO_AOUT = 8388608, WO_QKV = 12582912, WO_BOUT = 18874368, WO_GU = 20971520, WO_DN = 44040192, WO_END = 55574528;
static_assert(WS_W + WO_END * 2 <= WS_XB && WS_XB + (size_t)M * D * 2 <= WS_ACT && WS_ACT + (size_t)M * AP * 2 <= WS_END, "d_ws map");
constexpr int CW_BAR = 1024;

constexpr int RING_OFF = 0, RING_BYTES = 131072;
constexpr int LDSCTL_OFF = RING_BYTES, MISC_OFF = LDSCTL_OFF + 320, RSTAB_OFF = LDSCTL_OFF + 1024;
constexpr int LDS_BYTES = 163840;
static_assert(MISC_OFF + 128 <= LDS_BYTES, "LDS map");

#define GAS __attribute__((address_space(1)))
#define LAS __attribute__((address_space(3)))
typedef unsigned short bf16;
typedef unsigned v4u __attribute__((ext_vector_type(4)));
typedef unsigned v2u __attribute__((ext_vector_type(2)));
typedef float f32x4 __attribute__((ext_vector_type(4)));
typedef float f32x16 __attribute__((ext_vector_type(16)));
typedef short bf16x8 __attribute__((ext_vector_type(8)));
typedef short s16x4 __attribute__((ext_vector_type(4)));
typedef GAS unsigned gu32;
#define RLX_AGENT __ATOMIC_RELAXED, __HIP_MEMORY_SCOPE_AGENT
#define LDS_WAIT() asm volatile("s_waitcnt lgkmcnt(0)" ::: "memory")
#define VM_WAIT() asm volatile("s_waitcnt vmcnt(0)" ::: "memory")
__device__ __forceinline__ unsigned pk2(float lo, float hi) { return pg8::cvt_pk_bf16(lo, hi); }
__device__ __forceinline__ float bf_lo(unsigned w) { return __uint_as_float(w << 16); }
__device__ __forceinline__ float bf_hi(unsigned w) { return __uint_as_float(w & 0xffff0000u); }
__device__ __forceinline__ float wave_sum(float v) {
#pragma unroll
    for (int o = 1; o < 64; o <<= 1) v += __shfl_xor(v, o);
    return v;
}
#define XB_TMO      128
#define XB_XCNT(j)  (256  + 64 * (j))
#define XB_XSUB(j)  (1280 + 64 * (j))
#define XB_XGEN(j)  (2304 + 64 * (j))
#define XB_TOP      3328
#define XB_TOPGEN   3392
#define XB_LSUB(j)  (3456 + 64 * (j))
#define XB_LGEN(j)  (4480 + 64 * (j))
#define XCD_BAR_WORDS 5504
#define XB_SPIN_CAP (1u << 18)
#ifndef XB_EARLY
#define XB_EARLY 1
#endif
#if XB_EARLY
#define XB_EARLY_INV() asm volatile("buffer_inv sc1" ::: "memory")
#define XB_LATE_ACQ()  asm volatile("" ::: "memory")
#else
#define XB_EARLY_INV() do { } while (0)
#define XB_LATE_ACQ()  __builtin_amdgcn_fence(__ATOMIC_ACQUIRE, "agent")
#endif

__device__ __forceinline__ unsigned xb_ld(unsigned* p)              { return __hip_atomic_load(p, __ATOMIC_RELAXED, __HIP_MEMORY_SCOPE_AGENT); }
__device__ __forceinline__ unsigned xb_add(unsigned* p, unsigned v) { return __hip_atomic_fetch_add(p, v, __ATOMIC_RELAXED, __HIP_MEMORY_SCOPE_AGENT); }
__device__ __forceinline__ unsigned xb_xcc_id() { return (unsigned)__builtin_amdgcn_s_getreg((3 << 11) | 20) & 0xFu; }
#define XB_SPIN(cond, bar) do { unsigned _sp = 0; while (cond) { __builtin_amdgcn_s_sleep(1); \
    if ((++_sp & 255u) == 0u) { if (xb_ld(&(bar)[XB_TMO])) break; if (_sp > XB_SPIN_CAP) { atomicAdd(&(bar)[XB_TMO], 1u); break; } } } } while (0)

struct XcdBarrier {
    unsigned* bar; unsigned x;
    volatile LAS unsigned* st;
};

__device__ __forceinline__ XcdBarrier xcd_barrier_post(unsigned* bar, volatile LAS unsigned* st) {
    XcdBarrier b; b.bar = bar; b.x = xb_xcc_id(); b.st = st;
    if (threadIdx.x == 0) st[3] = xb_add(&bar[XB_XCNT(b.x)], 1u);
    return b;
}
__device__ __forceinline__ void xcd_barrier_complete(unsigned* bar, unsigned x, unsigned& nloc, unsigned& nx, unsigned& xi) {
    const unsigned G = gridDim.x * gridDim.y * gridDim.z;
    unsigned sum, cnt, mine, below, sp = 0u;
    for (;;) {
        sum = 0u; cnt = 0u; mine = 0u; below = 0u;
#pragma unroll
        for (unsigned j = 0; j < 16; ++j) { const unsigned c = xb_ld(&bar[XB_XCNT(j)]); sum += c; cnt += (c > 0u) ? 1u : 0u; mine = (j == x) ? c : mine; below += (j < x && c > 0u) ? 1u : 0u; }
        if (sum == G) break;
        __builtin_amdgcn_s_sleep(1);
        if ((++sp & 255u) == 0u) { if (xb_ld(&bar[XB_TMO])) break; if (sp > XB_SPIN_CAP) { atomicAdd(&bar[XB_TMO], 1u); break; } }
    }
    nloc = mine > 0u ? mine : 1u; nx = cnt > 0u ? cnt : 1u; xi = below;
}

__device__ __forceinline__ void xcd_barrier(const XcdBarrier& b) {
    asm volatile("s_waitcnt vmcnt(0)" ::: "memory");
    __syncthreads();
    if (threadIdx.x == 0) {
        const unsigned bx_ = xb_xcc_id();
        unsigned* bar = b.bar; asm volatile("" : "+s"(bar));
        __builtin_amdgcn_s_waitcnt(0);
        XB_EARLY_INV();
        unsigned nloc = b.st[0], nx = b.st[1];
        if (nloc == 0u) { unsigned xi_; xcd_barrier_complete(bar, bx_, nloc, nx, xi_); b.st[0] = nloc; b.st[1] = nx; b.st[2] = xi_; }
        const unsigned old = xb_add(&bar[XB_XSUB(bx_)], 1u);
        const unsigned gen = old / nloc;
        if (old + 1u == (gen + 1u) * nloc) {
            __builtin_amdgcn_fence(__ATOMIC_RELEASE, "agent");
            asm volatile("s_waitcnt vmcnt(0)" ::: "memory");
            const unsigned og = xb_add(&bar[XB_TOP], 1u);
            const unsigned tg = og / nx;
            if (og + 1u == (tg + 1u) * nx) xb_add(&bar[XB_TOPGEN], 1u);
            else XB_SPIN(xb_ld(&bar[XB_TOPGEN]) == tg, bar);
            XB_LATE_ACQ();
            xb_add(&bar[XB_XGEN(bx_)], 1u);
            asm volatile("s_waitcnt vmcnt(0)" ::: "memory");
        } else {
            XB_SPIN(xb_ld(&bar[XB_XGEN(bx_)]) == gen, bar);
            XB_LATE_ACQ();
            asm volatile("s_waitcnt vmcnt(0)" ::: "memory");
        }
    }
    __syncthreads();
}

__device__ __forceinline__ void xcd_barrier_local(const XcdBarrier& b) {
    asm volatile("s_waitcnt vmcnt(0)" ::: "memory");
    __syncthreads();
    if (threadIdx.x == 0) {
        const unsigned bx_ = xb_xcc_id();
        unsigned* bar = b.bar; asm volatile("" : "+s"(bar));
        const unsigned nloc = b.st[0];
        XB_EARLY_INV();
        const unsigned old = xb_add(&bar[XB_LSUB(bx_)], 1u);
        const unsigned gen = old / nloc;
        if (old + 1u == (gen + 1u) * nloc) xb_add(&bar[XB_LGEN(bx_)], 1u);
        else XB_SPIN(xb_ld(&bar[XB_LGEN(bx_)]) == gen, bar);
        XB_LATE_ACQ();
        asm volatile("s_waitcnt vmcnt(0)" ::: "memory");
    }
    __syncthreads();
}

__device__ __forceinline__ void p0_transpose_item(const float* W, const float* gain, int K, int N, bf16* WT, int drow0, bool sp, int k0, int n0, LAS unsigned* scr, int lane) {
    const int kp = lane >> 4, n4 = lane & 15;
    f32x4 w[8][2];
    const float* src = W + (size_t)(k0 + 2 * kp) * N + n0 + 4 * n4;
#pragma unroll
    for (int i = 0; i < 8; ++i) { w[i][0] = __builtin_nontemporal_load((const f32x4*)(src + (size_t)(8 * i) * N)); w[i][1] = __builtin_nontemporal_load((const f32x4*)(src + (size_t)(8 * i + 1) * N)); }
    if (gain) {
#pragma unroll
        for (int i = 0; i < 8; ++i) { const float g0 = gain[k0 + 8 * i + 2 * kp], g1 = gain[k0 + 8 * i + 2 * kp + 1]; w[i][0] = w[i][0] * g0; w[i][1] = w[i][1] * g1; }
    }
#pragma unroll
    for (int i = 0; i < 8; ++i)
#pragma unroll
        for (int e = 0; e < 4; ++e) scr[(4 * n4 + e) * 33 + 4 * i + kp] = pk2(w[i][0][e], w[i][1][e]);
    LDS_WAIT(); asm volatile("" ::: "memory");
    const int c = lane & 7;
#pragma unroll
    for (int jn = 0; jn < 8; ++jn) { const int n = (lane >> 3) + 8 * jn; const LAS unsigned* s = scr + n * 33 + 4 * c;
        v4u o; o.x = s[0]; o.y = s[1]; o.z = s[2]; o.w = s[3];
        const int dr = sp ? ((n >> 4) * 32 + ((n & 15) >> 2) * 8 + (n & 3)) : n;
        pg8::store16(WT + (size_t)(drow0 + dr) * K + k0 + 8 * c, o); }
    LDS_WAIT(); asm volatile("" ::: "memory");
}
struct Ptrs {
    const float *x, *norm_mix_g, *norm_ffn_g, *final_g, *a_w_in, *a_v_gain, *a_w_s, *a_b_s, *a_w_out, *b_w_qkv, *b_rel_bias, *b_w_out, *ffn_w_gate, *ffn_w_up, *ffn_w_down;
    float* out; bf16* wt; bf16* xb; bf16* act; float* xss; float* vss;
};
__device__ __forceinline__ void p0_prologue(const Ptrs& P, LAS unsigned char* lds, int vcu, int G, int wave, int lane) {
    LAS unsigned* scr = (LAS unsigned*)(lds + RING_OFF + wave * 16384);
    const int gw = vcu * NWAVES + wave, NGW = G * NWAVES;
    constexpr int I_IN = 16 * 64, I_AOUT = 32 * 16, I_QKV = 16 * 48, I_BOUT = 16 * 16, I_GU = 16 * 44, I_DN = 44 * 16;
    constexpr int NITEMS = 2 * I_IN + 2 * I_AOUT + 2 * I_QKV + 2 * I_BOUT + 8 * I_GU + 4 * I_DN;
    for (int it = gw; it < NITEMS; it += NGW) {
        int r = it; const float* W; const float* gain = nullptr; bf16* dst; int K, N, mode = 0;
        if (r < 2 * I_IN) { const int j = r / I_IN; r -= j * I_IN; W = P.a_w_in + (size_t)j * D * GH2; gain = P.norm_mix_g + (2 * j) * D; K = D; N = GH2; dst = P.wt + WO_IN + (size_t)j * D * GH2; }
        else if ((r -= 2 * I_IN) < 2 * I_AOUT) { const int j = r / I_AOUT; r -= j * I_AOUT; W = P.a_w_out + (size_t)j * GH * D; K = GH; N = D; dst = P.wt + WO_AOUT + (size_t)j * GH * D; }
        else if ((r -= 2 * I_AOUT) < 2 * I_QKV) { const int j = r / I_QKV; r -= j * I_QKV; W = P.b_w_qkv + (size_t)j * D * 3 * D; gain = P.norm_mix_g + (2 * j + 1) * D; K = D; N = 3 * D; dst = P.wt + WO_QKV + (size_t)j * D * 3 * D; }
        else if ((r -= 2 * I_QKV) < 2 * I_BOUT) { const int j = r / I_BOUT; r -= j * I_BOUT; W = P.b_w_out + (size_t)j * D * D; K = D; N = D; dst = P.wt + WO_BOUT + (size_t)j * D * D; }
        else if ((r -= 2 * I_BOUT) < 4 * I_GU) { const int i = r / I_GU; r -= i * I_GU; W = P.ffn_w_gate + (size_t)i * D * FF; gain = P.norm_ffn_g + i * D; K = D; N = FF; dst = P.wt + WO_GU + (size_t)i * D * FF2; mode = 1; }
        else if ((r -= 4 * I_GU) < 4 * I_GU) { const int i = r / I_GU; r -= i * I_GU; W = P.ffn_w_up + (size_t)i * D * FF; gain = P.norm_ffn_g + i * D; K = D; N = FF; dst = P.wt + WO_GU + (size_t)i * D * FF2; mode = 2; }
        else { r -= 4 * I_GU; const int i = r / I_DN; r -= i * I_DN; W = P.ffn_w_down + (size_t)i * FF * D; K = FF; N = D; dst = P.wt + WO_DN + (size_t)i * FF * D; }
        const int nblk = N / 64, kb = r / nblk, nb = r % nblk, k0 = 64 * kb, n0 = 64 * nb;
        const bool sp = (mode != 0) && (n0 >= FF_NFULL * 128);
        const int drow0 = (mode == 0) ? n0 : sp ? (FF_NFULL * 256 + ((n0 - FF_NFULL * 128) >> 6) * 128 + (mode == 2 ? 4 : 0)) : ((n0 >> 7) * 256 + (n0 & 127) + (mode == 2 ? 128 : 0));
        p0_transpose_item(W, gain, K, N, dst, drow0, sp, k0, n0, scr, lane);
    }
    for (int m = gw; m < M; m += 2 * NGW) {
        const int m2 = (m + NGW < M) ? m + NGW : m;
        const GAS f32x4* xr = (const GAS f32x4*)(P.x + (size_t)m * D) + 2 * lane; const GAS f32x4* xr2 = (const GAS f32x4*)(P.x + (size_t)m2 * D) + 2 * lane; f32x4 v[4], v2[4]; float s = 0.f, s2 = 0.f;
#pragma unroll
        for (int j = 0; j < 2; ++j) { v[2 * j] = __builtin_nontemporal_load(xr + 128 * j); v[2 * j + 1] = __builtin_nontemporal_load(xr + 128 * j + 1); v2[2 * j] = __builtin_nontemporal_load(xr2 + 128 * j); v2[2 * j + 1] = __builtin_nontemporal_load(xr2 + 128 * j + 1); }
#pragma unroll
        for (int j = 0; j < 4; ++j) { s += (v[j].x * v[j].x + v[j].y * v[j].y) + (v[j].z * v[j].z + v[j].w * v[j].w); s2 += (v2[j].x * v2[j].x + v2[j].y * v2[j].y) + (v2[j].z * v2[j].z + v2[j].w * v2[j].w); }
        s = wave_sum(s); s2 = wave_sum(s2);
        bf16* o8 = P.xb + (size_t)m * D + 8 * lane; bf16* o82 = P.xb + (size_t)m2 * D + 8 * lane;
#pragma unroll
        for (int j = 0; j < 2; ++j) {
            v4u w; w.x = pk2(v[2 * j].x, v[2 * j].y); w.y = pk2(v[2 * j].z, v[2 * j].w); w.z = pk2(v[2 * j + 1].x, v[2 * j + 1].y); w.w = pk2(v[2 * j + 1].z, v[2 * j + 1].w); pg8::store16(o8 + 512 * j, w);
            v4u w2; w2.x = pk2(v2[2 * j].x, v2[2 * j].y); w2.y = pk2(v2[2 * j].z, v2[2 * j].w); w2.z = pk2(v2[2 * j + 1].x, v2[2 * j + 1].y); w2.w = pk2(v2[2 * j + 1].z, v2[2 * j + 1].w); pg8::store16(o82 + 512 * j, w2); }
        if (lane < pg8::NSLOT_X) { P.xss[(size_t)m * pg8::NSLOT_X + lane] = (lane == 0) ? s : 0.f; P.xss[(size_t)m2 * pg8::NSLOT_X + lane] = (lane == 0) ? s2 : 0.f; }
    }
}

constexpr int SP_A_PITCH = 272, SP_V_PITCH = 528;
constexpr int SP_A_OFF = 0, SP_V_OFF = 36864, SP_R_OFF = 106496;
typedef short v4i16_t __attribute__((ext_vector_type(4)));
__device__ __forceinline__ s16x4 tr_read(const LAS unsigned char* p) { return __builtin_bit_cast(s16x4, __builtin_amdgcn_ds_read_tr16_b64_v4i16((LAS v4i16_t*)p)); }
template <bool DRY> __device__ __forceinline__ void spatial_phase(const Ptrs& P, int j, LAS unsigned char* lds, int vcu, int G, int wave, const pg8::Sch sc) {
    int tid = threadIdx.x; asm volatile("" : "+v"(tid)); const int lane = tid & 63;
    bf16* uv = P.act;
    LAS unsigned char* Aimg = lds + SP_A_OFF; LAS unsigned char* Vimg = lds + SP_V_OFF; LAS float* rsL = (LAS float*)(lds + SP_R_OFF);
    const int fr = lane & 15, fq = lane >> 4;
    const int NU = sc.lm ? 128 : (M / SGU_P) * SGU_G, ufirst = sc.lm ? sc.rank : vcu, ustride = sc.lm ? sc.nloc : G, ubase = sc.lm ? 128 * sc.gi : 0;
    f32x4 sv[2]; v4u vt[8]; f32x4 wq[8]; v4u uq[8]; float bq[8]; f32x4 gq0, gq1;
#define SP_LOAD_A(U) do { const int g_ = (U) & 7, row0_ = ((U) >> 3) * SGU_P; \
        { const f32x4* p_ = (const f32x4*)(P.vss + (size_t)(row0_ + (tid >> 2)) * pg8::NSLOT_V) + (tid & 3) * 2; sv[0] = p_[0]; sv[1] = p_[1]; } \
        _Pragma("unroll") for (int i = 0; i < 8; ++i) { const int pc = tid + 512 * i, q = pc >> 5, ch = pc & 31; vt[i] = __builtin_nontemporal_load((const v4u*)(uv + (size_t)(row0_ + q) * AP + GH + g_ * SGU_C + ch * 8)); } \
        { const float* ws_ = P.a_w_s + ((size_t)j * SGU_G + g_) * SGU_P * SGU_P; \
          _Pragma("unroll") for (int i = 0; i < 4; ++i) { const int e = tid + 512 * i, p = e >> 4, q0 = (e & 15) * 8; wq[2 * i] = *(const f32x4*)(ws_ + p * SGU_P + q0); wq[2 * i + 1] = *(const f32x4*)(ws_ + p * SGU_P + q0 + 4); } } } while (0)
#define SP_LOAD_B(U) do { const int g_ = (U) & 7, row0_ = ((U) >> 3) * SGU_P; \
        { const int cc_ = g_ * SGU_C + 32 * wave + 8 * fq; gq0 = *(const f32x4*)(P.a_v_gain + (size_t)j * GH + cc_); gq1 = *(const f32x4*)(P.a_v_gain + (size_t)j * GH + cc_ + 4); \
          _Pragma("unroll") for (int pt = 0; pt < 8; ++pt) { const int p = 16 * pt + fr; uq[pt] = __builtin_nontemporal_load((const v4u*)(uv + (size_t)(row0_ + p) * AP + cc_)); bq[pt] = P.a_b_s[((size_t)j * SGU_G + g_) * SGU_P + p]; } } } while (0)
    int uk = ufirst;
    if (uk < NU) { SP_LOAD_A(uk + ubase); SP_LOAD_B(uk + ubase); }
    for (; uk < NU; uk += ustride) {
        const int unit = uk + ubase, nb = unit >> 3, g = unit & 7, row0 = nb * SGU_P;
        { float s = ((sv[0][0] + sv[0][1]) + (sv[0][2] + sv[0][3])) + ((sv[1][0] + sv[1][1]) + (sv[1][2] + sv[1][3])); s += __shfl_xor(s, 1); s += __shfl_xor(s, 2);
            if ((tid & 3) == 0) rsL[tid >> 2] = __builtin_amdgcn_rsqf(s * (1.0f / GH) + EPS); }
#pragma unroll
        for (int i = 0; i < 8; ++i) { const int pc = tid + 512 * i, q = pc >> 5, ch = pc & 31; *(LAS v4u*)(Vimg + q * SP_V_PITCH + ch * 16) = vt[i]; }
        __syncthreads();
#pragma unroll
        for (int i = 0; i < 4; ++i) { const int e = tid + 512 * i, p = e >> 4, q0 = (e & 15) * 8;
            const f32x4 w0 = wq[2 * i], w1 = wq[2 * i + 1];
            const f32x4 r0 = *(const LAS f32x4*)(rsL + q0), r1 = *(const LAS f32x4*)(rsL + q0 + 4);
            v4u o; o.x = pk2(w0[0] * r0[0], w0[1] * r0[1]); o.y = pk2(w0[2] * r0[2], w0[3] * r0[3]); o.z = pk2(w1[0] * r1[0], w1[1] * r1[1]); o.w = pk2(w1[2] * r1[2], w1[3] * r1[3]);
            *(LAS v4u*)(Aimg + p * SP_A_PITCH + q0 * 2) = o; }
        __syncthreads();
        if (uk + ustride < NU) SP_LOAD_A(unit + ustride);
        const f32x4 gn0 = gq0, gn1 = gq1;
        bf16x8 vf[2][4];
        { const LAS unsigned char* vb = Vimg + (8 * fq + ((lane & 15) >> 2)) * SP_V_PITCH + (32 * wave + 8 * (lane & 3)) * 2;
#pragma unroll
            for (int ks = 0; ks < 4; ++ks)
#pragma unroll
                for (int n = 0; n < 2; ++n) { const s16x4 lo = tr_read(vb + ks * 32 * SP_V_PITCH + n * 8), hi = tr_read(vb + ks * 32 * SP_V_PITCH + 4 * SP_V_PITCH + n * 8);
                    vf[n][ks] = (bf16x8){lo[0], lo[1], lo[2], lo[3], hi[0], hi[1], hi[2], hi[3]}; } }
        const int cc = g * SGU_C + 32 * wave + 8 * fq;
#pragma unroll
        for (int pt = 0; pt < 8; ++pt) {
            f32x4 a0 = {0.f, 0.f, 0.f, 0.f}, a1 = {0.f, 0.f, 0.f, 0.f};
            const LAS unsigned char* ab = Aimg + (16 * pt + fr) * SP_A_PITCH + (8 * fq) * 2;
#pragma unroll
            for (int ks = 0; ks < 4; ++ks) if (ks < (pt < 4 ? 2 : 4)) { const bf16x8 af = *(const LAS bf16x8*)(ab + ks * 64);
                a0 = __builtin_amdgcn_mfma_f32_16x16x32_bf16(vf[0][ks], af, a0, 0, 0, 0); a1 = __builtin_amdgcn_mfma_f32_16x16x32_bf16(vf[1][ks], af, a1, 0, 0, 0); }
            const int p = 16 * pt + fr; bf16* up = uv + (size_t)(row0 + p) * AP + cc;
            const float b = bq[pt]; const v4u u8 = uq[pt];
            v4u o;
            o.x = pk2(bf_lo(u8.x) * (gn0[0] * a0[0] + b), bf_hi(u8.x) * (gn0[1] * a0[1] + b)); o.y = pk2(bf_lo(u8.y) * (gn0[2] * a0[2] + b), bf_hi(u8.y) * (gn0[3] * a0[3] + b));
            o.z = pk2(bf_lo(u8.z) * (gn1[0] * a1[0] + b), bf_hi(u8.z) * (gn1[1] * a1[1] + b)); o.w = pk2(bf_lo(u8.w) * (gn1[2] * a1[2] + b), bf_hi(u8.w) * (gn1[3] * a1[3] + b));
            if (DRY) *(v4u*)((bf16*)P.out + (size_t)(row0 + p) * D + (g & 3) * SGU_C + 32 * wave + 8 * fq) = o; else pg8::store16(up, o);
        }
        asm volatile("" ::: "memory");
        if (uk + ustride < NU) SP_LOAD_B(unit + ustride);
        __syncthreads();
    }
#undef SP_LOAD_A
#undef SP_LOAD_B
}

constexpr int AT_NSL = 8, AT_K = 0, AT_V = AT_NSL * 8192, AT_BT = RSTAB_OFF + 1024, AT_WS = AT_BT + 1024, AT_OST = AT_K;
static_assert(AT_WS + 2048 <= LDS_BYTES && 2 * AT_NSL * 8192 <= RING_BYTES, "attention LDS map");
constexpr int AT_OSTP = 147456;
static_assert(AT_OSTP + 8 * 2048 <= LDS_BYTES, "attention O stages");
constexpr float ATT_THR = 8.0f;
__device__ __forceinline__ int crow(int r, int hi) { return (r & 3) + 8 * (r >> 2) + 4 * hi; }
#define MX3(a, b, c) __builtin_fmaxf(__builtin_fmaxf((a), (b)), (c))
__device__ __forceinline__ void glds16(const void* gsrc, unsigned lds_dst) { unsigned keep;
    asm volatile("s_mov_b32 %0, m0\n\ts_mov_b32 m0, %2\n\ts_nop 0\n\tglobal_load_lds_dwordx4 %1, off\n\ts_mov_b32 m0, %0" : "=&s"(keep) : "v"(gsrc), "s"(lds_dst) : "memory"); }
template <int DRY> __device__ __forceinline__ void attn_phase(const Ptrs& P, int j, LAS unsigned char* lds, int vcu, int G, int wave, const pg8::Sch sc) {
    int tid = threadIdx.x; asm volatile("" : "+v"(tid)); const int lane = tid & 63;
    bf16* Q = P.act; const bf16* Kt = P.act + D; const bf16* Vt = P.act + 2 * D;
    const int r32 = lane & 31, hi = lane >> 5, ci = wave >> 1, qh = wave & 1;
    LAS float* bt = (LAS float*)(lds + AT_BT); LAS float* wsf = (LAS float*)(lds + AT_WS) + wave * 64;
    const unsigned lds0 = (unsigned)(size_t)lds;
    const bool shr = sc.lm && sc.nloc == 32;
    const int NUA = shr ? 4 : sc.lm ? 128 : BATCH * NH * (SEQ / 256), afirst = shr ? 0 : sc.lm ? sc.rank : vcu, astride = shr ? 1 : sc.lm ? sc.nloc : G;
#define ATT_DEC(UK, B_, H_, CQ_) do { if (shr) { const int p_ = 8 * sc.gi + 4 * (sc.rank >> 4) + (UK); H_ = sc.rank & 15; B_ = p_ >> 5; CQ_ = p_ & 31; } else if (sc.lm) { const int p_ = 8 * sc.gi + ((UK) & 7); H_ = (UK) >> 3; B_ = p_ >> 5; CQ_ = p_ & 31; } else { const int bh_ = (UK) >> 5; CQ_ = (UK) & 31; B_ = bh_ >> 4; H_ = bh_ & 15; } } while (0)
#define ATT_SLOT(t, pr) ((((t) + 4 * (pr)) & 7) * 8192)
    int par = 0;
    bf16x8 qnx[4] = {}; float rbx0 = 0.f, rbx1 = 0.f;
    for (int uk = afirst; uk < NUA; uk += astride, par ^= 1) {
        int b, h, cq; ATT_DEC(uk, b, h, cq);
        const size_t rowbase = (size_t)b * SEQ;
        const size_t qrow = rowbase + (size_t)(4 * cq + ci) * CHUNK + 32 * qh;
        const int s_lo = (4 * cq >= 8) ? 0 : 8 - 4 * cq;
        const long trow0 = (long)rowbase + (long)(4 * cq - 8) * CHUNK;
        const bf16* ksrc = Kt + (trow0 + 8 * wave + (lane >> 3)) * AP + h * HD + ((lane & 7) ^ ((4 * (wave & 1) + (lane >> 4)) & 7)) * 8;
        const bf16* vsrc = Vt + (trow0 + 16 * (wave & 3) + (lane >> 2)) * AP + h * HD + (wave >> 2) * 32 + (lane & 3) * 8;
        const bool has_n = uk + astride < NUA; int bn = 0, hn = 0, cqn = 0; if (has_n) ATT_DEC(uk + astride, bn, hn, cqn);
        const int s_lo_n = has_n ? ((4 * cqn >= 8) ? 0 : 8 - 4 * cqn) : 99;
        const bool res = shr && uk != afirst;
        const long trow0n = (long)bn * SEQ + (long)(4 * cqn - 8) * CHUNK;
        const bf16* ksrcn = Kt + (trow0n + 8 * wave + (lane >> 3)) * AP + hn * HD + ((lane & 7) ^ ((4 * (wave & 1) + (lane >> 4)) & 7)) * 8;
        const bf16* vsrcn = Vt + (trow0n + 16 * (wave & 3) + (lane >> 2)) * AP + hn * HD + (wave >> 2) * 32 + (lane & 3) * 8;
#define ATT_DMA_X(KS, VS, t, pr) do { const int sl_ = ATT_SLOT(t, pr); \
            glds16((KS) + (long)(t) * CHUNK * AP, (unsigned)__builtin_amdgcn_readfirstlane((int)(lds0 + AT_K + sl_ + wave * 1024))); \
            glds16((VS) + (long)(t) * CHUNK * AP, (unsigned)__builtin_amdgcn_readfirstlane((int)(lds0 + AT_V + sl_ + wave * 1024))); } while (0)
#define ATT_DMA(t) ATT_DMA_X(ksrc, vsrc, t, par)
#define ATT_DMA_ANY(T) do { if ((T) < 12) { if ((T) >= s_lo && !(res && (T) < 8)) ATT_DMA(T); } else { if (!shr && (T) - 12 >= s_lo_n) ATT_DMA_X(ksrcn, vsrcn, (T) - 12, par ^ 1); } } while (0)
#pragma unroll
        for (int t = 0; t < 5; ++t) if (uk == afirst && t >= s_lo) ATT_DMA(t);
        bf16x8 qr[4]; float rbv = rbx0, rbf = rbx1;
        if (uk == afirst) {
#pragma unroll
            for (int d0 = 0; d0 < 4; ++d0) qr[d0] = __builtin_nontemporal_load((const bf16x8*)(Q + (qrow + r32) * AP + h * HD + d0 * 16 + hi * 8));
            if (tid < NREL) { const float* rb = P.b_rel_bias + ((size_t)j * NH + h) * NREL; rbv = rb[tid]; rbf = rb[NREL - 1]; }
        } else {
#pragma unroll
            for (int d0 = 0; d0 < 4; ++d0) qr[d0] = qnx[d0];
        }
        if (tid < 256 && !res) bt[tid] = tid < NREL ? (rbv - rbf) * LOG2E : 0.f;
        asm volatile("" :: "v"(qr[0]), "v"(qr[1]), "v"(qr[2]), "v"(qr[3]));
        float mhat = 0.f, lrun = 0.f; f32x16 o0 = {}, o1 = {};
        const int j_first = (s_lo > ci) ? s_lo - ci : 0;
#pragma unroll 1
        for (int jj = 0; jj < 9; ++jj) {
            const int s = ci + jj;
            if ((jj & 1) == 0) {
                asm volatile("s_waitcnt vmcnt(0)" ::: "memory");
                __syncthreads();
                ATT_DMA_ANY(jj + 5);
                ATT_DMA_ANY(jj + 6);
            }
            const int delta = 8 - jj;
            if (jj >= j_first && DRY != 2) {
                const LAS unsigned char* Ks = lds + AT_K + ATT_SLOT(s, par); const LAS unsigned char* Vs = lds + AT_V + ATT_SLOT(s, par);
                f32x16 p0, p1;
                { const float c0 = -mhat;
#pragma unroll
                    for (int r = 0; r < 16; ++r) { p0[r] = c0; p1[r] = c0; } }
                { const LAS unsigned char* kb = Ks + r32 * 128; const int kx = (r32 >> 1) & 7; bf16x8 kf[8];
#pragma unroll
                    for (int d0 = 0; d0 < 4; ++d0) { const int kp = ((2 * d0 + hi) ^ kx) * 16; kf[2 * d0] = *(const LAS bf16x8*)(kb + kp); kf[2 * d0 + 1] = *(const LAS bf16x8*)(kb + 4096 + kp); }
                    __builtin_amdgcn_sched_barrier(0);
#pragma unroll
                    for (int d0 = 0; d0 < 4; ++d0) { p0 = __builtin_amdgcn_mfma_f32_32x32x16_bf16(kf[2 * d0], qr[d0], p0, 0, 0, 0); p1 = __builtin_amdgcn_mfma_f32_32x32x16_bf16(kf[2 * d0 + 1], qr[d0], p1, 0, 0, 0); } }
                if (delta < 3) {
                    const LAS float* bp = bt + (64 * delta + 32 * qh + r32 - 4 * hi);
                    asm volatile("" : "+v"(bp));
                    typedef pg8::f32x2 f32x2; typedef f32x2 __attribute__((aligned(4))) f32x2u;
                    f32x2 b0[8], b1[8];
#pragma unroll
                    for (int r = 0; r < 16; r += 2) { const int kc = (r & 3) + 8 * (r >> 2);
                        b0[r >> 1] = *(const LAS f32x2u*)(bp + 62 - kc); b1[r >> 1] = *(const LAS f32x2u*)(bp + 30 - kc); }
#pragma unroll
                    for (int r = 0; r < 8; ++r) { asm volatile("" : "+v"(b0[r])); asm volatile("" : "+v"(b1[r])); }
#pragma unroll
                    for (int r = 0; r < 16; r += 2) { p0[r] += b0[r >> 1][1]; p0[r + 1] += b0[r >> 1][0]; p1[r] += b1[r >> 1][1]; p1[r + 1] += b1[r >> 1][0]; }
                }
                float rm;
                { float a = MX3(p0[0], p0[1], p1[0]), c = MX3(p0[2], p0[3], p1[1]); a = MX3(a, p1[2], p1[3]);
#pragma unroll
                    for (int r = 4; r < 16; r += 4) { a = MX3(a, p0[r], p0[r + 1]); c = MX3(c, p0[r + 2], p0[r + 3]); a = MX3(a, p1[r], p1[r + 1]); c = MX3(c, p1[r + 2], p1[r + 3]); }
                    rm = __builtin_fmaxf(a, c);
                    auto rr = __builtin_amdgcn_permlane32_swap(__float_as_uint(rm), __float_as_uint(rm), false, false); rm = __builtin_fmaxf(__uint_as_float(rr[0]), __uint_as_float(rr[1])); }
                float dl = 0.f; bool resc = false;
                if (jj == j_first) { dl = rm; mhat = rm; }
                else if (__any(rm > ATT_THR)) {
                    dl = __builtin_fmaxf(rm, 0.f); mhat += dl;
                    const float f = __builtin_amdgcn_exp2f(-dl); lrun *= f;
                    if (hi == 0) wsf[r32] = f;
                    resc = true;
                }
                if (resc) {
#pragma unroll
                    for (int r = 0; r < 16; ++r) { const float fr_ = wsf[crow(r, hi)]; o0[r] *= fr_; o1[r] *= fr_; }
                }
                { typedef pg8::f32x2 f32x2; const f32x2 ndl = (f32x2){-dl, -dl}; f32x2 ps2 = (f32x2){0.f, 0.f};
#pragma unroll
                    for (int r = 0; r < 16; r += 2) { f32x2 a = (f32x2){p0[r], p0[r + 1]} + ndl, b = (f32x2){p1[r], p1[r + 1]} + ndl;
                        a[0] = __builtin_amdgcn_exp2f(a[0]); a[1] = __builtin_amdgcn_exp2f(a[1]); b[0] = __builtin_amdgcn_exp2f(b[0]); b[1] = __builtin_amdgcn_exp2f(b[1]);
                        ps2 = ps2 + a; ps2 = ps2 + b; p0[r] = a[0]; p0[r + 1] = a[1]; p1[r] = b[0]; p1[r + 1] = b[1]; }
                    lrun += ps2[0] + ps2[1]; }
                v4u pw[4];
                pw[0] = (v4u){pk2(p0[0], p0[1]), pk2(p0[2], p0[3]), pk2(p0[4], p0[5]), pk2(p0[6], p0[7])};
                pw[1] = (v4u){pk2(p0[8], p0[9]), pk2(p0[10], p0[11]), pk2(p0[12], p0[13]), pk2(p0[14], p0[15])};
                pw[2] = (v4u){pk2(p1[0], p1[1]), pk2(p1[2], p1[3]), pk2(p1[4], p1[5]), pk2(p1[6], p1[7])};
                pw[3] = (v4u){pk2(p1[8], p1[9]), pk2(p1[10], p1[11]), pk2(p1[12], p1[13]), pk2(p1[14], p1[15])};
                const LAS unsigned char* vb = Vs + ((lane >> 4) & 1) * 32 + (lane & 3) * 8 + (4 * hi + ((lane & 15) >> 2)) * 64;
#pragma unroll
                for (int kh = 0; kh < 2; ++kh) {
                    s16x4 vl[4], vh[4];
#pragma unroll
                    for (int i = 0; i < 4; ++i) { const int ks = 2 * kh + (i >> 1), dh = i & 1; vl[i] = tr_read(vb + dh * 4096 + ks * 1024); vh[i] = tr_read(vb + dh * 4096 + ks * 1024 + 512); }
                    __builtin_amdgcn_sched_barrier(0);
#pragma unroll
                    for (int i = 0; i < 4; ++i) { const int ks = 2 * kh + (i >> 1); const bf16x8 pa = __builtin_bit_cast(bf16x8, pw[ks]); const bf16x8 vfr = (bf16x8){vl[i][0], vl[i][1], vl[i][2], vl[i][3], vh[i][0], vh[i][1], vh[i][2], vh[i][3]};
                        if (i & 1) o1 = __builtin_amdgcn_mfma_f32_32x32x16_bf16(pa, vfr, o1, 0, 0, 0); else o0 = __builtin_amdgcn_mfma_f32_32x32x16_bf16(pa, vfr, o0, 0, 0, 0); } }
            }
        }
        if (!shr) { __syncthreads();
            ATT_DMA_ANY(15); ATT_DMA_ANY(16); }
#undef ATT_DMA_ANY
#undef ATT_DMA
#undef ATT_DMA_X
        if (has_n) {
            const size_t qrown = (size_t)bn * SEQ + (size_t)(4 * cqn + ci) * CHUNK + 32 * qh;
#pragma unroll
            for (int d0 = 0; d0 < 4; ++d0) qnx[d0] = __builtin_nontemporal_load((const bf16x8*)(Q + (qrown + r32) * AP + hn * HD + d0 * 16 + hi * 8));
            if (tid < NREL) { const float* rbn = P.b_rel_bias + ((size_t)j * NH + hn) * NREL; rbx0 = rbn[tid]; rbx1 = rbn[NREL - 1]; }
        }
        { auto rr = __builtin_amdgcn_permlane32_swap(__float_as_uint(lrun), __float_as_uint(lrun), false, false); lrun = __uint_as_float(rr[0]) + __uint_as_float(rr[1]); }
        if (hi == 0) wsf[32 + r32] = lrun;
        { LAS bf16* stg = (LAS bf16*)(lds + AT_OSTP + wave * 2048);
            bf16* Ow = (DRY ? (bf16*)P.out + qrow * D : Q + qrow * AP) + h * HD; const int opitch = DRY ? D : AP;
#pragma unroll
            for (int ph = 0; ph < 2; ++ph) {
#pragma unroll
                for (int r = 8 * ph; r < 8 * ph + 8; ++r) { const int orow = crow(r, hi); const float rl = __builtin_amdgcn_rcpf(wsf[32 + orow]); const int lr = orow - 16 * ph;
                    stg[lr * 64 + r32] = (bf16)(pk2(o0[r] * rl, 0.f) & 0xffffu); stg[lr * 64 + 32 + r32] = (bf16)(pk2(o1[r] * rl, 0.f) & 0xffffu); }
#pragma unroll
                for (int i = 0; i < 2; ++i) { const int row = i * 8 + (lane >> 3), ch = lane & 7; const v4u v = *(const LAS v4u*)(stg + row * 64 + ch * 8); *(v4u*)(Ow + (size_t)(16 * ph + row) * opitch + ch * 8) = v; }
            } }
        if (!shr) asm volatile("s_waitcnt lgkmcnt(0)\n\ts_barrier" ::: "memory");
    }
#undef ATT_DEC
#undef ATT_SLOT
}
#undef MX3

__device__ __forceinline__ void final_phase(const Ptrs& P, int vcu, int G, int wave, const pg8::Sch sc) {
    int tid_ = threadIdx.x; asm volatile("" : "+v"(tid_)); const int lane = tid_ & 63;
    const int gw = (sc.lm ? sc.rank : vcu) * NWAVES + wave, NGW = (sc.lm ? sc.nloc : G) * NWAVES, mbase = sc.lm ? 2048 * sc.gi : 0, mcount = sc.lm ? 2048 : M;
    f32x4 gn[4];
#pragma unroll
    for (int j = 0; j < 4; ++j) gn[j] = ((const f32x4*)P.final_g)[lane + 64 * j];
    for (int mk = gw; mk < mcount; mk += 4 * NGW) {
        v2u w[4][4]; f32x4 sv[4]; int mm[4];
#pragma unroll
        for (int q = 0; q < 4; ++q) { const int mq = mk + q * NGW; mm[q] = mbase + (mq < mcount ? mq : mk);
            sv[q] = *(const f32x4*)(P.xss + (size_t)mm[q] * pg8::NSLOT_X + (lane & 3) * 4);
            const GAS v2u* xr = (const GAS v2u*)(P.xb + (size_t)mm[q] * D) + lane;
#pragma unroll
            for (int j = 0; j < 4; ++j) w[q][j] = __builtin_nontemporal_load(xr + 64 * j); }
#pragma unroll
        for (int q = 0; q < 4; ++q) { if (mk + q * NGW >= mcount) break;
            float s = (sv[q][0] + sv[q][1]) + (sv[q][2] + sv[q][3]); s += __shfl_xor(s, 1); s += __shfl_xor(s, 2);
            const float r = __builtin_amdgcn_rsqf(s * (1.0f / D) + EPS);
            GAS f32x4* orow = (GAS f32x4*)(P.out + (size_t)mm[q] * D) + lane;
#pragma unroll
            for (int j = 0; j < 4; ++j) { const f32x4 v = {bf_lo(w[q][j].x), bf_hi(w[q][j].x), bf_lo(w[q][j].y), bf_hi(w[q][j].y)}; orow[64 * j] = v * r * gn[j]; } }
    }
}

#ifndef PANEL_OWNER
#define PANEL_OWNER 1
#endif
__device__ __forceinline__ pg8::Sch get_sch(volatile LAS unsigned* MISC, int G) {
    pg8::Sch s; const int nloc = __builtin_amdgcn_readfirstlane((int)MISC[8]), nx = __builtin_amdgcn_readfirstlane((int)MISC[9]);
    s.gi = __builtin_amdgcn_readfirstlane((int)MISC[10]); s.rank = __builtin_amdgcn_readfirstlane((int)MISC[11]); s.nloc = nloc > 0 ? nloc : 1;
    s.lm = (PANEL_OWNER && !MK_PER_PHASE && nx == 8 && nloc > 0 && M == 16384) ? 1 : 0; return s;
}
__device__ __forceinline__ int launder_s(int x) { asm volatile("" : "+s"(x)); return x; }
struct Args { const float* in[15]; float* out; unsigned char* ws; int ph_lo, ph_hi; };
static_assert(sizeof(Args) == 17 * 8 + 8, "Args has no padding");
__global__ void __launch_bounds__(NWAVES * 64, 2) trunk_fwd(Args args) {
    extern __shared__ __attribute__((aligned(16))) unsigned char lds_raw[];
    LAS unsigned char* lds = (LAS unsigned char*)lds_raw;
    volatile LAS unsigned* MISC = (volatile LAS unsigned*)(lds + MISC_OFF);
    const int tid = threadIdx.x, lane = tid & 63, wave = __builtin_amdgcn_readfirstlane(tid >> 6);
    const int G = gridDim.x; const int bx = blockIdx.x; const int vcu = (G % 8 == 0) ? (bx % 8) * (G / 8) + bx / 8 : bx;
    unsigned char* ws = args.ws;
    gu32* ctl = (gu32*)(ws + WS_CTL);
    Ptrs P;
    P.x = args.in[0]; P.norm_mix_g = args.in[1]; P.norm_ffn_g = args.in[2]; P.final_g = args.in[3]; P.a_w_in = args.in[4]; P.a_v_gain = args.in[5]; P.a_w_s = args.in[6]; P.a_b_s = args.in[7];
    P.a_w_out = args.in[8]; P.b_w_qkv = args.in[9]; P.b_rel_bias = args.in[10]; P.b_w_out = args.in[11]; P.ffn_w_gate = args.in[12]; P.ffn_w_up = args.in[13]; P.ffn_w_down = args.in[14];
    P.out = args.out; P.wt = (bf16*)(ws + WS_W); P.xb = (bf16*)(ws + WS_XB); P.act = (bf16*)(ws + WS_ACT); P.xss = (float*)(ws + WS_XSS); P.vss = (float*)(ws + WS_VSS);
    for (int u = tid; u < (LDS_BYTES - LDSCTL_OFF) / 4; u += NWAVES * 64) ((LAS unsigned*)(lds + LDSCTL_OFF))[u] = 0u;
    __syncthreads();
    XcdBarrier bar; bar.bar = (unsigned*)(ctl + CW_BAR); bar.x = 0; bar.st = nullptr;
    if (!MK_PER_PHASE) bar = xcd_barrier_post((unsigned*)(ctl + CW_BAR), MISC + 8);
    const int lo = args.ph_lo, hi = args.ph_hi;
#define RS_TABLE(S) pg8::RsTab rt{(const LAS float*)(lds + RSTAB_OFF), -1}; { pg8::Unit u0_; if (S.next(0, u0_)) { rt.pm = u0_.pm; pg8::build_rs_table(P.xss, u0_.pm, (LAS float*)(lds + RSTAB_OFF), tid, 1.0f / D, EPS); } }
#ifndef DBG_MASK
#define DBG_MASK 0xff
#endif
#if MK_PER_PHASE
#define IN(k) (lo <= (k) && (k) < hi)
#else
#define IN(k) true
#endif
#define SEAM(k, local_ok) do { if (IN(k) && IN((k) + 1)) { if ((local_ok) && get_sch(MISC, G).lm) xcd_barrier_local(bar); else xcd_barrier(bar); if (PROBE == 1) xcd_barrier(bar); } } while (0)

    if ((DBG_MASK & 1) && IN(0)) { p0_prologue(P, lds, vcu, G, wave, lane); if (PROBE == 2) { __syncthreads(); p0_prologue(P, lds, vcu, G, wave, lane); } }
    SEAM(0, false);
    if (PROBE == 12 && get_sch(MISC, G).lm) { const unsigned long long t0_ = __builtin_amdgcn_s_memrealtime(); while (__builtin_amdgcn_s_memrealtime() - t0_ < 20000ull) __builtin_amdgcn_s_sleep(8); }
#pragma unroll 1
    for (int layer = 0; layer < DEPTH; ++layer) {
        const int j = layer >> 1, ph = 1 + 5 * layer;
        const bf16* wgu = P.wt + WO_GU + (size_t)layer * D * FF2; const bf16* wdn = P.wt + WO_DN + (size_t)layer * FF * D;
        if ((layer & 1) == 0) {
            if ((DBG_MASK & 2) && IN(ph)) { pg8::Gemm g{P.xb, P.wt + WO_IN + (size_t)j * D * GH2, M, GH2, D, D}; const pg8::Sch sch = get_sch(MISC, G); pg8::PanelOrder S; S.init(M, GH2, G, launder_s(bx), sch);
                RS_TABLE(S);
                pg8::EpiGeluStats E{P.act, AP, P.xss, P.vss, GH / 256, EPS, rt};
                pg8::gemm_phase<pg8::EpiGeluStats, pg8::PanelOrder, true, true>(lds + RING_OFF, g, S, E);
                if (PROBE == 5) { __syncthreads(); pg8::gemm_phase<pg8::EpiGeluStats, pg8::PanelOrder, true, true>(lds + RING_OFF, g, S, E); } }
            SEAM(ph, true);
            if ((DBG_MASK & 4) && IN(ph + 1)) { if (PROBE == 4) spatial_phase<true>(P, j, lds, vcu, G, wave, get_sch(MISC, G)); spatial_phase<false>(P, j, lds, vcu, G, wave, get_sch(MISC, G)); }
            SEAM(ph + 1, true);
            if ((DBG_MASK & 8) && IN(ph + 2)) { pg8::Gemm g{P.act, P.wt + WO_AOUT + (size_t)j * GH * D, M, D, GH, AP}; const pg8::Sch sch = get_sch(MISC, G); pg8::PanelOrder S; S.init(M, D, G, launder_s(bx), sch);
                pg8::EpiResid E{P.xb, P.xss, D};
                pg8::gemm_phase<pg8::EpiResid, pg8::PanelOrder, false, true>(lds + RING_OFF, g, S, E); }
            SEAM(ph + 2, true);
        } else {
            if ((DBG_MASK & 16) && IN(ph)) { pg8::Gemm g{P.xb, P.wt + WO_QKV + (size_t)j * D * 3 * D, M, 3 * D, D, D}; const pg8::Sch sch = get_sch(MISC, G); pg8::PanelOrder S; S.init(M, 3 * D, G, launder_s(bx), sch);
                RS_TABLE(S);
                pg8::EpiQkv E{P.act, AP, (size_t)D, P.xss, EPS, QSCALE, rt};
                pg8::gemm_phase<pg8::EpiQkv, pg8::PanelOrder, true, true>(lds + RING_OFF, g, S, E);
                if (PROBE == 7) { __syncthreads(); pg8::gemm_phase<pg8::EpiQkv, pg8::PanelOrder, true, true>(lds + RING_OFF, g, S, E); } }
            SEAM(ph, false);
            if ((DBG_MASK & 32) && IN(ph + 1)) { if (PROBE == 3) attn_phase<1>(P, j, lds, vcu, G, wave, get_sch(MISC, G)); if (PROBE == 10) attn_phase<2>(P, j, lds, vcu, G, wave, get_sch(MISC, G)); attn_phase<0>(P, j, lds, vcu, G, wave, get_sch(MISC, G)); }
            SEAM(ph + 1, true);
            if ((DBG_MASK & 8) && IN(ph + 2)) { pg8::Gemm g{P.act, P.wt + WO_BOUT + (size_t)j * D * D, M, D, D, AP}; const pg8::Sch sch = get_sch(MISC, G); pg8::PanelOrder S; S.init(M, D, G, launder_s(bx), sch);
                pg8::EpiResid E{P.xb, P.xss, D};
                pg8::gemm_phase<pg8::EpiResid, pg8::PanelOrder, false, true>(lds + RING_OFF, g, S, E); }
            SEAM(ph + 2, false);
        }
        if ((DBG_MASK & 64) && IN(ph + 3)) { pg8::Gemm g{P.xb, wgu, M, FF2, D, D}; const pg8::Sch sch = get_sch(MISC, G); pg8::FfnOrder S; S.init(M, FF_NFULL, G, launder_s(bx), sch);
            RS_TABLE(S);
            pg8::EpiSwiglu E{P.act, AP, P.xss, EPS, rt, FF_NFULL * 128};
            pg8::gemm_phase<pg8::EpiSwiglu, pg8::FfnOrder, true, true>(lds + RING_OFF, g, S, E);
            if (PROBE == 6 || PROBE == 11) { __syncthreads(); pg8::gemm_phase<pg8::EpiSwiglu, pg8::FfnOrder, true, true>(lds + RING_OFF, g, S, E); } }
        SEAM(ph + 3, true);
        if ((DBG_MASK & 8) && IN(ph + 4)) { pg8::Gemm g{P.act, wdn, M, D, FF, AP}; const pg8::Sch sch = get_sch(MISC, G); pg8::PanelOrder S; S.init(M, D, G, launder_s(bx), sch);
            pg8::EpiResid E{P.xb, P.xss, D};
            pg8::gemm_phase<pg8::EpiResid, pg8::PanelOrder, false, true>(lds + RING_OFF, g, S, E); }
        SEAM(ph + 4, true);
    }
    if ((DBG_MASK & 128) && IN(N_PHASES - 1)) final_phase(P, vcu, G, wave, get_sch(MISC, G));
#undef IN
#undef SEAM
}

extern "C" void kernel_launch(void* const* d_in, const int* in_sizes, int n_in, void* d_out, int out_size, void* d_ws, size_t ws_size, hipStream_t stream) {
    static int grid = 0;
    if (grid == 0) {
        if (n_in != 15 || in_sizes[0] != M * D || out_size != M * D || ws_size < WS_END) { fprintf(stderr, "kernel_launch: unexpected shapes (n_in %d, in0 %d, out %d, ws %zu < %zu); nothing launched\n", n_in, n_in > 0 ? in_sizes[0] : -1, out_size, ws_size, (size_t)WS_END); grid = -1; return; }
        int dev = 0, cus = 0, per_cu = 0;
        if (hipGetDevice(&dev) != hipSuccess || hipDeviceGetAttribute(&cus, hipDeviceAttributeMultiprocessorCount, dev) != hipSuccess) { grid = -1; return; }
        if (hipFuncSetAttribute((const void*)trunk_fwd, hipFuncAttributeMaxDynamicSharedMemorySize, LDS_BYTES) != hipSuccess) { fprintf(stderr, "kernel_launch: hipFuncSetAttribute failed\n"); grid = -1; return; }
        if (hipOccupancyMaxActiveBlocksPerMultiprocessor(&per_cu, (const void*)trunk_fwd, NWAVES * 64, LDS_BYTES) != hipSuccess || per_cu < 1) { fprintf(stderr, "kernel_launch: occupancy query reports %d workgroups per CU; nothing launched\n", per_cu); (void)hipGetLastError(); grid = -1; return; }
        grid = cus;
    }
    if (grid < 0) return;
    if (hipMemsetAsync((char*)d_ws + WS_CTL, 0, CTL_ZERO_BYTES, stream) != hipSuccess) return;
    Args a{};
    for (int i = 0; i < 15; ++i) a.in[i] = (const float*)d_in[i];
    a.out = (float*)d_out; a.ws = (unsigned char*)d_ws;
#if MK_PER_PHASE
    for (int p = 0; p < N_PHASES; ++p) { a.ph_lo = p; a.ph_hi = p + 1; hipLaunchKernelGGL(trunk_fwd, dim3(grid), dim3(NWAVES * 64), LDS_BYTES, stream, a); }
#else
    a.ph_lo = 0; a.ph_hi = N_PHASES;
    hipLaunchKernelGGL(trunk_fwd, dim3(grid), dim3(NWAVES * 64), LDS_BYTES, stream, a);
#endif
}
```

```cpp
#include <hip/hip_runtime.h>
#include <cstdio>
#include <cstdint>
#ifndef PROBE
#define PROBE 0
#endif
#ifndef PG8_KROT
#define PG8_KROT 0
#endif
namespace pg8 {
#define PG8_LAS __attribute__((address_space(3)))
typedef unsigned short bf16_t;
typedef short bf16x8 __attribute__((ext_vector_type(8)));
typedef float f32x4 __attribute__((ext_vector_type(4)));
typedef unsigned u32x4 __attribute__((ext_vector_type(4)));
constexpr int BM = 256, BK = 64, HALF = 128, HTB = HALF * BK * 2  , STAGE_BYTES = 8 * HTB, NXCD = 8, WGM = 8;

__host__ __device__ __forceinline__ int lds_byte(int r, int c) { const int st = (r >> 4) * 2 + (c >> 5), rr = r & 15, cc = c & 31, ob = rr * 64 + cc * 2; return st * 1024 + (ob ^ (((ob >> 9) & 1) << 5)); }
__host__ __device__ __forceinline__ void stage_rc(int b, int& R, int& C) { const int st = b / 1024, sb = b % 1024, swz = sb ^ (((sb >> 9) & 1) << 5); R = (st >> 1) * 16 + swz / 64; C = (st & 1) * 32 + (swz % 64) / 2; }
__host__ __device__ __forceinline__ int perm32(int rho) { const int n = rho >> 4, i = rho & 15; return 8 * (i >> 2) + 4 * n + (i & 3); }

struct Unit { int pm, pn, hf; };
struct Gemm { const bf16_t* A; const bf16_t* Bt; int M, N, K, lda; };

struct StaticOrder {
    int nM, nN, nwg, G, c;
    __host__ __device__ void init(int M, int N, int G_, int c_) { nM = M / BM; nN = N / BM; nwg = nM * nN; G = G_; c = c_; }
    __host__ __device__ bool next(int i, Unit& u) const {
        const long L = (long)i * G + c; if (L >= nwg) return false;
        int wgid = (int)L; { const int q = nwg / NXCD, r = nwg % NXCD, xcd = wgid % NXCD, off = wgid / NXCD; wgid = (xcd < r ? xcd * (q + 1) : r * (q + 1) + (xcd - r) * q) + off; }
        const int nig = WGM * nN, gid = wgid / nig, fm = gid * WGM, gsz = (nM - fm) < WGM ? (nM - fm) : WGM;
        u.pm = fm + ((wgid % nig) % gsz); u.pn = (wgid % nig) / gsz; u.hf = 0; return true;
    }
    static constexpr bool HAS_HALF = false;
    __host__ __device__ int brow(const Unit& u) const { return u.pn * BM; }
    __device__ __forceinline__ int koff(const Unit& u, int nt) const { int k = PG8_KROT ? 2 * (u.pm & 7) + 4 * (u.pn & 3) : 0; k -= (k >= nt) ? nt : 0; return k; }
    __device__ __forceinline__ void a_ready(const Unit&) const {}
    __device__ __forceinline__ void done(const Unit&) const {}
};

__device__ __forceinline__ unsigned cvt_pk_bf16(float lo, float hi) { unsigned r; asm volatile("v_cvt_pk_bf16_f32 %0, %1, %2" : "=v"(r) : "v"(lo), "v"(hi)); return r; }
typedef float f32x2 __attribute__((ext_vector_type(2)));
struct Sch { int lm, gi, rank, nloc; };
struct PanelOrder {
    StaticOrder so; Sch sc; int nN;
    static constexpr bool HAS_HALF = false;
    __device__ void init(int M, int N, int G_, int c_, const Sch& s_) { so.init(M, N, G_, c_); sc = s_; nN = N / BM; }
    __device__ bool next(int i, Unit& u) const {
        if (sc.lm) { const int idx = sc.rank + sc.nloc * i; if (idx >= 8 * nN) return false; u.pm = 8 * sc.gi + (idx & 7); u.pn = idx >> 3; u.hf = 0; return true; }
        return so.next(i, u);
    }
    __device__ int brow(const Unit& u) const { return u.pn * BM; }
    __device__ __forceinline__ int koff(const Unit& u, int nt) const { int k = PG8_KROT ? 2 * (u.pm & 7) + 4 * (u.pn & 3) : 0; k -= (k >= nt) ? nt : 0; return k; }
    __device__ __forceinline__ void a_ready(const Unit&) const {}
    __device__ __forceinline__ void done(const Unit&) const {}
};
struct FfnOrder {
    PanelOrder po; int nfull, G, c, NFULL;
    static constexpr bool HAS_HALF = true;
    __device__ void init(int M, int NFULL_, int G_, int c_, const Sch& s_) { NFULL = NFULL_; po.init(M, NFULL_ * BM, G_, c_, s_); G = G_; c = c_;
        nfull = s_.lm ? ((s_.rank < 8 * NFULL_) ? (8 * NFULL_ - s_.rank + s_.nloc - 1) / s_.nloc : 0) : ((c_ < po.so.nwg) ? (po.so.nwg - c_ + G_ - 1) / G_ : 0); }
    __device__ bool next(int i, Unit& u) const {
        if (i < nfull) return po.next(i, u);
        const int k = i - nfull;
        if (po.sc.lm) { const int hidx = po.sc.rank + po.sc.nloc * k; if (hidx >= 32) return false; u.pm = 8 * po.sc.gi + (hidx & 7); u.pn = hidx >> 3; u.hf = 1; return true; }
        const int nh = po.so.nM * 4; const int hu = k * G + c; if (hu >= nh) return false;
        if (G == 256 && po.so.nM == 64) { Unit f; po.so.next(0, f); u.pm = f.pm; u.pn = f.pn & 3; }
        else { u.pm = hu % po.so.nM; u.pn = hu / po.so.nM; }
        u.hf = 1; return true;
    }
    __device__ int brow(const Unit& u) const { return u.hf ? NFULL * BM + u.pn * HALF : u.pn * BM; }
    __device__ __forceinline__ int koff(const Unit& u, int nt) const { int k = PG8_KROT ? 2 * (u.pm & 7) + 4 * (u.pn & 3) : 0; k -= (k >= nt) ? nt : 0; return k; }
    __device__ __forceinline__ void a_ready(const Unit&) const {}
    __device__ __forceinline__ void done(const Unit&) const {}
};

#ifndef PG8_B_AUX
#define PG8_B_AUX 0
#endif
#ifndef PG8_SKIPW
#define PG8_SKIPW 0
#endif
#ifndef STORE_WT
#define STORE_WT 1
#endif
__device__ __forceinline__ void store16(void* p, u32x4 v) {
#if STORE_WT
    asm volatile("global_store_dwordx4 %0, %1, off sc1\n\ts_nop 1" :: "v"(p), "v"(v) : "memory");
#else
    *(u32x4*)p = v;
#endif
}
__device__ __forceinline__ void store16f(void* p, f32x4 v) {
#if STORE_WT
    asm volatile("global_store_dwordx4 %0, %1, off sc1\n\ts_nop 1" :: "v"(p), "v"(v) : "memory");
#else
    *(f32x4*)p = v;
#endif
}
typedef unsigned u32x2 __attribute__((ext_vector_type(2)));
__device__ __forceinline__ void store8(void* p, u32x2 v) {
#if STORE_WT
    asm volatile("global_store_dwordx2 %0, %1, off sc1\n\ts_nop 1" :: "v"(p), "v"(v) : "memory");
#else
    *(u32x2*)p = v;
#endif
}
constexpr int NSLOT_X = 16;
constexpr int NSLOT_V = 32;
struct RsTab { const PG8_LAS float* t; int pm; };
__device__ __forceinline__ void row_scales(const float* ss, const RsTab& T, int pm, int wr, int fr, int fq, float inv_n, float eps, float (&rs)[2][4]) {
    if (pm == T.pm) {
#pragma unroll
        for (int ai = 0; ai < 2; ++ai)
#pragma unroll
            for (int m = 0; m < 4; ++m) rs[ai][m] = T.t[wr * 64 + fr + ai * HALF + m * 16];
    } else {
        const int row0 = pm * BM + wr * 64 + fr;
#pragma unroll
        for (int ai = 0; ai < 2; ++ai)
#pragma unroll
            for (int m = 0; m < 4; ++m) {
                const f32x4 v = *(const f32x4*)(ss + (size_t)(row0 + ai * HALF + m * 16) * NSLOT_X + fq * 4);
                float s = (v[0] + v[1]) + (v[2] + v[3]);
                s += __shfl_xor(s, 16); s += __shfl_xor(s, 32);
                rs[ai][m] = __builtin_amdgcn_rsqf(s * inv_n + eps);
            }
    }
}
__device__ __forceinline__ void build_rs_table(const float* ss, int pm, PG8_LAS float* t, int tid, float inv_n, float eps) {
    asm volatile("" : "+v"(tid));
    const int row = tid >> 1, half = tid & 1;
    const f32x4 a = *(const f32x4*)(ss + (size_t)(pm * BM + row) * NSLOT_X + half * 8), b = *(const f32x4*)(ss + (size_t)(pm * BM + row) * NSLOT_X + half * 8 + 4);
    float s = ((a[0] + a[1]) + (a[2] + a[3])) + ((b[0] + b[1]) + (b[2] + b[3]));
    s += __shfl_xor(s, 1);
    if (half == 0) t[row] = __builtin_amdgcn_rsqf(s * inv_n + eps);
    asm volatile("s_waitcnt lgkmcnt(0)" ::: "memory"); __syncthreads();
}
__device__ __forceinline__ float gelu_tanh(float x) {
    const float t = x * x, u2 = x * (2.302208198f + 0.1029432398f * t);
    const float e = __builtin_amdgcn_exp2f(-u2);
    return x * __builtin_amdgcn_rcpf(1.0f + e);
}
__device__ __forceinline__ float silu_mul(float g, float u) {
    const float e = __builtin_amdgcn_exp2f(g * -1.4426950408889634f);
    return (g * u) * __builtin_amdgcn_rcpf(1.0f + e);
}
__device__ __forceinline__ f32x2 gelu_tanh2(f32x2 x) {
    const f32x2 t = x * x;
    const f32x2 p = __builtin_elementwise_fma(t, (f32x2){-0.1029432398f, -0.1029432398f}, (f32x2){-2.302208198f, -2.302208198f});
    const f32x2 u2n = x * p;
    f32x2 d; d[0] = __builtin_amdgcn_exp2f(u2n[0]); d[1] = __builtin_amdgcn_exp2f(u2n[1]);
    d = d + (f32x2){1.0f, 1.0f};
    f32x2 r; r[0] = __builtin_amdgcn_rcpf(d[0]); r[1] = __builtin_amdgcn_rcpf(d[1]);
    return x * r;
}
__device__ __forceinline__ f32x2 silu_mul2(f32x2 g, f32x2 u, float rneg, float rr) {
    const f32x2 a = g * rneg;
    f32x2 d; d[0] = __builtin_amdgcn_exp2f(a[0]); d[1] = __builtin_amdgcn_exp2f(a[1]);
    d = d + (f32x2){1.0f, 1.0f};
    f32x2 q; q[0] = __builtin_amdgcn_rcpf(d[0]); q[1] = __builtin_amdgcn_rcpf(d[1]);
    return ((g * u) * rr) * q;
}
struct EpiGeluStats {
    static constexpr bool PERM = true, AFTER_DRAIN = false, PROBE_TWICE = false;
    bf16_t* O; int ldc; const float* xss; float* vss; int vtile0; float eps; RsTab rt;
    __device__ __forceinline__ void operator()(const f32x4 (&acc)[2][2][4][2], const Unit& u, int wr, int wc, int fr, int fq) const {
        const int row0 = u.pm * BM + wr * 64 + fr, col0 = u.pn * BM + wc * 32 + 8 * fq;
        float rs[2][4]; row_scales(xss, rt, u.pm, wr, fr, fq, 1.0f / 1024.0f, eps, rs);
        const bool isv = u.pn >= vtile0;
#pragma unroll
        for (int ai = 0; ai < 2; ++ai)
#pragma unroll
            for (int m = 0; m < 4; ++m) { const int row = row0 + ai * HALF + m * 16; bf16_t* rowp = O + (size_t)row * ldc + col0; const float r = rs[ai][m]; float ssq = 0.f;
                f32x2 sq2 = (f32x2){0.f, 0.f};
#pragma unroll
                for (int bj = 0; bj < 2; ++bj) { const f32x4 a0 = acc[ai][bj][m][0], a1 = acc[ai][bj][m][1];
                    const f32x2 y0 = gelu_tanh2((f32x2){a0[0], a0[1]} * r), y1 = gelu_tanh2((f32x2){a0[2], a0[3]} * r), y2 = gelu_tanh2((f32x2){a1[0], a1[1]} * r), y3 = gelu_tanh2((f32x2){a1[2], a1[3]} * r);
                    sq2 = __builtin_elementwise_fma(y0, y0, sq2); sq2 = __builtin_elementwise_fma(y1, y1, sq2); sq2 = __builtin_elementwise_fma(y2, y2, sq2); sq2 = __builtin_elementwise_fma(y3, y3, sq2);
                    u32x4 w; w.x = cvt_pk_bf16(y0[0], y0[1]); w.y = cvt_pk_bf16(y1[0], y1[1]); w.z = cvt_pk_bf16(y2[0], y2[1]); w.w = cvt_pk_bf16(y3[0], y3[1]);
                    store16(rowp + bj * HALF, w); }
                if (isv) { ssq = sq2[0] + sq2[1]; ssq += __shfl_xor(ssq, 16); ssq += __shfl_xor(ssq, 32); if (fq == 0) vss[(size_t)row * NSLOT_V + (u.pn - vtile0) * 4 + wc] = ssq; } }
    }
};
struct EpiSwiglu {
    static constexpr bool PERM = true, AFTER_DRAIN = false, PROBE_TWICE = true;
    bf16_t* O; int ldc; const float* xss; float eps; RsTab rt;
    int half_col0;
    __device__ __forceinline__ void operator()(const f32x4 (&acc)[2][2][4][2], const Unit& u, int wr, int wc, int fr, int fq) const {
        const int row0 = u.pm * BM + wr * 64 + fr, col0 = u.pn * HALF + wc * 32 + 8 * fq;
        float rs[2][4]; row_scales(xss, rt, u.pm, wr, fr, fq, 1.0f / 1024.0f, eps, rs);
        if (u.hf) {
            const int hc = half_col0 + u.pn * 64 + wc * 16 + 4 * fq;
#pragma unroll
            for (int ai = 0; ai < 2; ++ai)
#pragma unroll
                for (int m = 0; m < 4; ++m) { const int row = row0 + ai * HALF + m * 16; const float r = rs[ai][m], rneg = r * -1.4426950408889634f, rr = r * r;
                    const f32x4 g0 = acc[ai][0][m][0], u0 = acc[ai][0][m][1];
                    const f32x2 o0 = silu_mul2((f32x2){g0[0], g0[1]}, (f32x2){u0[0], u0[1]}, rneg, rr), o1 = silu_mul2((f32x2){g0[2], g0[3]}, (f32x2){u0[2], u0[3]}, rneg, rr);
                    u32x2 w; w.x = cvt_pk_bf16(o0[0], o0[1]); w.y = cvt_pk_bf16(o1[0], o1[1]);
                    *(u32x2*)(O + (size_t)row * ldc + hc) = w; }
            return;
        }
#pragma unroll
        for (int ai = 0; ai < 2; ++ai)
#pragma unroll
            for (int m = 0; m < 4; ++m) { const int row = row0 + ai * HALF + m * 16; const float r = rs[ai][m] * (PROBE == 9 ? 0.5f : 1.0f);
                const float rneg = r * -1.4426950408889634f, rr = r * r;
                const f32x4 g0 = acc[ai][0][m][0], g1 = acc[ai][0][m][1], u0 = acc[ai][1][m][0], u1 = acc[ai][1][m][1];
                const f32x2 o0 = silu_mul2((f32x2){g0[0], g0[1]}, (f32x2){u0[0], u0[1]}, rneg, rr), o1 = silu_mul2((f32x2){g0[2], g0[3]}, (f32x2){u0[2], u0[3]}, rneg, rr);
                const f32x2 o2 = silu_mul2((f32x2){g1[0], g1[1]}, (f32x2){u1[0], u1[1]}, rneg, rr), o3 = silu_mul2((f32x2){g1[2], g1[3]}, (f32x2){u1[2], u1[3]}, rneg, rr);
                u32x4 w; w.x = cvt_pk_bf16(o0[0], o0[1]); w.y = cvt_pk_bf16(o1[0], o1[1]); w.z = cvt_pk_bf16(o2[0], o2[1]); w.w = cvt_pk_bf16(o3[0], o3[1]);
                if (PROBE == 11) *(u32x4*)(O + (size_t)row * ldc + col0) = w; else store16(O + (size_t)row * ldc + col0, w); }
    }
};
struct EpiQkv {
    static constexpr bool PERM = true, AFTER_DRAIN = false, PROBE_TWICE = false;
    bf16_t* O; int ldc; size_t split_stride; const float* xss; float eps; float scale0; RsTab rt;
    __device__ __forceinline__ void operator()(const f32x4 (&acc)[2][2][4][2], const Unit& u, int wr, int wc, int fr, int fq) const {
        const int t = u.pn >> 2; bf16_t* base = O + (size_t)t * split_stride; const float sc = (t == 0) ? scale0 : 1.0f;
        const int row0 = u.pm * BM + wr * 64 + fr, col0 = (u.pn & 3) * BM + wc * 32 + 8 * fq;
        float rs[2][4]; row_scales(xss, rt, u.pm, wr, fr, fq, 1.0f / 1024.0f, eps, rs);
#pragma unroll
        for (int ai = 0; ai < 2; ++ai)
#pragma unroll
            for (int m = 0; m < 4; ++m) { const int row = row0 + ai * HALF + m * 16; bf16_t* rowp = base + (size_t)row * ldc + col0; const float r = rs[ai][m] * sc;
#pragma unroll
                for (int bj = 0; bj < 2; ++bj) { const f32x4 v0 = acc[ai][bj][m][0] * r, v1 = acc[ai][bj][m][1] * r;
                    u32x4 w; w.x = cvt_pk_bf16(v0[0], v0[1]); w.y = cvt_pk_bf16(v0[2], v0[3]); w.z = cvt_pk_bf16(v1[0], v1[1]); w.w = cvt_pk_bf16(v1[2], v1[3]);
                    store16(rowp + bj * HALF, w); } }
    }
};
struct EpiResid {
    static constexpr bool PERM = true, AFTER_DRAIN = false, PROBE_TWICE = false;
    bf16_t* xb; float* xss; int ldc;
    __device__ __forceinline__ void operator()(const f32x4 (&acc)[2][2][4][2], const Unit& u, int wr, int wc, int fr, int fq) const {
        asm volatile("" : "+v"(fr), "+v"(fq));
        const int row0 = u.pm * BM + wr * 64 + fr, col0 = u.pn * BM + wc * 32 + 8 * fq;
        u32x4 pre[2][4][2];
#pragma unroll
        for (int ai = 0; ai < 2; ++ai)
#pragma unroll
            for (int m = 0; m < 4; ++m)
#pragma unroll
                for (int bj = 0; bj < 2; ++bj) pre[ai][m][bj] = __builtin_nontemporal_load((const u32x4*)(xb + (size_t)(row0 + ai * HALF + m * 16) * ldc + col0 + bj * HALF));
#pragma unroll
        for (int ai = 0; ai < 2; ++ai)
#pragma unroll
            for (int m = 0; m < 4; ++m) { const int row = row0 + ai * HALF + m * 16; bf16_t* rowp = xb + (size_t)row * ldc + col0; float ssq = 0.f;
#pragma unroll
                for (int bj = 0; bj < 2; ++bj) { const u32x4 b = pre[ai][m][bj]; const f32x4 a0 = acc[ai][bj][m][0], a1 = acc[ai][bj][m][1];
                    float o[8];
                    o[0] = __uint_as_float(b.x << 16) + a0[0]; o[1] = __uint_as_float(b.x & 0xffff0000u) + a0[1]; o[2] = __uint_as_float(b.y << 16) + a0[2]; o[3] = __uint_as_float(b.y & 0xffff0000u) + a0[3];
                    o[4] = __uint_as_float(b.z << 16) + a1[0]; o[5] = __uint_as_float(b.z & 0xffff0000u) + a1[1]; o[6] = __uint_as_float(b.w << 16) + a1[2]; o[7] = __uint_as_float(b.w & 0xffff0000u) + a1[3];
                    ssq += ((o[0] * o[0] + o[1] * o[1]) + (o[2] * o[2] + o[3] * o[3])) + ((o[4] * o[4] + o[5] * o[5]) + (o[6] * o[6] + o[7] * o[7]));
                    u32x4 w; w.x = cvt_pk_bf16(o[0], o[1]); w.y = cvt_pk_bf16(o[2], o[3]); w.z = cvt_pk_bf16(o[4], o[5]); w.w = cvt_pk_bf16(o[6], o[7]);
                    store16(rowp + bj * HALF, w); }
                ssq += __shfl_xor(ssq, 16); ssq += __shfl_xor(ssq, 32);
                if (fq == 0) xss[(size_t)row * NSLOT_X + u.pn * 4 + wc] = ssq; }
    }
};

template <class Epi, class Sched, bool ALIGN_EPI = false, bool SP2 = false>
__device__ __forceinline__ void gemm_phase(PG8_LAS unsigned char* lds, const Gemm g, const Sched& S, const Epi& E) {
    int tid_ = threadIdx.x; asm volatile("" : "+v"(tid_));
    const int tid = tid_, wid = __builtin_amdgcn_readfirstlane(tid >> 6), lane = tid & 63, wr = wid >> 2, wc = wid & 3, fr = lane & 15, fq = lane >> 4;
    const int K = g.K, nt = K / BK;
    unsigned voffA[2], voffB[2];
#pragma unroll
    for (int i = 0; i < 2; ++i) { int R, C; stage_rc(tid * 16 + i * 8192, R, C); const int Rb = Epi::PERM ? ((R & ~31) + perm32(R & 31)) : R;
        voffA[i] = (unsigned)(R * g.lda + C) * 2u; voffB[i] = (unsigned)(Rb * K + C) * 2u; }
    const size_t kstep = (size_t)(BK * 2);
    const size_t hstep = (size_t)HALF * K * 2;
    const size_t tstep = 2 * hstep; const size_t hstepA = (size_t)HALF * g.lda * 2, tstepA = 2 * hstepA;
    const unsigned ldsw = (unsigned)wid * 1024u;
    const int aoff = lds_byte(wr * 64 + fr, fq * 8), boff = lds_byte(wc * 32 + fr, fq * 8);
#define PG8_SA(b, h) (((b) * 2 + (h)) * HTB)
#define PG8_SB(b, h) ((4 + (b) * 2 + (h)) * HTB)
#define PG8_STAGE(bufoff, gbase, voff) do { _Pragma("unroll") for (int _i = 0; _i < 2; ++_i) \
        __builtin_amdgcn_global_load_lds((const unsigned*)((const char*)(gbase) + (voff)[_i]), (PG8_LAS unsigned*)(lds + (bufoff) + ldsw + _i * 8192), 16, 0, 0); } while (0)
#define PG8_STAGE_B(bufoff, gbase, voff) do { _Pragma("unroll") for (int _i = 0; _i < 2; ++_i) \
        __builtin_amdgcn_global_load_lds((const unsigned*)((const char*)(gbase) + (voff)[_i]), (PG8_LAS unsigned*)(lds + (bufoff) + ldsw + _i * 8192), 16, 0, PG8_B_AUX); } while (0)
#define PG8_LDA(dst, b, h) do { _Pragma("unroll") for (int m = 0; m < 4; ++m) _Pragma("unroll") for (int k = 0; k < 2; ++k) dst[m][k] = *(const PG8_LAS bf16x8*)(lds + PG8_SA(b, h) + aoff + m * 2048 + k * 1024); } while (0)
#define PG8_LDB(dst, b, h) do { _Pragma("unroll") for (int n = 0; n < 2; ++n) _Pragma("unroll") for (int k = 0; k < 2; ++k) dst[n][k] = *(const PG8_LAS bf16x8*)(lds + PG8_SB(b, h) + boff + n * 2048 + k * 1024); } while (0)
#define PG8_MMA(ai, bj, At, Bt) do { __builtin_amdgcn_s_setprio(1); _Pragma("unroll") for (int m = 0; m < 4; ++m) _Pragma("unroll") for (int n = 0; n < 2; ++n) _Pragma("unroll") for (int k = 0; k < 2; ++k) \
        acc[ai][bj][m][n] = __builtin_amdgcn_mfma_f32_16x16x32_bf16(Bt[n][k], At[m][k], acc[ai][bj][m][n], 0, 0, 0); __builtin_amdgcn_s_setprio(0); } while (0)
#define PG8_WAIT_V(n) asm volatile("s_waitcnt vmcnt(" #n ")" ::: "memory")
#if PG8_SKIPW
#define PG8_WAIT_V8_UNLESS(c) asm volatile("s_cmp_lg_u32 %0, 0\n\ts_cbranch_scc1 .Lskipw%=\n\ts_waitcnt vmcnt(8)\n.Lskipw%=:" :: "s"(c) : "memory", "scc")
#else
#define PG8_WAIT_V8_UNLESS(c) PG8_WAIT_V(8)
#endif
#define PG8_WAIT_L(n) asm volatile("s_waitcnt lgkmcnt(" #n ")" ::: "memory")
#define PG8_BAR __builtin_amdgcn_s_barrier()
#define PG8_SCHED __builtin_amdgcn_sched_barrier(0)
    Unit cur, nxt; int ui = 0;
    if (!S.next(0, cur)) return;
    f32x4 acc[2][2][4][2];
#pragma unroll
    for (int a = 0; a < 2; ++a)
#pragma unroll
        for (int b = 0; b < 2; ++b)
#pragma unroll
            for (int m = 0; m < 4; ++m)
#pragma unroll
                for (int n = 0; n < 2; ++n) acc[a][b][m][n] = (f32x4){0.f, 0.f, 0.f, 0.f};
    bf16x8 At[4][2], B0[2][2], B1[2][2];
    const char* bA = (const char*)g.A + (size_t)cur.pm * tstepA; const char* bB = (const char*)g.Bt + (size_t)S.brow(cur) * K * 2;
    int ko = S.koff(cur, nt);
    const char* cA = bA + (size_t)ko * kstep; const char* cB = bB + (size_t)ko * kstep;
    S.a_ready(cur);
    if constexpr (SP2) {
        PG8_STAGE_B(PG8_SB(0, 0), cB, voffB); PG8_STAGE_B(PG8_SB(0, 1), cB + hstep, voffB); PG8_STAGE(PG8_SA(0, 0), cA, voffA); PG8_STAGE(PG8_SA(0, 1), cA + hstepA, voffA);
        if (wr == 1) PG8_BAR;
        PG8_WAIT_V(2); PG8_BAR;
        PG8_STAGE_B(PG8_SB(1, 0), cB + kstep, voffB); PG8_STAGE(PG8_SA(1, 0), cA + kstep, voffA); PG8_STAGE_B(PG8_SB(1, 1), cB + hstep + kstep, voffB);
        PG8_WAIT_V(6); PG8_BAR;
    } else {
        PG8_STAGE_B(PG8_SB(0, 0), cB, voffB); PG8_STAGE(PG8_SA(0, 0), cA, voffA); PG8_STAGE_B(PG8_SB(0, 1), cB + hstep, voffB); PG8_STAGE(PG8_SA(0, 1), cA + hstepA, voffA);
        if (wr == 1) PG8_BAR;
        PG8_WAIT_V(4); PG8_BAR;
        PG8_STAGE_B(PG8_SB(1, 0), cB + kstep, voffB); PG8_STAGE(PG8_SA(1, 0), cA + kstep, voffA); PG8_STAGE_B(PG8_SB(1, 1), cB + hstep + kstep, voffB);
        PG8_WAIT_V(6); PG8_BAR;
    }
    for (;;) {
        const bool has_next = S.next(ui + 1, nxt);
        const char* nbA = has_next ? (const char*)g.A + (size_t)nxt.pm * tstepA : bA; const char* nbB = has_next ? (const char*)g.Bt + (size_t)S.brow(nxt) * K * 2 : bB;
        const int kon = has_next ? S.koff(nxt, nt) : ko;
        const char* nA = nbA + (size_t)kon * kstep; const char* nB = nbB + (size_t)kon * kstep;
        const bool full = !(Sched::HAS_HALF && cur.hf);
        const int ntl = (PROBE == 9 && Epi::PROBE_TWICE) ? 2 * nt : nt;
        for (int t = 0; t < ntl; t += 2) {
            const bool last = (t == ntl - 2);
#if PG8_SKIPW
            int skipv_ = (ui > 0 && t == 0) ? 1 : 0; asm volatile("" : "+v"(skipv_)); const int skipw = __builtin_amdgcn_readfirstlane(skipv_);
#endif
            int t1 = t + 1 + ko, t2 = t + 2 + ko; t1 -= (t1 >= nt) ? nt : 0; t1 -= (t1 >= nt) ? nt : 0; t1 -= (t1 >= nt) ? nt : 0; t2 -= (t2 >= nt) ? nt : 0; t2 -= (t2 >= nt) ? nt : 0; t2 -= (t2 >= nt) ? nt : 0;
            const char* a1 = bA + (size_t)t1 * kstep;
            const char* a2 = last ? nA : bA + (size_t)t2 * kstep; const char* b2 = last ? nB : bB + (size_t)t2 * kstep;
            const char* a3 = a2 + kstep; const char* b3 = b2 + kstep;
            if (last && has_next) S.a_ready(nxt);
            if constexpr (SP2) {
            PG8_LDB(B0, 0, 0); if (full) PG8_LDB(B1, 0, 1); PG8_SCHED; PG8_LDA(At, 0, 0); PG8_STAGE(PG8_SA(1, 1), a1 + hstepA, voffA);
            PG8_WAIT_V8_UNLESS(skipw); PG8_WAIT_L(0); PG8_BAR; PG8_MMA(0, 0, At, B0); if (full) PG8_MMA(0, 1, At, B1); PG8_BAR; PG8_SCHED;
            PG8_LDA(At, 0, 1); PG8_STAGE_B(PG8_SB(0, 0), b2, voffB); PG8_STAGE_B(PG8_SB(0, 1), b2 + hstep, voffB); PG8_STAGE(PG8_SA(0, 0), a2, voffA);
            PG8_WAIT_V8_UNLESS(skipw); PG8_WAIT_L(0); PG8_BAR; PG8_MMA(1, 0, At, B0); if (full) PG8_MMA(1, 1, At, B1); PG8_BAR; PG8_SCHED;
            PG8_LDB(B0, 1, 0); if (full) PG8_LDB(B1, 1, 1); PG8_SCHED; PG8_LDA(At, 1, 0); PG8_STAGE(PG8_SA(0, 1), a2 + hstepA, voffA);
            PG8_WAIT_V(8); PG8_WAIT_L(0); PG8_BAR; PG8_MMA(0, 0, At, B0); if (full) PG8_MMA(0, 1, At, B1); PG8_BAR; PG8_SCHED;
            PG8_LDA(At, 1, 1); PG8_STAGE_B(PG8_SB(1, 0), b3, voffB); PG8_STAGE_B(PG8_SB(1, 1), b3 + hstep, voffB); PG8_STAGE(PG8_SA(1, 0), a3, voffA);
            PG8_WAIT_V(8); PG8_WAIT_L(0); PG8_BAR; PG8_MMA(1, 0, At, B0); if (full) PG8_MMA(1, 1, At, B1); PG8_BAR; PG8_SCHED;
            } else {
            PG8_LDB(B0, 0, 0); PG8_SCHED; PG8_LDA(At, 0, 0); PG8_STAGE(PG8_SA(1, 1), a1 + hstepA, voffA);
            PG8_WAIT_L(8); PG8_BAR; PG8_WAIT_L(0); PG8_MMA(0, 0, At, B0); PG8_BAR; PG8_SCHED;
            PG8_LDB(B1, 0, 1); PG8_STAGE_B(PG8_SB(0, 0), b2, voffB);
            PG8_BAR; PG8_WAIT_L(0); if (full) PG8_MMA(0, 1, At, B1); PG8_BAR;
            PG8_LDA(At, 0, 1); PG8_STAGE(PG8_SA(0, 0), a2, voffA);
            PG8_BAR; PG8_WAIT_L(0); PG8_MMA(1, 0, At, B0); PG8_BAR; PG8_SCHED;
            PG8_STAGE_B(PG8_SB(0, 1), b2 + hstep, voffB);
            PG8_WAIT_V(6); PG8_BAR; if (full) PG8_MMA(1, 1, At, B1); PG8_BAR;
            PG8_LDB(B0, 1, 0); PG8_SCHED; PG8_LDA(At, 1, 0); PG8_STAGE(PG8_SA(0, 1), a2 + hstepA, voffA);
            PG8_WAIT_L(8); PG8_BAR; PG8_WAIT_L(0); PG8_MMA(0, 0, At, B0); PG8_BAR; PG8_SCHED;
            PG8_LDB(B1, 1, 1); PG8_STAGE_B(PG8_SB(1, 0), b3, voffB);
            PG8_BAR; PG8_WAIT_L(0); if (full) PG8_MMA(0, 1, At, B1); PG8_BAR;
            PG8_LDA(At, 1, 1); PG8_STAGE(PG8_SA(1, 0), a3, voffA);
            PG8_BAR; PG8_WAIT_L(0); PG8_MMA(1, 0, At, B0); PG8_BAR; PG8_SCHED;
            PG8_STAGE_B(PG8_SB(1, 1), b3 + hstep, voffB);
            PG8_WAIT_V(6); PG8_BAR; if (full) PG8_MMA(1, 1, At, B1); PG8_BAR;
            }
        }
        if constexpr (ALIGN_EPI) { if (wr == 0) PG8_BAR; }
        if constexpr (!Epi::AFTER_DRAIN) { if (PG8_SKIPW) PG8_WAIT_V(0); E(acc, cur, wr, wc, fr, fq); if (PROBE == 8 && Epi::PROBE_TWICE) { asm volatile("" ::: "memory"); E(acc, cur, wr, wc, fr, fq); } S.done(cur); }
        if (!has_next) break;
#pragma unroll
        for (int a = 0; a < 2; ++a)
#pragma unroll
            for (int b = 0; b < 2; ++b)
#pragma unroll
                for (int m = 0; m < 4; ++m)
#pragma unroll
                    for (int n = 0; n < 2; ++n) acc[a][b][m][n] = (f32x4){0.f, 0.f, 0.f, 0.f};
        cur = nxt; bA = nbA; bB = nbB; ko = kon; ++ui;
        if constexpr (ALIGN_EPI) { if (wr == 1) PG8_BAR; }
    }
    PG8_WAIT_V(0);
    if constexpr (!ALIGN_EPI) { if (wr == 0) PG8_BAR; }
    PG8_BAR;
    if constexpr (Epi::AFTER_DRAIN) { E.fused(acc, cur, wr, wc, fr, fq, lds, wid, lane); S.done(cur); }
#undef PG8_SA
#undef PG8_SB
#undef PG8_STAGE
#undef PG8_STAGE_B
#undef PG8_LDA
#undef PG8_LDB
#undef PG8_MMA
#undef PG8_WAIT_V
#undef PG8_WAIT_V8_UNLESS
#undef PG8_WAIT_L
#undef PG8_BAR
#undef PG8_SCHED
}
}

constexpr int NWAVES = 8;
constexpr int BATCH = 2, SEQ = 8192, D = 1024, DEPTH = 4, M = BATCH * SEQ;
constexpr int AP = 4096 + 64;
constexpr int GH = 2048, GH2 = 4096, SGU_G = 8, SGU_P = 128, SGU_C = 256;
constexpr int NH = 16, HD = 64, NREL = 192, CHUNK = 64;
constexpr int FF = 2816, FF2 = 5632, FF_NFULL = 20;
constexpr float EPS = 1e-6f;
constexpr float LOG2E = 1.4426950408889634f;
constexpr float QSCALE = 0.125f * LOG2E;

#ifndef MK_PER_PHASE
#define MK_PER_PHASE 0
#endif
constexpr int N_PHASES = 22;

constexpr size_t MiB = 1u << 20;
constexpr size_t WS_CTL = 0, CTL_ZERO_BYTES = 64 * 1024;
constexpr size_t WS_XSS = 1 * MiB;
constexpr size_t WS_VSS = 2 * MiB;
constexpr size_t WS_W = 4 * MiB;
constexpr size_t WS_XB = 110 * MiB;
constexpr size_t WS_ACT = 142 * MiB;
constexpr size_t WS_END = 273 * MiB;
constexpr size_t WO_IN = 0, WO_AOUT = 8388608, WO_QKV = 12582912, WO_BOUT = 18874368, WO_GU = 20971520, WO_DN = 44040192, WO_END = 55574528;
static_assert(WS_W + WO_END * 2 <= WS_XB && WS_XB + (size_t)M * D * 2 <= WS_ACT && WS_ACT + (size_t)M * AP * 2 <= WS_END, "d_ws map");
constexpr int CW_BAR = 1024;

constexpr int RING_OFF = 0, RING_BYTES = 131072;
constexpr int LDSCTL_OFF = RING_BYTES, MISC_OFF = LDSCTL_OFF + 320, RSTAB_OFF = LDSCTL_OFF + 1024;
constexpr int LDS_BYTES = 163840;
static_assert(MISC_OFF + 128 <= LDS_BYTES, "LDS map");

#define GAS __attribute__((address_space(1)))
#define LAS __attribute__((address_space(3)))
typedef unsigned short bf16;
typedef unsigned v4u __attribute__((ext_vector_type(4)));
typedef unsigned v2u __attribute__((ext_vector_type(2)));
typedef float f32x4 __attribute__((ext_vector_type(4)));
typedef float f32x16 __attribute__((ext_vector_type(16)));
typedef short bf16x8 __attribute__((ext_vector_type(8)));
typedef short s16x4 __attribute__((ext_vector_type(4)));
typedef GAS unsigned gu32;
#define RLX_AGENT __ATOMIC_RELAXED, __HIP_MEMORY_SCOPE_AGENT
#define LDS_WAIT() asm volatile("s_waitcnt lgkmcnt(0)" ::: "memory")
#define VM_WAIT() asm volatile("s_waitcnt vmcnt(0)" ::: "memory")
__device__ __forceinline__ unsigned pk2(float lo, float hi) { return pg8::cvt_pk_bf16(lo, hi); }
__device__ __forceinline__ float bf_lo(unsigned w) { return __uint_as_float(w << 16); }
__device__ __forceinline__ float bf_hi(unsigned w) { return __uint_as_float(w & 0xffff0000u); }
__device__ __forceinline__ float wave_sum(float v) {
#pragma unroll
    for (int o = 1; o < 64; o <<= 1) v += __shfl_xor(v, o);
    return v;
}
#define XB_TMO      128
#define XB_XCNT(j)  (256  + 64 * (j))
#define XB_XSUB(j)  (1280 + 64 * (j))
#define XB_XGEN(j)  (2304 + 64 * (j))
#define XB_TOP      3328
#define XB_TOPGEN   3392
#define XB_LSUB(j)  (3456 + 64 * (j))
#define XB_LGEN(j)  (4480 + 64 * (j))
#define XCD_BAR_WORDS 5504
#define XB_SPIN_CAP (1u << 18)
#ifndef XB_LOCAL_FLAGS
#define XB_LOCAL_FLAGS 1
#endif
#ifndef XB_EARLY
#define XB_EARLY 1
#endif
#if XB_EARLY
#define XB_EARLY_INV() asm volatile("buffer_inv sc1" ::: "memory")
#define XB_LATE_ACQ()  asm volatile("" ::: "memory")
#else
#define XB_EARLY_INV() do { } while (0)
#define XB_LATE_ACQ()  __builtin_amdgcn_fence(__ATOMIC_ACQUIRE, "agent")
#endif

__device__ __forceinline__ unsigned xb_ld(unsigned* p)              { return __hip_atomic_load(p, __ATOMIC_RELAXED, __HIP_MEMORY_SCOPE_AGENT); }
__device__ __forceinline__ unsigned xb_add(unsigned* p, unsigned v) { return __hip_atomic_fetch_add(p, v, __ATOMIC_RELAXED, __HIP_MEMORY_SCOPE_AGENT); }
__device__ __forceinline__ unsigned xb_xcc_id() { return (unsigned)__builtin_amdgcn_s_getreg((3 << 11) | 20) & 0xFu; }
#define XB_SPIN(cond, bar) do { unsigned _sp = 0; while (cond) { __builtin_amdgcn_s_sleep(1); \
    if ((++_sp & 255u) == 0u) { if (xb_ld(&(bar)[XB_TMO])) break; if (_sp > XB_SPIN_CAP) { atomicAdd(&(bar)[XB_TMO], 1u); break; } } } } while (0)

struct XcdBarrier {
    unsigned* bar; unsigned x;
    volatile LAS unsigned* st;
};

__device__ __forceinline__ XcdBarrier xcd_barrier_post(unsigned* bar, volatile LAS unsigned* st) {
    XcdBarrier b; b.bar = bar; b.x = xb_xcc_id(); b.st = st;
    if (threadIdx.x == 0) st[3] = xb_add(&bar[XB_XCNT(b.x)], 1u);
    return b;
}
__device__ __forceinline__ void xcd_barrier_complete(unsigned* bar, unsigned x, unsigned& nloc, unsigned& nx, unsigned& xi) {
    const unsigned G = gridDim.x * gridDim.y * gridDim.z;
    unsigned sum, cnt, mine, below, sp = 0u;
    for (;;) {
        sum = 0u; cnt = 0u; mine = 0u; below = 0u;
#pragma unroll
        for (unsigned j = 0; j < 16; ++j) { const unsigned c = xb_ld(&bar[XB_XCNT(j)]); sum += c; cnt += (c > 0u) ? 1u : 0u; mine = (j == x) ? c : mine; below += (j < x && c > 0u) ? 1u : 0u; }
        if (sum == G) break;
        __builtin_amdgcn_s_sleep(1);
        if ((++sp & 255u) == 0u) { if (xb_ld(&bar[XB_TMO])) break; if (sp > XB_SPIN_CAP) { atomicAdd(&bar[XB_TMO], 1u); break; } }
    }
    nloc = mine > 0u ? mine : 1u; nx = cnt > 0u ? cnt : 1u; xi = below;
}

__device__ __forceinline__ void xcd_barrier(const XcdBarrier& b) {
    asm volatile("s_waitcnt vmcnt(0)" ::: "memory");
    __syncthreads();
    if (threadIdx.x == 0) {
        const unsigned bx_ = xb_xcc_id();
        unsigned* bar = b.bar; asm volatile("" : "+s"(bar));
        __builtin_amdgcn_s_waitcnt(0);
        XB_EARLY_INV();
        unsigned nloc = b.st[0], nx = b.st[1];
        if (nloc == 0u) { unsigned xi_; xcd_barrier_complete(bar, bx_, nloc, nx, xi_); b.st[0] = nloc; b.st[1] = nx; b.st[2] = xi_; }
        const unsigned old = xb_add(&bar[XB_XSUB(bx_)], 1u);
        const unsigned gen = old / nloc;
        if (old + 1u == (gen + 1u) * nloc) {
            __builtin_amdgcn_fence(__ATOMIC_RELEASE, "agent");
            asm volatile("s_waitcnt vmcnt(0)" ::: "memory");
            const unsigned og = xb_add(&bar[XB_TOP], 1u);
            const unsigned tg = og / nx;
            if (og + 1u == (tg + 1u) * nx) xb_add(&bar[XB_TOPGEN], 1u);
            else XB_SPIN(xb_ld(&bar[XB_TOPGEN]) == tg, bar);
            XB_LATE_ACQ();
            xb_add(&bar[XB_XGEN(bx_)], 1u);
            asm volatile("s_waitcnt vmcnt(0)" ::: "memory");
        } else {
            XB_SPIN(xb_ld(&bar[XB_XGEN(bx_)]) == gen, bar);
            XB_LATE_ACQ();
            asm volatile("s_waitcnt vmcnt(0)" ::: "memory");
        }
    }
    __syncthreads();
}

__device__ __forceinline__ void xcd_barrier_local(const XcdBarrier& b) {
#if XB_LOCAL_FLAGS
    asm volatile("s_waitcnt vmcnt(0)" ::: "memory");
    __syncthreads();
    if (threadIdx.x < 64) {
        const unsigned bx_ = xb_xcc_id();
        unsigned* bar = b.bar; asm volatile("" : "+s"(bar));
        const unsigned nloc = b.st[0], rank = b.st[3], gen = b.st[4] + 1u;
        unsigned* fl = bar + XB_LSUB(bx_);
        const unsigned ln = threadIdx.x;
        if (ln == 0) { XB_EARLY_INV(); b.st[4] = gen; unsigned* mine = fl + rank; asm volatile("global_store_dword %0, %1, off" :: "v"(mine), "v"(gen) : "memory"); }
        unsigned sp = 0;
        for (;;) {
            const unsigned v = (ln < nloc) ? xb_ld(&fl[ln]) : gen;
            if (__all((int)(v - gen) >= 0)) break;
            __builtin_amdgcn_s_sleep(1);
            if ((++sp & 255u) == 0u) { if (xb_ld(&bar[XB_TMO])) break; if (sp > XB_SPIN_CAP) { if (ln == 0) atomicAdd(&bar[XB_TMO], 1u); break; } }
        }
        XB_LATE_ACQ();
        asm volatile("s_waitcnt vmcnt(0)" ::: "memory");
    }
    __syncthreads();
#else
    asm volatile("s_waitcnt vmcnt(0)" ::: "memory");
    __syncthreads();
    if (threadIdx.x == 0) {
        const unsigned bx_ = xb_xcc_id();
        unsigned* bar = b.bar; asm volatile("" : "+s"(bar));
        const unsigned nloc = b.st[0];
        XB_EARLY_INV();
        const unsigned old = xb_add(&bar[XB_LSUB(bx_)], 1u);
        const unsigned gen = old / nloc;
        if (old + 1u == (gen + 1u) * nloc) xb_add(&bar[XB_LGEN(bx_)], 1u);
        else XB_SPIN(xb_ld(&bar[XB_LGEN(bx_)]) == gen, bar);
        XB_LATE_ACQ();
        asm volatile("s_waitcnt vmcnt(0)" ::: "memory");
    }
    __syncthreads();
#endif
}

__device__ __forceinline__ void p0_transpose_item(const float* W, const float* gain, int K, int N, bf16* WT, int drow0, bool sp, int k0, int n0, LAS unsigned* scr, int lane) {
    const int kp = lane >> 4, n4 = lane & 15;
    f32x4 w[8][2];
    const float* src = W + (size_t)(k0 + 2 * kp) * N + n0 + 4 * n4;
#pragma unroll
    for (int i = 0; i < 8; ++i) { w[i][0] = __builtin_nontemporal_load((const f32x4*)(src + (size_t)(8 * i) * N)); w[i][1] = __builtin_nontemporal_load((const f32x4*)(src + (size_t)(8 * i + 1) * N)); }
    if (gain) {
#pragma unroll
        for (int i = 0; i < 8; ++i) { const float g0 = gain[k0 + 8 * i + 2 * kp], g1 = gain[k0 + 8 * i + 2 * kp + 1]; w[i][0] = w[i][0] * g0; w[i][1] = w[i][1] * g1; }
    }
#pragma unroll
    for (int i = 0; i < 8; ++i)
#pragma unroll
        for (int e = 0; e < 4; ++e) scr[(4 * n4 + e) * 33 + 4 * i + kp] = pk2(w[i][0][e], w[i][1][e]);
    LDS_WAIT(); asm volatile("" ::: "memory");
    const int c = lane & 7;
#pragma unroll
    for (int jn = 0; jn < 8; ++jn) { const int n = (lane >> 3) + 8 * jn; const LAS unsigned* s = scr + n * 33 + 4 * c;
        v4u o; o.x = s[0]; o.y = s[1]; o.z = s[2]; o.w = s[3];
        const int dr = sp ? ((n >> 4) * 32 + ((n & 15) >> 2) * 8 + (n & 3)) : n;
        pg8::store16(WT + (size_t)(drow0 + dr) * K + k0 + 8 * c, o); }
    LDS_WAIT(); asm volatile("" ::: "memory");
}
struct Ptrs {
    const float *x, *norm_mix_g, *norm_ffn_g, *final_g, *a_w_in, *a_v_gain, *a_w_s, *a_b_s, *a_w_out, *b_w_qkv, *b_rel_bias, *b_w_out, *ffn_w_gate, *ffn_w_up, *ffn_w_down;
    float* out; bf16* wt; bf16* xb; bf16* act; float* xss; float* vss;
};
__device__ __forceinline__ void p0_prologue(const Ptrs& P, LAS unsigned char* lds, int vcu, int G, int wave, int lane) {
    LAS unsigned* scr = (LAS unsigned*)(lds + RING_OFF + wave * 16384);
    const int gw = vcu * NWAVES + wave, NGW = G * NWAVES;
    constexpr int I_IN = 16 * 64, I_AOUT = 32 * 16, I_QKV = 16 * 48, I_BOUT = 16 * 16, I_GU = 16 * 44, I_DN = 44 * 16;
    constexpr int NITEMS = 2 * I_IN + 2 * I_AOUT + 2 * I_QKV + 2 * I_BOUT + 8 * I_GU + 4 * I_DN;
    for (int it = gw; it < NITEMS; it += NGW) {
        int r = it; const float* W; const float* gain = nullptr; bf16* dst; int K, N, mode = 0;
        if (r < 2 * I_IN) { const int j = r / I_IN; r -= j * I_IN; W = P.a_w_in + (size_t)j * D * GH2; gain = P.norm_mix_g + (2 * j) * D; K = D; N = GH2; dst = P.wt + WO_IN + (size_t)j * D * GH2; }
        else if ((r -= 2 * I_IN) < 2 * I_AOUT) { const int j = r / I_AOUT; r -= j * I_AOUT; W = P.a_w_out + (size_t)j * GH * D; K = GH; N = D; dst = P.wt + WO_AOUT + (size_t)j * GH * D; }
        else if ((r -= 2 * I_AOUT) < 2 * I_QKV) { const int j = r / I_QKV; r -= j * I_QKV; W = P.b_w_qkv + (size_t)j * D * 3 * D; gain = P.norm_mix_g + (2 * j + 1) * D; K = D; N = 3 * D; dst = P.wt + WO_QKV + (size_t)j * D * 3 * D; }
        else if ((r -= 2 * I_QKV) < 2 * I_BOUT) { const int j = r / I_BOUT; r -= j * I_BOUT; W = P.b_w_out + (size_t)j * D * D; K = D; N = D; dst = P.wt + WO_BOUT + (size_t)j * D * D; }
        else if ((r -= 2 * I_BOUT) < 4 * I_GU) { const int i = r / I_GU; r -= i * I_GU; W = P.ffn_w_gate + (size_t)i * D * FF; gain = P.norm_ffn_g + i * D; K = D; N = FF; dst = P.wt + WO_GU + (size_t)i * D * FF2; mode = 1; }
        else if ((r -= 4 * I_GU) < 4 * I_GU) { const int i = r / I_GU; r -= i * I_GU; W = P.ffn_w_up + (size_t)i * D * FF; gain = P.norm_ffn_g + i * D; K = D; N = FF; dst = P.wt + WO_GU + (size_t)i * D * FF2; mode = 2; }
        else { r -= 4 * I_GU; const int i = r / I_DN; r -= i * I_DN; W = P.ffn_w_down + (size_t)i * FF * D; K = FF; N = D; dst = P.wt + WO_DN + (size_t)i * FF * D; }
        const int nblk = N / 64, kb = r / nblk, nb = r % nblk, k0 = 64 * kb, n0 = 64 * nb;
        const bool sp = (mode != 0) && (n0 >= FF_NFULL * 128);
        const int drow0 = (mode == 0) ? n0 : sp ? (FF_NFULL * 256 + ((n0 - FF_NFULL * 128) >> 6) * 128 + (mode == 2 ? 4 : 0)) : ((n0 >> 7) * 256 + (n0 & 127) + (mode == 2 ? 128 : 0));
        p0_transpose_item(W, gain, K, N, dst, drow0, sp, k0, n0, scr, lane);
    }
    for (int m = gw; m < M; m += 2 * NGW) {
        const int m2 = (m + NGW < M) ? m + NGW : m;
        const GAS f32x4* xr = (const GAS f32x4*)(P.x + (size_t)m * D) + 2 * lane; const GAS f32x4* xr2 = (const GAS f32x4*)(P.x + (size_t)m2 * D) + 2 * lane; f32x4 v[4], v2[4]; float s = 0.f, s2 = 0.f;
#pragma unroll
        for (int j = 0; j < 2; ++j) { v[2 * j] = __builtin_nontemporal_load(xr + 128 * j); v[2 * j + 1] = __builtin_nontemporal_load(xr + 128 * j + 1); v2[2 * j] = __builtin_nontemporal_load(xr2 + 128 * j); v2[2 * j + 1] = __builtin_nontemporal_load(xr2 + 128 * j + 1); }
#pragma unroll
        for (int j = 0; j < 4; ++j) { s += (v[j].x * v[j].x + v[j].y * v[j].y) + (v[j].z * v[j].z + v[j].w * v[j].w); s2 += (v2[j].x * v2[j].x + v2[j].y * v2[j].y) + (v2[j].z * v2[j].z + v2[j].w * v2[j].w); }
        s = wave_sum(s); s2 = wave_sum(s2);
        bf16* o8 = P.xb + (size_t)m * D + 8 * lane; bf16* o82 = P.xb + (size_t)m2 * D + 8 * lane;
#pragma unroll
        for (int j = 0; j < 2; ++j) {
            v4u w; w.x = pk2(v[2 * j].x, v[2 * j].y); w.y = pk2(v[2 * j].z, v[2 * j].w); w.z = pk2(v[2 * j + 1].x, v[2 * j + 1].y); w.w = pk2(v[2 * j + 1].z, v[2 * j + 1].w); pg8::store16(o8 + 512 * j, w);
            v4u w2; w2.x = pk2(v2[2 * j].x, v2[2 * j].y); w2.y = pk2(v2[2 * j].z, v2[2 * j].w); w2.z = pk2(v2[2 * j + 1].x, v2[2 * j + 1].y); w2.w = pk2(v2[2 * j + 1].z, v2[2 * j + 1].w); pg8::store16(o82 + 512 * j, w2); }
        if (lane < pg8::NSLOT_X) { P.xss[(size_t)m * pg8::NSLOT_X + lane] = (lane == 0) ? s : 0.f; P.xss[(size_t)m2 * pg8::NSLOT_X + lane] = (lane == 0) ? s2 : 0.f; }
    }
}

constexpr int SP_A_PITCH = 272, SP_V_PITCH = 528;
constexpr int SP_A_OFF = 0, SP_V_OFF = 36864, SP_R_OFF = 106496;
typedef short v4i16_t __attribute__((ext_vector_type(4)));
__device__ __forceinline__ s16x4 tr_read(const LAS unsigned char* p) { return __builtin_bit_cast(s16x4, __builtin_amdgcn_ds_read_tr16_b64_v4i16((LAS v4i16_t*)p)); }
template <bool DRY> __device__ __forceinline__ void spatial_phase(const Ptrs& P, int j, LAS unsigned char* lds, int vcu, int G, int wave, const pg8::Sch sc) {
    int tid = threadIdx.x; asm volatile("" : "+v"(tid)); const int lane = tid & 63;
    bf16* uv = P.act;
    LAS unsigned char* Aimg = lds + SP_A_OFF; LAS unsigned char* Vimg = lds + SP_V_OFF; LAS float* rsL = (LAS float*)(lds + SP_R_OFF);
    const int fr = lane & 15, fq = lane >> 4;
    const int NU = sc.lm ? 128 : (M / SGU_P) * SGU_G, ufirst = sc.lm ? sc.rank : vcu, ustride = sc.lm ? sc.nloc : G, ubase = sc.lm ? 128 * sc.gi : 0;
    f32x4 sv[2]; v4u vt[8]; f32x4 wq[8]; v4u uq[8]; float bq[8]; f32x4 gq0, gq1;
#define SP_LOAD_V(U) do { const int g_ = (U) & 7, row0_ = ((U) >> 3) * SGU_P; \
        { const f32x4* p_ = (const f32x4*)(P.vss + (size_t)(row0_ + (tid >> 2)) * pg8::NSLOT_V) + (tid & 3) * 2; sv[0] = p_[0]; sv[1] = p_[1]; } \
        _Pragma("unroll") for (int i = 0; i < 8; ++i) { const int pc = tid + 512 * i, q = pc >> 5, ch = pc & 31; vt[i] = __builtin_nontemporal_load((const v4u*)(uv + (size_t)(row0_ + q) * AP + GH + g_ * SGU_C + ch * 8)); } } while (0)
#define SP_LOAD_W(U) do { const int g_ = (U) & 7; \
        { const float* ws_ = P.a_w_s + ((size_t)j * SGU_G + g_) * SGU_P * SGU_P; \
          _Pragma("unroll") for (int i = 0; i < 4; ++i) { const int e = tid + 512 * i, p = e >> 4, q0 = (e & 15) * 8; wq[2 * i] = *(const f32x4*)(ws_ + p * SGU_P + q0); wq[2 * i + 1] = *(const f32x4*)(ws_ + p * SGU_P + q0 + 4); } } } while (0)
#define SP_LOAD_A(U) do { SP_LOAD_V(U); SP_LOAD_W(U); } while (0)
#define SP_LOAD_B(U) do { const int g_ = (U) & 7, row0_ = ((U) >> 3) * SGU_P; \
        { const int cc_ = g_ * SGU_C + 32 * wave + 8 * fq; gq0 = *(const f32x4*)(P.a_v_gain + (size_t)j * GH + cc_); gq1 = *(const f32x4*)(P.a_v_gain + (size_t)j * GH + cc_ + 4); \
          _Pragma("unroll") for (int pt = 0; pt < 8; ++pt) { const int p = 16 * pt + fr; uq[pt] = __builtin_nontemporal_load((const v4u*)(uv + (size_t)(row0_ + p) * AP + cc_)); bq[pt] = P.a_b_s[((size_t)j * SGU_G + g_) * SGU_P + p]; } } } while (0)
    int uk = ufirst;
    if (uk < NU) { SP_LOAD_A(uk + ubase); SP_LOAD_B(uk + ubase); }
    for (; uk < NU; uk += ustride) {
        const int unit = uk + ubase, nb = unit >> 3, g = unit & 7, row0 = nb * SGU_P;
        { float s = ((sv[0][0] + sv[0][1]) + (sv[0][2] + sv[0][3])) + ((sv[1][0] + sv[1][1]) + (sv[1][2] + sv[1][3])); s += __shfl_xor(s, 1); s += __shfl_xor(s, 2);
            if ((tid & 3) == 0) rsL[tid >> 2] = __builtin_amdgcn_rsqf(s * (1.0f / GH) + EPS); }
#pragma unroll
        for (int i = 0; i < 8; ++i) { const int pc = tid + 512 * i, q = pc >> 5, ch = pc & 31; *(LAS v4u*)(Vimg + q * SP_V_PITCH + ch * 16) = vt[i]; }
        __syncthreads();
        if (uk + ustride < NU) SP_LOAD_V(unit + ustride);
#pragma unroll
        for (int i = 0; i < 4; ++i) { const int e = tid + 512 * i, p = e >> 4, q0 = (e & 15) * 8;
            const f32x4 w0 = wq[2 * i], w1 = wq[2 * i + 1];
            const f32x4 r0 = *(const LAS f32x4*)(rsL + q0), r1 = *(const LAS f32x4*)(rsL + q0 + 4);
            v4u o; o.x = pk2(w0[0] * r0[0], w0[1] * r0[1]); o.y = pk2(w0[2] * r0[2], w0[3] * r0[3]); o.z = pk2(w1[0] * r1[0], w1[1] * r1[1]); o.w = pk2(w1[2] * r1[2], w1[3] * r1[3]);
            *(LAS v4u*)(Aimg + p * SP_A_PITCH + q0 * 2) = o; }
        __syncthreads();
        if (uk + ustride < NU) SP_LOAD_W(unit + ustride);
        const f32x4 gn0 = gq0, gn1 = gq1;
        bf16x8 vf[2][4];
        { const LAS unsigned char* vb = Vimg + (8 * fq + ((lane & 15) >> 2)) * SP_V_PITCH + (32 * wave + 8 * (lane & 3)) * 2;
#pragma unroll
            for (int ks = 0; ks < 4; ++ks)
#pragma unroll
                for (int n = 0; n < 2; ++n) { const s16x4 lo = tr_read(vb + ks * 32 * SP_V_PITCH + n * 8), hi = tr_read(vb + ks * 32 * SP_V_PITCH + 4 * SP_V_PITCH + n * 8);
                    vf[n][ks] = (bf16x8){lo[0], lo[1], lo[2], lo[3], hi[0], hi[1], hi[2], hi[3]}; } }
        const int cc = g * SGU_C + 32 * wave + 8 * fq;
#pragma unroll
        for (int ph4 = 0; ph4 < 2; ++ph4) {
            f32x4 sa0[4], sa1[4];
#pragma unroll
            for (int q4 = 0; q4 < 4; ++q4) { const int pt = 4 * ph4 + q4;
                f32x4 a0 = {0.f, 0.f, 0.f, 0.f}, a1 = {0.f, 0.f, 0.f, 0.f};
                const LAS unsigned char* ab = Aimg + (16 * pt + fr) * SP_A_PITCH + (8 * fq) * 2;
#pragma unroll
                for (int ks = 0; ks < 4; ++ks) if (ks < (pt < 4 ? 2 : 4)) { const bf16x8 af = *(const LAS bf16x8*)(ab + ks * 64);
                    a0 = __builtin_amdgcn_mfma_f32_16x16x32_bf16(vf[0][ks], af, a0, 0, 0, 0); a1 = __builtin_amdgcn_mfma_f32_16x16x32_bf16(vf[1][ks], af, a1, 0, 0, 0); }
                sa0[q4] = a0; sa1[q4] = a1; }
#pragma unroll
            for (int q4 = 0; q4 < 4; ++q4) { const int pt = 4 * ph4 + q4; const f32x4 a0 = sa0[q4], a1 = sa1[q4];
                const int p = 16 * pt + fr; bf16* up = uv + (size_t)(row0 + p) * AP + cc;
                const float b = bq[pt]; const v4u u8 = uq[pt];
                v4u o;
                o.x = pk2(bf_lo(u8.x) * (gn0[0] * a0[0] + b), bf_hi(u8.x) * (gn0[1] * a0[1] + b)); o.y = pk2(bf_lo(u8.y) * (gn0[2] * a0[2] + b), bf_hi(u8.y) * (gn0[3] * a0[3] + b));
                o.z = pk2(bf_lo(u8.z) * (gn1[0] * a1[0] + b), bf_hi(u8.z) * (gn1[1] * a1[1] + b)); o.w = pk2(bf_lo(u8.w) * (gn1[2] * a1[2] + b), bf_hi(u8.w) * (gn1[3] * a1[3] + b));
                if (DRY) *(v4u*)((bf16*)P.out + (size_t)(row0 + p) * D + (g & 3) * SGU_C + 32 * wave + 8 * fq) = o; else pg8::store16(up, o);
            }
        }
        asm volatile("" ::: "memory");
        if (uk + ustride < NU) SP_LOAD_B(unit + ustride);
        __syncthreads();
    }
#undef SP_LOAD_A
#undef SP_LOAD_B
#undef SP_LOAD_V
#undef SP_LOAD_W
}

constexpr int AT_NSL = 8, AT_K = 0, AT_V = AT_NSL * 8192, AT_BT = RSTAB_OFF + 1024, AT_WS = AT_BT + 1024, AT_OST = AT_K;
static_assert(AT_WS + 2048 <= LDS_BYTES && 2 * AT_NSL * 8192 <= RING_BYTES, "attention LDS map");
constexpr int AT_OSTP = 147456;
static_assert(AT_OSTP + 8 * 2048 <= LDS_BYTES, "attention O stages");
constexpr float ATT_THR = 8.0f;
__device__ __forceinline__ int crow(int r, int hi) { return (r & 3) + 8 * (r >> 2) + 4 * hi; }
#define MX3(a, b, c) __builtin_fmaxf(__builtin_fmaxf((a), (b)), (c))
__device__ __forceinline__ void glds16(const void* gsrc, unsigned lds_dst) { unsigned keep;
    asm volatile("s_mov_b32 %0, m0\n\ts_mov_b32 m0, %2\n\ts_nop 0\n\tglobal_load_lds_dwordx4 %1, off\n\ts_mov_b32 m0, %0" : "=&s"(keep) : "v"(gsrc), "s"(lds_dst) : "memory"); }
template <int DRY> __device__ __forceinline__ void attn_phase(const Ptrs& P, int j, LAS unsigned char* lds, int vcu, int G, int wave, const pg8::Sch sc) {
    int tid = threadIdx.x; asm volatile("" : "+v"(tid)); const int lane = tid & 63;
    bf16* Q = P.act; const bf16* Kt = P.act + D; const bf16* Vt = P.act + 2 * D;
    const int r32 = lane & 31, hi = lane >> 5, ci = wave >> 1, qh = wave & 1;
    LAS float* bt = (LAS float*)(lds + AT_BT); LAS float* wsf = (LAS float*)(lds + AT_WS) + wave * 64;
    const unsigned lds0 = (unsigned)(size_t)lds;
    const bool shr = sc.lm && sc.nloc == 32;
    const int NUA = shr ? 4 : sc.lm ? 128 : BATCH * NH * (SEQ / 256), afirst = shr ? 0 : sc.lm ? sc.rank : vcu, astride = shr ? 1 : sc.lm ? sc.nloc : G;
#define ATT_DEC(UK, B_, H_, CQ_) do { if (shr) { const int p_ = 8 * sc.gi + 4 * (sc.rank >> 4) + (UK); H_ = sc.rank & 15; B_ = p_ >> 5; CQ_ = p_ & 31; } else if (sc.lm) { const int p_ = 8 * sc.gi + ((UK) & 7); H_ = (UK) >> 3; B_ = p_ >> 5; CQ_ = p_ & 31; } else { const int bh_ = (UK) >> 5; CQ_ = (UK) & 31; B_ = bh_ >> 4; H_ = bh_ & 15; } } while (0)
#define ATT_SLOT(t, pr) ((((t) + 4 * (pr)) & 7) * 8192)
    int par = 0;
    bf16x8 qnx[4] = {}; float rbx0 = 0.f, rbx1 = 0.f;
    for (int uk = afirst; uk < NUA; uk += astride, par ^= 1) {
        int b, h, cq; ATT_DEC(uk, b, h, cq);
        const size_t rowbase = (size_t)b * SEQ;
        const size_t qrow = rowbase + (size_t)(4 * cq + ci) * CHUNK + 32 * qh;
        const int s_lo = (4 * cq >= 8) ? 0 : 8 - 4 * cq;
        const long trow0 = (long)rowbase + (long)(4 * cq - 8) * CHUNK;
        const bf16* ksrc = Kt + (trow0 + 8 * wave + (lane >> 3)) * AP + h * HD + ((lane & 7) ^ ((4 * (wave & 1) + (lane >> 4)) & 7)) * 8;
        const bf16* vsrc = Vt + (trow0 + 16 * (wave & 3) + (lane >> 2)) * AP + h * HD + (wave >> 2) * 32 + (lane & 3) * 8;
        const bool has_n = uk + astride < NUA; int bn = 0, hn = 0, cqn = 0; if (has_n) ATT_DEC(uk + astride, bn, hn, cqn);
        const int s_lo_n = has_n ? ((4 * cqn >= 8) ? 0 : 8 - 4 * cqn) : 99;
        const bool res = shr && uk != afirst;
        const long trow0n = (long)bn * SEQ + (long)(4 * cqn - 8) * CHUNK;
        const bf16* ksrcn = Kt + (trow0n + 8 * wave + (lane >> 3)) * AP + hn * HD + ((lane & 7) ^ ((4 * (wave & 1) + (lane >> 4)) & 7)) * 8;
        const bf16* vsrcn = Vt + (trow0n + 16 * (wave & 3) + (lane >> 2)) * AP + hn * HD + (wave >> 2) * 32 + (lane & 3) * 8;
#define ATT_DMA_X(KS, VS, t, pr) do { const int sl_ = ATT_SLOT(t, pr); \
            glds16((KS) + (long)(t) * CHUNK * AP, (unsigned)__builtin_amdgcn_readfirstlane((int)(lds0 + AT_K + sl_ + wave * 1024))); \
            glds16((VS) + (long)(t) * CHUNK * AP, (unsigned)__builtin_amdgcn_readfirstlane((int)(lds0 + AT_V + sl_ + wave * 1024))); } while (0)
#define ATT_DMA(t) ATT_DMA_X(ksrc, vsrc, t, par)
#define ATT_DMA_ANY(T) do { if ((T) < 12) { if ((T) >= s_lo && !(res && (T) < 8)) ATT_DMA(T); } else { if (!shr && (T) - 12 >= s_lo_n) ATT_DMA_X(ksrcn, vsrcn, (T) - 12, par ^ 1); } } while (0)
#pragma unroll
        for (int t = 0; t < 5; ++t) if (uk == afirst && t >= s_lo) ATT_DMA(t);
        bf16x8 qr[4]; float rbv = rbx0, rbf = rbx1;
        if (uk == afirst) {
#pragma unroll
            for (int d0 = 0; d0 < 4; ++d0) qr[d0] = __builtin_nontemporal_load((const bf16x8*)(Q + (qrow + r32) * AP + h * HD + d0 * 16 + hi * 8));
            if (tid < NREL) { const float* rb = P.b_rel_bias + ((size_t)j * NH + h) * NREL; rbv = rb[tid]; rbf = rb[NREL - 1]; }
        } else {
#pragma unroll
            for (int d0 = 0; d0 < 4; ++d0) qr[d0] = qnx[d0];
        }
        if (tid < 256 && !res) bt[tid] = tid < NREL ? (rbv - rbf) * LOG2E : 0.f;
        asm volatile("" :: "v"(qr[0]), "v"(qr[1]), "v"(qr[2]), "v"(qr[3]));
        float mhat = 0.f, lrun = 0.f; f32x16 o0 = {}, o1 = {};
        const int j_first = (s_lo > ci) ? s_lo - ci : 0;
#pragma unroll 1
        for (int jj = 0; jj < 9; ++jj) {
            const int s = ci + jj;
            if ((jj & 1) == 0) {
                asm volatile("s_waitcnt vmcnt(0)" ::: "memory");
                __syncthreads();
                ATT_DMA_ANY(jj + 5);
                ATT_DMA_ANY(jj + 6);
            }
            const int delta = 8 - jj;
            if (jj >= j_first && DRY != 2) {
                const LAS unsigned char* Ks = lds + AT_K + ATT_SLOT(s, par); const LAS unsigned char* Vs = lds + AT_V + ATT_SLOT(s, par);
                f32x16 p0 = {}, p1 = {};
                { const LAS unsigned char* kb = Ks + r32 * 128; const int kx = (r32 >> 1) & 7; bf16x8 kf[8];
#pragma unroll
                    for (int d0 = 0; d0 < 4; ++d0) { const int kp = ((2 * d0 + hi) ^ kx) * 16; kf[2 * d0] = *(const LAS bf16x8*)(kb + kp); kf[2 * d0 + 1] = *(const LAS bf16x8*)(kb + 4096 + kp); }
                    __builtin_amdgcn_sched_barrier(0);
#pragma unroll
                    for (int d0 = 0; d0 < 4; ++d0) { p0 = __builtin_amdgcn_mfma_f32_32x32x16_bf16(kf[2 * d0], qr[d0], p0, 0, 0, 0); p1 = __builtin_amdgcn_mfma_f32_32x32x16_bf16(kf[2 * d0 + 1], qr[d0], p1, 0, 0, 0); } }
                if (delta < 3) {
                    const LAS float* bp = bt + (64 * delta + 32 * qh + r32 - 4 * hi);
                    asm volatile("" : "+v"(bp));
                    typedef pg8::f32x2 f32x2; typedef f32x2 __attribute__((aligned(4))) f32x2u;
                    f32x2 b0[8], b1[8];
#pragma unroll
                    for (int r = 0; r < 16; r += 2) { const int kc = (r & 3) + 8 * (r >> 2);
                        b0[r >> 1] = *(const LAS f32x2u*)(bp + 62 - kc); b1[r >> 1] = *(const LAS f32x2u*)(bp + 30 - kc); }
#pragma unroll
                    for (int r = 0; r < 8; ++r) { asm volatile("" : "+v"(b0[r])); asm volatile("" : "+v"(b1[r])); }
#pragma unroll
                    for (int r = 0; r < 16; r += 2) { p0[r] += b0[r >> 1][1]; p0[r + 1] += b0[r >> 1][0]; p1[r] += b1[r >> 1][1]; p1[r + 1] += b1[r >> 1][0]; }
                }
                float rm;
                { float a = MX3(p0[0], p0[1], p1[0]), c = MX3(p0[2], p0[3], p1[1]); a = MX3(a, p1[2], p1[3]);
#pragma unroll
                    for (int r = 4; r < 16; r += 4) { a = MX3(a, p0[r], p0[r + 1]); c = MX3(c, p0[r + 2], p0[r + 3]); a = MX3(a, p1[r], p1[r + 1]); c = MX3(c, p1[r + 2], p1[r + 3]); }
                    rm = __builtin_fmaxf(a, c);
                    auto rr = __builtin_amdgcn_permlane32_swap(__float_as_uint(rm), __float_as_uint(rm), false, false); rm = __builtin_fmaxf(__uint_as_float(rr[0]), __uint_as_float(rr[1])); }
                rm -= mhat;
                float dl = 0.f; bool resc = false;
                if (jj == j_first) { dl = rm; mhat = rm; }
                else if (__any(rm > ATT_THR)) {
                    dl = __builtin_fmaxf(rm, 0.f); mhat += dl;
                    const float f = __builtin_amdgcn_exp2f(-dl); lrun *= f;
                    if (hi == 0) wsf[r32] = f;
                    resc = true;
                }
                if (resc) {
#pragma unroll
                    for (int r = 0; r < 16; ++r) { const float fr_ = wsf[crow(r, hi)]; o0[r] *= fr_; o1[r] *= fr_; }
                }
                { typedef pg8::f32x2 f32x2; const f32x2 ndl = (f32x2){-mhat, -mhat}; f32x2 ps2 = (f32x2){0.f, 0.f};
#pragma unroll
                    for (int r = 0; r < 16; r += 2) { f32x2 a = (f32x2){p0[r], p0[r + 1]} + ndl, b = (f32x2){p1[r], p1[r + 1]} + ndl;
                        a[0] = __builtin_amdgcn_exp2f(a[0]); a[1] = __builtin_amdgcn_exp2f(a[1]); b[0] = __builtin_amdgcn_exp2f(b[0]); b[1] = __builtin_amdgcn_exp2f(b[1]);
                        ps2 = ps2 + a; ps2 = ps2 + b; p0[r] = a[0]; p0[r + 1] = a[1]; p1[r] = b[0]; p1[r + 1] = b[1]; }
                    lrun += ps2[0] + ps2[1]; }
                v4u pw[4];
                pw[0] = (v4u){pk2(p0[0], p0[1]), pk2(p0[2], p0[3]), pk2(p0[4], p0[5]), pk2(p0[6], p0[7])};
                pw[1] = (v4u){pk2(p0[8], p0[9]), pk2(p0[10], p0[11]), pk2(p0[12], p0[13]), pk2(p0[14], p0[15])};
                pw[2] = (v4u){pk2(p1[0], p1[1]), pk2(p1[2], p1[3]), pk2(p1[4], p1[5]), pk2(p1[6], p1[7])};
                pw[3] = (v4u){pk2(p1[8], p1[9]), pk2(p1[10], p1[11]), pk2(p1[12], p1[13]), pk2(p1[14], p1[15])};
                const LAS unsigned char* vb = Vs + ((lane >> 4) & 1) * 32 + (lane & 3) * 8 + (4 * hi + ((lane & 15) >> 2)) * 64;
#pragma unroll
                for (int kh = 0; kh < 2; ++kh) {
                    s16x4 vl[4], vh[4];
#pragma unroll
                    for (int i = 0; i < 4; ++i) { const int ks = 2 * kh + (i >> 1), dh = i & 1; vl[i] = tr_read(vb + dh * 4096 + ks * 1024); vh[i] = tr_read(vb + dh * 4096 + ks * 1024 + 512); }
                    __builtin_amdgcn_sched_barrier(0);
#pragma unroll
                    for (int i = 0; i < 4; ++i) { const int ks = 2 * kh + (i >> 1); const bf16x8 pa = __builtin_bit_cast(bf16x8, pw[ks]); const bf16x8 vfr = (bf16x8){vl[i][0], vl[i][1], vl[i][2], vl[i][3], vh[i][0], vh[i][1], vh[i][2], vh[i][3]};
                        if (i & 1) o1 = __builtin_amdgcn_mfma_f32_32x32x16_bf16(pa, vfr, o1, 0, 0, 0); else o0 = __builtin_amdgcn_mfma_f32_32x32x16_bf16(pa, vfr, o0, 0, 0, 0); } }
            }
        }
        if (!shr) { __syncthreads();
            ATT_DMA_ANY(15); ATT_DMA_ANY(16); }
#undef ATT_DMA_ANY
#undef ATT_DMA
#undef ATT_DMA_X
        if (has_n) {
            const size_t qrown = (size_t)bn * SEQ + (size_t)(4 * cqn + ci) * CHUNK + 32 * qh;
#pragma unroll
            for (int d0 = 0; d0 < 4; ++d0) qnx[d0] = __builtin_nontemporal_load((const bf16x8*)(Q + (qrown + r32) * AP + hn * HD + d0 * 16 + hi * 8));
            if (tid < NREL) { const float* rbn = P.b_rel_bias + ((size_t)j * NH + hn) * NREL; rbx0 = rbn[tid]; rbx1 = rbn[NREL - 1]; }
        }
        { auto rr = __builtin_amdgcn_permlane32_swap(__float_as_uint(lrun), __float_as_uint(lrun), false, false); lrun = __uint_as_float(rr[0]) + __uint_as_float(rr[1]); }
        if (hi == 0) wsf[32 + r32] = lrun;
        { LAS bf16* stg = (LAS bf16*)(lds + AT_OSTP + wave * 2048);
            bf16* Ow = (DRY ? (bf16*)P.out + qrow * D : Q + qrow * AP) + h * HD; const int opitch = DRY ? D : AP;
#pragma unroll
            for (int ph = 0; ph < 2; ++ph) {
#pragma unroll
                for (int r = 8 * ph; r < 8 * ph + 8; ++r) { const int orow = crow(r, hi); const float rl = __builtin_amdgcn_rcpf(wsf[32 + orow]); const int lr = orow - 16 * ph;
                    stg[lr * 64 + r32] = (bf16)(pk2(o0[r] * rl, 0.f) & 0xffffu); stg[lr * 64 + 32 + r32] = (bf16)(pk2(o1[r] * rl, 0.f) & 0xffffu); }
#pragma unroll
                for (int i = 0; i < 2; ++i) { const int row = i * 8 + (lane >> 3), ch = lane & 7; const v4u v = *(const LAS v4u*)(stg + row * 64 + ch * 8); *(v4u*)(Ow + (size_t)(16 * ph + row) * opitch + ch * 8) = v; }
            } }
        if (!shr) asm volatile("s_waitcnt lgkmcnt(0)\n\ts_barrier" ::: "memory");
    }
#undef ATT_DEC
#undef ATT_SLOT
}
#undef MX3

__device__ __forceinline__ void final_phase(const Ptrs& P, int vcu, int G, int wave, const pg8::Sch sc) {
    int tid_ = threadIdx.x; asm volatile("" : "+v"(tid_)); const int lane = tid_ & 63;
    const int gw = (sc.lm ? sc.rank : vcu) * NWAVES + wave, NGW = (sc.lm ? sc.nloc : G) * NWAVES, mbase = sc.lm ? 2048 * sc.gi : 0, mcount = sc.lm ? 2048 : M;
    f32x4 gn[4];
#pragma unroll
    for (int j = 0; j < 4; ++j) gn[j] = ((const f32x4*)P.final_g)[lane + 64 * j];
    for (int mk = gw; mk < mcount; mk += 4 * NGW) {
        v2u w[4][4]; f32x4 sv[4]; int mm[4];
#pragma unroll
        for (int q = 0; q < 4; ++q) { const int mq = mk + q * NGW; mm[q] = mbase + (mq < mcount ? mq : mk);
            sv[q] = *(const f32x4*)(P.xss + (size_t)mm[q] * pg8::NSLOT_X + (lane & 3) * 4);
            const GAS v2u* xr = (const GAS v2u*)(P.xb + (size_t)mm[q] * D) + lane;
#pragma unroll
            for (int j = 0; j < 4; ++j) w[q][j] = __builtin_nontemporal_load(xr + 64 * j); }
#pragma unroll
        for (int q = 0; q < 4; ++q) { if (mk + q * NGW >= mcount) break;
            float s = (sv[q][0] + sv[q][1]) + (sv[q][2] + sv[q][3]); s += __shfl_xor(s, 1); s += __shfl_xor(s, 2);
            const float r = __builtin_amdgcn_rsqf(s * (1.0f / D) + EPS);
            GAS f32x4* orow = (GAS f32x4*)(P.out + (size_t)mm[q] * D) + lane;
#pragma unroll
            for (int j = 0; j < 4; ++j) { const f32x4 v = {bf_lo(w[q][j].x), bf_hi(w[q][j].x), bf_lo(w[q][j].y), bf_hi(w[q][j].y)}; orow[64 * j] = v * r * gn[j]; } }
    }
}

#ifndef PANEL_OWNER
#define PANEL_OWNER 1
#endif
__device__ __forceinline__ pg8::Sch get_sch(volatile LAS unsigned* MISC, int G) {
    pg8::Sch s; const int nloc = __builtin_amdgcn_readfirstlane((int)MISC[8]), nx = __builtin_amdgcn_readfirstlane((int)MISC[9]);
    s.gi = __builtin_amdgcn_readfirstlane((int)MISC[10]); s.rank = __builtin_amdgcn_readfirstlane((int)MISC[11]); s.nloc = nloc > 0 ? nloc : 1;
    s.lm = (PANEL_OWNER && !MK_PER_PHASE && nx == 8 && nloc > 0 && nloc <= 64 && M == 16384) ? 1 : 0; return s;
}
__device__ __forceinline__ int launder_s(int x) { asm volatile("" : "+s"(x)); return x; }
struct Args { const float* in[15]; float* out; unsigned char* ws; int ph_lo, ph_hi; };
static_assert(sizeof(Args) == 17 * 8 + 8, "Args has no padding");
__global__ void __launch_bounds__(NWAVES * 64, 2) trunk_fwd(Args args) {
    extern __shared__ __attribute__((aligned(16))) unsigned char lds_raw[];
    LAS unsigned char* lds = (LAS unsigned char*)lds_raw;
    volatile LAS unsigned* MISC = (volatile LAS unsigned*)(lds + MISC_OFF);
    const int tid = threadIdx.x, lane = tid & 63, wave = __builtin_amdgcn_readfirstlane(tid >> 6);
    const int G = gridDim.x; const int bx = blockIdx.x; const int vcu = (G % 8 == 0) ? (bx % 8) * (G / 8) + bx / 8 : bx;
    unsigned char* ws = args.ws;
    gu32* ctl = (gu32*)(ws + WS_CTL);
    Ptrs P;
    P.x = args.in[0]; P.norm_mix_g = args.in[1]; P.norm_ffn_g = args.in[2]; P.final_g = args.in[3]; P.a_w_in = args.in[4]; P.a_v_gain = args.in[5]; P.a_w_s = args.in[6]; P.a_b_s = args.in[7];
    P.a_w_out = args.in[8]; P.b_w_qkv = args.in[9]; P.b_rel_bias = args.in[10]; P.b_w_out = args.in[11]; P.ffn_w_gate = args.in[12]; P.ffn_w_up = args.in[13]; P.ffn_w_down = args.in[14];
    P.out = args.out; P.wt = (bf16*)(ws + WS_W); P.xb = (bf16*)(ws + WS_XB); P.act = (bf16*)(ws + WS_ACT); P.xss = (float*)(ws + WS_XSS); P.vss = (float*)(ws + WS_VSS);
    for (int u = tid; u < (LDS_BYTES - LDSCTL_OFF) / 4; u += NWAVES * 64) ((LAS unsigned*)(lds + LDSCTL_OFF))[u] = 0u;
    __syncthreads();
    XcdBarrier bar; bar.bar = (unsigned*)(ctl + CW_BAR); bar.x = 0; bar.st = nullptr;
    if (!MK_PER_PHASE) bar = xcd_barrier_post((unsigned*)(ctl + CW_BAR), MISC + 8);
    const int lo = args.ph_lo, hi = args.ph_hi;
#define RS_TABLE(S) pg8::RsTab rt{(const LAS float*)(lds + RSTAB_OFF), -1}; { pg8::Unit u0_; if (S.next(0, u0_)) { rt.pm = u0_.pm; pg8::build_rs_table(P.xss, u0_.pm, (LAS float*)(lds + RSTAB_OFF), tid, 1.0f / D, EPS); } }
#ifndef DBG_MASK
#define DBG_MASK 0xff
#endif
#if MK_PER_PHASE
#define IN(k) (lo <= (k) && (k) < hi)
#else
#define IN(k) true
#endif
#define SEAM(k, local_ok) do { if (IN(k) && IN((k) + 1)) { if ((local_ok) && get_sch(MISC, G).lm) xcd_barrier_local(bar); else xcd_barrier(bar); if (PROBE == 1) xcd_barrier(bar); } } while (0)

    if ((DBG_MASK & 1) && IN(0)) { p0_prologue(P, lds, vcu, G, wave, lane); if (PROBE == 2) { __syncthreads(); p0_prologue(P, lds, vcu, G, wave, lane); } }
    SEAM(0, false);
    if (PROBE == 12 && get_sch(MISC, G).lm) { const unsigned long long t0_ = __builtin_amdgcn_s_memrealtime(); while (__builtin_amdgcn_s_memrealtime() - t0_ < 20000ull) __builtin_amdgcn_s_sleep(8); }
#pragma unroll 1
    for (int layer = 0; layer < DEPTH; ++layer) {
        const int j = layer >> 1, ph = 1 + 5 * layer;
        const bf16* wgu = P.wt + WO_GU + (size_t)layer * D * FF2; const bf16* wdn = P.wt + WO_DN + (size_t)layer * FF * D;
        if ((layer & 1) == 0) {
            if ((DBG_MASK & 2) && IN(ph)) { pg8::Gemm g{P.xb, P.wt + WO_IN + (size_t)j * D * GH2, M, GH2, D, D}; const pg8::Sch sch = get_sch(MISC, G); pg8::PanelOrder S; S.init(M, GH2, G, launder_s(bx), sch);
                RS_TABLE(S);
                pg8::EpiGeluStats E{P.act, AP, P.xss, P.vss, GH / 256, EPS, rt};
                pg8::gemm_phase<pg8::EpiGeluStats, pg8::PanelOrder, true, true>(lds + RING_OFF, g, S, E);
                if (PROBE == 5) { __syncthreads(); pg8::gemm_phase<pg8::EpiGeluStats, pg8::PanelOrder, true, true>(lds + RING_OFF, g, S, E); } }
            SEAM(ph, true);
            if ((DBG_MASK & 4) && IN(ph + 1)) { if (PROBE == 4) spatial_phase<true>(P, j, lds, vcu, G, wave, get_sch(MISC, G)); spatial_phase<false>(P, j, lds, vcu, G, wave, get_sch(MISC, G)); }
            SEAM(ph + 1, true);
            if ((DBG_MASK & 8) && IN(ph + 2)) { pg8::Gemm g{P.act, P.wt + WO_AOUT + (size_t)j * GH * D, M, D, GH, AP}; const pg8::Sch sch = get_sch(MISC, G); pg8::PanelOrder S; S.init(M, D, G, launder_s(bx), sch);
                pg8::EpiResid E{P.xb, P.xss, D};
                pg8::gemm_phase<pg8::EpiResid, pg8::PanelOrder, false, true>(lds + RING_OFF, g, S, E); }
            SEAM(ph + 2, true);
        } else {
            if ((DBG_MASK & 16) && IN(ph)) { pg8::Gemm g{P.xb, P.wt + WO_QKV + (size_t)j * D * 3 * D, M, 3 * D, D, D}; const pg8::Sch sch = get_sch(MISC, G); pg8::PanelOrder S; S.init(M, 3 * D, G, launder_s(bx), sch);
                RS_TABLE(S);
                pg8::EpiQkv E{P.act, AP, (size_t)D, P.xss, EPS, QSCALE, rt};
                pg8::gemm_phase<pg8::EpiQkv, pg8::PanelOrder, true, true>(lds + RING_OFF, g, S, E);
                if (PROBE == 7) { __syncthreads(); pg8::gemm_phase<pg8::EpiQkv, pg8::PanelOrder, true, true>(lds + RING_OFF, g, S, E); } }
            SEAM(ph, false);
            if ((DBG_MASK & 32) && IN(ph + 1)) { if (PROBE == 3) attn_phase<1>(P, j, lds, vcu, G, wave, get_sch(MISC, G)); if (PROBE == 10) attn_phase<2>(P, j, lds, vcu, G, wave, get_sch(MISC, G)); attn_phase<0>(P, j, lds, vcu, G, wave, get_sch(MISC, G)); }
            SEAM(ph + 1, true);
            if ((DBG_MASK & 8) && IN(ph + 2)) { pg8::Gemm g{P.act, P.wt + WO_BOUT + (size_t)j * D * D, M, D, D, AP}; const pg8::Sch sch = get_sch(MISC, G); pg8::PanelOrder S; S.init(M, D, G, launder_s(bx), sch);
                pg8::EpiResid E{P.xb, P.xss, D};
                pg8::gemm_phase<pg8::EpiResid, pg8::PanelOrder, false, true>(lds + RING_OFF, g, S, E); }
            SEAM(ph + 2, false);
        }
        if ((DBG_MASK & 64) && IN(ph + 3)) { pg8::Gemm g{P.xb, wgu, M, FF2, D, D}; const pg8::Sch sch = get_sch(MISC, G); pg8::FfnOrder S; S.init(M, FF_NFULL, G, launder_s(bx), sch);
            RS_TABLE(S);
            pg8::EpiSwiglu E{P.act, AP, P.xss, EPS, rt, FF_NFULL * 128};
            pg8::gemm_phase<pg8::EpiSwiglu, pg8::FfnOrder, true, true>(lds + RING_OFF, g, S, E);
            if (PROBE == 6 || PROBE == 11) { __syncthreads(); pg8::gemm_phase<pg8::EpiSwiglu, pg8::FfnOrder, true, true>(lds + RING_OFF, g, S, E); } }
        SEAM(ph + 3, true);
        if ((DBG_MASK & 8) && IN(ph + 4)) { pg8::Gemm g{P.act, wdn, M, D, FF, AP}; const pg8::Sch sch = get_sch(MISC, G); pg8::PanelOrder S; S.init(M, D, G, launder_s(bx), sch);
            pg8::EpiResid E{P.xb, P.xss, D};
            pg8::gemm_phase<pg8::EpiResid, pg8::PanelOrder, false, true>(lds + RING_OFF, g, S, E); }
        SEAM(ph + 4, true);
    }
    if ((DBG_MASK & 128) && IN(N_PHASES - 1)) final_phase(P, vcu, G, wave, get_sch(MISC, G));
#undef IN
#undef SEAM
}

extern "C" void kernel_launch(void* const* d_in, const int* in_sizes, int n_in, void* d_out, int out_size, void* d_ws, size_t ws_size, hipStream_t stream) {
    static int grid = 0;
    if (grid == 0) {
        if (n_in != 15 || in_sizes[0] != M * D || out_size != M * D || ws_size < WS_END) { fprintf(stderr, "kernel_launch: unexpected shapes (n_in %d, in0 %d, out %d, ws %zu < %zu); nothing launched\n", n_in, n_in > 0 ? in_sizes[0] : -1, out_size, ws_size, (size_t)WS_END); grid = -1; return; }
        int dev = 0, cus = 0, per_cu = 0;
        if (hipGetDevice(&dev) != hipSuccess || hipDeviceGetAttribute(&cus, hipDeviceAttributeMultiprocessorCount, dev) != hipSuccess) { grid = -1; return; }
        if (hipFuncSetAttribute((const void*)trunk_fwd, hipFuncAttributeMaxDynamicSharedMemorySize, LDS_BYTES) != hipSuccess) { fprintf(stderr, "kernel_launch: hipFuncSetAttribute failed\n"); grid = -1; return; }
        if (hipOccupancyMaxActiveBlocksPerMultiprocessor(&per_cu, (const void*)trunk_fwd, NWAVES * 64, LDS_BYTES) != hipSuccess || per_cu < 1) { fprintf(stderr, "kernel_launch: occupancy query reports %d workgroups per CU; nothing launched\n", per_cu); (void)hipGetLastError(); grid = -1; return; }
        grid = cus;
    }
    if (grid < 0) return;
    if (hipMemsetAsync((char*)d_ws + WS_CTL, 0, CTL_ZERO_BYTES, stream) != hipSuccess) return;
    Args a{};
    for (int i = 0; i < 15; ++i) a.in[i] = (const float*)d_in[i];
    a.out = (float*)d_out; a.ws = (unsigned char*)d_ws;
#if MK_PER_PHASE
    for (int p = 0; p < N_PHASES; ++p) { a.ph_lo = p; a.ph_hi = p + 1; hipLaunchKernelGGL(trunk_fwd, dim3(grid), dim3(NWAVES * 64), LDS_BYTES, stream, a); }
#else
    a.ph_lo = 0; a.ph_hi = N_PHASES;
    hipLaunchKernelGGL(trunk_fwd, dim3(grid), dim3(NWAVES * 64), LDS_BYTES, stream, a);
#endif
}
```
